# Optimizing an MI355X kernel written in HIP

```python
import math, functools
import jax, jax.numpy as jnp
from jax import lax
import numpy as np

D_MODEL = 1024
BATCH = 32
SEQ = 256
DEPTH = 2
DEC_BATCH = 2
DEC_SEQ = 2048
PAST_LEN = 512

GRID_W = 64
N_MIXERS = 2
N_HEADS = 16
HEAD_DIM = D_MODEL // N_HEADS
N_FOURIER_GROUPS = 4
FOURIER_GROUP = D_MODEL // N_FOURIER_GROUPS
WIN_ROWS_MAX = 8
WIN_COLS = 16
D_FF = -(-8 * D_MODEL // (3 * 256)) * 256
N_FOURIER_LAYERS = (DEPTH + N_MIXERS - 1) // N_MIXERS
N_NA_LAYERS = DEPTH // N_MIXERS
N_NORMS = 4
EPS = 1e-6
Q_BLOCK = 128
NEG_INF = -1e30

kernel_name = "hybrid_fourier_natten_prefix_dit_step"


def _rmsnorm(x, g):
    xf = x.astype(jnp.float32)
    y = xf * lax.rsqrt(jnp.mean(xf * xf, axis=-1, keepdims=True) + EPS)
    return (y * g.astype(jnp.float32)).astype(x.dtype)


def _modulation(cond, w, b):
    m = jax.nn.silu(cond) @ w + b
    return jnp.split(m[:, None, :], 6, axis=-1)


def _fourier_mix(h, w_out):
    b, s, d = h.shape
    hg = h.astype(jnp.float32).reshape(b, s, N_FOURIER_GROUPS, FOURIER_GROUP)
    f = jnp.fft.fft2(hg, axes=(1, 3)).real
    return f.reshape(b, s, d).astype(h.dtype) @ w_out


def _qkv(h, w_qkv):
    b, s, _ = h.shape
    q, k, v = jnp.split(h @ w_qkv, 3, axis=-1)
    sh = (b, s, N_HEADS, HEAD_DIM)
    return q.reshape(sh), k.reshape(sh), v.reshape(sh)


def _dense_attn(q, k, v):
    b, s, h, dh = q.shape
    scale = dh ** -0.5
    qb = q.reshape(b, s // Q_BLOCK, Q_BLOCK, h, dh).transpose(1, 0, 2, 3, 4)

    def one_block(qi):
        sc = jnp.einsum('bqhd,bkhd->bhqk', qi, k).astype(jnp.float32) * scale
        p = jax.nn.softmax(sc, axis=-1)
        return jnp.einsum('bhqk,bkhd->bqhd', p.astype(v.dtype), v)

    out = lax.map(one_block, qb)
    return out.transpose(1, 0, 2, 3, 4).reshape(b, s, h, dh)


def _na_latent(q, k, v, ck, cv, rpb):
    b, s, h, dh = q.shape
    rows = s // GRID_W
    kr = min(WIN_ROWS_MAX, rows)
    scale = dh ** -0.5
    qg = q.reshape(b, rows, GRID_W, h, dh)
    kg = k.reshape(b, rows, GRID_W, h, dh)
    vg = v.reshape(b, rows, GRID_W, h, dh)
    r = jnp.arange(rows)
    rs = jnp.clip(r - kr // 2, 0, rows - kr)
    row_idx = rs[:, None] + jnp.arange(kr)[None, :]
    kb = kg[:, row_idx]
    vb = vg[:, row_idx]
    col = jnp.arange(GRID_W)
    cs = jnp.clip(col - WIN_COLS // 2, 0, GRID_W - WIN_COLS)
    col_mask = (col[None, :] >= cs[:, None]) & (col[None, :] < cs[:, None] + WIN_COLS)
    dr = row_idx - r[:, None]
    dc = jnp.clip(col[None, :] - col[:, None], -(WIN_COLS - 1), WIN_COLS - 1)
    bias = rpb[:, dr[:, None, :, None] + (WIN_ROWS_MAX - 1), dc[None, :, None, :] + (WIN_COLS - 1)]
    bias = jnp.where(col_mask[None, None, :, None, :], bias.astype(jnp.float32), NEG_INF)
    s_loc = jnp.einsum('brqhd,brikhd->bhrqik', qg, kb).astype(jnp.float32) * scale + bias[None]
    s_loc = s_loc.reshape(b, h, rows, GRID_W, kr * GRID_W)
    s_ctx = jnp.einsum('brqhd,bnhd->bhrqn', qg, ck).astype(jnp.float32) * scale
    p = jax.nn.softmax(jnp.concatenate([s_loc, s_ctx], axis=-1), axis=-1)
    p_loc = p[..., :kr * GRID_W].reshape(b, h, rows, GRID_W, kr, GRID_W).astype(v.dtype)
    p_ctx = p[..., kr * GRID_W:].astype(v.dtype)
    out = (jnp.einsum('bhrqik,brikhd->brqhd', p_loc, vb)
           + jnp.einsum('bhrqn,bnhd->brqhd', p_ctx, cv))
    return out.reshape(b, s, h, dh)


def _swiglu(h, w_gate, w_up, w_down):
    return (jax.nn.silu(h @ w_gate) * (h @ w_up)) @ w_down


def setup_inputs(seed: int = 0) -> dict:
    key = jax.random.key(seed)
    ks = jax.random.split(key, 16)
    f32 = jnp.float32
    n = lambda k, shape, s: (jax.random.normal(k, shape, f32) * s)
    return {
        "x_prompt": n(ks[0], (BATCH, SEQ, D_MODEL), 1.0),
        "x_sample": n(ks[1], (DEC_BATCH, DEC_SEQ, D_MODEL), 1.0),
        "c": n(ks[2], (DEC_BATCH, D_MODEL), 1.0),
        "cache_k": n(ks[3], (DEC_BATCH, N_NA_LAYERS, PAST_LEN, N_HEADS, HEAD_DIM), 1.0),
        "cache_v": n(ks[4], (DEC_BATCH, N_NA_LAYERS, PAST_LEN, N_HEADS, HEAD_DIM), 1.0),
        "c_ctx": n(ks[5], (D_MODEL,), 1.0),
        "ada_w": n(ks[6], (DEPTH, D_MODEL, 6 * D_MODEL), 0.5 * D_MODEL ** -0.5),
        "ada_b": n(ks[7], (DEPTH, 6 * D_MODEL), 0.02),
        "norm_g": 1.0 + n(ks[8], (DEPTH, N_NORMS, D_MODEL), 0.01),
        "fourier_w_out": n(ks[9], (N_FOURIER_LAYERS, D_MODEL, D_MODEL), D_MODEL ** -0.5),
        "na_w_qkv": n(ks[10], (N_NA_LAYERS, D_MODEL, 3 * D_MODEL), D_MODEL ** -0.5),
        "na_rpb": n(ks[11], (N_NA_LAYERS, N_HEADS, 2 * WIN_ROWS_MAX - 1, 2 * WIN_COLS - 1), 0.1),
        "na_w_out": n(ks[12], (N_NA_LAYERS, D_MODEL, D_MODEL), D_MODEL ** -0.5),
        "ffn_w_gate": n(ks[13], (DEPTH, D_MODEL, D_FF), D_MODEL ** -0.5),
        "ffn_w_up": n(ks[14], (DEPTH, D_MODEL, D_FF), D_MODEL ** -0.5),
        "ffn_w_down": n(ks[15], (DEPTH, D_FF, D_MODEL), D_FF ** -0.5),
    }


def reference(x_prompt, x_sample, c, cache_k, cache_v, c_ctx, ada_w, ada_b, norm_g,
              fourier_w_out, na_w_qkv, na_rpb, na_w_out, ffn_w_gate, ffn_w_up, ffn_w_down):
    xp, xs = x_prompt, x_sample
    new_k, new_v = [], []
    for i in range(DEPTH):
        g = norm_g[i]
        sh_mp, sc_mp, gt_mp, sh_fp, sc_fp, gt_fp = _modulation(c_ctx[None, :], ada_w[i], ada_b[i])
        sh_ms, sc_ms, gt_ms, sh_fs, sc_fs, gt_fs = _modulation(c, ada_w[i], ada_b[i])
        hp = _rmsnorm(xp, g[0]) * (1.0 + sc_mp) + sh_mp
        hs = _rmsnorm(xs, g[0]) * (1.0 + sc_ms) + sh_ms
        j = i // N_MIXERS
        if i % N_MIXERS == 0:
            mp = _fourier_mix(hp, fourier_w_out[j])
            ms = _fourier_mix(hs, fourier_w_out[j])
        else:
            qp, kp, vp = _qkv(hp, na_w_qkv[j])
            new_k.append(kp)
            new_v.append(vp)
            op = _dense_attn(qp, kp, vp)
            mp = op.reshape(xp.shape) @ na_w_out[j]
            qs, ks_, vs = _qkv(hs, na_w_qkv[j])
            os_ = _na_latent(qs, ks_, vs, cache_k[:, j], cache_v[:, j], na_rpb[j])
            ms = os_.reshape(xs.shape) @ na_w_out[j]
        xp = xp + gt_mp * _rmsnorm(mp, g[1])
        xs = xs + gt_ms * _rmsnorm(ms, g[1])
        fp = _rmsnorm(xp, g[2]) * (1.0 + sc_fp) + sh_fp
        fs = _rmsnorm(xs, g[2]) * (1.0 + sc_fs) + sh_fs
        xp = xp + gt_fp * _rmsnorm(_swiglu(fp, ffn_w_gate[i], ffn_w_up[i], ffn_w_down[i]), g[3])
        xs = xs + gt_fs * _rmsnorm(_swiglu(fs, ffn_w_gate[i], ffn_w_up[i], ffn_w_down[i]), g[3])
    new_cache_k = jnp.stack(new_k, axis=1)
    new_cache_v = jnp.stack(new_v, axis=1)
    return (xp, xs, new_cache_k, new_cache_v)
```

```cpp
#include <hip/hip_runtime.h>
#include <hip/hip_cooperative_groups.h>
#include <cstdio>
#include <cstdint>
namespace cg = cooperative_groups;

#ifndef MK_N_LAUNCHES
#define MK_N_LAUNCHES 1
#endif

#define LAS __attribute__((address_space(3)))
typedef unsigned short bf16_t;
typedef short bf16x8 __attribute__((ext_vector_type(8)));
typedef float f32x2 __attribute__((ext_vector_type(2)));
typedef float f32x4 __attribute__((ext_vector_type(4)));
typedef float f32x16 __attribute__((ext_vector_type(16)));
typedef unsigned u32x2 __attribute__((ext_vector_type(2)));
typedef unsigned u32x4 __attribute__((ext_vector_type(4)));
typedef __bf16 bf16x2_t __attribute__((ext_vector_type(2)));

constexpr int D = 1024, NP = 8192, NS = 4096, M = NP + NS, SP = 256, SS = 2048, FF = 2816, NH = 16, HD = 64;
constexpr int NPHASE = 16;
constexpr size_t MiB = 1u << 20;
constexpr size_t WS_MOD = 0, WS_CSCH = 256 * 1024, WS_TP = 512 * 1024, WS_KC = 1 * MiB, WS_VCT = 3 * MiB, WS_WF = 5 * MiB, WS_WQKV = 7 * MiB,
                 WS_WO = 13 * MiB, WS_WGU = 15 * MiB, WS_WD = 37 * MiB, WS_H = 48 * MiB, WS_MP = 72 * MiB, WS_U = 96 * MiB, WS_R = 162 * MiB;
constexpr size_t WS_YTP = WS_U, WS_YTS = WS_U + 32 * MiB;
constexpr size_t WS_TS = WS_R, WS_F = WS_R + 16 * MiB;
constexpr size_t WS_Q = WS_R, WS_K = WS_R + 24 * MiB, WS_VT = WS_R + 48 * MiB, WS_END = WS_R + 72 * MiB;
constexpr size_t OUT_X = 0, OUT_CK = (size_t)M * D, OUT_CV = OUT_CK + (size_t)NP * D;

struct Params {
    const float* in[16];
    float* out; unsigned char* ws;
    int ph_lo, ph_hi;
};

__device__ __forceinline__ unsigned pk2(float lo, float hi) { f32x2 v = {lo, hi}; bf16x2_t b = __builtin_convertvector(v, bf16x2_t); return __builtin_bit_cast(unsigned, b); }
__device__ __forceinline__ float bf_lo(unsigned w) { return __uint_as_float(w << 16); }
__device__ __forceinline__ float bf_hi(unsigned w) { return __uint_as_float(w & 0xffff0000u); }
__device__ __forceinline__ float wave_sum(float v) {
#pragma unroll
    for (int o = 1; o < 64; o <<= 1) v += __shfl_xor(v, o);
    return v;
}

namespace pg8 {
constexpr int BM = 256, BK = 64, HALF = 128, HTB = HALF * BK * 2, STAGE_BYTES = 8 * HTB;
__device__ __forceinline__ int lds_byte(int r, int c) { const int st = (r >> 4) * 2 + (c >> 5), rr = r & 15, cc = c & 31, ob = rr * 64 + cc * 2; return st * 1024 + (ob ^ (((ob >> 9) & 1) << 5)); }
__device__ __forceinline__ void stage_rc(int b, int& R, int& C) { const int st = b / 1024, sb = b % 1024, swz = sb ^ (((sb >> 9) & 1) << 5); R = (st >> 1) * 16 + swz / 64; C = (st & 1) * 32 + (swz % 64) / 2; }
__device__ __forceinline__ int perm32(int rho) { const int n = rho >> 4, i = rho & 15; return 8 * (i >> 2) + 4 * n + (i & 3); }

struct UnitDesc { const char* A; const char* B; bf16_t* out; int ldc; int aux; };

__device__ __forceinline__ void tile_order(int L, int nM, int nN, int& pm, int& pn) {
    const int nwg = nM * nN; int wgid = L;
    { const int q = nwg / 8, r = nwg % 8, xcd = wgid % 8, off = wgid / 8; wgid = (xcd < r ? xcd * (q + 1) : r * (q + 1) + (xcd - r) * q) + off; }
    const int nig = 8 * nN, gid = wgid / nig, fm = gid * 8, gsz = (nM - fm) < 8 ? (nM - fm) : 8;
    pm = fm + ((wgid % nig) % gsz); pn = (wgid % nig) / gsz;
}

template <class Epi, class Sched, bool ALIGN_EPI>
__device__ __forceinline__ void gemm_phase(LAS unsigned char* lds, const int lda, const int ldb, const int K, const Sched& S, const Epi& E) {
    const int tid = threadIdx.x, wid = __builtin_amdgcn_readfirstlane(tid >> 6), lane = tid & 63, wr = wid >> 2, wc = wid & 3, fr = lane & 15, fq = lane >> 4;
    const int nt = K / BK;
    unsigned voffA[2], voffB[2];
#pragma unroll
    for (int i = 0; i < 2; ++i) { int R, C; stage_rc(tid * 16 + i * 8192, R, C); const int Rb = (R & ~31) + perm32(R & 31);
        voffA[i] = (unsigned)(R * lda + C) * 2u; voffB[i] = (unsigned)(Rb * ldb + C) * 2u; }
    const size_t kstep = (size_t)(BK * 2);
    const size_t hstepA = (size_t)HALF * lda * 2, hstepB = (size_t)HALF * ldb * 2;
    const unsigned ldsw = (unsigned)wid * 1024u;
    const int aoff = lds_byte(wr * 64 + fr, fq * 8), boff = lds_byte(wc * 32 + fr, fq * 8);
#define PG8_SA(b, h) (((b) * 2 + (h)) * HTB)
#define PG8_SB(b, h) ((4 + (b) * 2 + (h)) * HTB)
#define PG8_STAGE(bufoff, gbase, voff) do { _Pragma("unroll") for (int _i = 0; _i < 2; ++_i) \
        __builtin_amdgcn_global_load_lds((const unsigned*)((const char*)(gbase) + (voff)[_i]), (LAS unsigned*)(lds + (bufoff) + ldsw + _i * 8192), 16, 0, 0); } while (0)
#define PG8_LDA(dst, b, h) do { _Pragma("unroll") for (int m = 0; m < 4; ++m) _Pragma("unroll") for (int k = 0; k < 2; ++k) dst[m][k] = *(const LAS bf16x8*)(lds + PG8_SA(b, h) + aoff + m * 2048 + k * 1024); } while (0)
#define PG8_LDB(dst, b, h) do { _Pragma("unroll") for (int n = 0; n < 2; ++n) _Pragma("unroll") for (int k = 0; k < 2; ++k) dst[n][k] = *(const LAS bf16x8*)(lds + PG8_SB(b, h) + boff + n * 2048 + k * 1024); } while (0)
#define PG8_MMA(ai, bj, At, Bt) do { __builtin_amdgcn_s_setprio(1); _Pragma("unroll") for (int m = 0; m < 4; ++m) _Pragma("unroll") for (int n = 0; n < 2; ++n) _Pragma("unroll") for (int k = 0; k < 2; ++k) \
        acc[ai][bj][m][n] = __builtin_amdgcn_mfma_f32_16x16x32_bf16(Bt[n][k], At[m][k], acc[ai][bj][m][n], 0, 0, 0); __builtin_amdgcn_s_setprio(0); } while (0)
#define PG8_WAIT_V(n) asm volatile("s_waitcnt vmcnt(" #n ")" ::: "memory")
#define PG8_WAIT_L(n) asm volatile("s_waitcnt lgkmcnt(" #n ")" ::: "memory")
#define PG8_BAR __builtin_amdgcn_s_barrier()
#define PG8_SCHED __builtin_amdgcn_sched_barrier(0)
    UnitDesc cur, nxt; int ui = 0;
    if (!S.next(0, cur)) return;
    f32x4 acc[2][2][4][2];
#pragma unroll
    for (int a = 0; a < 2; ++a)
#pragma unroll
        for (int b = 0; b < 2; ++b)
#pragma unroll
            for (int m = 0; m < 4; ++m)
#pragma unroll
                for (int n = 0; n < 2; ++n) acc[a][b][m][n] = (f32x4){0.f, 0.f, 0.f, 0.f};
    bf16x8 At[4][2], B0[2][2], B1[2][2];
    const char* cA = cur.A; const char* cB = cur.B;
    PG8_STAGE(PG8_SB(0, 0), cB, voffB); PG8_STAGE(PG8_SB(0, 1), cB + hstepB, voffB); PG8_STAGE(PG8_SA(0, 0), cA, voffA); PG8_STAGE(PG8_SA(0, 1), cA + hstepA, voffA);
    if (wr == 1) PG8_BAR;
    PG8_WAIT_V(2); PG8_BAR;
    PG8_STAGE(PG8_SB(1, 0), cB + kstep, voffB); PG8_STAGE(PG8_SA(1, 0), cA + kstep, voffA); PG8_STAGE(PG8_SB(1, 1), cB + hstepB + kstep, voffB);
    PG8_WAIT_V(6); PG8_BAR;
    for (;;) {
        const bool has_next = S.next(ui + 1, nxt);
        const char* nA = has_next ? nxt.A : cA; const char* nB = has_next ? nxt.B : cB;
#pragma unroll 1
        for (int t = 0; t < nt; t += 2) {
            const bool last = (t == nt - 2);
            const char* a1 = cA + (size_t)(t + 1) * kstep;
            const char* a2 = last ? nA : cA + (size_t)(t + 2) * kstep; const char* b2 = last ? nB : cB + (size_t)(t + 2) * kstep;
            const char* a3 = a2 + kstep; const char* b3 = b2 + kstep;
            PG8_LDB(B0, 0, 0); PG8_LDB(B1, 0, 1); PG8_SCHED; PG8_LDA(At, 0, 0); PG8_STAGE(PG8_SA(1, 1), a1 + hstepA, voffA);
            PG8_WAIT_V(8); PG8_WAIT_L(0); PG8_BAR; PG8_MMA(0, 0, At, B0); PG8_MMA(0, 1, At, B1); PG8_BAR; PG8_SCHED;
            PG8_LDA(At, 0, 1); PG8_STAGE(PG8_SB(0, 0), b2, voffB); PG8_STAGE(PG8_SB(0, 1), b2 + hstepB, voffB); PG8_STAGE(PG8_SA(0, 0), a2, voffA);
            PG8_WAIT_V(8); PG8_WAIT_L(0); PG8_BAR; PG8_MMA(1, 0, At, B0); PG8_MMA(1, 1, At, B1); PG8_BAR; PG8_SCHED;
            PG8_LDB(B0, 1, 0); PG8_LDB(B1, 1, 1); PG8_SCHED; PG8_LDA(At, 1, 0); PG8_STAGE(PG8_SA(0, 1), a2 + hstepA, voffA);
            PG8_WAIT_V(8); PG8_WAIT_L(0); PG8_BAR; PG8_MMA(0, 0, At, B0); PG8_MMA(0, 1, At, B1); PG8_BAR; PG8_SCHED;
            PG8_LDA(At, 1, 1); PG8_STAGE(PG8_SB(1, 0), b3, voffB); PG8_STAGE(PG8_SB(1, 1), b3 + hstepB, voffB); PG8_STAGE(PG8_SA(1, 0), a3, voffA);
            PG8_WAIT_V(8); PG8_WAIT_L(0); PG8_BAR; PG8_MMA(1, 0, At, B0); PG8_MMA(1, 1, At, B1); PG8_BAR; PG8_SCHED;
        }
        if constexpr (ALIGN_EPI) { if (wr == 0) PG8_BAR; }
        E(acc, cur, wr, wc, fr, fq);
        if (!has_next) break;
#pragma unroll
        for (int a = 0; a < 2; ++a)
#pragma unroll
            for (int b = 0; b < 2; ++b)
#pragma unroll
                for (int m = 0; m < 4; ++m)
#pragma unroll
                    for (int n = 0; n < 2; ++n) acc[a][b][m][n] = (f32x4){0.f, 0.f, 0.f, 0.f};
        cur = nxt; cA = nA; cB = nB; ++ui;
        if constexpr (ALIGN_EPI) { if (wr == 1) PG8_BAR; }
    }
    PG8_WAIT_V(0);
    if constexpr (!ALIGN_EPI) { if (wr == 0) PG8_BAR; }
    PG8_BAR;
#undef PG8_SA
#undef PG8_SB
#undef PG8_STAGE
#undef PG8_LDA
#undef PG8_LDB
#undef PG8_MMA
#undef PG8_WAIT_V
#undef PG8_WAIT_L
#undef PG8_BAR
#undef PG8_SCHED
}

struct EpiStore {
    __device__ __forceinline__ void operator()(const f32x4 (&acc)[2][2][4][2], const UnitDesc& u, int wr, int wc, int fr, int fq) const {
#pragma unroll
        for (int ai = 0; ai < 2; ++ai)
#pragma unroll
            for (int m = 0; m < 4; ++m) { bf16_t* rowp = u.out + (size_t)(ai * HALF + wr * 64 + m * 16 + fr) * u.ldc + wc * 32 + 8 * fq;
#pragma unroll
                for (int bj = 0; bj < 2; ++bj) { const f32x4 v0 = acc[ai][bj][m][0], v1 = acc[ai][bj][m][1];
                    u32x4 w; w.x = pk2(v0[0], v0[1]); w.y = pk2(v0[2], v0[3]); w.z = pk2(v1[0], v1[1]); w.w = pk2(v1[2], v1[3]);
                    *(u32x4*)(rowp + bj * HALF) = w; } }
    }
};
__device__ __forceinline__ float swiglu1(float g, float u) { return g * u * __builtin_amdgcn_rcpf(1.0f + __builtin_amdgcn_exp2f(-1.4426950408889634f * g)); }
struct EpiSwiGLU {
    __device__ __forceinline__ void operator()(const f32x4 (&acc)[2][2][4][2], const UnitDesc& u, int wr, int wc, int fr, int fq) const {
#pragma unroll
        for (int ai = 0; ai < 2; ++ai)
#pragma unroll
            for (int m = 0; m < 4; ++m) { bf16_t* rowp = u.out + (size_t)(ai * HALF + wr * 64 + m * 16 + fr) * u.ldc + wc * 32 + 8 * fq;
                const f32x4 g0 = acc[ai][0][m][0], g1 = acc[ai][0][m][1], u0 = acc[ai][1][m][0], u1 = acc[ai][1][m][1];
                u32x4 w; w.x = pk2(swiglu1(g0[0], u0[0]), swiglu1(g0[1], u0[1])); w.y = pk2(swiglu1(g0[2], u0[2]), swiglu1(g0[3], u0[3]));
                w.z = pk2(swiglu1(g1[0], u1[0]), swiglu1(g1[1], u1[1])); w.w = pk2(swiglu1(g1[2], u1[2]), swiglu1(g1[3], u1[3]));
                *(u32x4*)rowp = w; }
    }
};
struct EpiQKV {
    bf16_t* Q; bf16_t* Kb; bf16_t* VT; float* ck; float* cv;
    __device__ __forceinline__ void operator()(const f32x4 (&acc)[2][2][4][2], const UnitDesc& u, int wr, int wc, int fr, int fq) const {
        const int pm = u.aux & 0xffff, pn = u.aux >> 16, sel = pn >> 2, ct = (pn & 3) * BM;
        const int row0 = pm * BM + wr * 64 + fr, col0 = ct + wc * 32 + 8 * fq;
        if (sel < 2) {
            bf16_t* base = sel == 0 ? Q : Kb;
#pragma unroll
            for (int ai = 0; ai < 2; ++ai)
#pragma unroll
                for (int m = 0; m < 4; ++m) { const size_t off = (size_t)(row0 + ai * HALF + m * 16) * D + col0;
#pragma unroll
                    for (int bj = 0; bj < 2; ++bj) { const f32x4 v0 = acc[ai][bj][m][0], v1 = acc[ai][bj][m][1];
                        u32x4 w; w.x = pk2(v0[0], v0[1]); w.y = pk2(v0[2], v0[3]); w.z = pk2(v1[0], v1[1]); w.w = pk2(v1[2], v1[3]);
                        *(u32x4*)(base + off + bj * HALF) = w;
                        if (sel == 1 && pm < NP / BM) { *(f32x4*)(ck + off + bj * HALF) = v0; *(f32x4*)(ck + off + bj * HALF + 4) = v1; } } }
        } else {
#pragma unroll
            for (int ai = 0; ai < 2; ++ai)
#pragma unroll
                for (int m = 0; m < 4; ++m) { const int row = row0 + ai * HALF + m * 16; const size_t off = (size_t)row * D + col0;
#pragma unroll
                    for (int bj = 0; bj < 2; ++bj) { const f32x4 v0 = acc[ai][bj][m][0], v1 = acc[ai][bj][m][1];
                        bf16_t* vt = VT + (size_t)(col0 + bj * HALF) * M + row;
                        const unsigned w0 = pk2(v0[0], v0[1]), w1 = pk2(v0[2], v0[3]), w2 = pk2(v1[0], v1[1]), w3 = pk2(v1[2], v1[3]);
                        vt[0] = (bf16_t)w0; vt[(size_t)M] = (bf16_t)(w0 >> 16); vt[(size_t)2 * M] = (bf16_t)w1; vt[(size_t)3 * M] = (bf16_t)(w1 >> 16);
                        vt[(size_t)4 * M] = (bf16_t)w2; vt[(size_t)5 * M] = (bf16_t)(w2 >> 16); vt[(size_t)6 * M] = (bf16_t)w3; vt[(size_t)7 * M] = (bf16_t)(w3 >> 16);
                        if (pm < NP / BM) { *(f32x4*)(cv + off + bj * HALF) = v0; *(f32x4*)(cv + off + bj * HALF + 4) = v1; } } }
        }
    }
};

struct GSched {
    int nM, nN, G, c; const char* A; size_t a_tile; const char* B; size_t b_tile; bf16_t* out; size_t o_pm, o_pn; int ldc;
    __device__ __forceinline__ bool next(int i, UnitDesc& u) const {
        const long L = (long)i * G + c; if (L >= (long)nM * nN) return false;
        int pm, pn; tile_order((int)L, nM, nN, pm, pn);
        u.A = A + (size_t)pm * a_tile; u.B = B + (size_t)pn * b_tile; u.out = out + (size_t)pm * o_pm + (size_t)pn * o_pn; u.ldc = ldc; u.aux = pm | (pn << 16); return true;
    }
};
struct ChDftSched {
    int G, c; const char* cs_tab; const char* H; bf16_t* ytp; bf16_t* yts;
    __device__ __forceinline__ bool next(int i, UnitDesc& u) const {
        const long L = (long)i * G + c; if (L >= 48 * 8) return false;
        int tok, gc; tile_order((int)L, 48, 8, tok, gc); const int g = gc >> 1, cs = gc & 1;
        u.A = cs_tab + (size_t)cs * 256 * 256 * 2; u.B = H + ((size_t)tok * 256 * D + g * 256) * 2;
        if (tok < 32) { u.out = ytp + ((size_t)(tok * D + g * 256) * 512 + cs * 256); u.ldc = 512; }
        else { const int idx = tok - 32, b = idx >> 3, s0 = (idx & 7) * 256; u.out = yts + ((size_t)(b * D + g * 256) * 4096 + cs * 2048 + s0); u.ldc = 4096; }
        u.aux = 0; return true;
    }
};
struct SeqSSched {
    int c; const char* ts; const char* yts; bf16_t* F;
    __device__ __forceinline__ bool next(int i, UnitDesc& u) const {
        if (i > 0 || c >= 64) return false;
        const int b = c >> 5, pm = (c >> 2) & 7, pn = c & 3;
        u.A = ts + (size_t)pm * 256 * 4096 * 2; u.B = yts + (size_t)(b * D + pn * 256) * 4096 * 2;
        u.out = F + ((size_t)(NP + b * SS + pm * 256) * D + pn * 256); u.ldc = D; u.aux = 0; return true;
    }
};
struct SeqPSched {
    int G, c; const char* tp; const char* ytp; bf16_t* F;
    __device__ __forceinline__ bool next(int i, UnitDesc& u) const {
        const int G2 = G - 64; if (c < 64 || G2 <= 0) return false;
        const long L = (long)i * G2 + (c - 64); if (L >= 128) return false;
        const int b = (int)L >> 2, pn = (int)L & 3;
        u.A = tp; u.B = ytp + (size_t)(b * D + pn * 256) * 512 * 2;
        u.out = F + ((size_t)(b * 256) * D + pn * 256); u.ldc = D; u.aux = 0; return true;
    }
};
}

__device__ __forceinline__ void transpose_item(const float* W, int N, bf16_t* WT, int ldt, int dst_row0, LAS float* scr, int k0, int n0, int lane) {
#pragma unroll 8
    for (int i = 0; i < 32; ++i) { const int kk = 2 * i + (lane >> 5); scr[kk * 33 + (lane & 31)] = W[(size_t)(k0 + kk) * N + n0 + (lane & 31)]; }
    asm volatile("s_waitcnt lgkmcnt(0)" ::: "memory");
    const int c = lane & 7;
#pragma unroll
    for (int j = 0; j < 4; ++j) { const int n = (lane >> 3) + 8 * j; const LAS float* s = scr + (8 * c) * 33 + n;
        u32x4 o; o.x = pk2(s[0 * 33], s[1 * 33]); o.y = pk2(s[2 * 33], s[3 * 33]); o.z = pk2(s[4 * 33], s[5 * 33]); o.w = pk2(s[6 * 33], s[7 * 33]);
        *(u32x4*)(WT + (size_t)(dst_row0 + n) * ldt + k0 + 8 * c) = o; }
    asm volatile("s_waitcnt lgkmcnt(0)" ::: "memory");
}

__device__ __forceinline__ void phase_prologue(const Params& p, LAS unsigned char* lds) {
    const int tid = threadIdx.x, lane = tid & 63, wave = tid >> 6, G = gridDim.x, bx = blockIdx.x;
    unsigned char* ws = p.ws;
    for (int item = bx; item < 192; item += G) {
        LAS float* sl = (LAS float*)lds;
        LAS float* red = (LAS float*)(lds + 12288);
        __syncthreads();
        for (int i = tid; i < 3072; i += 512) { const int cond = i >> 10, k = i & 1023; const float v = cond == 0 ? p.in[5][k] : p.in[2][(cond - 1) * D + k]; sl[i] = v / (1.0f + __expf(-v)); }
        __syncthreads();
        const int l = item / 96, n0 = (item % 96) * 64, kq = lane >> 4, c4 = lane & 15;
        const float* W = p.in[6] + (size_t)l * D * 6144 + n0 + 4 * c4;
        f32x4 a0 = {0.f, 0.f, 0.f, 0.f}, a1 = a0, a2 = a0;
#pragma unroll 8
        for (int it = 0; it < 32; ++it) { const int k = wave * 128 + it * 4 + kq; const f32x4 w = *(const f32x4*)(W + (size_t)k * 6144);
            a0 += sl[k] * w; a1 += sl[1024 + k] * w; a2 += sl[2048 + k] * w; }
#pragma unroll
        for (int j = 0; j < 4; ++j) { a0[j] += __shfl_xor(a0[j], 16); a0[j] += __shfl_xor(a0[j], 32); a1[j] += __shfl_xor(a1[j], 16); a1[j] += __shfl_xor(a1[j], 32); a2[j] += __shfl_xor(a2[j], 16); a2[j] += __shfl_xor(a2[j], 32); }
        if (kq == 0) {
#pragma unroll
            for (int j = 0; j < 4; ++j) { red[(wave * 3 + 0) * 64 + 4 * c4 + j] = a0[j]; red[(wave * 3 + 1) * 64 + 4 * c4 + j] = a1[j]; red[(wave * 3 + 2) * 64 + 4 * c4 + j] = a2[j]; } }
        __syncthreads();
        if (tid < 192) { const int cond = tid >> 6, n = tid & 63; float s = p.in[7][l * 6144 + n0 + n];
#pragma unroll
            for (int w = 0; w < 8; ++w) s += red[(w * 3 + cond) * 64 + n];
            ((float*)(ws + WS_MOD))[(l * 3 + cond) * 6144 + n0 + n] = s; }
    }
    __syncthreads();
    {
        LAS float* scr = (LAS float*)(lds + wave * 8448);
        const int gw = bx * 8 + wave, NGW = G * 8;
        constexpr int I_F = 16 * 32, I_QKV = 16 * 96, I_O = 16 * 32, I_G = 16 * 88, I_D = 44 * 32, I_CV = 8 * 32;
        constexpr int NITEMS = I_F + I_QKV + I_O + 4 * I_G + 2 * I_D + 2 * I_CV;
        for (int it = gw; it < NITEMS; it += NGW) {
            int r = it; const float* W; int N, ldt; bf16_t* WT; int mode = 0;
            if (r < I_F) { W = p.in[9]; N = D; ldt = D; WT = (bf16_t*)(ws + WS_WF); }
            else if ((r -= I_F) < I_QKV) { W = p.in[10]; N = 3 * D; ldt = D; WT = (bf16_t*)(ws + WS_WQKV); }
            else if ((r -= I_QKV) < I_O) { W = p.in[12]; N = D; ldt = D; WT = (bf16_t*)(ws + WS_WO); }
            else if ((r -= I_O) < 2 * I_G) { const int l = r / I_G; r -= l * I_G; W = p.in[13] + (size_t)l * D * FF; N = FF; ldt = D; WT = (bf16_t*)(ws + WS_WGU) + (size_t)l * 2 * FF * D; mode = 1; }
            else if ((r -= 2 * I_G) < 2 * I_G) { const int l = r / I_G; r -= l * I_G; W = p.in[14] + (size_t)l * D * FF; N = FF; ldt = D; WT = (bf16_t*)(ws + WS_WGU) + (size_t)l * 2 * FF * D; mode = 2; }
            else if ((r -= 2 * I_G) < 2 * I_D) { const int l = r / I_D; r -= l * I_D; W = p.in[15] + (size_t)l * FF * D; N = D; ldt = FF; WT = (bf16_t*)(ws + WS_WD) + (size_t)l * D * FF; }
            else { r -= 2 * I_D; const int b = r / I_CV; r -= b * I_CV; W = p.in[4] + (size_t)b * 512 * D; N = D; ldt = 512; WT = (bf16_t*)(ws + WS_VCT) + (size_t)b * D * 512; }
            const int nblk = N / 32, kb = r / nblk, nb = r % nblk, n0 = nb * 32;
            int dst = n0; if (mode) dst = (n0 >> 7) * 256 + (n0 & 127) + (mode == 2 ? 128 : 0);
            transpose_item(W, N, WT, ldt, dst, scr, kb * 64, n0, lane);
        }
    }
    {
        const int gt = bx * 512 + tid, GT = G * 512;
        for (int i = gt; i < 2 * 512 * D / 8; i += GT) { const f32x4 a = ((const f32x4*)p.in[3])[2 * i], b = ((const f32x4*)p.in[3])[2 * i + 1];
            u32x4 o; o.x = pk2(a[0], a[1]); o.y = pk2(a[2], a[3]); o.z = pk2(b[0], b[1]); o.w = pk2(b[2], b[3]); ((u32x4*)(ws + WS_KC))[i] = o; }
        for (int i = gt; i < 512 * 256 / 8; i += GT) { const int row = i >> 5, c0 = (i & 31) * 8, cs = row >> 8, m = row & 255; float v[8];
#pragma unroll
            for (int j = 0; j < 8; ++j) { const float a = (float)((m * (c0 + j)) & 255) * (1.0f / 128.0f); v[j] = cs ? sinpif(a) : cospif(a); }
            u32x4 o; o.x = pk2(v[0], v[1]); o.y = pk2(v[2], v[3]); o.z = pk2(v[4], v[5]); o.w = pk2(v[6], v[7]); ((u32x4*)(ws + WS_CSCH))[i] = o; }
        for (int i = gt; i < 256 * 512 / 8; i += GT) { const int k = i >> 6, c0 = (i & 63) * 8; float v[8];
#pragma unroll
            for (int j = 0; j < 8; ++j) { const int kk = c0 + j, s = kk & 255; const float a = (float)((k * s) & 255) * (1.0f / 128.0f); v[j] = kk < 256 ? cospif(a) : -sinpif(a); }
            u32x4 o; o.x = pk2(v[0], v[1]); o.y = pk2(v[2], v[3]); o.z = pk2(v[4], v[5]); o.w = pk2(v[6], v[7]); ((u32x4*)(ws + WS_TP))[i] = o; }
        for (int i = gt; i < 2048 * 4096 / 8; i += GT) { const int k = i >> 9, c0 = (i & 511) * 8; float v[8];
#pragma unroll
            for (int j = 0; j < 8; ++j) { const int kk = c0 + j, s = kk & 2047; const float a = (float)((k * s) & 2047) * (1.0f / 1024.0f); v[j] = kk < 2048 ? cospif(a) : -sinpif(a); }
            u32x4 o; o.x = pk2(v[0], v[1]); o.y = pk2(v[2], v[3]); o.z = pk2(v[4], v[5]); o.w = pk2(v[6], v[7]); ((u32x4*)(ws + WS_TS))[i] = o; }
    }
}

template <bool HAS_MP, bool HAS_NEXT>
__device__ __forceinline__ void row_phase(const float* xin_p, const float* xin_s, const bf16_t* mp, float* Xout, bf16_t* Hout,
                                          const float* gate, const float* gA, const float* gB, const float* sc, const float* sh) {
    const int tid = threadIdx.x, lane = tid & 63, gw = blockIdx.x * 8 + (tid >> 6), NGW = gridDim.x * 8;
    for (int row = gw; row < M; row += NGW) {
        const int cond = row < NP ? 0 : (row < NP + SS ? 1 : 2);
        const float* xr = row < NP ? xin_p + (size_t)row * D : xin_s + (size_t)(row - NP) * D;
        f32x4 v[4];
#pragma unroll
        for (int j = 0; j < 4; ++j) v[j] = *(const f32x4*)(xr + 4 * lane + 256 * j);
        if constexpr (HAS_MP) {
            f32x4 mv[4]; float s = 0.f;
#pragma unroll
            for (int j = 0; j < 4; ++j) { const u32x2 w = *(const u32x2*)(mp + (size_t)row * D + 4 * lane + 256 * j);
                mv[j] = (f32x4){bf_lo(w.x), bf_hi(w.x), bf_lo(w.y), bf_hi(w.y)}; s += (mv[j][0] * mv[j][0] + mv[j][1] * mv[j][1]) + (mv[j][2] * mv[j][2] + mv[j][3] * mv[j][3]); }
            const float rstd = 1.0f / sqrtf(wave_sum(s) * (1.0f / D) + 1e-6f);
#pragma unroll
            for (int j = 0; j < 4; ++j) { const f32x4 gt = *(const f32x4*)(gate + cond * 6144 + 4 * lane + 256 * j), ga = *(const f32x4*)(gA + 4 * lane + 256 * j);
                v[j] = v[j] + gt * (mv[j] * rstd * ga);
                *(f32x4*)(Xout + (size_t)row * D + 4 * lane + 256 * j) = v[j]; }
        }
        if constexpr (HAS_NEXT) {
            float s = 0.f;
#pragma unroll
            for (int j = 0; j < 4; ++j) s += (v[j][0] * v[j][0] + v[j][1] * v[j][1]) + (v[j][2] * v[j][2] + v[j][3] * v[j][3]);
            const float rstd = 1.0f / sqrtf(wave_sum(s) * (1.0f / D) + 1e-6f);
#pragma unroll
            for (int j = 0; j < 4; ++j) { const int col = 4 * lane + 256 * j;
                const f32x4 gb = *(const f32x4*)(gB + col), s1 = *(const f32x4*)(sc + cond * 6144 + col), s0 = *(const f32x4*)(sh + cond * 6144 + col);
                const f32x4 h = (v[j] * rstd * gb) * (1.0f + s1) + s0;
                u32x2 w; w.x = pk2(h[0], h[1]); w.y = pk2(h[2], h[3]); *(u32x2*)(Hout + (size_t)row * D + col) = w; }
        }
    }
}

__device__ __forceinline__ void attn_phase(const Params& p, LAS unsigned char* lds) {
    const int tid = threadIdx.x, lane = tid & 63, wave = __builtin_amdgcn_readfirstlane(tid >> 6), r = lane & 31, hh = lane >> 5;
    unsigned char* ws = p.ws;
    const bf16_t* Qb = (const bf16_t*)(ws + WS_Q); const bf16_t* Kb = (const bf16_t*)(ws + WS_K); const bf16_t* VT = (const bf16_t*)(ws + WS_VT);
    const bf16_t* Kc = (const bf16_t*)(ws + WS_KC); const bf16_t* VcT = (const bf16_t*)(ws + WS_VCT);
    bf16_t* Ob = (bf16_t*)(ws + WS_Q);
    LAS unsigned char* Kl = lds; LAS unsigned char* Vl = lds + 9216; LAS float* Bl = (LAS float*)(lds + 18432 + 512);
    const int srow = tid >> 3, sch = tid & 7, krho = (srow & ~12) | ((srow & 4) << 1) | ((srow & 8) >> 1);
    const float c2 = 0.125f * 1.4426950408889634f;
    for (int unit = blockIdx.x; unit < 768; unit += gridDim.x) {
        const bool is_na = unit < 256;
        int b, h, qtok, nt, jmin = 0, nloc = 0, rq = 0, half = 0, ktok0;
        if (is_na) { b = unit >> 7; h = (unit >> 3) & 15; const int r0 = (unit & 7) * 4; rq = r0 + (wave >> 1); half = wave & 1;
            jmin = min(max(r0 - 4, 0), 24); const int jmax = min(max(r0 - 1, 0), 24) + 7; nloc = jmax - jmin + 1; nt = nloc + 8;
            qtok = NP + b * SS + rq * 64 + half * 32 + r; ktok0 = NP + b * SS; }
        else { const int u2 = unit - 256; b = u2 >> 4; h = u2 & 15; nt = 4; qtok = b * SP + wave * 32 + r; ktok0 = b * SP; }
        const int rs = min(max(rq - 4, 0), 24);
        __syncthreads();
        if (is_na) { for (int i = tid; i < 15 * 32; i += 512) { const int rr = i >> 5, x = i & 31; Bl[i] = x < 31 ? p.in[11][(h * 15 + rr) * 31 + x] * 1.4426950408889634f : 0.f; } }
        bf16x8 qf[4];
#pragma unroll
        for (int d0 = 0; d0 < 4; ++d0) qf[d0] = *(const bf16x8*)(Qb + (size_t)qtok * D + h * HD + d0 * 16 + hh * 8);
        f32x16 o0, o1;
#pragma unroll
        for (int i = 0; i < 16; ++i) { o0[i] = 0.f; o1[i] = 0.f; }
        float m_run = -1e30f, l_run = 0.f;
        u32x4 kreg, vreg;
#define ATT_LOAD(t) do { const int t_ = (t); const bf16_t* kp; const bf16_t* vp; \
            if (is_na && t_ >= nloc) { const int key0 = (t_ - nloc) * 64; kp = Kc + ((size_t)(b * 512 + key0 + srow)) * D + h * HD + sch * 8; vp = VcT + ((size_t)(b * D + h * HD + srow)) * 512 + key0 + sch * 8; } \
            else { const int tok0 = ktok0 + (is_na ? (jmin + t_) * 64 : t_ * 64); kp = Kb + (size_t)(tok0 + srow) * D + h * HD + sch * 8; vp = VT + (size_t)(h * HD + srow) * M + tok0 + sch * 8; } \
            kreg = *(const u32x4*)kp; vreg = *(const u32x4*)vp; } while (0)
        ATT_LOAD(0);
        for (int t = 0; t < nt; ++t) {
            __syncthreads();
            *(LAS u32x4*)(Kl + krho * 144 + sch * 16) = kreg; *(LAS u32x4*)(Vl + srow * 144 + sch * 16) = vreg;
            __syncthreads();
            if (t + 1 < nt) ATT_LOAD(t + 1);
            const bool local = is_na && t < nloc; const int j = jmin + t;
            if (local && (j < rs || j >= rs + 8)) continue;
            f32x16 p0, p1;
#pragma unroll
            for (int i = 0; i < 16; ++i) { p0[i] = 0.f; p1[i] = 0.f; }
#pragma unroll
            for (int d0 = 0; d0 < 4; ++d0) { const bf16x8 a0 = *(const LAS bf16x8*)(Kl + r * 144 + d0 * 32 + hh * 16), a1 = *(const LAS bf16x8*)(Kl + (32 + r) * 144 + d0 * 32 + hh * 16);
                p0 = __builtin_amdgcn_mfma_f32_32x32x16_bf16(a0, qf[d0], p0, 0, 0, 0); p1 = __builtin_amdgcn_mfma_f32_32x32x16_bf16(a1, qf[d0], p1, 0, 0, 0); }
            if (local) {
                const int qc = half * 32 + r, cs = min(max(qc - 8, 0), 48);
                const LAS float* bp = Bl + (j - rq + 7) * 32 + 8 * hh - qc + 15;
#pragma unroll
                for (int i = 0; i < 16; ++i) { const int kc = 16 * (i >> 3) + (i & 7);
                    const float b0 = bp[kc], b1 = bp[kc + 32];
                    const bool v0 = (unsigned)(kc + 8 * hh - cs) < 16u, v1 = (unsigned)(kc + 32 + 8 * hh - cs) < 16u;
                    p0[i] = v0 ? p0[i] * c2 + b0 : -1e30f; p1[i] = v1 ? p1[i] * c2 + b1 : -1e30f; }
            } else {
#pragma unroll
                for (int i = 0; i < 16; ++i) { p0[i] *= c2; p1[i] *= c2; }
            }
            float mt = fmaxf(p0[0], p1[0]);
#pragma unroll
            for (int i = 1; i < 16; ++i) mt = fmaxf(mt, fmaxf(p0[i], p1[i]));
            mt = fmaxf(mt, __shfl_xor(mt, 32));
            const float m_new = fmaxf(m_run, mt), alpha = __builtin_amdgcn_exp2f(m_run - m_new);
            m_run = m_new;
            float ls = 0.f;
#pragma unroll
            for (int i = 0; i < 16; ++i) { p0[i] = __builtin_amdgcn_exp2f(p0[i] - m_new); p1[i] = __builtin_amdgcn_exp2f(p1[i] - m_new); ls += p0[i] + p1[i]; }
            l_run = l_run * alpha + ls;
#pragma unroll
            for (int i = 0; i < 16; ++i) { o0[i] *= alpha; o1[i] *= alpha; }
            bf16x8 pa[4];
#pragma unroll
            for (int s = 0; s < 2; ++s) { u32x4 w; w.x = pk2(p0[8 * s], p0[8 * s + 1]); w.y = pk2(p0[8 * s + 2], p0[8 * s + 3]); w.z = pk2(p0[8 * s + 4], p0[8 * s + 5]); w.w = pk2(p0[8 * s + 6], p0[8 * s + 7]); pa[s] = __builtin_bit_cast(bf16x8, w);
                u32x4 w2; w2.x = pk2(p1[8 * s], p1[8 * s + 1]); w2.y = pk2(p1[8 * s + 2], p1[8 * s + 3]); w2.z = pk2(p1[8 * s + 4], p1[8 * s + 5]); w2.w = pk2(p1[8 * s + 6], p1[8 * s + 7]); pa[2 + s] = __builtin_bit_cast(bf16x8, w2); }
#pragma unroll
            for (int s = 0; s < 4; ++s) { const bf16x8 v0 = *(const LAS bf16x8*)(Vl + r * 144 + s * 32 + hh * 16), v1 = *(const LAS bf16x8*)(Vl + (32 + r) * 144 + s * 32 + hh * 16);
                o0 = __builtin_amdgcn_mfma_f32_32x32x16_bf16(v0, pa[s], o0, 0, 0, 0); o1 = __builtin_amdgcn_mfma_f32_32x32x16_bf16(v1, pa[s], o1, 0, 0, 0); }
        }
#undef ATT_LOAD
        const float inv = 1.0f / (l_run + __shfl_xor(l_run, 32));
        bf16_t* orow = Ob + (size_t)qtok * D + h * HD + 4 * hh;
#pragma unroll
        for (int g = 0; g < 4; ++g) { u32x2 w; w.x = pk2(o0[4 * g] * inv, o0[4 * g + 1] * inv); w.y = pk2(o0[4 * g + 2] * inv, o0[4 * g + 3] * inv); *(u32x2*)(orow + 8 * g) = w;
            u32x2 w2; w2.x = pk2(o1[4 * g] * inv, o1[4 * g + 1] * inv); w2.y = pk2(o1[4 * g + 2] * inv, o1[4 * g + 3] * inv); *(u32x2*)(orow + 32 + 8 * g) = w2; }
    }
    __syncthreads();
}

__global__ void __launch_bounds__(512, 2) mega_fwd(Params p) {
    extern __shared__ __attribute__((aligned(16))) unsigned char lds_raw[];
    LAS unsigned char* lds = (LAS unsigned char*)lds_raw;
    unsigned char* ws = p.ws;
    const int G = gridDim.x, c = blockIdx.x, lo = p.ph_lo, hi = p.ph_hi;
    const float* mod = (const float*)(ws + WS_MOD);
    const float* norm_g = p.in[8];
    bf16_t* H = (bf16_t*)(ws + WS_H); bf16_t* MPb = (bf16_t*)(ws + WS_MP); bf16_t* U = (bf16_t*)(ws + WS_U);
    float* X = p.out + OUT_X;
#ifndef PH_MASK
#define PH_MASK 0xffff
#endif
#define IN(k) (((PH_MASK >> (k)) & 1) && lo <= (k) && (k) < hi)
#define SEAM(k) do { if ((k) + 1 < hi) cg::this_grid().sync(); } while (0)

    if (IN(0)) { phase_prologue(p, lds); SEAM(0); }
    if (IN(1)) {
        row_phase<false, true>(p.in[0], p.in[1], nullptr, nullptr, H, nullptr, nullptr, norm_g, mod + 1 * D, mod + 0 * D);
        SEAM(1);
    }
    if (IN(2)) {
        pg8::ChDftSched S{G, c, (const char*)(ws + WS_CSCH), (const char*)H, (bf16_t*)(ws + WS_YTP), (bf16_t*)(ws + WS_YTS)};
        pg8::gemm_phase<pg8::EpiStore, pg8::ChDftSched, true>(lds, 256, D, 256, S, pg8::EpiStore{});
        SEAM(2);
    }
    if (IN(3)) {
        { pg8::SeqSSched S{c, (const char*)(ws + WS_TS), (const char*)(ws + WS_YTS), (bf16_t*)(ws + WS_F)};
          pg8::gemm_phase<pg8::EpiStore, pg8::SeqSSched, true>(lds, 4096, 4096, 4096, S, pg8::EpiStore{}); }
        { pg8::SeqPSched S{G, c, (const char*)(ws + WS_TP), (const char*)(ws + WS_YTP), (bf16_t*)(ws + WS_F)};
          pg8::gemm_phase<pg8::EpiStore, pg8::SeqPSched, true>(lds, 512, 512, 512, S, pg8::EpiStore{}); }
        SEAM(3);
    }
    if (IN(4)) {
        pg8::GSched S{48, 4, G, c, (const char*)(ws + WS_F), (size_t)256 * D * 2, (const char*)(ws + WS_WF), (size_t)256 * D * 2, MPb, (size_t)256 * D, 256, D};
        pg8::gemm_phase<pg8::EpiStore, pg8::GSched, true>(lds, D, D, D, S, pg8::EpiStore{});
        SEAM(4);
    }
    if (IN(5)) {
        row_phase<true, true>(p.in[0], p.in[1], MPb, X, H, mod + 2 * D, norm_g + 1 * D, norm_g + 2 * D, mod + 4 * D, mod + 3 * D);
        SEAM(5);
    }
    if (IN(6)) {
        pg8::GSched S{48, 22, G, c, (const char*)H, (size_t)256 * D * 2, (const char*)(ws + WS_WGU), (size_t)256 * D * 2, U, (size_t)256 * FF, 128, FF};
        pg8::gemm_phase<pg8::EpiSwiGLU, pg8::GSched, true>(lds, D, D, D, S, pg8::EpiSwiGLU{});
        SEAM(6);
    }
    if (IN(7)) {
        pg8::GSched S{48, 4, G, c, (const char*)U, (size_t)256 * FF * 2, (const char*)(ws + WS_WD), (size_t)256 * FF * 2, MPb, (size_t)256 * D, 256, D};
        pg8::gemm_phase<pg8::EpiStore, pg8::GSched, true>(lds, FF, FF, FF, S, pg8::EpiStore{});
        SEAM(7);
    }
    if (IN(8)) {
        row_phase<true, true>(X, X + (size_t)NP * D, MPb, X, H, mod + 5 * D, norm_g + 3 * D, norm_g + 4 * D, mod + 3 * 6144 + 1 * D, mod + 3 * 6144 + 0 * D);
        SEAM(8);
    }
    if (IN(9)) {
        pg8::GSched S{48, 12, G, c, (const char*)H, (size_t)256 * D * 2, (const char*)(ws + WS_WQKV), (size_t)256 * D * 2, nullptr, 0, 0, D};
        pg8::EpiQKV E{(bf16_t*)(ws + WS_Q), (bf16_t*)(ws + WS_K), (bf16_t*)(ws + WS_VT), p.out + OUT_CK, p.out + OUT_CV};
        pg8::gemm_phase<pg8::EpiQKV, pg8::GSched, true>(lds, D, D, D, S, E);
        SEAM(9);
    }
    if (IN(10)) { attn_phase(p, lds); SEAM(10); }
    if (IN(11)) {
        pg8::GSched S{48, 4, G, c, (const char*)(ws + WS_Q), (size_t)256 * D * 2, (const char*)(ws + WS_WO), (size_t)256 * D * 2, MPb, (size_t)256 * D, 256, D};
        pg8::gemm_phase<pg8::EpiStore, pg8::GSched, true>(lds, D, D, D, S, pg8::EpiStore{});
        SEAM(11);
    }
    if (IN(12)) {
        row_phase<true, true>(X, X + (size_t)NP * D, MPb, X, H, mod + 3 * 6144 + 2 * D, norm_g + 5 * D, norm_g + 6 * D, mod + 3 * 6144 + 4 * D, mod + 3 * 6144 + 3 * D);
        SEAM(12);
    }
    if (IN(13)) {
        pg8::GSched S{48, 22, G, c, (const char*)H, (size_t)256 * D * 2, (const char*)(ws + WS_WGU) + (size_t)2 * FF * D * 2, (size_t)256 * D * 2, U, (size_t)256 * FF, 128, FF};
        pg8::gemm_phase<pg8::EpiSwiGLU, pg8::GSched, true>(lds, D, D, D, S, pg8::EpiSwiGLU{});
        SEAM(13);
    }
    if (IN(14)) {
        pg8::GSched S{48, 4, G, c, (const char*)U, (size_t)256 * FF * 2, (const char*)(ws + WS_WD) + (size_t)D * FF * 2, (size_t)256 * FF * 2, MPb, (size_t)256 * D, 256, D};
        pg8::gemm_phase<pg8::EpiStore, pg8::GSched, true>(lds, FF, FF, FF, S, pg8::EpiStore{});
        SEAM(14);
    }
    if (IN(15)) {
        row_phase<true, false>(X, X + (size_t)NP * D, MPb, X, nullptr, mod + 3 * 6144 + 5 * D, norm_g + 7 * D, nullptr, nullptr, nullptr);
    }
#undef IN
#undef SEAM
}

constexpr int LDS_BYTES = 147456;
extern "C" void kernel_launch(void* const* d_in, const int* in_sizes, int n_in, void* d_out, int out_size, void* d_ws, size_t ws_size, hipStream_t stream) {
    static int grid = 0;
    if (grid == 0) {
        int dev = 0, cus = 0, per_cu = 0;
        hipGetDevice(&dev);
        hipDeviceGetAttribute(&cus, hipDeviceAttributeMultiprocessorCount, dev);
        if (hipFuncSetAttribute((const void*)mega_fwd, hipFuncAttributeMaxDynamicSharedMemorySize, LDS_BYTES) != hipSuccess) fprintf(stderr, "kernel_launch: hipFuncSetAttribute failed\n");
        if (hipOccupancyMaxActiveBlocksPerMultiprocessor(&per_cu, (const void*)mega_fwd, 512, LDS_BYTES) != hipSuccess || per_cu < 1) { fprintf(stderr, "kernel_launch: occupancy query says %d\n", per_cu); per_cu = 1; }
        (void)hipGetLastError();
        grid = cus * 1;
        if (n_in != 16 || ws_size < WS_END) { fprintf(stderr, "kernel_launch: unexpected n_in %d / ws %zu\n", n_in, ws_size); }
    }
    Params p{};
    for (int i = 0; i < 16; ++i) p.in[i] = (const float*)d_in[i];
    p.out = (float*)d_out; p.ws = (unsigned char*)d_ws;
    if (MK_N_LAUNCHES == 1) {
        p.ph_lo = 0; p.ph_hi = NPHASE;
        void* args[] = {&p};
        hipError_t e = hipLaunchCooperativeKernel((const void*)mega_fwd, dim3(grid), dim3(512), args, LDS_BYTES, stream);
        if (e != hipSuccess) fprintf(stderr, "cooperative launch failed: %s (grid %d)\n", hipGetErrorString(e), grid);
    } else {
        for (int k = 0; k < NPHASE; ++k) { p.ph_lo = k; p.ph_hi = k + 1; hipLaunchKernelGGL(mega_fwd, dim3(grid), dim3(512), LDS_BYTES, stream, p); }
    }
}
```

```cpp
#include <hip/hip_runtime.h>
#include <hip/hip_cooperative_groups.h>
#include <cstdio>
#include <cstdint>
namespace cg = cooperative_groups;

#ifndef MK_N_LAUNCHES
#define MK_N_LAUNCHES 1
#endif

#define LAS __attribute__((address_space(3)))
typedef unsigned short bf16_t;
typedef short bf16x8 __attribute__((ext_vector_type(8)));
typedef float f32x2 __attribute__((ext_vector_type(2)));
typedef float f32x4 __attribute__((ext_vector_type(4)));
typedef float f32x16 __attribute__((ext_vector_type(16)));
typedef unsigned u32x2 __attribute__((ext_vector_type(2)));
typedef unsigned u32x4 __attribute__((ext_vector_type(4)));
typedef __bf16 bf16x2_t __attribute__((ext_vector_type(2)));

constexpr int D = 1024, NP = 8192, NS = 4096, M = NP + NS, SP = 256, SS = 2048, FF = 2816, NH = 16, HD = 64;
constexpr int NPHASE = 16;
constexpr size_t MiB = 1u << 20;
constexpr size_t WS_CTL = 160 * 1024, CTL_BYTES = 16 * 1024;
constexpr size_t WS_MOD = 0, WS_CSCH = 256 * 1024, WS_TP = 512 * 1024, WS_KC = 1 * MiB, WS_VCT = 3 * MiB, WS_WF = 5 * MiB, WS_WQKV = 7 * MiB,
                 WS_WO = 13 * MiB, WS_WGU = 15 * MiB, WS_WD = 37 * MiB, WS_H = 48 * MiB, WS_MP = 72 * MiB, WS_U = 96 * MiB, WS_R = 162 * MiB;
constexpr size_t WS_YTP = WS_U, WS_YTS = WS_U + 32 * MiB;
constexpr size_t WS_TS = WS_R, WS_F = WS_R + 16 * MiB;
constexpr size_t WS_Q = WS_R, WS_K = WS_R + 24 * MiB, WS_VT = WS_R + 48 * MiB, WS_END = WS_R + 72 * MiB;
constexpr size_t OUT_X = 0, OUT_CK = (size_t)M * D, OUT_CV = OUT_CK + (size_t)NP * D;

struct Params {
    const float* in[16];
    float* out; unsigned char* ws;
    int ph_lo, ph_hi;
};

__device__ __forceinline__ unsigned pk2(float lo, float hi) { f32x2 v = {lo, hi}; bf16x2_t b = __builtin_convertvector(v, bf16x2_t); return __builtin_bit_cast(unsigned, b); }
__device__ __forceinline__ float bf_lo(unsigned w) { return __uint_as_float(w << 16); }
__device__ __forceinline__ float bf_hi(unsigned w) { return __uint_as_float(w & 0xffff0000u); }
__device__ __forceinline__ float wave_sum(float v) {
#pragma unroll
    for (int o = 1; o < 64; o <<= 1) v += __shfl_xor(v, o);
    return v;
}

namespace pg8 {
constexpr int BM = 256, BK = 64, HALF = 128, HTB = HALF * BK * 2, STAGE_BYTES = 8 * HTB;
__device__ __forceinline__ int lds_byte(int r, int c) { const int st = (r >> 4) * 2 + (c >> 5), rr = r & 15, cc = c & 31, ob = rr * 64 + cc * 2; return st * 1024 + (ob ^ (((ob >> 9) & 1) << 5)); }
__device__ __forceinline__ void stage_rc(int b, int& R, int& C) { const int st = b / 1024, sb = b % 1024, swz = sb ^ (((sb >> 9) & 1) << 5); R = (st >> 1) * 16 + swz / 64; C = (st & 1) * 32 + (swz % 64) / 2; }
__device__ __forceinline__ int perm32(int rho) { const int n = rho >> 4, i = rho & 15; return 8 * (i >> 2) + 4 * n + (i & 3); }

struct UnitDesc { const char* A; const char* B; bf16_t* out; int ldc; int aux; };

__device__ __forceinline__ void tile_order(int L, int nM, int nN, int& pm, int& pn) {
    const int nwg = nM * nN; int wgid = L;
    { const int q = nwg / 8, r = nwg % 8, xcd = wgid % 8, off = wgid / 8; wgid = (xcd < r ? xcd * (q + 1) : r * (q + 1) + (xcd - r) * q) + off; }
    const int nig = 8 * nN, gid = wgid / nig, fm = gid * 8, gsz = (nM - fm) < 8 ? (nM - fm) : 8;
    pm = fm + ((wgid % nig) % gsz); pn = (wgid % nig) / gsz;
}

template <class Epi, class Sched, bool ALIGN_EPI>
__device__ __forceinline__ void gemm_phase(LAS unsigned char* lds, const int lda, const int ldb, const int K, const Sched& S, const Epi& E) {
    const int tid = threadIdx.x, wid = __builtin_amdgcn_readfirstlane(tid >> 6), lane = tid & 63, wr = wid >> 2, wc = wid & 3, fr = lane & 15, fq = lane >> 4;
    const int nt = K / BK;
    unsigned voffA[2], voffB[2];
#pragma unroll
    for (int i = 0; i < 2; ++i) { int R, C; stage_rc(tid * 16 + i * 8192, R, C); const int Rb = (R & ~31) + perm32(R & 31);
        voffA[i] = (unsigned)(R * lda + C) * 2u; voffB[i] = (unsigned)(Rb * ldb + C) * 2u; }
    const size_t kstep = (size_t)(BK * 2);
    const size_t hstepA = (size_t)HALF * lda * 2, hstepB = (size_t)HALF * ldb * 2;
    const unsigned ldsw = (unsigned)wid * 1024u;
    const int aoff = lds_byte(wr * 64 + fr, fq * 8), boff = lds_byte(wc * 32 + fr, fq * 8);
#define PG8_SA(b, h) (((b) * 2 + (h)) * HTB)
#define PG8_SB(b, h) ((4 + (b) * 2 + (h)) * HTB)
#define PG8_STAGE(bufoff, gbase, voff) do { _Pragma("unroll") for (int _i = 0; _i < 2; ++_i) \
        __builtin_amdgcn_global_load_lds((const unsigned*)((const char*)(gbase) + (voff)[_i]), (LAS unsigned*)(lds + (bufoff) + ldsw + _i * 8192), 16, 0, 0); } while (0)
#define PG8_LDA(dst, b, h) do { _Pragma("unroll") for (int m = 0; m < 4; ++m) _Pragma("unroll") for (int k = 0; k < 2; ++k) dst[m][k] = *(const LAS bf16x8*)(lds + PG8_SA(b, h) + aoff + m * 2048 + k * 1024); } while (0)
#define PG8_LDB(dst, b, h) do { _Pragma("unroll") for (int n = 0; n < 2; ++n) _Pragma("unroll") for (int k = 0; k < 2; ++k) dst[n][k] = *(const LAS bf16x8*)(lds + PG8_SB(b, h) + boff + n * 2048 + k * 1024); } while (0)
#define PG8_MMA(ai, bj, At, Bt) do { __builtin_amdgcn_s_setprio(1); _Pragma("unroll") for (int m = 0; m < 4; ++m) _Pragma("unroll") for (int n = 0; n < 2; ++n) _Pragma("unroll") for (int k = 0; k < 2; ++k) \
        acc[ai][bj][m][n] = __builtin_amdgcn_mfma_f32_16x16x32_bf16(Bt[n][k], At[m][k], acc[ai][bj][m][n], 0, 0, 0); __builtin_amdgcn_s_setprio(0); } while (0)
#define PG8_WAIT_V(n) asm volatile("s_waitcnt vmcnt(" #n ")" ::: "memory")
#define PG8_WAIT_L(n) asm volatile("s_waitcnt lgkmcnt(" #n ")" ::: "memory")
#define PG8_BAR __builtin_amdgcn_s_barrier()
#define PG8_SCHED __builtin_amdgcn_sched_barrier(0)
    UnitDesc cur, nxt; int ui = 0;
    if (!S.next(0, cur)) return;
    f32x4 acc[2][2][4][2];
#pragma unroll
    for (int a = 0; a < 2; ++a)
#pragma unroll
        for (int b = 0; b < 2; ++b)
#pragma unroll
            for (int m = 0; m < 4; ++m)
#pragma unroll
                for (int n = 0; n < 2; ++n) acc[a][b][m][n] = (f32x4){0.f, 0.f, 0.f, 0.f};
    bf16x8 At[4][2], B0[2][2], B1[2][2];
    const char* cA = cur.A; const char* cB = cur.B;
    PG8_STAGE(PG8_SB(0, 0), cB, voffB); PG8_STAGE(PG8_SB(0, 1), cB + hstepB, voffB); PG8_STAGE(PG8_SA(0, 0), cA, voffA); PG8_STAGE(PG8_SA(0, 1), cA + hstepA, voffA);
    if (wr == 1) PG8_BAR;
    PG8_WAIT_V(2); PG8_BAR;
    PG8_STAGE(PG8_SB(1, 0), cB + kstep, voffB); PG8_STAGE(PG8_SA(1, 0), cA + kstep, voffA); PG8_STAGE(PG8_SB(1, 1), cB + hstepB + kstep, voffB);
    PG8_WAIT_V(6); PG8_BAR;
    for (;;) {
        const bool has_next = S.next(ui + 1, nxt);
        const char* nA = has_next ? nxt.A : cA; const char* nB = has_next ? nxt.B : cB;
#pragma unroll 1
        for (int t = 0; t < nt; t += 2) {
            const bool last = (t == nt - 2);
            const char* a1 = cA + (size_t)(t + 1) * kstep;
            const char* a2 = last ? nA : cA + (size_t)(t + 2) * kstep; const char* b2 = last ? nB : cB + (size_t)(t + 2) * kstep;
            const char* a3 = a2 + kstep; const char* b3 = b2 + kstep;
            PG8_LDB(B0, 0, 0); PG8_LDB(B1, 0, 1); PG8_SCHED; PG8_LDA(At, 0, 0); PG8_STAGE(PG8_SA(1, 1), a1 + hstepA, voffA);
            PG8_WAIT_V(8); PG8_WAIT_L(0); PG8_BAR; PG8_MMA(0, 0, At, B0); PG8_MMA(0, 1, At, B1); PG8_BAR; PG8_SCHED;
            PG8_LDA(At, 0, 1); PG8_STAGE(PG8_SB(0, 0), b2, voffB); PG8_STAGE(PG8_SB(0, 1), b2 + hstepB, voffB); PG8_STAGE(PG8_SA(0, 0), a2, voffA);
            PG8_WAIT_V(8); PG8_WAIT_L(0); PG8_BAR; PG8_MMA(1, 0, At, B0); PG8_MMA(1, 1, At, B1); PG8_BAR; PG8_SCHED;
            PG8_LDB(B0, 1, 0); PG8_LDB(B1, 1, 1); PG8_SCHED; PG8_LDA(At, 1, 0); PG8_STAGE(PG8_SA(0, 1), a2 + hstepA, voffA);
            PG8_WAIT_V(8); PG8_WAIT_L(0); PG8_BAR; PG8_MMA(0, 0, At, B0); PG8_MMA(0, 1, At, B1); PG8_BAR; PG8_SCHED;
            PG8_LDA(At, 1, 1); PG8_STAGE(PG8_SB(1, 0), b3, voffB); PG8_STAGE(PG8_SB(1, 1), b3 + hstepB, voffB); PG8_STAGE(PG8_SA(1, 0), a3, voffA);
            PG8_WAIT_V(8); PG8_WAIT_L(0); PG8_BAR; PG8_MMA(1, 0, At, B0); PG8_MMA(1, 1, At, B1); PG8_BAR; PG8_SCHED;
        }
        if constexpr (ALIGN_EPI) { if (wr == 0) PG8_BAR; }
        E(acc, cur, wr, wc, fr, fq);
        if (!has_next) break;
#pragma unroll
        for (int a = 0; a < 2; ++a)
#pragma unroll
            for (int b = 0; b < 2; ++b)
#pragma unroll
                for (int m = 0; m < 4; ++m)
#pragma unroll
                    for (int n = 0; n < 2; ++n) acc[a][b][m][n] = (f32x4){0.f, 0.f, 0.f, 0.f};
        cur = nxt; cA = nA; cB = nB; ++ui;
        if constexpr (ALIGN_EPI) { if (wr == 1) PG8_BAR; }
    }
    PG8_WAIT_V(0);
    if constexpr (!ALIGN_EPI) { if (wr == 0) PG8_BAR; }
    PG8_BAR;
#undef PG8_SA
#undef PG8_SB
#undef PG8_STAGE
#undef PG8_LDA
#undef PG8_LDB
#undef PG8_MMA
#undef PG8_WAIT_V
#undef PG8_WAIT_L
#undef PG8_BAR
#undef PG8_SCHED
}

struct EpiStore {
    __device__ __forceinline__ void operator()(const f32x4 (&acc)[2][2][4][2], const UnitDesc& u, int wr, int wc, int fr, int fq) const {
#pragma unroll
        for (int ai = 0; ai < 2; ++ai)
#pragma unroll
            for (int m = 0; m < 4; ++m) { bf16_t* rowp = u.out + (size_t)(ai * HALF + wr * 64 + m * 16 + fr) * u.ldc + wc * 32 + 8 * fq;
#pragma unroll
                for (int bj = 0; bj < 2; ++bj) { const f32x4 v0 = acc[ai][bj][m][0], v1 = acc[ai][bj][m][1];
                    u32x4 w; w.x = pk2(v0[0], v0[1]); w.y = pk2(v0[2], v0[3]); w.z = pk2(v1[0], v1[1]); w.w = pk2(v1[2], v1[3]);
                    *(u32x4*)(rowp + bj * HALF) = w; } }
    }
};
__device__ __forceinline__ float swiglu1(float g, float u) { return g * u * __builtin_amdgcn_rcpf(1.0f + __builtin_amdgcn_exp2f(-1.4426950408889634f * g)); }
struct EpiSwiGLU {
    __device__ __forceinline__ void operator()(const f32x4 (&acc)[2][2][4][2], const UnitDesc& u, int wr, int wc, int fr, int fq) const {
#pragma unroll
        for (int ai = 0; ai < 2; ++ai)
#pragma unroll
            for (int m = 0; m < 4; ++m) { bf16_t* rowp = u.out + (size_t)(ai * HALF + wr * 64 + m * 16 + fr) * u.ldc + wc * 32 + 8 * fq;
                const f32x4 g0 = acc[ai][0][m][0], g1 = acc[ai][0][m][1], u0 = acc[ai][1][m][0], u1 = acc[ai][1][m][1];
                u32x4 w; w.x = pk2(swiglu1(g0[0], u0[0]), swiglu1(g0[1], u0[1])); w.y = pk2(swiglu1(g0[2], u0[2]), swiglu1(g0[3], u0[3]));
                w.z = pk2(swiglu1(g1[0], u1[0]), swiglu1(g1[1], u1[1])); w.w = pk2(swiglu1(g1[2], u1[2]), swiglu1(g1[3], u1[3]));
                *(u32x4*)rowp = w; }
    }
};
struct EpiQKV {
    bf16_t* Q; bf16_t* Kb; bf16_t* VT; float* ck; float* cv;
    __device__ __forceinline__ void operator()(const f32x4 (&acc)[2][2][4][2], const UnitDesc& u, int wr, int wc, int fr, int fq) const {
        const int pm = u.aux & 0xffff, pn = u.aux >> 16, sel = pn >> 2, ct = (pn & 3) * BM;
        const int row0 = pm * BM + wr * 64 + fr, col0 = ct + wc * 32 + 8 * fq;
        if (sel < 2) {
            bf16_t* base = sel == 0 ? Q : Kb;
#pragma unroll
            for (int ai = 0; ai < 2; ++ai)
#pragma unroll
                for (int m = 0; m < 4; ++m) { const size_t off = (size_t)(row0 + ai * HALF + m * 16) * D + col0;
#pragma unroll
                    for (int bj = 0; bj < 2; ++bj) { const f32x4 v0 = acc[ai][bj][m][0], v1 = acc[ai][bj][m][1];
                        u32x4 w; w.x = pk2(v0[0], v0[1]); w.y = pk2(v0[2], v0[3]); w.z = pk2(v1[0], v1[1]); w.w = pk2(v1[2], v1[3]);
                        *(u32x4*)(base + off + bj * HALF) = w;
                        if (sel == 1 && pm < NP / BM) { *(f32x4*)(ck + off + bj * HALF) = v0; *(f32x4*)(ck + off + bj * HALF + 4) = v1; } } }
        } else {
#pragma unroll
            for (int ai = 0; ai < 2; ++ai)
#pragma unroll
                for (int m = 0; m < 4; ++m) { const int row = row0 + ai * HALF + m * 16; const size_t off = (size_t)row * D + col0;
#pragma unroll
                    for (int bj = 0; bj < 2; ++bj) { const f32x4 v0 = acc[ai][bj][m][0], v1 = acc[ai][bj][m][1];
                        bf16_t* vt = VT + (size_t)(col0 + bj * HALF) * M + row;
                        const unsigned w0 = pk2(v0[0], v0[1]), w1 = pk2(v0[2], v0[3]), w2 = pk2(v1[0], v1[1]), w3 = pk2(v1[2], v1[3]);
                        vt[0] = (bf16_t)w0; vt[(size_t)M] = (bf16_t)(w0 >> 16); vt[(size_t)2 * M] = (bf16_t)w1; vt[(size_t)3 * M] = (bf16_t)(w1 >> 16);
                        vt[(size_t)4 * M] = (bf16_t)w2; vt[(size_t)5 * M] = (bf16_t)(w2 >> 16); vt[(size_t)6 * M] = (bf16_t)w3; vt[(size_t)7 * M] = (bf16_t)(w3 >> 16);
                        if (pm < NP / BM) { *(f32x4*)(cv + off + bj * HALF) = v0; *(f32x4*)(cv + off + bj * HALF + 4) = v1; } } }
        }
    }
};

struct GSched {
    int nM, nN, G, c; const char* A; size_t a_tile; const char* B; size_t b_tile; bf16_t* out; size_t o_pm, o_pn; int ldc;
    __device__ __forceinline__ bool next(int i, UnitDesc& u) const {
        const long L = (long)i * G + c; if (L >= (long)nM * nN) return false;
        int pm, pn; tile_order((int)L, nM, nN, pm, pn);
        u.A = A + (size_t)pm * a_tile; u.B = B + (size_t)pn * b_tile; u.out = out + (size_t)pm * o_pm + (size_t)pn * o_pn; u.ldc = ldc; u.aux = pm | (pn << 16); return true;
    }
};
struct ChDftSched {
    int G, c; const char* cs_tab; const char* H; bf16_t* ytp; bf16_t* yts;
    __device__ __forceinline__ bool next(int i, UnitDesc& u) const {
        const long L = (long)i * G + c; if (L >= 48 * 8) return false;
        int tok, gc; tile_order((int)L, 48, 8, tok, gc); const int g = gc >> 1, cs = gc & 1;
        u.A = cs_tab + (size_t)cs * 256 * 256 * 2; u.B = H + ((size_t)tok * 256 * D + g * 256) * 2;
        if (tok < 32) { u.out = ytp + ((size_t)(tok * D + g * 256) * 512 + cs * 256); u.ldc = 512; }
        else { const int idx = tok - 32, b = idx >> 3, s0 = (idx & 7) * 256; u.out = yts + ((size_t)(b * D + g * 256) * 4096 + cs * 2048 + s0); u.ldc = 4096; }
        u.aux = 0; return true;
    }
};
struct SeqSSched {
    int c; const char* ts; const char* yts; bf16_t* F;
    __device__ __forceinline__ bool next(int i, UnitDesc& u) const {
        if (i > 0 || c >= 64) return false;
        const int b = c >> 5, pm = (c >> 2) & 7, pn = c & 3;
        u.A = ts + (size_t)pm * 256 * 4096 * 2; u.B = yts + (size_t)(b * D + pn * 256) * 4096 * 2;
        u.out = F + ((size_t)(NP + b * SS + pm * 256) * D + pn * 256); u.ldc = D; u.aux = 0; return true;
    }
};
struct SeqPSched {
    int G, c; const char* tp; const char* ytp; bf16_t* F;
    __device__ __forceinline__ bool next(int i, UnitDesc& u) const {
        const int G2 = G - 64; if (c < 64 || G2 <= 0) return false;
        const long L = (long)i * G2 + (c - 64); if (L >= 128) return false;
        const int b = (int)L >> 2, pn = (int)L & 3;
        u.A = tp; u.B = ytp + (size_t)(b * D + pn * 256) * 512 * 2;
        u.out = F + ((size_t)(b * 256) * D + pn * 256); u.ldc = D; u.aux = 0; return true;
    }
};
}

__device__ __forceinline__ void transpose_item(const float* W, int N, bf16_t* WT, int ldt, int dst_row0, LAS float* scr, int k0, int n0, int lane) {
#pragma unroll 8
    for (int i = 0; i < 32; ++i) { const int kk = 2 * i + (lane >> 5); scr[kk * 33 + (lane & 31)] = W[(size_t)(k0 + kk) * N + n0 + (lane & 31)]; }
    asm volatile("s_waitcnt lgkmcnt(0)" ::: "memory");
    const int c = lane & 7;
#pragma unroll
    for (int j = 0; j < 4; ++j) { const int n = (lane >> 3) + 8 * j; const LAS float* s = scr + (8 * c) * 33 + n;
        u32x4 o; o.x = pk2(s[0 * 33], s[1 * 33]); o.y = pk2(s[2 * 33], s[3 * 33]); o.z = pk2(s[4 * 33], s[5 * 33]); o.w = pk2(s[6 * 33], s[7 * 33]);
        *(u32x4*)(WT + (size_t)(dst_row0 + n) * ldt + k0 + 8 * c) = o; }
    asm volatile("s_waitcnt lgkmcnt(0)" ::: "memory");
}

__device__ __forceinline__ void phase_prologue(const Params& p, LAS unsigned char* lds) {
    const int tid = threadIdx.x, lane = tid & 63, wave = tid >> 6, G = gridDim.x, bx = blockIdx.x;
    unsigned char* ws = p.ws;
    for (int item = bx; item < 192; item += G) {
        LAS float* sl = (LAS float*)lds;
        LAS float* red = (LAS float*)(lds + 12288);
        __syncthreads();
        for (int i = tid; i < 3072; i += 512) { const int cond = i >> 10, k = i & 1023; const float v = cond == 0 ? p.in[5][k] : p.in[2][(cond - 1) * D + k]; sl[i] = v / (1.0f + __expf(-v)); }
        __syncthreads();
        const int l = item / 96, n0 = (item % 96) * 64, kq = lane >> 4, c4 = lane & 15;
        const float* W = p.in[6] + (size_t)l * D * 6144 + n0 + 4 * c4;
        f32x4 a0 = {0.f, 0.f, 0.f, 0.f}, a1 = a0, a2 = a0;
#pragma unroll 8
        for (int it = 0; it < 32; ++it) { const int k = wave * 128 + it * 4 + kq; const f32x4 w = *(const f32x4*)(W + (size_t)k * 6144);
            a0 += sl[k] * w; a1 += sl[1024 + k] * w; a2 += sl[2048 + k] * w; }
#pragma unroll
        for (int j = 0; j < 4; ++j) { a0[j] += __shfl_xor(a0[j], 16); a0[j] += __shfl_xor(a0[j], 32); a1[j] += __shfl_xor(a1[j], 16); a1[j] += __shfl_xor(a1[j], 32); a2[j] += __shfl_xor(a2[j], 16); a2[j] += __shfl_xor(a2[j], 32); }
        if (kq == 0) {
#pragma unroll
            for (int j = 0; j < 4; ++j) { red[(wave * 3 + 0) * 64 + 4 * c4 + j] = a0[j]; red[(wave * 3 + 1) * 64 + 4 * c4 + j] = a1[j]; red[(wave * 3 + 2) * 64 + 4 * c4 + j] = a2[j]; } }
        __syncthreads();
        if (tid < 192) { const int cond = tid >> 6, n = tid & 63; float s = p.in[7][l * 6144 + n0 + n];
#pragma unroll
            for (int w = 0; w < 8; ++w) s += red[(w * 3 + cond) * 64 + n];
            ((float*)(ws + WS_MOD))[(l * 3 + cond) * 6144 + n0 + n] = s; }
    }
    __syncthreads();
    {
        LAS float* scr = (LAS float*)(lds + wave * 8448);
        const int gw = bx * 8 + wave, NGW = G * 8;
        constexpr int I_F = 16 * 32, I_QKV = 16 * 96, I_O = 16 * 32, I_G = 16 * 88, I_D = 44 * 32, I_CV = 8 * 32;
        constexpr int NITEMS = I_F + I_QKV + I_O + 4 * I_G + 2 * I_D + 2 * I_CV;
        for (int it = gw; it < NITEMS; it += NGW) {
            int r = it; const float* W; int N, ldt; bf16_t* WT; int mode = 0;
            if (r < I_F) { W = p.in[9]; N = D; ldt = D; WT = (bf16_t*)(ws + WS_WF); }
            else if ((r -= I_F) < I_QKV) { W = p.in[10]; N = 3 * D; ldt = D; WT = (bf16_t*)(ws + WS_WQKV); }
            else if ((r -= I_QKV) < I_O) { W = p.in[12]; N = D; ldt = D; WT = (bf16_t*)(ws + WS_WO); }
            else if ((r -= I_O) < 2 * I_G) { const int l = r / I_G; r -= l * I_G; W = p.in[13] + (size_t)l * D * FF; N = FF; ldt = D; WT = (bf16_t*)(ws + WS_WGU) + (size_t)l * 2 * FF * D; mode = 1; }
            else if ((r -= 2 * I_G) < 2 * I_G) { const int l = r / I_G; r -= l * I_G; W = p.in[14] + (size_t)l * D * FF; N = FF; ldt = D; WT = (bf16_t*)(ws + WS_WGU) + (size_t)l * 2 * FF * D; mode = 2; }
            else if ((r -= 2 * I_G) < 2 * I_D) { const int l = r / I_D; r -= l * I_D; W = p.in[15] + (size_t)l * FF * D; N = D; ldt = FF; WT = (bf16_t*)(ws + WS_WD) + (size_t)l * D * FF; }
            else { r -= 2 * I_D; const int b = r / I_CV; r -= b * I_CV; W = p.in[4] + (size_t)b * 512 * D; N = D; ldt = 512; WT = (bf16_t*)(ws + WS_VCT) + (size_t)b * D * 512; }
            const int nblk = N / 32, kb = r / nblk, nb = r % nblk, n0 = nb * 32;
            int dst = n0; if (mode) dst = (n0 >> 7) * 256 + (n0 & 127) + (mode == 2 ? 128 : 0);
            transpose_item(W, N, WT, ldt, dst, scr, kb * 64, n0, lane);
        }
    }
    {
        const int gt = bx * 512 + tid, GT = G * 512;
        for (int i = gt; i < 2 * 512 * D / 8; i += GT) { const f32x4 a = ((const f32x4*)p.in[3])[2 * i], b = ((const f32x4*)p.in[3])[2 * i + 1];
            u32x4 o; o.x = pk2(a[0], a[1]); o.y = pk2(a[2], a[3]); o.z = pk2(b[0], b[1]); o.w = pk2(b[2], b[3]); ((u32x4*)(ws + WS_KC))[i] = o; }
        for (int i = gt; i < 512 * 256 / 8; i += GT) { const int row = i >> 5, c0 = (i & 31) * 8, cs = row >> 8, m = row & 255; float v[8];
#pragma unroll
            for (int j = 0; j < 8; ++j) { const float a = (float)((m * (c0 + j)) & 255) * (1.0f / 128.0f); v[j] = cs ? sinpif(a) : cospif(a); }
            u32x4 o; o.x = pk2(v[0], v[1]); o.y = pk2(v[2], v[3]); o.z = pk2(v[4], v[5]); o.w = pk2(v[6], v[7]); ((u32x4*)(ws + WS_CSCH))[i] = o; }
        for (int i = gt; i < 256 * 512 / 8; i += GT) { const int k = i >> 6, c0 = (i & 63) * 8; float v[8];
#pragma unroll
            for (int j = 0; j < 8; ++j) { const int kk = c0 + j, s = kk & 255; const float a = (float)((k * s) & 255) * (1.0f / 128.0f); v[j] = kk < 256 ? cospif(a) : -sinpif(a); }
            u32x4 o; o.x = pk2(v[0], v[1]); o.y = pk2(v[2], v[3]); o.z = pk2(v[4], v[5]); o.w = pk2(v[6], v[7]); ((u32x4*)(ws + WS_TP))[i] = o; }
        for (int i = gt; i < 2048 * 4096 / 8; i += GT) { const int k = i >> 9, c0 = (i & 511) * 8; float v[8];
#pragma unroll
            for (int j = 0; j < 8; ++j) { const int kk = c0 + j, s = kk & 2047; const float a = (float)((k * s) & 2047) * (1.0f / 1024.0f); v[j] = kk < 2048 ? cospif(a) : -sinpif(a); }
            u32x4 o; o.x = pk2(v[0], v[1]); o.y = pk2(v[2], v[3]); o.z = pk2(v[4], v[5]); o.w = pk2(v[6], v[7]); ((u32x4*)(ws + WS_TS))[i] = o; }
    }
}

template <bool HAS_MP, bool HAS_NEXT>
__device__ __forceinline__ void row_phase(const float* xin_p, const float* xin_s, const bf16_t* mp, float* Xout, bf16_t* Hout,
                                          const float* gate, const float* gA, const float* gB, const float* sc, const float* sh) {
    const int tid = threadIdx.x, lane = tid & 63, gw = blockIdx.x * 8 + (tid >> 6), NGW = gridDim.x * 8;
    for (int row = gw; row < M; row += NGW) {
        const int cond = row < NP ? 0 : (row < NP + SS ? 1 : 2);
        const float* xr = row < NP ? xin_p + (size_t)row * D : xin_s + (size_t)(row - NP) * D;
        f32x4 v[4];
#pragma unroll
        for (int j = 0; j < 4; ++j) v[j] = *(const f32x4*)(xr + 4 * lane + 256 * j);
        if constexpr (HAS_MP) {
            f32x4 mv[4]; float s = 0.f;
#pragma unroll
            for (int j = 0; j < 4; ++j) { const u32x2 w = *(const u32x2*)(mp + (size_t)row * D + 4 * lane + 256 * j);
                mv[j] = (f32x4){bf_lo(w.x), bf_hi(w.x), bf_lo(w.y), bf_hi(w.y)}; s += (mv[j][0] * mv[j][0] + mv[j][1] * mv[j][1]) + (mv[j][2] * mv[j][2] + mv[j][3] * mv[j][3]); }
            const float rstd = 1.0f / sqrtf(wave_sum(s) * (1.0f / D) + 1e-6f);
#pragma unroll
            for (int j = 0; j < 4; ++j) { const f32x4 gt = *(const f32x4*)(gate + cond * 6144 + 4 * lane + 256 * j), ga = *(const f32x4*)(gA + 4 * lane + 256 * j);
                v[j] = v[j] + gt * (mv[j] * rstd * ga);
                *(f32x4*)(Xout + (size_t)row * D + 4 * lane + 256 * j) = v[j]; }
        }
        if constexpr (HAS_NEXT) {
            float s = 0.f;
#pragma unroll
            for (int j = 0; j < 4; ++j) s += (v[j][0] * v[j][0] + v[j][1] * v[j][1]) + (v[j][2] * v[j][2] + v[j][3] * v[j][3]);
            const float rstd = 1.0f / sqrtf(wave_sum(s) * (1.0f / D) + 1e-6f);
#pragma unroll
            for (int j = 0; j < 4; ++j) { const int col = 4 * lane + 256 * j;
                const f32x4 gb = *(const f32x4*)(gB + col), s1 = *(const f32x4*)(sc + cond * 6144 + col), s0 = *(const f32x4*)(sh + cond * 6144 + col);
                const f32x4 h = (v[j] * rstd * gb) * (1.0f + s1) + s0;
                u32x2 w; w.x = pk2(h[0], h[1]); w.y = pk2(h[2], h[3]); *(u32x2*)(Hout + (size_t)row * D + col) = w; }
        }
    }
}

__device__ __forceinline__ void attn_phase(const Params& p, LAS unsigned char* lds) {
    const int tid = threadIdx.x, lane = tid & 63, wave = __builtin_amdgcn_readfirstlane(tid >> 6), r = lane & 31, hh = lane >> 5;
    unsigned char* ws = p.ws;
    const bf16_t* Qb = (const bf16_t*)(ws + WS_Q); const bf16_t* Kb = (const bf16_t*)(ws + WS_K); const bf16_t* VT = (const bf16_t*)(ws + WS_VT);
    const bf16_t* Kc = (const bf16_t*)(ws + WS_KC); const bf16_t* VcT = (const bf16_t*)(ws + WS_VCT);
    bf16_t* Ob = (bf16_t*)(ws + WS_Q);
    LAS unsigned char* Kl = lds; LAS unsigned char* Vl = lds + 9216; LAS float* Bl = (LAS float*)(lds + 18432 + 512);
    const int srow = tid >> 3, sch = tid & 7, krho = (srow & ~12) | ((srow & 4) << 1) | ((srow & 8) >> 1);
    const float c2 = 0.125f * 1.4426950408889634f;
    for (int unit = blockIdx.x; unit < 768; unit += gridDim.x) {
        const bool is_na = unit < 256;
        int b, h, qtok, nt, jmin = 0, nloc = 0, rq = 0, half = 0, ktok0;
        if (is_na) { b = unit >> 7; h = (unit >> 3) & 15; const int r0 = (unit & 7) * 4; rq = r0 + (wave >> 1); half = wave & 1;
            jmin = min(max(r0 - 4, 0), 24); const int jmax = min(max(r0 - 1, 0), 24) + 7; nloc = jmax - jmin + 1; nt = nloc + 8;
            qtok = NP + b * SS + rq * 64 + half * 32 + r; ktok0 = NP + b * SS; }
        else { const int u2 = unit - 256; b = u2 >> 4; h = u2 & 15; nt = 4; qtok = b * SP + wave * 32 + r; ktok0 = b * SP; }
        const int rs = min(max(rq - 4, 0), 24);
        __syncthreads();
        if (is_na) { for (int i = tid; i < 15 * 32; i += 512) { const int rr = i >> 5, x = i & 31; Bl[i] = x < 31 ? p.in[11][(h * 15 + rr) * 31 + x] * 1.4426950408889634f : 0.f; } }
        bf16x8 qf[4];
#pragma unroll
        for (int d0 = 0; d0 < 4; ++d0) qf[d0] = *(const bf16x8*)(Qb + (size_t)qtok * D + h * HD + d0 * 16 + hh * 8);
        f32x16 o0, o1;
#pragma unroll
        for (int i = 0; i < 16; ++i) { o0[i] = 0.f; o1[i] = 0.f; }
        float m_run = -1e30f, l_run = 0.f;
        u32x4 kreg, vreg;
#define ATT_LOAD(t) do { const int t_ = (t); const bf16_t* kp; const bf16_t* vp; \
            if (is_na && t_ >= nloc) { const int key0 = (t_ - nloc) * 64; kp = Kc + ((size_t)(b * 512 + key0 + srow)) * D + h * HD + sch * 8; vp = VcT + ((size_t)(b * D + h * HD + srow)) * 512 + key0 + sch * 8; } \
            else { const int tok0 = ktok0 + (is_na ? (jmin + t_) * 64 : t_ * 64); kp = Kb + (size_t)(tok0 + srow) * D + h * HD + sch * 8; vp = VT + (size_t)(h * HD + srow) * M + tok0 + sch * 8; } \
            kreg = *(const u32x4*)kp; vreg = *(const u32x4*)vp; } while (0)
        ATT_LOAD(0);
        for (int t = 0; t < nt; ++t) {
            __syncthreads();
            *(LAS u32x4*)(Kl + krho * 144 + sch * 16) = kreg; *(LAS u32x4*)(Vl + srow * 144 + sch * 16) = vreg;
            __syncthreads();
            if (t + 1 < nt) ATT_LOAD(t + 1);
            const bool local = is_na && t < nloc; const int j = jmin + t;
            if (local && (j < rs || j >= rs + 8)) continue;
            f32x16 p0, p1;
#pragma unroll
            for (int i = 0; i < 16; ++i) { p0[i] = 0.f; p1[i] = 0.f; }
#pragma unroll
            for (int d0 = 0; d0 < 4; ++d0) { const bf16x8 a0 = *(const LAS bf16x8*)(Kl + r * 144 + d0 * 32 + hh * 16), a1 = *(const LAS bf16x8*)(Kl + (32 + r) * 144 + d0 * 32 + hh * 16);
                p0 = __builtin_amdgcn_mfma_f32_32x32x16_bf16(a0, qf[d0], p0, 0, 0, 0); p1 = __builtin_amdgcn_mfma_f32_32x32x16_bf16(a1, qf[d0], p1, 0, 0, 0); }
            if (local) {
                const int qc = half * 32 + r, cs = min(max(qc - 8, 0), 48);
                const LAS float* bp = Bl + (j - rq + 7) * 32 + 8 * hh - qc + 15;
#pragma unroll
                for (int i = 0; i < 16; ++i) { const int kc = 16 * (i >> 3) + (i & 7);
                    const float b0 = bp[kc], b1 = bp[kc + 32];
                    const bool v0 = (unsigned)(kc + 8 * hh - cs) < 16u, v1 = (unsigned)(kc + 32 + 8 * hh - cs) < 16u;
                    p0[i] = v0 ? p0[i] * c2 + b0 : -1e30f; p1[i] = v1 ? p1[i] * c2 + b1 : -1e30f; }
            } else {
#pragma unroll
                for (int i = 0; i < 16; ++i) { p0[i] *= c2; p1[i] *= c2; }
            }
            float mt = fmaxf(p0[0], p1[0]);
#pragma unroll
            for (int i = 1; i < 16; ++i) mt = fmaxf(mt, fmaxf(p0[i], p1[i]));
            mt = fmaxf(mt, __shfl_xor(mt, 32));
            const float m_new = fmaxf(m_run, mt), alpha = __builtin_amdgcn_exp2f(m_run - m_new);
            m_run = m_new;
            float ls = 0.f;
#pragma unroll
            for (int i = 0; i < 16; ++i) { p0[i] = __builtin_amdgcn_exp2f(p0[i] - m_new); p1[i] = __builtin_amdgcn_exp2f(p1[i] - m_new); ls += p0[i] + p1[i]; }
            l_run = l_run * alpha + ls;
#pragma unroll
            for (int i = 0; i < 16; ++i) { o0[i] *= alpha; o1[i] *= alpha; }
            bf16x8 pa[4];
#pragma unroll
            for (int s = 0; s < 2; ++s) { u32x4 w; w.x = pk2(p0[8 * s], p0[8 * s + 1]); w.y = pk2(p0[8 * s + 2], p0[8 * s + 3]); w.z = pk2(p0[8 * s + 4], p0[8 * s + 5]); w.w = pk2(p0[8 * s + 6], p0[8 * s + 7]); pa[s] = __builtin_bit_cast(bf16x8, w);
                u32x4 w2; w2.x = pk2(p1[8 * s], p1[8 * s + 1]); w2.y = pk2(p1[8 * s + 2], p1[8 * s + 3]); w2.z = pk2(p1[8 * s + 4], p1[8 * s + 5]); w2.w = pk2(p1[8 * s + 6], p1[8 * s + 7]); pa[2 + s] = __builtin_bit_cast(bf16x8, w2); }
#pragma unroll
            for (int s = 0; s < 4; ++s) { const bf16x8 v0 = *(const LAS bf16x8*)(Vl + r * 144 + s * 32 + hh * 16), v1 = *(const LAS bf16x8*)(Vl + (32 + r) * 144 + s * 32 + hh * 16);
                o0 = __builtin_amdgcn_mfma_f32_32x32x16_bf16(v0, pa[s], o0, 0, 0, 0); o1 = __builtin_amdgcn_mfma_f32_32x32x16_bf16(v1, pa[s], o1, 0, 0, 0); }
        }
#undef ATT_LOAD
        const float inv = 1.0f / (l_run + __shfl_xor(l_run, 32));
        bf16_t* orow = Ob + (size_t)qtok * D + h * HD + 4 * hh;
#pragma unroll
        for (int g = 0; g < 4; ++g) { u32x2 w; w.x = pk2(o0[4 * g] * inv, o0[4 * g + 1] * inv); w.y = pk2(o0[4 * g + 2] * inv, o0[4 * g + 3] * inv); *(u32x2*)(orow + 8 * g) = w;
            u32x2 w2; w2.x = pk2(o1[4 * g] * inv, o1[4 * g + 1] * inv); w2.y = pk2(o1[4 * g + 2] * inv, o1[4 * g + 3] * inv); *(u32x2*)(orow + 32 + 8 * g) = w2; }
    }
    __syncthreads();
}


#define XB_TMO      128
#define XB_XCNT(j)  (256  + 64 * (j))
#define XB_XSUB(j)  (1280 + 64 * (j))
#define XB_XGEN(j)  (2304 + 64 * (j))
#define XB_TOP      3328
#define XB_TOPGEN   3392
#define XCD_BAR_WORDS 3456
#define XB_SPIN_CAP (1u << 18)
__device__ __forceinline__ unsigned xb_ld(unsigned* p)              { return __hip_atomic_load(p, __ATOMIC_RELAXED, __HIP_MEMORY_SCOPE_AGENT); }
__device__ __forceinline__ unsigned xb_add(unsigned* p, unsigned v) { return __hip_atomic_fetch_add(p, v, __ATOMIC_RELAXED, __HIP_MEMORY_SCOPE_AGENT); }
__device__ __forceinline__ unsigned xb_xcc_id() { return (unsigned)__builtin_amdgcn_s_getreg((3 << 11) | 20) & 0xFu; }
#define XB_SPIN(cond, bar) do { unsigned _sp = 0; while (cond) { __builtin_amdgcn_s_sleep(1); \
    if ((++_sp & 255u) == 0u) { if (xb_ld(&(bar)[XB_TMO])) break; if (_sp > XB_SPIN_CAP) { atomicAdd(&(bar)[XB_TMO], 1u); break; } } } } while (0)
struct XcdBarrier { unsigned* bar; unsigned x; volatile LAS unsigned* st; };
__device__ __forceinline__ XcdBarrier xcd_barrier_post(unsigned* bar, volatile LAS unsigned* st) {
    XcdBarrier b; b.bar = bar; b.x = xb_xcc_id(); b.st = st;
    if (threadIdx.x == 0) (void)xb_add(&bar[XB_XCNT(b.x)], 1u);
    return b;
}
__device__ __forceinline__ void xcd_barrier_complete(unsigned* bar, unsigned x, unsigned& nloc, unsigned& nx) {
    const unsigned G = gridDim.x * gridDim.y * gridDim.z;
    unsigned sum, cnt, mine, sp = 0u;
    for (;;) {
        sum = 0u; cnt = 0u; mine = 0u;
#pragma unroll
        for (unsigned j = 0; j < 16; ++j) { const unsigned c = xb_ld(&bar[XB_XCNT(j)]); sum += c; cnt += (c > 0u) ? 1u : 0u; mine = (j == x) ? c : mine; }
        if (sum == G) break;
        __builtin_amdgcn_s_sleep(1);
        if ((++sp & 255u) == 0u) { if (xb_ld(&bar[XB_TMO])) break; if (sp > XB_SPIN_CAP) { atomicAdd(&bar[XB_TMO], 1u); break; } }
    }
    nloc = mine > 0u ? mine : 1u; nx = cnt > 0u ? cnt : 1u;
}
__device__ __forceinline__ void xcd_barrier(const XcdBarrier& b) {
    asm volatile("s_waitcnt vmcnt(0)" ::: "memory");
    __syncthreads();
    if (threadIdx.x == 0) {
        unsigned* bar = b.bar;
        __builtin_amdgcn_s_waitcnt(0);
        unsigned nloc = b.st[0], nx = b.st[1];
        if (nloc == 0u) { xcd_barrier_complete(bar, b.x, nloc, nx); b.st[0] = nloc; b.st[1] = nx; }
        const unsigned old = xb_add(&bar[XB_XSUB(b.x)], 1u);
        const unsigned gen = old / nloc;
        if (old + 1u == (gen + 1u) * nloc) {
            __builtin_amdgcn_fence(__ATOMIC_RELEASE, "agent");
            asm volatile("s_waitcnt vmcnt(0)" ::: "memory");
            const unsigned og = xb_add(&bar[XB_TOP], 1u);
            const unsigned tg = og / nx;
            if (og + 1u == (tg + 1u) * nx) xb_add(&bar[XB_TOPGEN], 1u);
            else XB_SPIN(xb_ld(&bar[XB_TOPGEN]) == tg, bar);
            __builtin_amdgcn_fence(__ATOMIC_ACQUIRE, "agent");
            xb_add(&bar[XB_XGEN(b.x)], 1u);
            asm volatile("s_waitcnt vmcnt(0)" ::: "memory");
        } else {
            XB_SPIN(xb_ld(&bar[XB_XGEN(b.x)]) == gen, bar);
            __builtin_amdgcn_fence(__ATOMIC_ACQUIRE, "agent");
            asm volatile("s_waitcnt vmcnt(0)" ::: "memory");
        }
    }
    __syncthreads();
}

__global__ void __launch_bounds__(512, 2) mega_fwd(Params p) {
    extern __shared__ __attribute__((aligned(16))) unsigned char lds_raw[];
    LAS unsigned char* lds = (LAS unsigned char*)lds_raw;
    unsigned char* ws = p.ws;
    const int G = gridDim.x, c = blockIdx.x, lo = p.ph_lo, hi = p.ph_hi;
    const float* mod = (const float*)(ws + WS_MOD);
    const float* norm_g = p.in[8];
    bf16_t* H = (bf16_t*)(ws + WS_H); bf16_t* MPb = (bf16_t*)(ws + WS_MP); bf16_t* U = (bf16_t*)(ws + WS_U);
    float* X = p.out + OUT_X;
    volatile LAS unsigned* MISC = (volatile LAS unsigned*)(lds + 131072 + 320);
    if (threadIdx.x < 32) MISC[threadIdx.x] = 0u;
    __syncthreads();
    XcdBarrier bar; bar.bar = (unsigned*)(ws + WS_CTL); bar.x = 0; bar.st = nullptr;
    if (hi - lo > 1) bar = xcd_barrier_post((unsigned*)(ws + WS_CTL), MISC + 8);
    if (hi > 1000) cg::this_grid().sync();
#ifndef PH_MASK
#define PH_MASK 0xffff
#endif
#define IN(k) (((PH_MASK >> (k)) & 1) && lo <= (k) && (k) < hi)
#ifndef PROBE_REP
#define PROBE_REP -1
#endif
#ifndef PROBE_SYNC2
#define PROBE_SYNC2 0
#endif
#define REPS(k) for (int rep_ = 0; rep_ < ((k) == PROBE_REP ? 2 : 1); ++rep_)
#define SEAM(k) do { if ((k) + 1 < hi) { xcd_barrier(bar); if (PROBE_SYNC2) xcd_barrier(bar); } } while (0)

    if (IN(0)) { REPS(0) { phase_prologue(p, lds); } SEAM(0); }
    if (IN(1)) { REPS(1) {
        row_phase<false, true>(p.in[0], p.in[1], nullptr, nullptr, H, nullptr, nullptr, norm_g, mod + 1 * D, mod + 0 * D);
        } SEAM(1);
    }
    if (IN(2)) { REPS(2) {
        pg8::ChDftSched S{G, c, (const char*)(ws + WS_CSCH), (const char*)H, (bf16_t*)(ws + WS_YTP), (bf16_t*)(ws + WS_YTS)};
        pg8::gemm_phase<pg8::EpiStore, pg8::ChDftSched, true>(lds, 256, D, 256, S, pg8::EpiStore{});
        } SEAM(2);
    }
    if (IN(3)) { REPS(3) {
        { pg8::SeqSSched S{c, (const char*)(ws + WS_TS), (const char*)(ws + WS_YTS), (bf16_t*)(ws + WS_F)};
          pg8::gemm_phase<pg8::EpiStore, pg8::SeqSSched, true>(lds, 4096, 4096, 4096, S, pg8::EpiStore{}); }
        { pg8::SeqPSched S{G, c, (const char*)(ws + WS_TP), (const char*)(ws + WS_YTP), (bf16_t*)(ws + WS_F)};
          pg8::gemm_phase<pg8::EpiStore, pg8::SeqPSched, true>(lds, 512, 512, 512, S, pg8::EpiStore{}); }
        } SEAM(3);
    }
    if (IN(4)) { REPS(4) {
        pg8::GSched S{48, 4, G, c, (const char*)(ws + WS_F), (size_t)256 * D * 2, (const char*)(ws + WS_WF), (size_t)256 * D * 2, MPb, (size_t)256 * D, 256, D};
        pg8::gemm_phase<pg8::EpiStore, pg8::GSched, true>(lds, D, D, D, S, pg8::EpiStore{});
        } SEAM(4);
    }
    if (IN(5)) { REPS(5) {
        row_phase<true, true>(p.in[0], p.in[1], MPb, X, H, mod + 2 * D, norm_g + 1 * D, norm_g + 2 * D, mod + 4 * D, mod + 3 * D);
        } SEAM(5);
    }
    if (IN(6)) { REPS(6) {
        pg8::GSched S{48, 22, G, c, (const char*)H, (size_t)256 * D * 2, (const char*)(ws + WS_WGU), (size_t)256 * D * 2, U, (size_t)256 * FF, 128, FF};
        pg8::gemm_phase<pg8::EpiSwiGLU, pg8::GSched, true>(lds, D, D, D, S, pg8::EpiSwiGLU{});
        } SEAM(6);
    }
    if (IN(7)) { REPS(7) {
        pg8::GSched S{48, 4, G, c, (const char*)U, (size_t)256 * FF * 2, (const char*)(ws + WS_WD), (size_t)256 * FF * 2, MPb, (size_t)256 * D, 256, D};
        pg8::gemm_phase<pg8::EpiStore, pg8::GSched, true>(lds, FF, FF, FF, S, pg8::EpiStore{});
        } SEAM(7);
    }
    if (IN(8)) { REPS(8) {
        row_phase<true, true>(X, X + (size_t)NP * D, MPb, X, H, mod + 5 * D, norm_g + 3 * D, norm_g + 4 * D, mod + 3 * 6144 + 1 * D, mod + 3 * 6144 + 0 * D);
        } SEAM(8);
    }
    if (IN(9)) { REPS(9) {
        pg8::GSched S{48, 12, G, c, (const char*)H, (size_t)256 * D * 2, (const char*)(ws + WS_WQKV), (size_t)256 * D * 2, nullptr, 0, 0, D};
        pg8::EpiQKV E{(bf16_t*)(ws + WS_Q), (bf16_t*)(ws + WS_K), (bf16_t*)(ws + WS_VT), p.out + OUT_CK, p.out + OUT_CV};
        pg8::gemm_phase<pg8::EpiQKV, pg8::GSched, true>(lds, D, D, D, S, E);
        } SEAM(9);
    }
    if (IN(10)) { REPS(10) { attn_phase(p, lds); } SEAM(10); }
    if (IN(11)) { REPS(11) {
        pg8::GSched S{48, 4, G, c, (const char*)(ws + WS_Q), (size_t)256 * D * 2, (const char*)(ws + WS_WO), (size_t)256 * D * 2, MPb, (size_t)256 * D, 256, D};
        pg8::gemm_phase<pg8::EpiStore, pg8::GSched, true>(lds, D, D, D, S, pg8::EpiStore{});
        } SEAM(11);
    }
    if (IN(12)) { REPS(12) {
        row_phase<true, true>(X, X + (size_t)NP * D, MPb, X, H, mod + 3 * 6144 + 2 * D, norm_g + 5 * D, norm_g + 6 * D, mod + 3 * 6144 + 4 * D, mod + 3 * 6144 + 3 * D);
        } SEAM(12);
    }
    if (IN(13)) { REPS(13) {
        pg8::GSched S{48, 22, G, c, (const char*)H, (size_t)256 * D * 2, (const char*)(ws + WS_WGU) + (size_t)2 * FF * D * 2, (size_t)256 * D * 2, U, (size_t)256 * FF, 128, FF};
        pg8::gemm_phase<pg8::EpiSwiGLU, pg8::GSched, true>(lds, D, D, D, S, pg8::EpiSwiGLU{});
        } SEAM(13);
    }
    if (IN(14)) { REPS(14) {
        pg8::GSched S{48, 4, G, c, (const char*)U, (size_t)256 * FF * 2, (const char*)(ws + WS_WD) + (size_t)D * FF * 2, (size_t)256 * FF * 2, MPb, (size_t)256 * D, 256, D};
        pg8::gemm_phase<pg8::EpiStore, pg8::GSched, true>(lds, FF, FF, FF, S, pg8::EpiStore{});
        } SEAM(14);
    }
    if (IN(15)) { REPS(15) {
        row_phase<true, false>(X, X + (size_t)NP * D, MPb, X, nullptr, mod + 3 * 6144 + 5 * D, norm_g + 7 * D, nullptr, nullptr, nullptr); }
    }
#undef IN
#undef SEAM
}

constexpr int LDS_BYTES = 147456;
extern "C" void kernel_launch(void* const* d_in, const int* in_sizes, int n_in, void* d_out, int out_size, void* d_ws, size_t ws_size, hipStream_t stream) {
    static int grid = 0;
    if (grid == 0) {
        int dev = 0, cus = 0, per_cu = 0;
        hipGetDevice(&dev);
        hipDeviceGetAttribute(&cus, hipDeviceAttributeMultiprocessorCount, dev);
        if (hipFuncSetAttribute((const void*)mega_fwd, hipFuncAttributeMaxDynamicSharedMemorySize, LDS_BYTES) != hipSuccess) fprintf(stderr, "kernel_launch: hipFuncSetAttribute failed\n");
        if (hipOccupancyMaxActiveBlocksPerMultiprocessor(&per_cu, (const void*)mega_fwd, 512, LDS_BYTES) != hipSuccess || per_cu < 1) { fprintf(stderr, "kernel_launch: occupancy query says %d\n", per_cu); per_cu = 1; }
        (void)hipGetLastError();
        grid = cus * 1;
        if (n_in != 16 || ws_size < WS_END) { fprintf(stderr, "kernel_launch: unexpected n_in %d / ws %zu\n", n_in, ws_size); }
    }
    Params p{};
    if (MK_N_LAUNCHES == 1) (void)hipMemsetAsync((unsigned char*)d_ws + WS_CTL, 0, CTL_BYTES, stream);
    for (int i = 0; i < 16; ++i) p.in[i] = (const float*)d_in[i];
    p.out = (float*)d_out; p.ws = (unsigned char*)d_ws;
    if (MK_N_LAUNCHES == 1) {
        p.ph_lo = 0; p.ph_hi = NPHASE;
        void* args[] = {&p};
        hipError_t e = hipLaunchCooperativeKernel((const void*)mega_fwd, dim3(grid), dim3(512), args, LDS_BYTES, stream);
        if (e != hipSuccess) fprintf(stderr, "cooperative launch failed: %s (grid %d)\n", hipGetErrorString(e), grid);
    } else {
        for (int k = 0; k < NPHASE; ++k) { p.ph_lo = k; p.ph_hi = k + 1; hipLaunchKernelGGL(mega_fwd, dim3(grid), dim3(512), LDS_BYTES, stream, p); }
    }
}
```

```cpp
#include <hip/hip_runtime.h>
#include <hip/hip_cooperative_groups.h>
#include <cstdio>
#include <cstdint>
namespace cg = cooperative_groups;

#ifndef MK_N_LAUNCHES
#define MK_N_LAUNCHES 1
#endif

#define LAS __attribute__((address_space(3)))
typedef unsigned short bf16_t;
typedef short bf16x8 __attribute__((ext_vector_type(8)));
typedef float f32x2 __attribute__((ext_vector_type(2)));
typedef float f32x4 __attribute__((ext_vector_type(4)));
typedef float f32x16 __attribute__((ext_vector_type(16)));
typedef unsigned u32x2 __attribute__((ext_vector_type(2)));
typedef unsigned u32x4 __attribute__((ext_vector_type(4)));
typedef __bf16 bf16x2_t __attribute__((ext_vector_type(2)));

constexpr int D = 1024, NP = 8192, NS = 4096, M = NP + NS, SP = 256, SS = 2048, FF = 2816, NH = 16, HD = 64;
constexpr int NPHASE = 16;
constexpr size_t MiB = 1u << 20;
constexpr size_t WS_CTL = 160 * 1024, CTL_BYTES = 16 * 1024;
constexpr size_t WS_MOD = 0, WS_CSCH = 256 * 1024, WS_TP = 512 * 1024, WS_WF = 1 * MiB, WS_WQKV = 3 * MiB,
                 WS_WO = 9 * MiB, WS_WGU = 11 * MiB, WS_WD = 33 * MiB, WS_H = 44 * MiB, WS_MP = 68 * MiB, WS_U = 92 * MiB, WS_R = 158 * MiB;
constexpr size_t WS_YTP = WS_U, WS_YTS = WS_U + 32 * MiB;
constexpr size_t WS_TS = WS_R, WS_F = WS_R + 16 * MiB;
constexpr size_t WS_Q = WS_R, WS_K = WS_R + 24 * MiB, WS_VT = WS_R + 48 * MiB;
constexpr size_t WS_XB = WS_R + 72 * MiB, WS_END = WS_XB + 24 * MiB;
constexpr size_t OUTB_KC = 0, OUTB_VC = 2 * MiB;
constexpr size_t OUT_X = 0, OUT_CK = (size_t)M * D, OUT_CV = OUT_CK + (size_t)NP * D;

struct Params {
    const float* in[16];
    float* out; unsigned char* ws;
    int ph_lo, ph_hi;
};

__device__ __forceinline__ unsigned pk2(float lo, float hi) { f32x2 v = {lo, hi}; bf16x2_t b = __builtin_convertvector(v, bf16x2_t); return __builtin_bit_cast(unsigned, b); }
__device__ __forceinline__ float bf_lo(unsigned w) { return __uint_as_float(w << 16); }
__device__ __forceinline__ float bf_hi(unsigned w) { return __uint_as_float(w & 0xffff0000u); }
__device__ __forceinline__ float wave_sum(float v) {
#pragma unroll
    for (int o = 1; o < 64; o <<= 1) v += __shfl_xor(v, o);
    return v;
}

namespace pg8 {
constexpr int BM = 256, BK = 64, HALF = 128, HTB = HALF * BK * 2, STAGE_BYTES = 8 * HTB;
__device__ __forceinline__ int lds_byte(int r, int c) { const int st = (r >> 4) * 2 + (c >> 5), rr = r & 15, cc = c & 31, ob = rr * 64 + cc * 2; return st * 1024 + (ob ^ (((ob >> 9) & 1) << 5)); }
__device__ __forceinline__ void stage_rc(int b, int& R, int& C) { const int st = b / 1024, sb = b % 1024, swz = sb ^ (((sb >> 9) & 1) << 5); R = (st >> 1) * 16 + swz / 64; C = (st & 1) * 32 + (swz % 64) / 2; }
__device__ __forceinline__ int perm32(int rho) { const int n = rho >> 4, i = rho & 15; return 8 * (i >> 2) + 4 * n + (i & 3); }

struct UnitDesc { const char* A; const char* B; bf16_t* out; int ldc; int aux; };

__device__ __forceinline__ void tile_order(int L, int nM, int nN, int& pm, int& pn) {
    const int nwg = nM * nN; int wgid = L;
    { const int q = nwg / 8, r = nwg % 8, xcd = wgid % 8, off = wgid / 8; wgid = (xcd < r ? xcd * (q + 1) : r * (q + 1) + (xcd - r) * q) + off; }
    const int nig = 8 * nN, gid = wgid / nig, fm = gid * 8, gsz = (nM - fm) < 8 ? (nM - fm) : 8;
    pm = fm + ((wgid % nig) % gsz); pn = (wgid % nig) / gsz;
}

template <class Epi, class Sched, bool ALIGN_EPI>
__device__ __forceinline__ void gemm_phase(LAS unsigned char* lds, const int lda, const int ldb, const int K, const Sched& S, const Epi& E) {
    const int tid = threadIdx.x, wid = __builtin_amdgcn_readfirstlane(tid >> 6), lane = tid & 63, wr = wid >> 2, wc = wid & 3, fr = lane & 15, fq = lane >> 4;
    const int nt = K / BK;
    unsigned voffA[2], voffB[2];
#pragma unroll
    for (int i = 0; i < 2; ++i) { int R, C; stage_rc(tid * 16 + i * 8192, R, C); const int Rb = (R & ~31) + perm32(R & 31);
        voffA[i] = (unsigned)(R * lda + C) * 2u; voffB[i] = (unsigned)(Rb * ldb + C) * 2u; }
    const size_t kstep = (size_t)(BK * 2);
    const size_t hstepA = (size_t)HALF * lda * 2, hstepB = (size_t)HALF * ldb * 2;
    const unsigned ldsw = (unsigned)wid * 1024u;
    const int aoff = lds_byte(wr * 64 + fr, fq * 8), boff = lds_byte(wc * 32 + fr, fq * 8);
#define PG8_SA(b, h) (((b) * 2 + (h)) * HTB)
#define PG8_SB(b, h) ((4 + (b) * 2 + (h)) * HTB)
#define PG8_STAGE(bufoff, gbase, voff) do { _Pragma("unroll") for (int _i = 0; _i < 2; ++_i) \
        __builtin_amdgcn_global_load_lds((const unsigned*)((const char*)(gbase) + (voff)[_i]), (LAS unsigned*)(lds + (bufoff) + ldsw + _i * 8192), 16, 0, 0); } while (0)
#define PG8_LDA(dst, b, h) do { _Pragma("unroll") for (int m = 0; m < 4; ++m) _Pragma("unroll") for (int k = 0; k < 2; ++k) dst[m][k] = *(const LAS bf16x8*)(lds + PG8_SA(b, h) + aoff + m * 2048 + k * 1024); } while (0)
#define PG8_LDB(dst, b, h) do { _Pragma("unroll") for (int n = 0; n < 2; ++n) _Pragma("unroll") for (int k = 0; k < 2; ++k) dst[n][k] = *(const LAS bf16x8*)(lds + PG8_SB(b, h) + boff + n * 2048 + k * 1024); } while (0)
#define PG8_MMA(ai, bj, At, Bt) do { __builtin_amdgcn_s_setprio(1); _Pragma("unroll") for (int m = 0; m < 4; ++m) _Pragma("unroll") for (int n = 0; n < 2; ++n) _Pragma("unroll") for (int k = 0; k < 2; ++k) \
        acc[ai][bj][m][n] = __builtin_amdgcn_mfma_f32_16x16x32_bf16(Bt[n][k], At[m][k], acc[ai][bj][m][n], 0, 0, 0); __builtin_amdgcn_s_setprio(0); } while (0)
#define PG8_WAIT_V(n) asm volatile("s_waitcnt vmcnt(" #n ")" ::: "memory")
#define PG8_WAIT_L(n) asm volatile("s_waitcnt lgkmcnt(" #n ")" ::: "memory")
#define PG8_BAR __builtin_amdgcn_s_barrier()
#define PG8_SCHED __builtin_amdgcn_sched_barrier(0)
    UnitDesc cur, nxt; int ui = 0;
    if (!S.next(0, cur)) return;
    f32x4 acc[2][2][4][2];
#pragma unroll
    for (int a = 0; a < 2; ++a)
#pragma unroll
        for (int b = 0; b < 2; ++b)
#pragma unroll
            for (int m = 0; m < 4; ++m)
#pragma unroll
                for (int n = 0; n < 2; ++n) acc[a][b][m][n] = (f32x4){0.f, 0.f, 0.f, 0.f};
    bf16x8 At[4][2], B0[2][2], B1[2][2];
    const char* cA = cur.A; const char* cB = cur.B;
    PG8_STAGE(PG8_SB(0, 0), cB, voffB); PG8_STAGE(PG8_SB(0, 1), cB + hstepB, voffB); PG8_STAGE(PG8_SA(0, 0), cA, voffA); PG8_STAGE(PG8_SA(0, 1), cA + hstepA, voffA);
    if (wr == 1) PG8_BAR;
    PG8_WAIT_V(2); PG8_BAR;
    PG8_STAGE(PG8_SB(1, 0), cB + kstep, voffB); PG8_STAGE(PG8_SA(1, 0), cA + kstep, voffA); PG8_STAGE(PG8_SB(1, 1), cB + hstepB + kstep, voffB);
    PG8_WAIT_V(6); PG8_BAR;
    for (;;) {
        const bool has_next = S.next(ui + 1, nxt);
        const char* nA = has_next ? nxt.A : cA; const char* nB = has_next ? nxt.B : cB;
#pragma unroll 1
        for (int t = 0; t < nt; t += 2) {
            const bool last = (t == nt - 2);
            const char* a1 = cA + (size_t)(t + 1) * kstep;
            const char* a2 = last ? nA : cA + (size_t)(t + 2) * kstep; const char* b2 = last ? nB : cB + (size_t)(t + 2) * kstep;
            const char* a3 = a2 + kstep; const char* b3 = b2 + kstep;
            PG8_LDB(B0, 0, 0); PG8_LDB(B1, 0, 1); PG8_SCHED; PG8_LDA(At, 0, 0); PG8_STAGE(PG8_SA(1, 1), a1 + hstepA, voffA);
            PG8_WAIT_V(8); PG8_WAIT_L(0); PG8_BAR; PG8_MMA(0, 0, At, B0); PG8_MMA(0, 1, At, B1); PG8_BAR; PG8_SCHED;
            PG8_LDA(At, 0, 1); PG8_STAGE(PG8_SB(0, 0), b2, voffB); PG8_STAGE(PG8_SB(0, 1), b2 + hstepB, voffB); PG8_STAGE(PG8_SA(0, 0), a2, voffA);
            PG8_WAIT_V(8); PG8_WAIT_L(0); PG8_BAR; PG8_MMA(1, 0, At, B0); PG8_MMA(1, 1, At, B1); PG8_BAR; PG8_SCHED;
            PG8_LDB(B0, 1, 0); PG8_LDB(B1, 1, 1); PG8_SCHED; PG8_LDA(At, 1, 0); PG8_STAGE(PG8_SA(0, 1), a2 + hstepA, voffA);
            PG8_WAIT_V(8); PG8_WAIT_L(0); PG8_BAR; PG8_MMA(0, 0, At, B0); PG8_MMA(0, 1, At, B1); PG8_BAR; PG8_SCHED;
            PG8_LDA(At, 1, 1); PG8_STAGE(PG8_SB(1, 0), b3, voffB); PG8_STAGE(PG8_SB(1, 1), b3 + hstepB, voffB); PG8_STAGE(PG8_SA(1, 0), a3, voffA);
            PG8_WAIT_V(8); PG8_WAIT_L(0); PG8_BAR; PG8_MMA(1, 0, At, B0); PG8_MMA(1, 1, At, B1); PG8_BAR; PG8_SCHED;
        }
        if constexpr (ALIGN_EPI) { if (wr == 0) PG8_BAR; }
        E(acc, cur, wr, wc, fr, fq);
        if (!has_next) break;
#pragma unroll
        for (int a = 0; a < 2; ++a)
#pragma unroll
            for (int b = 0; b < 2; ++b)
#pragma unroll
                for (int m = 0; m < 4; ++m)
#pragma unroll
                    for (int n = 0; n < 2; ++n) acc[a][b][m][n] = (f32x4){0.f, 0.f, 0.f, 0.f};
        cur = nxt; cA = nA; cB = nB; ++ui;
        if constexpr (ALIGN_EPI) { if (wr == 1) PG8_BAR; }
    }
    PG8_WAIT_V(0);
    if constexpr (!ALIGN_EPI) { if (wr == 0) PG8_BAR; }
    PG8_BAR;
#undef PG8_SA
#undef PG8_SB
#undef PG8_STAGE
#undef PG8_LDA
#undef PG8_LDB
#undef PG8_MMA
#undef PG8_WAIT_V
#undef PG8_WAIT_L
#undef PG8_BAR
#undef PG8_SCHED
}

struct EpiStore {
    __device__ __forceinline__ void operator()(const f32x4 (&acc)[2][2][4][2], const UnitDesc& u, int wr, int wc, int fr, int fq) const {
#pragma unroll
        for (int ai = 0; ai < 2; ++ai)
#pragma unroll
            for (int m = 0; m < 4; ++m) { bf16_t* rowp = u.out + (size_t)(ai * HALF + wr * 64 + m * 16 + fr) * u.ldc + wc * 32 + 8 * fq;
#pragma unroll
                for (int bj = 0; bj < 2; ++bj) { const f32x4 v0 = acc[ai][bj][m][0], v1 = acc[ai][bj][m][1];
                    u32x4 w; w.x = pk2(v0[0], v0[1]); w.y = pk2(v0[2], v0[3]); w.z = pk2(v1[0], v1[1]); w.w = pk2(v1[2], v1[3]);
                    *(u32x4*)(rowp + bj * HALF) = w; } }
    }
};
__device__ __forceinline__ float swiglu1(float g, float u) { return g * u * __builtin_amdgcn_rcpf(1.0f + __builtin_amdgcn_exp2f(-1.4426950408889634f * g)); }
struct EpiSwiGLU {
    __device__ __forceinline__ void operator()(const f32x4 (&acc)[2][2][4][2], const UnitDesc& u, int wr, int wc, int fr, int fq) const {
#pragma unroll
        for (int ai = 0; ai < 2; ++ai)
#pragma unroll
            for (int m = 0; m < 4; ++m) { bf16_t* rowp = u.out + (size_t)(ai * HALF + wr * 64 + m * 16 + fr) * u.ldc + wc * 32 + 8 * fq;
                const f32x4 g0 = acc[ai][0][m][0], g1 = acc[ai][0][m][1], u0 = acc[ai][1][m][0], u1 = acc[ai][1][m][1];
                u32x4 w; w.x = pk2(swiglu1(g0[0], u0[0]), swiglu1(g0[1], u0[1])); w.y = pk2(swiglu1(g0[2], u0[2]), swiglu1(g0[3], u0[3]));
                w.z = pk2(swiglu1(g1[0], u1[0]), swiglu1(g1[1], u1[1])); w.w = pk2(swiglu1(g1[2], u1[2]), swiglu1(g1[3], u1[3]));
                *(u32x4*)rowp = w; }
    }
};
struct EpiQKV {
    bf16_t* Q; bf16_t* Kb; bf16_t* Vb; float* ck; float* cv;
    __device__ __forceinline__ void operator()(const f32x4 (&acc)[2][2][4][2], const UnitDesc& u, int wr, int wc, int fr, int fq) const {
        const int pm = u.aux & 0xffff, pn = u.aux >> 16, sel = pn >> 2, ct = (pn & 3) * BM;
        const int row0 = pm * BM + wr * 64 + fr, col0 = ct + wc * 32 + 8 * fq;
        bf16_t* base = Q + (size_t)sel * (size_t)(12 * 1024 * 1024); float* cb = ck + (size_t)(sel >= 1 ? sel - 1 : 0) * (size_t)NP * D;
        const bool wc32 = sel >= 1 && pm < NP / BM;
#pragma unroll
        for (int ai = 0; ai < 2; ++ai)
#pragma unroll
            for (int m = 0; m < 4; ++m) { const size_t off = (size_t)(row0 + ai * HALF + m * 16) * D + col0;
#pragma unroll
                for (int bj = 0; bj < 2; ++bj) { const f32x4 v0 = acc[ai][bj][m][0], v1 = acc[ai][bj][m][1];
                    u32x4 w; w.x = pk2(v0[0], v0[1]); w.y = pk2(v0[2], v0[3]); w.z = pk2(v1[0], v1[1]); w.w = pk2(v1[2], v1[3]);
                    *(u32x4*)(base + off + bj * HALF) = w;
                    if (wc32) { *(f32x4*)(cb + off + bj * HALF) = v0; *(f32x4*)(cb + off + bj * HALF + 4) = v1; } } }
    }
};

struct GSched {
    int nM, nN, G, c; const char* A; size_t a_tile; const char* B; size_t b_tile; bf16_t* out; size_t o_pm, o_pn; int ldc;
    __device__ __forceinline__ bool next(int i, UnitDesc& u) const {
        const long L = (long)i * G + c; if (L >= (long)nM * nN) return false;
        int pm, pn; tile_order((int)L, nM, nN, pm, pn);
        u.A = A + (size_t)pm * a_tile; u.B = B + (size_t)pn * b_tile; u.out = out + (size_t)pm * o_pm + (size_t)pn * o_pn; u.ldc = ldc; u.aux = pm | (pn << 16); return true;
    }
};
struct ChDftSched {
    int G, c; const char* cs_tab; const char* H; bf16_t* ytp; bf16_t* yts;
    __device__ __forceinline__ bool next(int i, UnitDesc& u) const {
        const long L = (long)i * G + c; if (L >= 48 * 8) return false;
        int tok, gc; tile_order((int)L, 48, 8, tok, gc); const int g = gc >> 1, cs = gc & 1;
        u.A = cs_tab + (size_t)cs * 256 * 256 * 2; u.B = H + ((size_t)tok * 256 * D + g * 256) * 2;
        if (tok < 32) { u.out = ytp + ((size_t)(tok * D + g * 256) * 512 + cs * 256); u.ldc = 512; }
        else { const int idx = tok - 32, b = idx >> 3, s0 = (idx & 7) * 256; u.out = yts + ((size_t)(b * D + g * 256) * 4096 + cs * 2048 + s0); u.ldc = 4096; }
        u.aux = 0; return true;
    }
};
struct SeqSSched {
    int c; const char* ts; const char* yts; bf16_t* F;
    __device__ __forceinline__ bool next(int i, UnitDesc& u) const {
        if (i > 0 || c >= 64) return false;
        const int b = c >> 5, pm = (c >> 2) & 7, pn = c & 3;
        u.A = ts + (size_t)pm * 256 * 4096 * 2; u.B = yts + (size_t)(b * D + pn * 256) * 4096 * 2;
        u.out = F + ((size_t)(NP + b * SS + pm * 256) * D + pn * 256); u.ldc = D; u.aux = 0; return true;
    }
};
struct SeqPSched {
    int G, c; const char* tp; const char* ytp; bf16_t* F;
    __device__ __forceinline__ bool next(int i, UnitDesc& u) const {
        const int G2 = G - 64; if (c < 64 || G2 <= 0) return false;
        const long L = (long)i * G2 + (c - 64); if (L >= 128) return false;
        const int b = (int)L >> 2, pn = (int)L & 3;
        u.A = tp; u.B = ytp + (size_t)(b * D + pn * 256) * 512 * 2;
        u.out = F + ((size_t)(b * 256) * D + pn * 256); u.ldc = D; u.aux = 0; return true;
    }
};
}

constexpr int TI_L0 = 16 * 32 + 2 * 16 * 88 + 44 * 32, TI_ALL = 16 * 32 + 16 * 96 + 16 * 32 + 4 * 16 * 88 + 2 * 44 * 32;
struct TItem { const float* W; bf16_t* WT; int N, ldt, dst, k0, n0; };
__device__ __forceinline__ bool titem_decode(const Params& p, int it, TItem& t) {
    constexpr int I_F = 16 * 32, I_QKV = 16 * 96, I_O = 16 * 32, I_G = 16 * 88, I_D = 44 * 32;
    constexpr int NITEMS = I_F + I_QKV + I_O + 4 * I_G + 2 * I_D;
    if (it >= NITEMS) return false;
    unsigned char* ws = p.ws; int r = it; int mode = 0;
    if (r < I_F) { t.W = p.in[9]; t.N = D; t.ldt = D; t.WT = (bf16_t*)(ws + WS_WF); }
    else { r -= I_F; int l = 0; if (r >= 2 * I_G + I_D) { r -= 2 * I_G + I_D; l = 1; }
        if (r < I_G) { t.W = p.in[13] + (size_t)l * D * FF; t.N = FF; t.ldt = D; t.WT = (bf16_t*)(ws + WS_WGU) + (size_t)l * 2 * FF * D; mode = 1; }
        else if ((r -= I_G) < I_G) { t.W = p.in[14] + (size_t)l * D * FF; t.N = FF; t.ldt = D; t.WT = (bf16_t*)(ws + WS_WGU) + (size_t)l * 2 * FF * D; mode = 2; }
        else if ((r -= I_G) < I_D) { t.W = p.in[15] + (size_t)l * FF * D; t.N = D; t.ldt = FF; t.WT = (bf16_t*)(ws + WS_WD) + (size_t)l * D * FF; }
        else if ((r -= I_D) < I_QKV) { t.W = p.in[10]; t.N = 3 * D; t.ldt = D; t.WT = (bf16_t*)(ws + WS_WQKV); }
        else { r -= I_QKV; t.W = p.in[12]; t.N = D; t.ldt = D; t.WT = (bf16_t*)(ws + WS_WO); } }
    const int nblk = t.N / 32, kb = r / nblk, nb = r % nblk; t.n0 = nb * 32; t.k0 = kb * 64;
    t.dst = t.n0; if (mode) t.dst = (t.n0 >> 7) * 256 + (t.n0 & 127) + (mode == 2 ? 128 : 0);
    return true;
}
__device__ __forceinline__ void titem_load(const TItem& t, f32x4 (&wv)[8], int lane) {
#pragma unroll
    for (int i = 0; i < 8; ++i) wv[i] = *(const f32x4*)(t.W + (size_t)(t.k0 + 8 * i + (lane >> 3)) * t.N + t.n0 + 4 * (lane & 7));
}
__device__ __forceinline__ void titem_finish(const TItem& t, const f32x4 (&wv)[8], LAS float* scr, int lane) {
#pragma unroll
    for (int i = 0; i < 8; ++i) { LAS float* d = scr + (8 * i + (lane >> 3)) * 33 + 4 * (lane & 7); d[0] = wv[i][0]; d[1] = wv[i][1]; d[2] = wv[i][2]; d[3] = wv[i][3]; }
    asm volatile("s_waitcnt lgkmcnt(0)" ::: "memory");
    const int c = lane & 7;
#pragma unroll
    for (int j = 0; j < 4; ++j) { const int n = (lane >> 3) + 8 * j; const LAS float* s = scr + (8 * c) * 33 + n;
        u32x4 o; o.x = pk2(s[0 * 33], s[1 * 33]); o.y = pk2(s[2 * 33], s[3 * 33]); o.z = pk2(s[4 * 33], s[5 * 33]); o.w = pk2(s[6 * 33], s[7 * 33]);
        *(u32x4*)(t.WT + (size_t)(t.dst + n) * t.ldt + t.k0 + 8 * c) = o; }
    asm volatile("s_waitcnt lgkmcnt(0)" ::: "memory");
}

__device__ __forceinline__ void gemv_layer(const Params& p, LAS unsigned char* lds, const int l, const int rb, const int nb) {
    const int tid = threadIdx.x;
    LAS float* sl = (LAS float*)lds;
    LAS f32x4* red = (LAS f32x4*)(lds + 12288);
    for (int i = tid; i < 3072; i += 512) { const int cond = i >> 10, k = i & 1023; const float v = cond == 0 ? p.in[5][k] : p.in[2][(cond - 1) * D + k]; sl[i] = v / (1.0f + __expf(-v)); }
    __syncthreads();
    float* mod = (float*)(p.ws + WS_MOD);
    for (int item = rb; item < 192; item += nb) {
        const int rem = item, cc = rem >> 5, kc = rem & 31, rpar = tid >> 8, col = cc * 1024 + 4 * (tid & 255);
        const float* W = p.in[6] + ((size_t)l * D + kc * 32 + rpar) * 6144 + col;
        f32x4 w[16];
#pragma unroll
        for (int i = 0; i < 16; ++i) w[i] = *(const f32x4*)(W + (size_t)(2 * i) * 6144);
        f32x4 a0 = {0.f, 0.f, 0.f, 0.f}, a1 = a0, a2 = a0;
#pragma unroll
        for (int i = 0; i < 16; ++i) { const int k = kc * 32 + 2 * i + rpar; a0 += sl[k] * w[i]; a1 += sl[1024 + k] * w[i]; a2 += sl[2048 + k] * w[i]; }
        if (rpar == 1) { red[tid - 256] = a0; red[256 + tid - 256] = a1; red[512 + tid - 256] = a2; }
        __syncthreads();
        if (rpar == 0) {
            a0 += red[tid]; a1 += red[256 + tid]; a2 += red[512 + tid];
            if (kc == 0) { const f32x4 bv = *(const f32x4*)(p.in[7] + l * 6144 + col); a0 += bv; a1 += bv; a2 += bv; }
#pragma unroll
            for (int j = 0; j < 4; ++j) {
                unsafeAtomicAdd(mod + (l * 3 + 0) * 6144 + col + j, a0[j]);
                unsafeAtomicAdd(mod + (l * 3 + 1) * 6144 + col + j, a1[j]);
                unsafeAtomicAdd(mod + (l * 3 + 2) * 6144 + col + j, a2[j]); }
        }
        __syncthreads();
    }
}
__device__ __forceinline__ void transpose_jobs(const Params& p, LAS unsigned char* lds, int gw, int NGW, int it_lo, int it_hi) {
    const int lane = threadIdx.x & 63, wave = threadIdx.x >> 6;
    LAS float* scr = (LAS float*)(lds + wave * 8448);
    TItem cur, nxt; f32x4 wa[8], wb[8];
    int it = it_lo + gw;
    bool have = it < it_hi && titem_decode(p, it, cur);
    if (have) titem_load(cur, wa, lane);
    while (have) {
        const bool hn = it + NGW < it_hi && titem_decode(p, it + NGW, nxt);
        if (hn) titem_load(nxt, wb, lane);
        titem_finish(cur, wa, scr, lane);
        if (!hn) break;
        it += 2 * NGW;
        have = it < it_hi && titem_decode(p, it, cur);
        if (have) titem_load(cur, wa, lane);
        titem_finish(nxt, wb, scr, lane);
    }
}
__device__ __forceinline__ void phase_prologue(const Params& p, LAS unsigned char* lds) {
    const int tid = threadIdx.x, G = gridDim.x, bx = blockIdx.x;
    unsigned char* ws = p.ws;
    LAS float* ct = (LAS float*)(lds + 32768);
    for (int i = tid; i < 2048; i += 512) ct[i] = cospif((float)i * (1.0f / 1024.0f));
    gemv_layer(p, lds, 0, bx, G);
    const int gt = bx * 512 + tid, GT = G * 512;
    for (int i = gt; i < 2 * 2 * 512 * D / 8; i += GT) { const int which = i >= 2 * 512 * D / 8; const int ii = which ? i - 2 * 512 * D / 8 : i;
        const f32x4* src = (const f32x4*)p.in[which ? 4 : 3]; const f32x4 a = src[2 * ii], b = src[2 * ii + 1];
        u32x4 o; o.x = pk2(a[0], a[1]); o.y = pk2(a[2], a[3]); o.z = pk2(b[0], b[1]); o.w = pk2(b[2], b[3]); ((u32x4*)((unsigned char*)p.out + (which ? OUTB_VC : OUTB_KC)))[ii] = o; }
    for (int i = gt; i < 512 * 256 / 8; i += GT) { const int row = i >> 5, c0 = (i & 31) * 8, cs = row >> 8, m = row & 255; float v[8];
#pragma unroll
        for (int j = 0; j < 8; ++j) { const int idx = ((m * (c0 + j)) & 255) * 8; v[j] = ct[(idx - (cs ? 512 : 0)) & 2047]; }
        u32x4 o; o.x = pk2(v[0], v[1]); o.y = pk2(v[2], v[3]); o.z = pk2(v[4], v[5]); o.w = pk2(v[6], v[7]); ((u32x4*)(ws + WS_CSCH))[i] = o; }
    for (int i = gt; i < 256 * 512 / 8; i += GT) { const int k = i >> 6, c0 = (i & 63) * 8; float v[8];
#pragma unroll
        for (int j = 0; j < 8; ++j) { const int kk = c0 + j, sidx = kk & 255; const int idx = ((k * sidx) & 255) * 8; v[j] = kk < 256 ? ct[idx] : -ct[(idx - 512) & 2047]; }
        u32x4 o; o.x = pk2(v[0], v[1]); o.y = pk2(v[2], v[3]); o.z = pk2(v[4], v[5]); o.w = pk2(v[6], v[7]); ((u32x4*)(ws + WS_TP))[i] = o; }
    for (int i = gt; i < 2048 * 4096 / 8; i += GT) { const int k = i >> 9, c0 = (i & 511) * 8; float v[8];
#pragma unroll
        for (int j = 0; j < 8; ++j) { const int kk = c0 + j, sidx = kk & 2047; const int idx = (k * sidx) & 2047; v[j] = kk < 2048 ? ct[idx] : -ct[(idx - 512) & 2047]; }
        u32x4 o; o.x = pk2(v[0], v[1]); o.y = pk2(v[2], v[3]); o.z = pk2(v[4], v[5]); o.w = pk2(v[6], v[7]); ((u32x4*)(ws + WS_TS))[i] = o; }
}
__device__ __forceinline__ void phase_side_jobs(const Params& p, LAS unsigned char* lds) {
    const int G = gridDim.x, bx = blockIdx.x;
    const int nb = G > 64 ? G - 64 : G, b0 = G > 64 ? 64 : 0;
    if (bx < b0) return;
    const int rb = bx - b0;
    gemv_layer(p, lds, 1, nb - 1 - rb, nb);
    transpose_jobs(p, lds, rb * 8 + (threadIdx.x >> 6), nb * 8, 0, TI_L0);
}
__device__ __forceinline__ void phase_side_jobs2(const Params& p, LAS unsigned char* lds) {
    const int G = gridDim.x, bx = blockIdx.x;
    const int nb = G > 192 ? G - 192 : G, b0 = G > 192 ? 192 : 0;
    if (bx < b0) return;
    transpose_jobs(p, lds, (bx - b0) * 8 + (threadIdx.x >> 6), nb * 8, TI_L0, TI_ALL);
}

template <bool HAS_MP, bool HAS_NEXT, bool XIN_F32>
__device__ __forceinline__ void row_phase(const float* xin_p, const float* xin_s, bf16_t* XB, const bf16_t* mp, float* Yout, bf16_t* Hout,
                                          const float* gate, const float* gA, const float* gB, const float* sc, const float* sh) {
    const int tid = threadIdx.x, lane = tid & 63, gw = blockIdx.x * 8 + (tid >> 6), NGW = gridDim.x * 8;
    for (int row = gw; row < M; row += NGW) {
        const int cond = row < NP ? 0 : (row < NP + SS ? 1 : 2);
        f32x4 v[4];
        if constexpr (XIN_F32) { const float* xr = row < NP ? xin_p + (size_t)row * D : xin_s + (size_t)(row - NP) * D;
#pragma unroll
            for (int j = 0; j < 4; ++j) v[j] = *(const f32x4*)(xr + 4 * lane + 256 * j);
        } else {
#pragma unroll
            for (int j = 0; j < 4; ++j) { const u32x2 w = *(const u32x2*)(XB + (size_t)row * D + 4 * lane + 256 * j); v[j] = (f32x4){bf_lo(w.x), bf_hi(w.x), bf_lo(w.y), bf_hi(w.y)}; }
        }
        if constexpr (HAS_MP) {
            f32x4 mv[4]; float s = 0.f;
#pragma unroll
            for (int j = 0; j < 4; ++j) { const u32x2 w = *(const u32x2*)(mp + (size_t)row * D + 4 * lane + 256 * j);
                mv[j] = (f32x4){bf_lo(w.x), bf_hi(w.x), bf_lo(w.y), bf_hi(w.y)}; s += (mv[j][0] * mv[j][0] + mv[j][1] * mv[j][1]) + (mv[j][2] * mv[j][2] + mv[j][3] * mv[j][3]); }
            const float rstd = 1.0f / sqrtf(wave_sum(s) * (1.0f / D) + 1e-6f);
#pragma unroll
            for (int j = 0; j < 4; ++j) { const f32x4 gt = *(const f32x4*)(gate + cond * 6144 + 4 * lane + 256 * j), ga = *(const f32x4*)(gA + 4 * lane + 256 * j);
                v[j] = v[j] + gt * (mv[j] * rstd * ga);
                if constexpr (HAS_NEXT) { u32x2 w; w.x = pk2(v[j][0], v[j][1]); w.y = pk2(v[j][2], v[j][3]); *(u32x2*)(XB + (size_t)row * D + 4 * lane + 256 * j) = w; }
                else *(f32x4*)(Yout + (size_t)row * D + 4 * lane + 256 * j) = v[j]; }
        }
        if constexpr (HAS_NEXT) {
            float s = 0.f;
#pragma unroll
            for (int j = 0; j < 4; ++j) s += (v[j][0] * v[j][0] + v[j][1] * v[j][1]) + (v[j][2] * v[j][2] + v[j][3] * v[j][3]);
            const float rstd = 1.0f / sqrtf(wave_sum(s) * (1.0f / D) + 1e-6f);
#pragma unroll
            for (int j = 0; j < 4; ++j) { const int col = 4 * lane + 256 * j;
                const f32x4 gb = *(const f32x4*)(gB + col), s1 = *(const f32x4*)(sc + cond * 6144 + col), s0 = *(const f32x4*)(sh + cond * 6144 + col);
                const f32x4 h = (v[j] * rstd * gb) * (1.0f + s1) + s0;
                u32x2 w; w.x = pk2(h[0], h[1]); w.y = pk2(h[2], h[3]); *(u32x2*)(Hout + (size_t)row * D + col) = w; }
        }
    }
}

__device__ __forceinline__ void attn_phase(const Params& p, LAS unsigned char* lds) {
    const int tid = threadIdx.x, lane = tid & 63, wave = __builtin_amdgcn_readfirstlane(tid >> 6), r = lane & 31, hh = lane >> 5;
    unsigned char* ws = p.ws;
    const bf16_t* Qb = (const bf16_t*)(ws + WS_Q); const bf16_t* Kb = (const bf16_t*)(ws + WS_K); const bf16_t* Vb = (const bf16_t*)(ws + WS_VT);
    const bf16_t* Kc = (const bf16_t*)((const unsigned char*)p.out + OUTB_KC); const bf16_t* Vc = (const bf16_t*)((const unsigned char*)p.out + OUTB_VC);
    bf16_t* Ob = (bf16_t*)(ws + WS_H);
    LAS float* Bl = (LAS float*)(lds + 36864 + 512);
    const int srow = tid >> 3, sch = tid & 7, krho = (srow & ~12) | ((srow & 4) << 1) | ((srow & 8) >> 1);
    const float c2 = 0.125f * 1.4426950408889634f;
    for (int unit = blockIdx.x; unit < 768; unit += gridDim.x) {
        const bool is_na = unit < 256;
        int b, h, qtok, nt, jmin = 0, nloc = 0, rq = 0, half = 0, ktok0;
        if (is_na) { b = unit >> 7; h = (unit >> 3) & 15; const int r0 = (unit & 7) * 4; rq = r0 + (wave >> 1); half = wave & 1;
            jmin = min(max(r0 - 4, 0), 24); const int jmax = min(max(r0 - 1, 0), 24) + 7; nloc = jmax - jmin + 1; nt = nloc + 8;
            qtok = NP + b * SS + rq * 64 + half * 32 + r; ktok0 = NP + b * SS; }
        else { const int u2 = unit - 256; b = u2 >> 4; h = u2 & 15; nt = 4; qtok = b * SP + wave * 32 + r; ktok0 = b * SP; }
        const int rs = min(max(rq - 4, 0), 24);
        if (is_na) { for (int i = tid; i < 15 * 32; i += 512) { const int rr = i >> 5, x = i & 31; Bl[i] = x < 31 ? p.in[11][(h * 15 + rr) * 31 + x] * 1.4426950408889634f : 0.f; } }
        bf16x8 qf[4];
#pragma unroll
        for (int d0 = 0; d0 < 4; ++d0) qf[d0] = *(const bf16x8*)(Qb + (size_t)qtok * D + h * HD + d0 * 16 + hh * 8);
        f32x16 o0, o1;
#pragma unroll
        for (int i = 0; i < 16; ++i) { o0[i] = 0.f; o1[i] = 0.f; }
        float m_run = -1e30f, l_run = 0.f;
        u32x4 kreg, vreg;
#define ATT_LOAD(t) do { const int t_ = (t); size_t off_; const bf16_t* kb_; const bf16_t* vb_; \
            if (is_na && t_ >= nloc) { off_ = ((size_t)(b * 512 + (t_ - nloc) * 64 + srow)) * D + h * HD + sch * 8; kb_ = Kc; vb_ = Vc; } \
            else { off_ = (size_t)(ktok0 + (is_na ? (jmin + t_) * 64 : t_ * 64) + srow) * D + h * HD + sch * 8; kb_ = Kb; vb_ = Vb; } \
            kreg = *(const u32x4*)(kb_ + off_); vreg = *(const u32x4*)(vb_ + off_); } while (0)
#define ATT_STORE(buf) do { LAS unsigned char* kl_ = lds + (buf) * 18432; LAS unsigned char* vl_ = kl_ + 9216; \
            *(LAS u32x4*)(kl_ + krho * 144 + sch * 16) = kreg; \
            LAS bf16_t* vd_ = (LAS bf16_t*)(vl_ + (8 * sch) * 144 + srow * 2); \
            vd_[0 * 72] = (bf16_t)vreg.x; vd_[1 * 72] = (bf16_t)(vreg.x >> 16); vd_[2 * 72] = (bf16_t)vreg.y; vd_[3 * 72] = (bf16_t)(vreg.y >> 16); \
            vd_[4 * 72] = (bf16_t)vreg.z; vd_[5 * 72] = (bf16_t)(vreg.z >> 16); vd_[6 * 72] = (bf16_t)vreg.w; vd_[7 * 72] = (bf16_t)(vreg.w >> 16); } while (0)
        ATT_LOAD(0); ATT_STORE(0); if (nt > 1) ATT_LOAD(1);
        __syncthreads();
        for (int t = 0; t < nt; ++t) {
            if (t + 1 < nt) { ATT_STORE((t + 1) & 1); if (t + 2 < nt) ATT_LOAD(t + 2); }
            const bool local = is_na && t < nloc; const int j = jmin + t;
            if (!(local && (j < rs || j >= rs + 8))) {
                const LAS unsigned char* Kl = lds + (t & 1) * 18432; const LAS unsigned char* Vl = Kl + 9216;
                f32x16 p0, p1;
#pragma unroll
                for (int i = 0; i < 16; ++i) { p0[i] = 0.f; p1[i] = 0.f; }
#pragma unroll
                for (int d0 = 0; d0 < 4; ++d0) { const bf16x8 a0 = *(const LAS bf16x8*)(Kl + r * 144 + d0 * 32 + hh * 16), a1 = *(const LAS bf16x8*)(Kl + (32 + r) * 144 + d0 * 32 + hh * 16);
                    p0 = __builtin_amdgcn_mfma_f32_32x32x16_bf16(a0, qf[d0], p0, 0, 0, 0); p1 = __builtin_amdgcn_mfma_f32_32x32x16_bf16(a1, qf[d0], p1, 0, 0, 0); }
                float m_new, alpha;
                if (local) {
                    const int qc = half * 32 + r, cs = min(max(qc - 8, 0), 48);
                    const LAS float* bp = Bl + (j - rq + 7) * 32 + 8 * hh - qc + 15;
                    float bb0[16], bb1[16];
#pragma unroll
                    for (int i = 0; i < 16; ++i) { const int kc = 16 * (i >> 3) + (i & 7); bb0[i] = bp[kc]; bb1[i] = bp[kc + 32]; }
                    asm volatile("" : "+v"(bb0[0]), "+v"(bb0[1]), "+v"(bb0[2]), "+v"(bb0[3]), "+v"(bb0[4]), "+v"(bb0[5]), "+v"(bb0[6]), "+v"(bb0[7]));
                    asm volatile("" : "+v"(bb0[8]), "+v"(bb0[9]), "+v"(bb0[10]), "+v"(bb0[11]), "+v"(bb0[12]), "+v"(bb0[13]), "+v"(bb0[14]), "+v"(bb0[15]));
                    asm volatile("" : "+v"(bb1[0]), "+v"(bb1[1]), "+v"(bb1[2]), "+v"(bb1[3]), "+v"(bb1[4]), "+v"(bb1[5]), "+v"(bb1[6]), "+v"(bb1[7]));
                    asm volatile("" : "+v"(bb1[8]), "+v"(bb1[9]), "+v"(bb1[10]), "+v"(bb1[11]), "+v"(bb1[12]), "+v"(bb1[13]), "+v"(bb1[14]), "+v"(bb1[15]));
                    const unsigned sh0 = (unsigned)(8 * hh - cs);
#pragma unroll
                    for (int i = 0; i < 16; ++i) { const int kc = 16 * (i >> 3) + (i & 7);
                        const float s0 = __builtin_fmaf(p0[i], c2, bb0[i]), s1 = __builtin_fmaf(p1[i], c2, bb1[i]);
                        p0[i] = (sh0 + (unsigned)kc) < 16u ? s0 : -1e30f; p1[i] = (sh0 + (unsigned)(kc + 32)) < 16u ? s1 : -1e30f; }
                    float mt = fmaxf(p0[0], p1[0]);
#pragma unroll
                    for (int i = 1; i < 16; ++i) mt = fmaxf(mt, fmaxf(p0[i], p1[i]));
                    mt = fmaxf(mt, __shfl_xor(mt, 32));
                    m_new = fmaxf(m_run, mt); alpha = __builtin_amdgcn_exp2f(m_run - m_new);
#pragma unroll
                    for (int i = 0; i < 16; ++i) { p0[i] = __builtin_amdgcn_exp2f(p0[i] - m_new); p1[i] = __builtin_amdgcn_exp2f(p1[i] - m_new); }
                } else {
                    float mt = fmaxf(p0[0], p1[0]);
#pragma unroll
                    for (int i = 1; i < 16; ++i) mt = fmaxf(mt, fmaxf(p0[i], p1[i]));
                    mt = fmaxf(mt, __shfl_xor(mt, 32)) * c2;
                    m_new = fmaxf(m_run, mt); alpha = __builtin_amdgcn_exp2f(m_run - m_new);
#pragma unroll
                    for (int i = 0; i < 16; ++i) { p0[i] = __builtin_amdgcn_exp2f(__builtin_fmaf(p0[i], c2, -m_new)); p1[i] = __builtin_amdgcn_exp2f(__builtin_fmaf(p1[i], c2, -m_new)); }
                }
                m_run = m_new;
                float ls = 0.f;
#pragma unroll
                for (int i = 0; i < 16; ++i) ls += p0[i] + p1[i];
                l_run = l_run * alpha + ls;
#pragma unroll
                for (int i = 0; i < 16; ++i) { o0[i] *= alpha; o1[i] *= alpha; }
                bf16x8 pa[4];
#pragma unroll
                for (int s2 = 0; s2 < 2; ++s2) { u32x4 w; w.x = pk2(p0[8 * s2], p0[8 * s2 + 1]); w.y = pk2(p0[8 * s2 + 2], p0[8 * s2 + 3]); w.z = pk2(p0[8 * s2 + 4], p0[8 * s2 + 5]); w.w = pk2(p0[8 * s2 + 6], p0[8 * s2 + 7]); pa[s2] = __builtin_bit_cast(bf16x8, w);
                    u32x4 w2; w2.x = pk2(p1[8 * s2], p1[8 * s2 + 1]); w2.y = pk2(p1[8 * s2 + 2], p1[8 * s2 + 3]); w2.z = pk2(p1[8 * s2 + 4], p1[8 * s2 + 5]); w2.w = pk2(p1[8 * s2 + 6], p1[8 * s2 + 7]); pa[2 + s2] = __builtin_bit_cast(bf16x8, w2); }
#pragma unroll
                for (int s2 = 0; s2 < 4; ++s2) { const bf16x8 v0 = *(const LAS bf16x8*)(Vl + r * 144 + s2 * 32 + hh * 16), v1 = *(const LAS bf16x8*)(Vl + (32 + r) * 144 + s2 * 32 + hh * 16);
                    o0 = __builtin_amdgcn_mfma_f32_32x32x16_bf16(v0, pa[s2], o0, 0, 0, 0); o1 = __builtin_amdgcn_mfma_f32_32x32x16_bf16(v1, pa[s2], o1, 0, 0, 0); }
            }
            __syncthreads();
        }
#undef ATT_LOAD
#undef ATT_STORE
        const float inv = 1.0f / (l_run + __shfl_xor(l_run, 32));
        bf16_t* orow = Ob + (size_t)qtok * D + h * HD + 4 * hh;
#pragma unroll
        for (int g = 0; g < 4; ++g) { u32x2 w; w.x = pk2(o0[4 * g] * inv, o0[4 * g + 1] * inv); w.y = pk2(o0[4 * g + 2] * inv, o0[4 * g + 3] * inv); *(u32x2*)(orow + 8 * g) = w;
            u32x2 w2; w2.x = pk2(o1[4 * g] * inv, o1[4 * g + 1] * inv); w2.y = pk2(o1[4 * g + 2] * inv, o1[4 * g + 3] * inv); *(u32x2*)(orow + 32 + 8 * g) = w2; }
    }
    __syncthreads();
}

#define XB_TMO      128
#define XB_XCNT(j)  (256  + 64 * (j))
#define XB_XSUB(j)  (1280 + 64 * (j))
#define XB_XGEN(j)  (2304 + 64 * (j))
#define XB_TOP      3328
#define XB_TOPGEN   3392
#define XCD_BAR_WORDS 3456
#define XB_SPIN_CAP (1u << 18)
__device__ __forceinline__ unsigned xb_ld(unsigned* p)              { return __hip_atomic_load(p, __ATOMIC_RELAXED, __HIP_MEMORY_SCOPE_AGENT); }
__device__ __forceinline__ unsigned xb_add(unsigned* p, unsigned v) { return __hip_atomic_fetch_add(p, v, __ATOMIC_RELAXED, __HIP_MEMORY_SCOPE_AGENT); }
__device__ __forceinline__ unsigned xb_xcc_id() { return (unsigned)__builtin_amdgcn_s_getreg((3 << 11) | 20) & 0xFu; }
#define XB_SPIN(cond, bar) do { unsigned _sp = 0; while (cond) { __builtin_amdgcn_s_sleep(1); \
    if ((++_sp & 255u) == 0u) { if (xb_ld(&(bar)[XB_TMO])) break; if (_sp > XB_SPIN_CAP) { atomicAdd(&(bar)[XB_TMO], 1u); break; } } } } while (0)
struct XcdBarrier { unsigned* bar; unsigned x; volatile LAS unsigned* st; };
__device__ __forceinline__ XcdBarrier xcd_barrier_post(unsigned* bar, volatile LAS unsigned* st) {
    XcdBarrier b; b.bar = bar; b.x = xb_xcc_id(); b.st = st;
    if (threadIdx.x == 0) (void)xb_add(&bar[XB_XCNT(b.x)], 1u);
    return b;
}
__device__ __forceinline__ void xcd_barrier_complete(unsigned* bar, unsigned x, unsigned& nloc, unsigned& nx) {
    const unsigned G = gridDim.x * gridDim.y * gridDim.z;
    unsigned sum, cnt, mine, sp = 0u;
    for (;;) {
        sum = 0u; cnt = 0u; mine = 0u;
#pragma unroll
        for (unsigned j = 0; j < 16; ++j) { const unsigned c = xb_ld(&bar[XB_XCNT(j)]); sum += c; cnt += (c > 0u) ? 1u : 0u; mine = (j == x) ? c : mine; }
        if (sum == G) break;
        __builtin_amdgcn_s_sleep(1);
        if ((++sp & 255u) == 0u) { if (xb_ld(&bar[XB_TMO])) break; if (sp > XB_SPIN_CAP) { atomicAdd(&bar[XB_TMO], 1u); break; } }
    }
    nloc = mine > 0u ? mine : 1u; nx = cnt > 0u ? cnt : 1u;
}
__device__ __forceinline__ void xcd_barrier(const XcdBarrier& b) {
    asm volatile("s_waitcnt vmcnt(0)" ::: "memory");
    __syncthreads();
    if (threadIdx.x == 0) {
        unsigned* bar = b.bar;
        __builtin_amdgcn_s_waitcnt(0);
        unsigned nloc = b.st[0], nx = b.st[1];
        if (nloc == 0u) { xcd_barrier_complete(bar, b.x, nloc, nx); b.st[0] = nloc; b.st[1] = nx; }
        const unsigned old = xb_add(&bar[XB_XSUB(b.x)], 1u);
        const unsigned gen = old / nloc;
        if (old + 1u == (gen + 1u) * nloc) {
            __builtin_amdgcn_fence(__ATOMIC_RELEASE, "agent");
            asm volatile("s_waitcnt vmcnt(0)" ::: "memory");
            const unsigned og = xb_add(&bar[XB_TOP], 1u);
            const unsigned tg = og / nx;
            if (og + 1u == (tg + 1u) * nx) xb_add(&bar[XB_TOPGEN], 1u);
            else XB_SPIN(xb_ld(&bar[XB_TOPGEN]) == tg, bar);
            __builtin_amdgcn_fence(__ATOMIC_ACQUIRE, "agent");
            xb_add(&bar[XB_XGEN(b.x)], 1u);
            asm volatile("s_waitcnt vmcnt(0)" ::: "memory");
        } else {
            XB_SPIN(xb_ld(&bar[XB_XGEN(b.x)]) == gen, bar);
            __builtin_amdgcn_fence(__ATOMIC_ACQUIRE, "agent");
            asm volatile("s_waitcnt vmcnt(0)" ::: "memory");
        }
    }
    __syncthreads();
}

__global__ void __launch_bounds__(512, 2) mega_fwd(Params p) {
    extern __shared__ __attribute__((aligned(16))) unsigned char lds_raw[];
    LAS unsigned char* lds = (LAS unsigned char*)lds_raw;
    unsigned char* ws = p.ws;
    const int G = gridDim.x, c = blockIdx.x, lo = p.ph_lo, hi = p.ph_hi;
    const float* mod = (const float*)(ws + WS_MOD);
    const float* norm_g = p.in[8];
    bf16_t* H = (bf16_t*)(ws + WS_H); bf16_t* MPb = (bf16_t*)(ws + WS_MP); bf16_t* U = (bf16_t*)(ws + WS_U);
    float* X = p.out + OUT_X; bf16_t* XB = (bf16_t*)(ws + WS_XB);
    volatile LAS unsigned* MISC = (volatile LAS unsigned*)(lds + 131072 + 320);
    if (threadIdx.x < 32) MISC[threadIdx.x] = 0u;
    __syncthreads();
    XcdBarrier bar; bar.bar = (unsigned*)(ws + WS_CTL); bar.x = 0; bar.st = nullptr;
    if (hi - lo > 1) bar = xcd_barrier_post((unsigned*)(ws + WS_CTL), MISC + 8);
    if (hi > 1000) cg::this_grid().sync();
#ifndef PH_MASK
#define PH_MASK 0xffff
#endif
#define IN(k) (((PH_MASK >> (k)) & 1) && lo <= (k) && (k) < hi)
#ifndef PROBE_REP
#define PROBE_REP -1
#endif
#ifndef PROBE_SYNC2
#define PROBE_SYNC2 0
#endif
#define REPS(k) for (int rep_ = 0; rep_ < ((k) == PROBE_REP ? 2 : 1); ++rep_)
#ifndef PROBE_PHASE
#define PROBE_PHASE -1
#endif
    unsigned long long pt0 = 0, pt1 = 0;
    if (PROBE_PHASE == 0) pt0 = __builtin_amdgcn_s_memrealtime();
#define SEAM(k) do { if ((k) + 1 < hi) { xcd_barrier(bar); if (PROBE_SYNC2) xcd_barrier(bar); } \
        if ((k) == PROBE_PHASE) pt1 = __builtin_amdgcn_s_memrealtime(); if ((k) + 1 == PROBE_PHASE) pt0 = __builtin_amdgcn_s_memrealtime(); } while (0)

    if (IN(0)) { REPS(0) { phase_prologue(p, lds); } SEAM(0); }
    if (IN(1)) { REPS(1) {
        row_phase<false, true, true>(p.in[0], p.in[1], nullptr, nullptr, nullptr, H, nullptr, nullptr, norm_g, mod + 1 * D, mod + 0 * D);
        } SEAM(1);
    }
    if (IN(2)) { REPS(2) {
        pg8::ChDftSched S{G, c, (const char*)(ws + WS_CSCH), (const char*)H, (bf16_t*)(ws + WS_YTP), (bf16_t*)(ws + WS_YTS)};
        pg8::gemm_phase<pg8::EpiStore, pg8::ChDftSched, true>(lds, 256, D, 256, S, pg8::EpiStore{});
        } SEAM(2);
    }
    if (IN(3)) { REPS(3) {
        { pg8::SeqSSched S{c, (const char*)(ws + WS_TS), (const char*)(ws + WS_YTS), (bf16_t*)(ws + WS_F)};
          pg8::gemm_phase<pg8::EpiStore, pg8::SeqSSched, true>(lds, 4096, 4096, 4096, S, pg8::EpiStore{}); }
        { pg8::SeqPSched S{G, c, (const char*)(ws + WS_TP), (const char*)(ws + WS_YTP), (bf16_t*)(ws + WS_F)};
          pg8::gemm_phase<pg8::EpiStore, pg8::SeqPSched, true>(lds, 512, 512, 512, S, pg8::EpiStore{}); }
        phase_side_jobs(p, lds);
        } SEAM(3);
    }
    if (IN(4)) { REPS(4) {
        pg8::GSched S{48, 4, G, c, (const char*)(ws + WS_F), (size_t)256 * D * 2, (const char*)(ws + WS_WF), (size_t)256 * D * 2, MPb, (size_t)256 * D, 256, D};
        pg8::gemm_phase<pg8::EpiStore, pg8::GSched, true>(lds, D, D, D, S, pg8::EpiStore{});
        phase_side_jobs2(p, lds);
        } SEAM(4);
    }
    if (IN(5)) { REPS(5) {
        row_phase<true, true, true>(p.in[0], p.in[1], XB, MPb, nullptr, H, mod + 2 * D, norm_g + 1 * D, norm_g + 2 * D, mod + 4 * D, mod + 3 * D);
        } SEAM(5);
    }
    if (IN(6)) { REPS(6) {
        pg8::GSched S{48, 22, G, c, (const char*)H, (size_t)256 * D * 2, (const char*)(ws + WS_WGU), (size_t)256 * D * 2, U, (size_t)256 * FF, 128, FF};
        pg8::gemm_phase<pg8::EpiSwiGLU, pg8::GSched, true>(lds, D, D, D, S, pg8::EpiSwiGLU{});
        } SEAM(6);
    }
    if (IN(7)) { REPS(7) {
        pg8::GSched S{48, 4, G, c, (const char*)U, (size_t)256 * FF * 2, (const char*)(ws + WS_WD), (size_t)256 * FF * 2, MPb, (size_t)256 * D, 256, D};
        pg8::gemm_phase<pg8::EpiStore, pg8::GSched, true>(lds, FF, FF, FF, S, pg8::EpiStore{});
        } SEAM(7);
    }
    if (IN(8)) { REPS(8) {
        row_phase<true, true, false>(nullptr, nullptr, XB, MPb, nullptr, H, mod + 5 * D, norm_g + 3 * D, norm_g + 4 * D, mod + 3 * 6144 + 1 * D, mod + 3 * 6144 + 0 * D);
        } SEAM(8);
    }
    if (IN(9)) { REPS(9) {
        pg8::GSched S{48, 12, G, c, (const char*)H, (size_t)256 * D * 2, (const char*)(ws + WS_WQKV), (size_t)256 * D * 2, nullptr, 0, 0, D};
        pg8::EpiQKV E{(bf16_t*)(ws + WS_Q), (bf16_t*)(ws + WS_K), (bf16_t*)(ws + WS_VT), p.out + OUT_CK, p.out + OUT_CV};
        pg8::gemm_phase<pg8::EpiQKV, pg8::GSched, true>(lds, D, D, D, S, E);
        } SEAM(9);
    }
    if (IN(10)) { REPS(10) { attn_phase(p, lds); } SEAM(10); }
    if (IN(11)) { REPS(11) {
        pg8::GSched S{48, 4, G, c, (const char*)H, (size_t)256 * D * 2, (const char*)(ws + WS_WO), (size_t)256 * D * 2, MPb, (size_t)256 * D, 256, D};
        pg8::gemm_phase<pg8::EpiStore, pg8::GSched, true>(lds, D, D, D, S, pg8::EpiStore{});
        } SEAM(11);
    }
    if (IN(12)) { REPS(12) {
        row_phase<true, true, false>(nullptr, nullptr, XB, MPb, nullptr, H, mod + 3 * 6144 + 2 * D, norm_g + 5 * D, norm_g + 6 * D, mod + 3 * 6144 + 4 * D, mod + 3 * 6144 + 3 * D);
        } SEAM(12);
    }
    if (IN(13)) { REPS(13) {
        pg8::GSched S{48, 22, G, c, (const char*)H, (size_t)256 * D * 2, (const char*)(ws + WS_WGU) + (size_t)2 * FF * D * 2, (size_t)256 * D * 2, U, (size_t)256 * FF, 128, FF};
        pg8::gemm_phase<pg8::EpiSwiGLU, pg8::GSched, true>(lds, D, D, D, S, pg8::EpiSwiGLU{});
        } SEAM(13);
    }
    if (IN(14)) { REPS(14) {
        pg8::GSched S{48, 4, G, c, (const char*)U, (size_t)256 * FF * 2, (const char*)(ws + WS_WD) + (size_t)D * FF * 2, (size_t)256 * FF * 2, MPb, (size_t)256 * D, 256, D};
        pg8::gemm_phase<pg8::EpiStore, pg8::GSched, true>(lds, FF, FF, FF, S, pg8::EpiStore{});
        } SEAM(14);
    }
    if (IN(15)) { REPS(15) {
        row_phase<true, false, false>(nullptr, nullptr, XB, MPb, X, nullptr, mod + 3 * 6144 + 5 * D, norm_g + 7 * D, nullptr, nullptr, nullptr); }
    }
    if (PROBE_PHASE >= 0 && blockIdx.x == 0) { if (PROBE_PHASE == 15) pt1 = __builtin_amdgcn_s_memrealtime();
        const unsigned long long tend = __builtin_amdgcn_s_memrealtime(), wait = 9ull * (pt1 - pt0);
        while (__builtin_amdgcn_s_memrealtime() - tend < wait) __builtin_amdgcn_s_sleep(8); }
#undef IN
#undef SEAM
}

constexpr int LDS_BYTES = 147456;
extern "C" void kernel_launch(void* const* d_in, const int* in_sizes, int n_in, void* d_out, int out_size, void* d_ws, size_t ws_size, hipStream_t stream) {
    static int grid = 0;
    if (grid == 0) {
        int dev = 0, cus = 0, per_cu = 0;
        hipGetDevice(&dev);
        hipDeviceGetAttribute(&cus, hipDeviceAttributeMultiprocessorCount, dev);
        if (hipFuncSetAttribute((const void*)mega_fwd, hipFuncAttributeMaxDynamicSharedMemorySize, LDS_BYTES) != hipSuccess) fprintf(stderr, "kernel_launch: hipFuncSetAttribute failed\n");
        if (hipOccupancyMaxActiveBlocksPerMultiprocessor(&per_cu, (const void*)mega_fwd, 512, LDS_BYTES) != hipSuccess || per_cu < 1) { fprintf(stderr, "kernel_launch: occupancy query says %d\n", per_cu); per_cu = 1; }
        (void)hipGetLastError();
        grid = cus * 1;
        if (n_in != 16 || ws_size < WS_END) { fprintf(stderr, "kernel_launch: unexpected n_in %d / ws %zu\n", n_in, ws_size); }
    }
    Params p{};
    (void)hipMemsetAsync((unsigned char*)d_ws, 0, WS_CTL + CTL_BYTES, stream);
    for (int i = 0; i < 16; ++i) p.in[i] = (const float*)d_in[i];
    p.out = (float*)d_out; p.ws = (unsigned char*)d_ws;
    if (MK_N_LAUNCHES == 1) {
        p.ph_lo = 0; p.ph_hi = NPHASE;
        void* args[] = {&p};
        hipError_t e = hipLaunchCooperativeKernel((const void*)mega_fwd, dim3(grid), dim3(512), args, LDS_BYTES, stream);
        if (e != hipSuccess) fprintf(stderr, "cooperative launch failed: %s (grid %d)\n", hipGetErrorString(e), grid);
    } else {
        for (int k = 0; k < NPHASE; ++k) { p.ph_lo = k; p.ph_hi = k + 1; hipLaunchKernelGGL(mega_fwd, dim3(grid), dim3(512), LDS_BYTES, stream, p); }
    }
}
```

```cpp
#include <hip/hip_runtime.h>
#include <hip/hip_cooperative_groups.h>
#include <cstdio>
#include <cstdint>
namespace cg = cooperative_groups;

#ifndef MK_N_LAUNCHES
#define MK_N_LAUNCHES 1
#endif

#define LAS __attribute__((address_space(3)))
typedef unsigned short bf16_t;
typedef short bf16x8 __attribute__((ext_vector_type(8)));
typedef float f32x2 __attribute__((ext_vector_type(2)));
typedef float f32x4 __attribute__((ext_vector_type(4)));
typedef float f32x16 __attribute__((ext_vector_type(16)));
typedef unsigned u32x2 __attribute__((ext_vector_type(2)));
typedef unsigned u32x4 __attribute__((ext_vector_type(4)));
typedef __bf16 bf16x2_t __attribute__((ext_vector_type(2)));

constexpr int D = 1024, NP = 8192, NS = 4096, M = NP + NS, SP = 256, SS = 2048, FF = 2816, NH = 16, HD = 64;
constexpr int NPHASE = 16;
constexpr size_t MiB = 1u << 20;
constexpr size_t WS_CTL = 160 * 1024, CTL_BYTES = 16 * 1024;
constexpr size_t WS_MOD = 0, WS_CSCH = 256 * 1024, WS_TP = 512 * 1024, WS_WF = 1 * MiB, WS_WQKV = 3 * MiB,
                 WS_WO = 9 * MiB, WS_WGU = 11 * MiB, WS_WD = 33 * MiB, WS_H = 44 * MiB, WS_MP = 68 * MiB, WS_U = 92 * MiB, WS_R = 158 * MiB;
constexpr size_t WS_YTP = WS_U, WS_YTS = WS_U + 32 * MiB;
constexpr size_t WS_TS = WS_R, WS_F = WS_R + 16 * MiB;
constexpr size_t WS_Q = WS_R, WS_K = WS_R + 24 * MiB, WS_VT = WS_R + 48 * MiB;
constexpr size_t WS_XB = WS_R + 72 * MiB, WS_END = WS_XB + 24 * MiB;
constexpr size_t OUTB_KC = 0, OUTB_VC = 2 * MiB;
constexpr size_t OUT_X = 0, OUT_CK = (size_t)M * D, OUT_CV = OUT_CK + (size_t)NP * D;

struct Params {
    const float* in[16];
    float* out; unsigned char* ws;
    int ph_lo, ph_hi;
};

__device__ __forceinline__ unsigned pk2(float lo, float hi) { f32x2 v = {lo, hi}; bf16x2_t b = __builtin_convertvector(v, bf16x2_t); return __builtin_bit_cast(unsigned, b); }
__device__ __forceinline__ float bf_lo(unsigned w) { return __uint_as_float(w << 16); }
__device__ __forceinline__ float bf_hi(unsigned w) { return __uint_as_float(w & 0xffff0000u); }
template <int CTRL> __device__ __forceinline__ float dpp_mov(float v) { return __builtin_bit_cast(float, __builtin_amdgcn_mov_dpp(__builtin_bit_cast(int, v), CTRL, 0xf, 0xf, true)); }
__device__ __forceinline__ float wave_sum(float v) {
    v += dpp_mov<0xB1>(v); v += dpp_mov<0x4E>(v); v += dpp_mov<0x141>(v); v += dpp_mov<0x140>(v);
    { auto rr = __builtin_amdgcn_permlane16_swap(__float_as_uint(v), __float_as_uint(v), false, false); v = __uint_as_float(rr[0]) + __uint_as_float(rr[1]); }
    { auto rr = __builtin_amdgcn_permlane32_swap(__float_as_uint(v), __float_as_uint(v), false, false); v = __uint_as_float(rr[0]) + __uint_as_float(rr[1]); }
    return v;
}

namespace pg8 {
constexpr int BM = 256, BK = 64, HALF = 128, HTB = HALF * BK * 2, STAGE_BYTES = 8 * HTB;
__device__ __forceinline__ int lds_byte(int r, int c) { const int st = (r >> 4) * 2 + (c >> 5), rr = r & 15, cc = c & 31, ob = rr * 64 + cc * 2; return st * 1024 + (ob ^ (((ob >> 9) & 1) << 5)); }
__device__ __forceinline__ void stage_rc(int b, int& R, int& C) { const int st = b / 1024, sb = b % 1024, swz = sb ^ (((sb >> 9) & 1) << 5); R = (st >> 1) * 16 + swz / 64; C = (st & 1) * 32 + (swz % 64) / 2; }
__device__ __forceinline__ int perm32(int rho) { const int n = rho >> 4, i = rho & 15; return 8 * (i >> 2) + 4 * n + (i & 3); }

struct UnitDesc { const char* A; const char* B; bf16_t* out; int ldc; int aux; };

__device__ __forceinline__ void tile_order(int L, int nM, int nN, int& pm, int& pn) {
    const int nwg = nM * nN; int wgid = L;
    { const int q = nwg / 8, r = nwg % 8, xcd = wgid % 8, off = wgid / 8; wgid = (xcd < r ? xcd * (q + 1) : r * (q + 1) + (xcd - r) * q) + off; }
    const int nig = 8 * nN, gid = wgid / nig, fm = gid * 8, gsz = (nM - fm) < 8 ? (nM - fm) : 8;
    pm = fm + ((wgid % nig) % gsz); pn = (wgid % nig) / gsz;
}

template <class Epi, class Sched, bool ALIGN_EPI>
__device__ __forceinline__ void gemm_phase(LAS unsigned char* lds, const int lda, const int ldb, const int K, const Sched& S, const Epi& E) {
    const int tid = threadIdx.x, wid = __builtin_amdgcn_readfirstlane(tid >> 6), lane = tid & 63, wr = wid >> 2, wc = wid & 3, fr = lane & 15, fq = lane >> 4;
    const int nt = K / BK;
    unsigned voffA[2], voffB[2];
#pragma unroll
    for (int i = 0; i < 2; ++i) { int R, C; stage_rc(tid * 16 + i * 8192, R, C); const int Rb = (R & ~31) + perm32(R & 31);
        voffA[i] = (unsigned)(R * lda + C) * 2u; voffB[i] = (unsigned)(Rb * ldb + C) * 2u; }
    const size_t kstep = (size_t)(BK * 2);
    const size_t hstepA = (size_t)HALF * lda * 2, hstepB = (size_t)HALF * ldb * 2;
    const unsigned ldsw = (unsigned)wid * 1024u;
    const int aoff = lds_byte(wr * 64 + fr, fq * 8), boff = lds_byte(wc * 32 + fr, fq * 8);
#define PG8_SA(b, h) (((b) * 2 + (h)) * HTB)
#define PG8_SB(b, h) ((4 + (b) * 2 + (h)) * HTB)
#define PG8_STAGE(bufoff, gbase, voff) do { _Pragma("unroll") for (int _i = 0; _i < 2; ++_i) \
        __builtin_amdgcn_global_load_lds((const unsigned*)((const char*)(gbase) + (voff)[_i]), (LAS unsigned*)(lds + (bufoff) + ldsw + _i * 8192), 16, 0, 0); } while (0)
#define PG8_LDA(dst, b, h) do { _Pragma("unroll") for (int m = 0; m < 4; ++m) _Pragma("unroll") for (int k = 0; k < 2; ++k) dst[m][k] = *(const LAS bf16x8*)(lds + PG8_SA(b, h) + aoff + m * 2048 + k * 1024); } while (0)
#define PG8_LDB(dst, b, h) do { _Pragma("unroll") for (int n = 0; n < 2; ++n) _Pragma("unroll") for (int k = 0; k < 2; ++k) dst[n][k] = *(const LAS bf16x8*)(lds + PG8_SB(b, h) + boff + n * 2048 + k * 1024); } while (0)
#define PG8_MMA(ai, bj, At, Bt) do { __builtin_amdgcn_s_setprio(1); _Pragma("unroll") for (int m = 0; m < 4; ++m) _Pragma("unroll") for (int n = 0; n < 2; ++n) _Pragma("unroll") for (int k = 0; k < 2; ++k) \
        acc[ai][bj][m][n] = __builtin_amdgcn_mfma_f32_16x16x32_bf16(Bt[n][k], At[m][k], acc[ai][bj][m][n], 0, 0, 0); __builtin_amdgcn_s_setprio(0); } while (0)
#define PG8_WAIT_V(n) asm volatile("s_waitcnt vmcnt(" #n ")" ::: "memory")
#define PG8_WAIT_L(n) asm volatile("s_waitcnt lgkmcnt(" #n ")" ::: "memory")
#define PG8_BAR __builtin_amdgcn_s_barrier()
#define PG8_SCHED __builtin_amdgcn_sched_barrier(0)
    UnitDesc cur, nxt; int ui = 0;
    if (!S.next(0, cur)) return;
    f32x4 acc[2][2][4][2];
#pragma unroll
    for (int a = 0; a < 2; ++a)
#pragma unroll
        for (int b = 0; b < 2; ++b)
#pragma unroll
            for (int m = 0; m < 4; ++m)
#pragma unroll
                for (int n = 0; n < 2; ++n) acc[a][b][m][n] = (f32x4){0.f, 0.f, 0.f, 0.f};
    bf16x8 At[4][2], B0[2][2], B1[2][2];
    const char* cA = cur.A; const char* cB = cur.B;
    PG8_STAGE(PG8_SB(0, 0), cB, voffB); PG8_STAGE(PG8_SB(0, 1), cB + hstepB, voffB); PG8_STAGE(PG8_SA(0, 0), cA, voffA); PG8_STAGE(PG8_SA(0, 1), cA + hstepA, voffA);
    if (wr == 1) PG8_BAR;
    PG8_WAIT_V(2); PG8_BAR;
    PG8_STAGE(PG8_SB(1, 0), cB + kstep, voffB); PG8_STAGE(PG8_SA(1, 0), cA + kstep, voffA); PG8_STAGE(PG8_SB(1, 1), cB + hstepB + kstep, voffB);
    PG8_WAIT_V(6); PG8_BAR;
    for (;;) {
        const bool has_next = S.next(ui + 1, nxt);
        const char* nA = has_next ? nxt.A : cA; const char* nB = has_next ? nxt.B : cB;
#pragma unroll 1
        for (int t = 0; t < nt; t += 2) {
            const bool last = (t == nt - 2);
            const char* a1 = cA + (size_t)(t + 1) * kstep;
            const char* a2 = last ? nA : cA + (size_t)(t + 2) * kstep; const char* b2 = last ? nB : cB + (size_t)(t + 2) * kstep;
            const char* a3 = a2 + kstep; const char* b3 = b2 + kstep;
            PG8_LDB(B0, 0, 0); PG8_LDB(B1, 0, 1); PG8_SCHED; PG8_LDA(At, 0, 0); PG8_STAGE(PG8_SA(1, 1), a1 + hstepA, voffA);
            PG8_WAIT_V(8); PG8_WAIT_L(0); PG8_BAR; PG8_MMA(0, 0, At, B0); PG8_MMA(0, 1, At, B1); PG8_BAR; PG8_SCHED;
            PG8_LDA(At, 0, 1); PG8_STAGE(PG8_SB(0, 0), b2, voffB); PG8_STAGE(PG8_SB(0, 1), b2 + hstepB, voffB); PG8_STAGE(PG8_SA(0, 0), a2, voffA);
            PG8_WAIT_V(8); PG8_WAIT_L(0); PG8_BAR; PG8_MMA(1, 0, At, B0); PG8_MMA(1, 1, At, B1); PG8_BAR; PG8_SCHED;
            PG8_LDB(B0, 1, 0); PG8_LDB(B1, 1, 1); PG8_SCHED; PG8_LDA(At, 1, 0); PG8_STAGE(PG8_SA(0, 1), a2 + hstepA, voffA);
            PG8_WAIT_V(8); PG8_WAIT_L(0); PG8_BAR; PG8_MMA(0, 0, At, B0); PG8_MMA(0, 1, At, B1); PG8_BAR; PG8_SCHED;
            PG8_LDA(At, 1, 1); PG8_STAGE(PG8_SB(1, 0), b3, voffB); PG8_STAGE(PG8_SB(1, 1), b3 + hstepB, voffB); PG8_STAGE(PG8_SA(1, 0), a3, voffA);
            PG8_WAIT_V(8); PG8_WAIT_L(0); PG8_BAR; PG8_MMA(1, 0, At, B0); PG8_MMA(1, 1, At, B1); PG8_BAR; PG8_SCHED;
        }
        if constexpr (ALIGN_EPI) { if (wr == 0) PG8_BAR; }
        E(acc, cur, wr, wc, fr, fq);
        if (!has_next) break;
#pragma unroll
        for (int a = 0; a < 2; ++a)
#pragma unroll
            for (int b = 0; b < 2; ++b)
#pragma unroll
                for (int m = 0; m < 4; ++m)
#pragma unroll
                    for (int n = 0; n < 2; ++n) acc[a][b][m][n] = (f32x4){0.f, 0.f, 0.f, 0.f};
        cur = nxt; cA = nA; cB = nB; ++ui;
        if constexpr (ALIGN_EPI) { if (wr == 1) PG8_BAR; }
    }
    PG8_WAIT_V(0);
    if constexpr (!ALIGN_EPI) { if (wr == 0) PG8_BAR; }
    PG8_BAR;
#undef PG8_SA
#undef PG8_SB
#undef PG8_STAGE
#undef PG8_LDA
#undef PG8_LDB
#undef PG8_MMA
#undef PG8_WAIT_V
#undef PG8_WAIT_L
#undef PG8_BAR
#undef PG8_SCHED
}

struct EpiStore {
    __device__ __forceinline__ void operator()(const f32x4 (&acc)[2][2][4][2], const UnitDesc& u, int wr, int wc, int fr, int fq) const {
#pragma unroll
        for (int ai = 0; ai < 2; ++ai)
#pragma unroll
            for (int m = 0; m < 4; ++m) { bf16_t* rowp = u.out + (size_t)(ai * HALF + wr * 64 + m * 16 + fr) * u.ldc + wc * 32 + 8 * fq;
#pragma unroll
                for (int bj = 0; bj < 2; ++bj) { const f32x4 v0 = acc[ai][bj][m][0], v1 = acc[ai][bj][m][1];
                    u32x4 w; w.x = pk2(v0[0], v0[1]); w.y = pk2(v0[2], v0[3]); w.z = pk2(v1[0], v1[1]); w.w = pk2(v1[2], v1[3]);
                    *(u32x4*)(rowp + bj * HALF) = w; } }
    }
};
__device__ __forceinline__ float swiglu1(float g, float u) { return g * u * __builtin_amdgcn_rcpf(1.0f + __builtin_amdgcn_exp2f(-1.4426950408889634f * g)); }
struct EpiSwiGLU {
    __device__ __forceinline__ void operator()(const f32x4 (&acc)[2][2][4][2], const UnitDesc& u, int wr, int wc, int fr, int fq) const {
#pragma unroll
        for (int ai = 0; ai < 2; ++ai)
#pragma unroll
            for (int m = 0; m < 4; ++m) { bf16_t* rowp = u.out + (size_t)(ai * HALF + wr * 64 + m * 16 + fr) * u.ldc + wc * 32 + 8 * fq;
                const f32x4 g0 = acc[ai][0][m][0], g1 = acc[ai][0][m][1], u0 = acc[ai][1][m][0], u1 = acc[ai][1][m][1];
                u32x4 w; w.x = pk2(swiglu1(g0[0], u0[0]), swiglu1(g0[1], u0[1])); w.y = pk2(swiglu1(g0[2], u0[2]), swiglu1(g0[3], u0[3]));
                w.z = pk2(swiglu1(g1[0], u1[0]), swiglu1(g1[1], u1[1])); w.w = pk2(swiglu1(g1[2], u1[2]), swiglu1(g1[3], u1[3]));
                *(u32x4*)rowp = w; }
    }
};
struct EpiQKV {
    bf16_t* Q; bf16_t* Kb; bf16_t* Vb; float* ck; float* cv;
    __device__ __forceinline__ void operator()(const f32x4 (&acc)[2][2][4][2], const UnitDesc& u, int wr, int wc, int fr, int fq) const {
        const int pm = u.aux & 0xffff, pn = u.aux >> 16, sel = pn >> 2, ct = (pn & 3) * BM;
        const int row0 = pm * BM + wr * 64 + fr, col0 = ct + wc * 32 + 8 * fq;
        bf16_t* base = Q + (size_t)sel * (size_t)(12 * 1024 * 1024); float* cb = ck + (size_t)(sel >= 1 ? sel - 1 : 0) * (size_t)NP * D;
        const bool wc32 = sel >= 1 && pm < NP / BM;
#pragma unroll
        for (int ai = 0; ai < 2; ++ai)
#pragma unroll
            for (int m = 0; m < 4; ++m) { const size_t off = (size_t)(row0 + ai * HALF + m * 16) * D + col0;
#pragma unroll
                for (int bj = 0; bj < 2; ++bj) { const f32x4 v0 = acc[ai][bj][m][0], v1 = acc[ai][bj][m][1];
                    u32x4 w; w.x = pk2(v0[0], v0[1]); w.y = pk2(v0[2], v0[3]); w.z = pk2(v1[0], v1[1]); w.w = pk2(v1[2], v1[3]);
                    *(u32x4*)(base + off + bj * HALF) = w;
                    if (wc32) { *(f32x4*)(cb + off + bj * HALF) = v0; *(f32x4*)(cb + off + bj * HALF + 4) = v1; } } }
    }
};

struct GSched {
    int nM, nN, G, c; const char* A; size_t a_tile; const char* B; size_t b_tile; bf16_t* out; size_t o_pm, o_pn; int ldc;
    __device__ __forceinline__ bool next(int i, UnitDesc& u) const {
        const long L = (long)i * G + c; if (L >= (long)nM * nN) return false;
        int pm, pn; tile_order((int)L, nM, nN, pm, pn);
        u.A = A + (size_t)pm * a_tile; u.B = B + (size_t)pn * b_tile; u.out = out + (size_t)pm * o_pm + (size_t)pn * o_pn; u.ldc = ldc; u.aux = pm | (pn << 16); return true;
    }
};
struct ChDftSched {
    int G, c; const char* cs_tab; const char* H; bf16_t* ytp; bf16_t* yts;
    __device__ __forceinline__ bool next(int i, UnitDesc& u) const {
        const long L = (long)i * G + c; if (L >= 48 * 8) return false;
        int tok, gc; tile_order((int)L, 48, 8, tok, gc); const int g = gc >> 1, cs = gc & 1;
        u.A = cs_tab + (size_t)cs * 256 * 256 * 2; u.B = H + ((size_t)tok * 256 * D + g * 256) * 2;
        if (tok < 32) { u.out = ytp + ((size_t)(tok * D + g * 256) * 512 + cs * 256); u.ldc = 512; }
        else { const int idx = tok - 32, b = idx >> 3, s0 = (idx & 7) * 256; u.out = yts + ((size_t)(b * D + g * 256) * 4096 + cs * 2048 + s0); u.ldc = 4096; }
        u.aux = 0; return true;
    }
};
struct SeqSSched {
    int c; const char* ts; const char* yts; bf16_t* F;
    __device__ __forceinline__ bool next(int i, UnitDesc& u) const {
        if (i > 0 || c >= 64) return false;
        const int b = c >> 5, pm = (c >> 2) & 7, pn = c & 3;
        u.A = ts + (size_t)pm * 256 * 4096 * 2; u.B = yts + (size_t)(b * D + pn * 256) * 4096 * 2;
        u.out = F + ((size_t)(NP + b * SS + pm * 256) * D + pn * 256); u.ldc = D; u.aux = 0; return true;
    }
};
struct SeqPSched {
    int G, c; const char* tp; const char* ytp; bf16_t* F;
    __device__ __forceinline__ bool next(int i, UnitDesc& u) const {
        const int G2 = G - 64; if (c < 64 || G2 <= 0) return false;
        const long L = (long)i * G2 + (c - 64); if (L >= 128) return false;
        const int b = (int)L >> 2, pn = (int)L & 3;
        u.A = tp; u.B = ytp + (size_t)(b * D + pn * 256) * 512 * 2;
        u.out = F + ((size_t)(b * 256) * D + pn * 256); u.ldc = D; u.aux = 0; return true;
    }
};
}

constexpr int TI_L0 = 16 * 32 + 2 * 16 * 88 + 44 * 32, TI_ALL = 16 * 32 + 16 * 96 + 16 * 32 + 4 * 16 * 88 + 2 * 44 * 32;
struct TItem { const float* W; bf16_t* WT; int N, ldt, dst, k0, n0; };
__device__ __forceinline__ bool titem_decode(const Params& p, int it, TItem& t) {
    constexpr int I_F = 16 * 32, I_QKV = 16 * 96, I_O = 16 * 32, I_G = 16 * 88, I_D = 44 * 32;
    constexpr int NITEMS = I_F + I_QKV + I_O + 4 * I_G + 2 * I_D;
    if (it >= NITEMS) return false;
    unsigned char* ws = p.ws; int r = it; int mode = 0;
    if (r < I_F) { t.W = p.in[9]; t.N = D; t.ldt = D; t.WT = (bf16_t*)(ws + WS_WF); }
    else { r -= I_F; int l = 0; if (r >= 2 * I_G + I_D) { r -= 2 * I_G + I_D; l = 1; }
        if (r < I_G) { t.W = p.in[13] + (size_t)l * D * FF; t.N = FF; t.ldt = D; t.WT = (bf16_t*)(ws + WS_WGU) + (size_t)l * 2 * FF * D; mode = 1; }
        else if ((r -= I_G) < I_G) { t.W = p.in[14] + (size_t)l * D * FF; t.N = FF; t.ldt = D; t.WT = (bf16_t*)(ws + WS_WGU) + (size_t)l * 2 * FF * D; mode = 2; }
        else if ((r -= I_G) < I_D) { t.W = p.in[15] + (size_t)l * FF * D; t.N = D; t.ldt = FF; t.WT = (bf16_t*)(ws + WS_WD) + (size_t)l * D * FF; }
        else if ((r -= I_D) < I_QKV) { t.W = p.in[10]; t.N = 3 * D; t.ldt = D; t.WT = (bf16_t*)(ws + WS_WQKV); }
        else { r -= I_QKV; t.W = p.in[12]; t.N = D; t.ldt = D; t.WT = (bf16_t*)(ws + WS_WO); } }
    const int nblk = t.N / 32, kb = r / nblk, nb = r % nblk; t.n0 = nb * 32; t.k0 = kb * 64;
    t.dst = t.n0; if (mode) t.dst = (t.n0 >> 7) * 256 + (t.n0 & 127) + (mode == 2 ? 128 : 0);
    return true;
}
__device__ __forceinline__ void titem_load(const TItem& t, f32x4 (&wv)[8], int lane) {
#pragma unroll
    for (int i = 0; i < 8; ++i) wv[i] = *(const f32x4*)(t.W + (size_t)(t.k0 + 8 * i + (lane >> 3)) * t.N + t.n0 + 4 * (lane & 7));
}
__device__ __forceinline__ void titem_finish(const TItem& t, const f32x4 (&wv)[8], LAS float* scr, int lane) {
#pragma unroll
    for (int i = 0; i < 8; ++i) { LAS float* d = scr + (8 * i + (lane >> 3)) * 33 + 4 * (lane & 7); d[0] = wv[i][0]; d[1] = wv[i][1]; d[2] = wv[i][2]; d[3] = wv[i][3]; }
    asm volatile("s_waitcnt lgkmcnt(0)" ::: "memory");
    const int c = lane & 7;
#pragma unroll
    for (int j = 0; j < 4; ++j) { const int n = (lane >> 3) + 8 * j; const LAS float* s = scr + (8 * c) * 33 + n;
        u32x4 o; o.x = pk2(s[0 * 33], s[1 * 33]); o.y = pk2(s[2 * 33], s[3 * 33]); o.z = pk2(s[4 * 33], s[5 * 33]); o.w = pk2(s[6 * 33], s[7 * 33]);
        *(u32x4*)(t.WT + (size_t)(t.dst + n) * t.ldt + t.k0 + 8 * c) = o; }
    asm volatile("s_waitcnt lgkmcnt(0)" ::: "memory");
}

__device__ __forceinline__ void gemv_layer(const Params& p, LAS unsigned char* lds, const int l, const int rb, const int nb) {
    const int tid = threadIdx.x;
    LAS float* sl = (LAS float*)lds;
    LAS f32x4* red = (LAS f32x4*)(lds + 12288);
    for (int i = tid; i < 3072; i += 512) { const int cond = i >> 10, k = i & 1023; const float v = cond == 0 ? p.in[5][k] : p.in[2][(cond - 1) * D + k]; sl[i] = v / (1.0f + __expf(-v)); }
    __syncthreads();
    float* mod = (float*)(p.ws + WS_MOD);
    for (int item = rb; item < 192; item += nb) {
        const int rem = item, cc = rem >> 5, kc = rem & 31, rpar = tid >> 8, col = cc * 1024 + 4 * (tid & 255);
        const float* W = p.in[6] + ((size_t)l * D + kc * 32 + rpar) * 6144 + col;
        f32x4 w[16];
#pragma unroll
        for (int i = 0; i < 16; ++i) w[i] = *(const f32x4*)(W + (size_t)(2 * i) * 6144);
        f32x4 a0 = {0.f, 0.f, 0.f, 0.f}, a1 = a0, a2 = a0;
#pragma unroll
        for (int i = 0; i < 16; ++i) { const int k = kc * 32 + 2 * i + rpar; a0 += sl[k] * w[i]; a1 += sl[1024 + k] * w[i]; a2 += sl[2048 + k] * w[i]; }
        if (rpar == 1) { red[tid - 256] = a0; red[256 + tid - 256] = a1; red[512 + tid - 256] = a2; }
        __syncthreads();
        if (rpar == 0) {
            a0 += red[tid]; a1 += red[256 + tid]; a2 += red[512 + tid];
            if (kc == 0) { const f32x4 bv = *(const f32x4*)(p.in[7] + l * 6144 + col); a0 += bv; a1 += bv; a2 += bv; }
#pragma unroll
            for (int j = 0; j < 4; ++j) {
                unsafeAtomicAdd(mod + (l * 3 + 0) * 6144 + col + j, a0[j]);
                unsafeAtomicAdd(mod + (l * 3 + 1) * 6144 + col + j, a1[j]);
                unsafeAtomicAdd(mod + (l * 3 + 2) * 6144 + col + j, a2[j]); }
        }
        __syncthreads();
    }
}
__device__ __forceinline__ void transpose_jobs(const Params& p, LAS unsigned char* lds, int gw, int NGW, int it_lo, int it_hi) {
    const int lane = threadIdx.x & 63, wave = threadIdx.x >> 6;
    LAS float* scr = (LAS float*)(lds + wave * 8448);
    TItem cur, nxt; f32x4 wa[8], wb[8];
    int it = it_lo + gw;
    bool have = it < it_hi && titem_decode(p, it, cur);
    if (have) titem_load(cur, wa, lane);
    while (have) {
        const bool hn = it + NGW < it_hi && titem_decode(p, it + NGW, nxt);
        if (hn) titem_load(nxt, wb, lane);
        titem_finish(cur, wa, scr, lane);
        if (!hn) break;
        it += 2 * NGW;
        have = it < it_hi && titem_decode(p, it, cur);
        if (have) titem_load(cur, wa, lane);
        titem_finish(nxt, wb, scr, lane);
    }
}
__device__ __forceinline__ void phase_prologue(const Params& p, LAS unsigned char* lds) {
    const int tid = threadIdx.x, G = gridDim.x, bx = blockIdx.x;
    unsigned char* ws = p.ws;
    LAS float* ct = (LAS float*)(lds + 32768);
    for (int i = tid; i < 2048; i += 512) ct[i] = cospif((float)i * (1.0f / 1024.0f));
    gemv_layer(p, lds, 0, bx, G);
    const int gt = bx * 512 + tid, GT = G * 512;
    for (int i = gt; i < 2 * 2 * 512 * D / 8; i += GT) { const int which = i >= 2 * 512 * D / 8; const int ii = which ? i - 2 * 512 * D / 8 : i;
        const f32x4* src = (const f32x4*)p.in[which ? 4 : 3]; const f32x4 a = src[2 * ii], b = src[2 * ii + 1];
        u32x4 o; o.x = pk2(a[0], a[1]); o.y = pk2(a[2], a[3]); o.z = pk2(b[0], b[1]); o.w = pk2(b[2], b[3]); ((u32x4*)((unsigned char*)p.out + (which ? OUTB_VC : OUTB_KC)))[ii] = o; }
    for (int i = gt; i < 512 * 256 / 8; i += GT) { const int row = i >> 5, c0 = (i & 31) * 8, cs = row >> 8, m = row & 255; float v[8];
#pragma unroll
        for (int j = 0; j < 8; ++j) { const int idx = ((m * (c0 + j)) & 255) * 8; v[j] = ct[(idx - (cs ? 512 : 0)) & 2047]; }
        u32x4 o; o.x = pk2(v[0], v[1]); o.y = pk2(v[2], v[3]); o.z = pk2(v[4], v[5]); o.w = pk2(v[6], v[7]); ((u32x4*)(ws + WS_CSCH))[i] = o; }
    for (int i = gt; i < 256 * 512 / 8; i += GT) { const int k = i >> 6, c0 = (i & 63) * 8; float v[8];
#pragma unroll
        for (int j = 0; j < 8; ++j) { const int kk = c0 + j, sidx = kk & 255; const int idx = ((k * sidx) & 255) * 8; v[j] = kk < 256 ? ct[idx] : -ct[(idx - 512) & 2047]; }
        u32x4 o; o.x = pk2(v[0], v[1]); o.y = pk2(v[2], v[3]); o.z = pk2(v[4], v[5]); o.w = pk2(v[6], v[7]); ((u32x4*)(ws + WS_TP))[i] = o; }
    for (int i = gt; i < 2048 * 4096 / 8; i += GT) { const int k = i >> 9, c0 = (i & 511) * 8; float v[8];
#pragma unroll
        for (int j = 0; j < 8; ++j) { const int kk = c0 + j, sidx = kk & 2047; const int idx = (k * sidx) & 2047; v[j] = kk < 2048 ? ct[idx] : -ct[(idx - 512) & 2047]; }
        u32x4 o; o.x = pk2(v[0], v[1]); o.y = pk2(v[2], v[3]); o.z = pk2(v[4], v[5]); o.w = pk2(v[6], v[7]); ((u32x4*)(ws + WS_TS))[i] = o; }
}
__device__ __forceinline__ void phase_side_jobs(const Params& p, LAS unsigned char* lds, const int which) {
    const int G = gridDim.x, bx = blockIdx.x, first = which == 0 ? 64 : 192;
    const int nb = G > first ? G - first : G, b0 = G > first ? first : 0;
    if (bx < b0) return;
    const int rb = bx - b0;
    if (which == 0) transpose_jobs(p, lds, rb * 8 + (threadIdx.x >> 6), nb * 8, 0, TI_L0);
    else if (which == 1) gemv_layer(p, lds, 1, rb, nb);
    else transpose_jobs(p, lds, rb * 8 + (threadIdx.x >> 6), nb * 8, TI_L0, TI_ALL);
}

#ifndef ROW_WT
#define ROW_WT 0
#endif
__device__ __forceinline__ void store16_wt(void* ptr, u32x4 v) {
#if ROW_WT
    asm volatile("global_store_dwordx4 %0, %1, off sc0 sc1\n\ts_nop 3" :: "v"(ptr), "v"(v) : "memory");
#else
    *(u32x4*)ptr = v;
#endif
}
__device__ __forceinline__ void bf8_to_f32(const u32x4 w, f32x4& a, f32x4& b) { a = (f32x4){bf_lo(w.x), bf_hi(w.x), bf_lo(w.y), bf_hi(w.y)}; b = (f32x4){bf_lo(w.z), bf_hi(w.z), bf_lo(w.w), bf_hi(w.w)}; }
__device__ __forceinline__ u32x4 f32_to_bf8(const f32x4 a, const f32x4 b) { u32x4 w; w.x = pk2(a[0], a[1]); w.y = pk2(a[2], a[3]); w.z = pk2(b[0], b[1]); w.w = pk2(b[2], b[3]); return w; }
template <bool HAS_MP, bool HAS_NEXT, bool XIN_F32>
__device__ __forceinline__ void row_phase(const float* xin_p, const float* xin_s, bf16_t* XB, const bf16_t* mp, float* Yout, bf16_t* Hout,
                                          const float* gate, const float* gA, const float* gB, const float* sc, const float* sh) {
    const int tid = threadIdx.x, lane = tid & 63, gw = blockIdx.x * 8 + (tid >> 6), NGW = gridDim.x * 8;
    constexpr int R = 3, RW = 6;
    int cur_cond = -1;
    f32x4 gga[4], gbs[4], shv[4];
    for (int rowb = gw * RW; rowb < M; rowb += NGW * RW)
    for (int row0 = rowb; row0 < rowb + RW; row0 += R) {
        f32x4 v[R][4]; u32x4 mw[R][2];
#pragma unroll
        for (int q = 0; q < R; ++q) { const int row = row0 + q;
            if constexpr (XIN_F32) { const float* xr = row < NP ? xin_p + (size_t)row * D : xin_s + (size_t)(row - NP) * D;
#pragma unroll
                for (int j = 0; j < 2; ++j) { v[q][2 * j] = *(const f32x4*)(xr + 8 * lane + 512 * j); v[q][2 * j + 1] = *(const f32x4*)(xr + 8 * lane + 512 * j + 4); }
            } else {
#pragma unroll
                for (int j = 0; j < 2; ++j) { const u32x4 w = *(const u32x4*)(XB + (size_t)row * D + 8 * lane + 512 * j); bf8_to_f32(w, v[q][2 * j], v[q][2 * j + 1]); }
            }
            if constexpr (HAS_MP) {
#pragma unroll
                for (int j = 0; j < 2; ++j) mw[q][j] = *(const u32x4*)(mp + (size_t)row * D + 8 * lane + 512 * j);
            } }
        u32x4 xo[R][2], ho[R][2];
#pragma unroll
        for (int q = 0; q < R; ++q) { const int row = row0 + q; const int cond = row < NP ? 0 : (row < NP + SS ? 1 : 2);
            if (cond != cur_cond) { cur_cond = cond;
#pragma unroll
                for (int j = 0; j < 4; ++j) { const int col = 8 * lane + 512 * (j >> 1) + 4 * (j & 1);
                    if constexpr (HAS_MP) gga[j] = *(const f32x4*)(gate + cond * 6144 + col) * *(const f32x4*)(gA + col);
                    if constexpr (HAS_NEXT) { gbs[j] = *(const f32x4*)(gB + col) * (1.0f + *(const f32x4*)(sc + cond * 6144 + col)); shv[j] = *(const f32x4*)(sh + cond * 6144 + col); } } }
            if constexpr (HAS_MP) {
                f32x4 mv[4]; float s = 0.f;
#pragma unroll
                for (int j = 0; j < 2; ++j) bf8_to_f32(mw[q][j], mv[2 * j], mv[2 * j + 1]);
#pragma unroll
                for (int j = 0; j < 4; ++j) s += (mv[j][0] * mv[j][0] + mv[j][1] * mv[j][1]) + (mv[j][2] * mv[j][2] + mv[j][3] * mv[j][3]);
                const float rstd = 1.0f / sqrtf(wave_sum(s) * (1.0f / D) + 1e-6f);
#pragma unroll
                for (int j = 0; j < 4; ++j) v[q][j] = v[q][j] + gga[j] * (mv[j] * rstd);
                if constexpr (HAS_NEXT) {
#pragma unroll
                    for (int j = 0; j < 2; ++j) xo[q][j] = f32_to_bf8(v[q][2 * j], v[q][2 * j + 1]);
                }
            }
            if constexpr (HAS_NEXT) {
                float s = 0.f;
#pragma unroll
                for (int j = 0; j < 4; ++j) s += (v[q][j][0] * v[q][j][0] + v[q][j][1] * v[q][j][1]) + (v[q][j][2] * v[q][j][2] + v[q][j][3] * v[q][j][3]);
                const float rstd = 1.0f / sqrtf(wave_sum(s) * (1.0f / D) + 1e-6f);
                f32x4 hh[4];
#pragma unroll
                for (int j = 0; j < 4; ++j) hh[j] = (v[q][j] * rstd) * gbs[j] + shv[j];
#pragma unroll
                for (int j = 0; j < 2; ++j) ho[q][j] = f32_to_bf8(hh[2 * j], hh[2 * j + 1]);
            } }
#pragma unroll
        for (int q = 0; q < R; ++q) { const int row = row0 + q;
            if constexpr (HAS_MP && !HAS_NEXT) {
#pragma unroll
                for (int j = 0; j < 4; ++j) *(f32x4*)(Yout + (size_t)row * D + 8 * lane + 512 * (j >> 1) + 4 * (j & 1)) = v[q][j];
            }
            if constexpr (HAS_MP && HAS_NEXT) {
#pragma unroll
                for (int j = 0; j < 2; ++j) store16_wt(XB + (size_t)row * D + 8 * lane + 512 * j, xo[q][j]);
            }
            if constexpr (HAS_NEXT) {
#pragma unroll
                for (int j = 0; j < 2; ++j) store16_wt(Hout + (size_t)row * D + 8 * lane + 512 * j, ho[q][j]);
            } }
    }
}

__device__ __forceinline__ void attn_phase(const Params& p, LAS unsigned char* lds) {
    const int tid = threadIdx.x, lane = tid & 63, wave = __builtin_amdgcn_readfirstlane(tid >> 6), r = lane & 31, hh = lane >> 5;
    unsigned char* ws = p.ws;
    const bf16_t* Qb = (const bf16_t*)(ws + WS_Q); const bf16_t* Kb = (const bf16_t*)(ws + WS_K); const bf16_t* Vb = (const bf16_t*)(ws + WS_VT);
    const bf16_t* Kc = (const bf16_t*)((const unsigned char*)p.out + OUTB_KC); const bf16_t* Vc = (const bf16_t*)((const unsigned char*)p.out + OUTB_VC);
    bf16_t* Ob = (bf16_t*)(ws + WS_H);
    LAS float* Bl = (LAS float*)(lds + 36864 + 512);
    const int srow = tid >> 3, sch = tid & 7, krho = (srow & ~12) | ((srow & 4) << 1) | ((srow & 8) >> 1);
    const float c2 = 0.125f * 1.4426950408889634f;
    for (int unit = blockIdx.x; unit < 768; unit += gridDim.x) {
        const bool is_na = unit < 256;
        int b, h, qtok, nt, jmin = 0, nloc = 0, rq = 0, half = 0, ktok0;
        if (is_na) { b = unit >> 7; h = (unit >> 3) & 15; const int r0 = (unit & 7) * 4; rq = r0 + (wave >> 1); half = wave & 1;
            jmin = min(max(r0 - 4, 0), 24); const int jmax = min(max(r0 - 1, 0), 24) + 7; nloc = jmax - jmin + 1; nt = nloc + 8;
            qtok = NP + b * SS + rq * 64 + half * 32 + r; ktok0 = NP + b * SS; }
        else { const int u2 = unit - 256; b = u2 >> 4; h = u2 & 15; nt = 4; qtok = b * SP + wave * 32 + r; ktok0 = b * SP; }
        const int rs = min(max(rq - 4, 0), 24);
        if (is_na) { for (int i = tid; i < 15 * 32; i += 512) { const int rr = i >> 5, x = i & 31; Bl[i] = x < 31 ? p.in[11][(h * 15 + rr) * 31 + x] * 1.4426950408889634f : 0.f; } }
        bf16x8 qf[4];
#pragma unroll
        for (int d0 = 0; d0 < 4; ++d0) qf[d0] = *(const bf16x8*)(Qb + (size_t)qtok * D + h * HD + d0 * 16 + hh * 8);
        f32x16 o0, o1;
#pragma unroll
        for (int i = 0; i < 16; ++i) { o0[i] = 0.f; o1[i] = 0.f; }
        float m_run = -1e30f, l_run = 0.f;
        u32x4 kreg, vreg;
#define ATT_LOAD(t) do { const int t_ = (t); size_t off_; const bf16_t* kb_; const bf16_t* vb_; \
            if (is_na && t_ >= nloc) { off_ = ((size_t)(b * 512 + (t_ - nloc) * 64 + srow)) * D + h * HD + sch * 8; kb_ = Kc; vb_ = Vc; } \
            else { off_ = (size_t)(ktok0 + (is_na ? (jmin + t_) * 64 : t_ * 64) + srow) * D + h * HD + sch * 8; kb_ = Kb; vb_ = Vb; } \
            kreg = *(const u32x4*)(kb_ + off_); vreg = *(const u32x4*)(vb_ + off_); } while (0)
#define ATT_STORE(buf) do { LAS unsigned char* kl_ = lds + (buf) * 18432; LAS unsigned char* vl_ = kl_ + 9216; \
            *(LAS u32x4*)(kl_ + krho * 144 + sch * 16) = kreg; \
            LAS bf16_t* vd_ = (LAS bf16_t*)(vl_ + (8 * sch) * 144 + srow * 2); \
            vd_[0 * 72] = (bf16_t)vreg.x; vd_[1 * 72] = (bf16_t)(vreg.x >> 16); vd_[2 * 72] = (bf16_t)vreg.y; vd_[3 * 72] = (bf16_t)(vreg.y >> 16); \
            vd_[4 * 72] = (bf16_t)vreg.z; vd_[5 * 72] = (bf16_t)(vreg.z >> 16); vd_[6 * 72] = (bf16_t)vreg.w; vd_[7 * 72] = (bf16_t)(vreg.w >> 16); } while (0)
        ATT_LOAD(0); ATT_STORE(0); if (nt > 1) ATT_LOAD(1);
        __syncthreads();
        for (int t = 0; t < nt; ++t) {
            if (t + 1 < nt) { ATT_STORE((t + 1) & 1); if (t + 2 < nt) ATT_LOAD(t + 2); }
            const bool local = is_na && t < nloc; const int j = jmin + t;
            if (!(local && (j < rs || j >= rs + 8))) {
                const LAS unsigned char* Kl = lds + (t & 1) * 18432; const LAS unsigned char* Vl = Kl + 9216;
                f32x16 p0, p1;
#pragma unroll
                for (int i = 0; i < 16; ++i) { p0[i] = 0.f; p1[i] = 0.f; }
#pragma unroll
                for (int d0 = 0; d0 < 4; ++d0) { const bf16x8 a0 = *(const LAS bf16x8*)(Kl + r * 144 + d0 * 32 + hh * 16), a1 = *(const LAS bf16x8*)(Kl + (32 + r) * 144 + d0 * 32 + hh * 16);
                    p0 = __builtin_amdgcn_mfma_f32_32x32x16_bf16(a0, qf[d0], p0, 0, 0, 0); p1 = __builtin_amdgcn_mfma_f32_32x32x16_bf16(a1, qf[d0], p1, 0, 0, 0); }
                float m_new, alpha;
                if (local) {
                    const int qc = half * 32 + r, cs = min(max(qc - 8, 0), 48);
                    const LAS float* bp = Bl + (j - rq + 7) * 32 + 8 * hh - qc + 15;
                    float bb0[16], bb1[16];
#pragma unroll
                    for (int i = 0; i < 16; ++i) { const int kc = 16 * (i >> 3) + (i & 7); bb0[i] = bp[kc]; bb1[i] = bp[kc + 32]; }
                    asm volatile("" : "+v"(bb0[0]), "+v"(bb0[1]), "+v"(bb0[2]), "+v"(bb0[3]), "+v"(bb0[4]), "+v"(bb0[5]), "+v"(bb0[6]), "+v"(bb0[7]));
                    asm volatile("" : "+v"(bb0[8]), "+v"(bb0[9]), "+v"(bb0[10]), "+v"(bb0[11]), "+v"(bb0[12]), "+v"(bb0[13]), "+v"(bb0[14]), "+v"(bb0[15]));
                    asm volatile("" : "+v"(bb1[0]), "+v"(bb1[1]), "+v"(bb1[2]), "+v"(bb1[3]), "+v"(bb1[4]), "+v"(bb1[5]), "+v"(bb1[6]), "+v"(bb1[7]));
                    asm volatile("" : "+v"(bb1[8]), "+v"(bb1[9]), "+v"(bb1[10]), "+v"(bb1[11]), "+v"(bb1[12]), "+v"(bb1[13]), "+v"(bb1[14]), "+v"(bb1[15]));
                    const unsigned sh0 = (unsigned)(8 * hh - cs);
#pragma unroll
                    for (int i = 0; i < 16; ++i) { const int kc = 16 * (i >> 3) + (i & 7);
                        const float s0 = __builtin_fmaf(p0[i], c2, bb0[i]), s1 = __builtin_fmaf(p1[i], c2, bb1[i]);
                        p0[i] = (sh0 + (unsigned)kc) < 16u ? s0 : -1e30f; p1[i] = (sh0 + (unsigned)(kc + 32)) < 16u ? s1 : -1e30f; }
                    float mt = fmaxf(p0[0], p1[0]);
#pragma unroll
                    for (int i = 1; i < 16; ++i) mt = fmaxf(mt, fmaxf(p0[i], p1[i]));
                    mt = fmaxf(mt, __shfl_xor(mt, 32));
                    m_new = fmaxf(m_run, mt); alpha = __builtin_amdgcn_exp2f(m_run - m_new);
#pragma unroll
                    for (int i = 0; i < 16; ++i) { p0[i] = __builtin_amdgcn_exp2f(p0[i] - m_new); p1[i] = __builtin_amdgcn_exp2f(p1[i] - m_new); }
                } else {
                    float mt = fmaxf(p0[0], p1[0]);
#pragma unroll
                    for (int i = 1; i < 16; ++i) mt = fmaxf(mt, fmaxf(p0[i], p1[i]));
                    mt = fmaxf(mt, __shfl_xor(mt, 32)) * c2;
                    m_new = fmaxf(m_run, mt); alpha = __builtin_amdgcn_exp2f(m_run - m_new);
#pragma unroll
                    for (int i = 0; i < 16; ++i) { p0[i] = __builtin_amdgcn_exp2f(__builtin_fmaf(p0[i], c2, -m_new)); p1[i] = __builtin_amdgcn_exp2f(__builtin_fmaf(p1[i], c2, -m_new)); }
                }
                m_run = m_new;
                float ls = 0.f;
#pragma unroll
                for (int i = 0; i < 16; ++i) ls += p0[i] + p1[i];
                l_run = l_run * alpha + ls;
#pragma unroll
                for (int i = 0; i < 16; ++i) { o0[i] *= alpha; o1[i] *= alpha; }
                bf16x8 pa[4];
#pragma unroll
                for (int s2 = 0; s2 < 2; ++s2) { u32x4 w; w.x = pk2(p0[8 * s2], p0[8 * s2 + 1]); w.y = pk2(p0[8 * s2 + 2], p0[8 * s2 + 3]); w.z = pk2(p0[8 * s2 + 4], p0[8 * s2 + 5]); w.w = pk2(p0[8 * s2 + 6], p0[8 * s2 + 7]); pa[s2] = __builtin_bit_cast(bf16x8, w);
                    u32x4 w2; w2.x = pk2(p1[8 * s2], p1[8 * s2 + 1]); w2.y = pk2(p1[8 * s2 + 2], p1[8 * s2 + 3]); w2.z = pk2(p1[8 * s2 + 4], p1[8 * s2 + 5]); w2.w = pk2(p1[8 * s2 + 6], p1[8 * s2 + 7]); pa[2 + s2] = __builtin_bit_cast(bf16x8, w2); }
#pragma unroll
                for (int s2 = 0; s2 < 4; ++s2) { const bf16x8 v0 = *(const LAS bf16x8*)(Vl + r * 144 + s2 * 32 + hh * 16), v1 = *(const LAS bf16x8*)(Vl + (32 + r) * 144 + s2 * 32 + hh * 16);
                    o0 = __builtin_amdgcn_mfma_f32_32x32x16_bf16(v0, pa[s2], o0, 0, 0, 0); o1 = __builtin_amdgcn_mfma_f32_32x32x16_bf16(v1, pa[s2], o1, 0, 0, 0); }
            }
            __syncthreads();
        }
#undef ATT_LOAD
#undef ATT_STORE
        const float inv = 1.0f / (l_run + __shfl_xor(l_run, 32));
        bf16_t* orow = Ob + (size_t)qtok * D + h * HD + 4 * hh;
#pragma unroll
        for (int g = 0; g < 4; ++g) { u32x2 w; w.x = pk2(o0[4 * g] * inv, o0[4 * g + 1] * inv); w.y = pk2(o0[4 * g + 2] * inv, o0[4 * g + 3] * inv); *(u32x2*)(orow + 8 * g) = w;
            u32x2 w2; w2.x = pk2(o1[4 * g] * inv, o1[4 * g + 1] * inv); w2.y = pk2(o1[4 * g + 2] * inv, o1[4 * g + 3] * inv); *(u32x2*)(orow + 32 + 8 * g) = w2; }
    }
    __syncthreads();
}

#define XB_TMO      128
#define XB_XCNT(j)  (256  + 64 * (j))
#define XB_XSUB(j)  (1280 + 64 * (j))
#define XB_XGEN(j)  (2304 + 64 * (j))
#define XB_TOP      3328
#define XB_TOPGEN   3392
#define XCD_BAR_WORDS 3456
#define XB_SPIN_CAP (1u << 18)
__device__ __forceinline__ unsigned xb_ld(unsigned* p)              { return __hip_atomic_load(p, __ATOMIC_RELAXED, __HIP_MEMORY_SCOPE_AGENT); }
__device__ __forceinline__ unsigned xb_add(unsigned* p, unsigned v) { return __hip_atomic_fetch_add(p, v, __ATOMIC_RELAXED, __HIP_MEMORY_SCOPE_AGENT); }
__device__ __forceinline__ unsigned xb_xcc_id() { return (unsigned)__builtin_amdgcn_s_getreg((3 << 11) | 20) & 0xFu; }
#define XB_SPIN(cond, bar) do { unsigned _sp = 0; while (cond) { __builtin_amdgcn_s_sleep(1); \
    if ((++_sp & 255u) == 0u) { if (xb_ld(&(bar)[XB_TMO])) break; if (_sp > XB_SPIN_CAP) { atomicAdd(&(bar)[XB_TMO], 1u); break; } } } } while (0)
struct XcdBarrier { unsigned* bar; unsigned x; volatile LAS unsigned* st; };
__device__ __forceinline__ XcdBarrier xcd_barrier_post(unsigned* bar, volatile LAS unsigned* st) {
    XcdBarrier b; b.bar = bar; b.x = xb_xcc_id(); b.st = st;
    if (threadIdx.x == 0) (void)xb_add(&bar[XB_XCNT(b.x)], 1u);
    return b;
}
__device__ __forceinline__ void xcd_barrier_complete(unsigned* bar, unsigned x, unsigned& nloc, unsigned& nx) {
    const unsigned G = gridDim.x * gridDim.y * gridDim.z;
    unsigned sum, cnt, mine, sp = 0u;
    for (;;) {
        sum = 0u; cnt = 0u; mine = 0u;
#pragma unroll
        for (unsigned j = 0; j < 16; ++j) { const unsigned c = xb_ld(&bar[XB_XCNT(j)]); sum += c; cnt += (c > 0u) ? 1u : 0u; mine = (j == x) ? c : mine; }
        if (sum == G) break;
        __builtin_amdgcn_s_sleep(1);
        if ((++sp & 255u) == 0u) { if (xb_ld(&bar[XB_TMO])) break; if (sp > XB_SPIN_CAP) { atomicAdd(&bar[XB_TMO], 1u); break; } }
    }
    nloc = mine > 0u ? mine : 1u; nx = cnt > 0u ? cnt : 1u;
}
__device__ __forceinline__ void xcd_barrier(const XcdBarrier& b) {
    asm volatile("s_waitcnt vmcnt(0)" ::: "memory");
    __syncthreads();
    if (threadIdx.x == 0) {
        unsigned* bar = b.bar;
        __builtin_amdgcn_s_waitcnt(0);
        unsigned nloc = b.st[0], nx = b.st[1];
        if (nloc == 0u) { xcd_barrier_complete(bar, b.x, nloc, nx); b.st[0] = nloc; b.st[1] = nx; }
        const unsigned old = xb_add(&bar[XB_XSUB(b.x)], 1u);
        const unsigned gen = old / nloc;
        if (old + 1u == (gen + 1u) * nloc) {
            __builtin_amdgcn_fence(__ATOMIC_RELEASE, "agent");
            asm volatile("s_waitcnt vmcnt(0)" ::: "memory");
            const unsigned og = xb_add(&bar[XB_TOP], 1u);
            const unsigned tg = og / nx;
            if (og + 1u == (tg + 1u) * nx) xb_add(&bar[XB_TOPGEN], 1u);
            else XB_SPIN(xb_ld(&bar[XB_TOPGEN]) == tg, bar);
            __builtin_amdgcn_fence(__ATOMIC_ACQUIRE, "agent");
            xb_add(&bar[XB_XGEN(b.x)], 1u);
            asm volatile("s_waitcnt vmcnt(0)" ::: "memory");
        } else {
            XB_SPIN(xb_ld(&bar[XB_XGEN(b.x)]) == gen, bar);
            __builtin_amdgcn_fence(__ATOMIC_ACQUIRE, "agent");
            asm volatile("s_waitcnt vmcnt(0)" ::: "memory");
        }
    }
    __syncthreads();
}

__global__ void __launch_bounds__(512, 2) mega_fwd(Params p) {
    extern __shared__ __attribute__((aligned(16))) unsigned char lds_raw[];
    LAS unsigned char* lds = (LAS unsigned char*)lds_raw;
    unsigned char* ws = p.ws;
    const int G = gridDim.x, c = blockIdx.x, lo = p.ph_lo, hi = p.ph_hi;
    const float* mod = (const float*)(ws + WS_MOD);
    const float* norm_g = p.in[8];
    bf16_t* H = (bf16_t*)(ws + WS_H); bf16_t* MPb = (bf16_t*)(ws + WS_MP); bf16_t* U = (bf16_t*)(ws + WS_U);
    float* X = p.out + OUT_X; bf16_t* XB = (bf16_t*)(ws + WS_XB);
    volatile LAS unsigned* MISC = (volatile LAS unsigned*)(lds + 131072 + 320);
    if (threadIdx.x < 32) MISC[threadIdx.x] = 0u;
    __syncthreads();
    XcdBarrier bar; bar.bar = (unsigned*)(ws + WS_CTL); bar.x = 0; bar.st = nullptr;
    if (hi - lo > 1) bar = xcd_barrier_post((unsigned*)(ws + WS_CTL), MISC + 8);
    if (hi > 1000) cg::this_grid().sync();
#ifndef PH_MASK
#define PH_MASK 0xffff
#endif
#define IN(k) (((PH_MASK >> (k)) & 1) && lo <= (k) && (k) < hi)
#ifndef PROBE_REP
#define PROBE_REP -1
#endif
#ifndef PROBE_SYNC2
#define PROBE_SYNC2 0
#endif
#define REPS(k) for (int rep_ = 0; rep_ < ((k) == PROBE_REP ? 2 : 1); ++rep_)
#ifndef PROBE_PHASE
#define PROBE_PHASE -1
#endif
    unsigned long long pt0 = 0, pt1 = 0;
    if (PROBE_PHASE == 0) pt0 = __builtin_amdgcn_s_memrealtime();
#define SEAM(k) do { if ((k) + 1 < hi) { xcd_barrier(bar); if (PROBE_SYNC2) xcd_barrier(bar); } \
        if ((k) == PROBE_PHASE) pt1 = __builtin_amdgcn_s_memrealtime(); if ((k) + 1 == PROBE_PHASE) pt0 = __builtin_amdgcn_s_memrealtime(); } while (0)

    if (IN(0)) { REPS(0) { phase_prologue(p, lds); } SEAM(0); }
    if (IN(1)) { REPS(1) {
        row_phase<false, true, true>(p.in[0], p.in[1], nullptr, nullptr, nullptr, H, nullptr, nullptr, norm_g, mod + 1 * D, mod + 0 * D);
        } SEAM(1);
    }
    if (IN(2)) { REPS(2) {
        pg8::ChDftSched S{G, c, (const char*)(ws + WS_CSCH), (const char*)H, (bf16_t*)(ws + WS_YTP), (bf16_t*)(ws + WS_YTS)};
        pg8::gemm_phase<pg8::EpiStore, pg8::ChDftSched, true>(lds, 256, D, 256, S, pg8::EpiStore{});
        } SEAM(2);
    }
    if (IN(3)) { REPS(3) {
        { pg8::SeqSSched S{c, (const char*)(ws + WS_TS), (const char*)(ws + WS_YTS), (bf16_t*)(ws + WS_F)};
          pg8::gemm_phase<pg8::EpiStore, pg8::SeqSSched, true>(lds, 4096, 4096, 4096, S, pg8::EpiStore{}); }
        { pg8::SeqPSched S{G, c, (const char*)(ws + WS_TP), (const char*)(ws + WS_YTP), (bf16_t*)(ws + WS_F)};
          pg8::gemm_phase<pg8::EpiStore, pg8::SeqPSched, true>(lds, 512, 512, 512, S, pg8::EpiStore{}); }
        phase_side_jobs(p, lds, 0);
        } SEAM(3);
    }
    if (IN(4)) { REPS(4) {
        pg8::GSched S{48, 4, G, c, (const char*)(ws + WS_F), (size_t)256 * D * 2, (const char*)(ws + WS_WF), (size_t)256 * D * 2, MPb, (size_t)256 * D, 256, D};
        pg8::gemm_phase<pg8::EpiStore, pg8::GSched, true>(lds, D, D, D, S, pg8::EpiStore{});
        phase_side_jobs(p, lds, 1);
        } SEAM(4);
    }
    if (IN(5)) { REPS(5) {
        row_phase<true, true, true>(p.in[0], p.in[1], XB, MPb, nullptr, H, mod + 2 * D, norm_g + 1 * D, norm_g + 2 * D, mod + 4 * D, mod + 3 * D);
        } SEAM(5);
    }
    if (IN(6)) { REPS(6) {
        pg8::GSched S{48, 22, G, c, (const char*)H, (size_t)256 * D * 2, (const char*)(ws + WS_WGU), (size_t)256 * D * 2, U, (size_t)256 * FF, 128, FF};
        pg8::gemm_phase<pg8::EpiSwiGLU, pg8::GSched, true>(lds, D, D, D, S, pg8::EpiSwiGLU{});
        } SEAM(6);
    }
    if (IN(7)) { REPS(7) {
        pg8::GSched S{48, 4, G, c, (const char*)U, (size_t)256 * FF * 2, (const char*)(ws + WS_WD), (size_t)256 * FF * 2, MPb, (size_t)256 * D, 256, D};
        pg8::gemm_phase<pg8::EpiStore, pg8::GSched, true>(lds, FF, FF, FF, S, pg8::EpiStore{});
        phase_side_jobs(p, lds, 2);
        } SEAM(7);
    }
    if (IN(8)) { REPS(8) {
        row_phase<true, true, false>(nullptr, nullptr, XB, MPb, nullptr, H, mod + 5 * D, norm_g + 3 * D, norm_g + 4 * D, mod + 3 * 6144 + 1 * D, mod + 3 * 6144 + 0 * D);
        } SEAM(8);
    }
    if (IN(9)) { REPS(9) {
        pg8::GSched S{48, 12, G, c, (const char*)H, (size_t)256 * D * 2, (const char*)(ws + WS_WQKV), (size_t)256 * D * 2, nullptr, 0, 0, D};
        pg8::EpiQKV E{(bf16_t*)(ws + WS_Q), (bf16_t*)(ws + WS_K), (bf16_t*)(ws + WS_VT), p.out + OUT_CK, p.out + OUT_CV};
        pg8::gemm_phase<pg8::EpiQKV, pg8::GSched, true>(lds, D, D, D, S, E);
        } SEAM(9);
    }
    if (IN(10)) { REPS(10) { attn_phase(p, lds); } SEAM(10); }
    if (IN(11)) { REPS(11) {
        pg8::GSched S{48, 4, G, c, (const char*)H, (size_t)256 * D * 2, (const char*)(ws + WS_WO), (size_t)256 * D * 2, MPb, (size_t)256 * D, 256, D};
        pg8::gemm_phase<pg8::EpiStore, pg8::GSched, true>(lds, D, D, D, S, pg8::EpiStore{});
        } SEAM(11);
    }
    if (IN(12)) { REPS(12) {
        row_phase<true, true, false>(nullptr, nullptr, XB, MPb, nullptr, H, mod + 3 * 6144 + 2 * D, norm_g + 5 * D, norm_g + 6 * D, mod + 3 * 6144 + 4 * D, mod + 3 * 6144 + 3 * D);
        } SEAM(12);
    }
    if (IN(13)) { REPS(13) {
        pg8::GSched S{48, 22, G, c, (const char*)H, (size_t)256 * D * 2, (const char*)(ws + WS_WGU) + (size_t)2 * FF * D * 2, (size_t)256 * D * 2, U, (size_t)256 * FF, 128, FF};
        pg8::gemm_phase<pg8::EpiSwiGLU, pg8::GSched, true>(lds, D, D, D, S, pg8::EpiSwiGLU{});
        } SEAM(13);
    }
    if (IN(14)) { REPS(14) {
        pg8::GSched S{48, 4, G, c, (const char*)U, (size_t)256 * FF * 2, (const char*)(ws + WS_WD) + (size_t)D * FF * 2, (size_t)256 * FF * 2, MPb, (size_t)256 * D, 256, D};
        pg8::gemm_phase<pg8::EpiStore, pg8::GSched, true>(lds, FF, FF, FF, S, pg8::EpiStore{});
        } SEAM(14);
    }
    if (IN(15)) { REPS(15) {
        row_phase<true, false, false>(nullptr, nullptr, XB, MPb, X, nullptr, mod + 3 * 6144 + 5 * D, norm_g + 7 * D, nullptr, nullptr, nullptr); }
    }
    if (PROBE_PHASE >= 0 && blockIdx.x == 0) { if (PROBE_PHASE == 15) pt1 = __builtin_amdgcn_s_memrealtime();
        const unsigned long long tend = __builtin_amdgcn_s_memrealtime(), wait = 9ull * (pt1 - pt0);
        while (__builtin_amdgcn_s_memrealtime() - tend < wait) __builtin_amdgcn_s_sleep(8); }
#undef IN
#undef SEAM
}

constexpr int LDS_BYTES = 147456;
extern "C" void kernel_launch(void* const* d_in, const int* in_sizes, int n_in, void* d_out, int out_size, void* d_ws, size_t ws_size, hipStream_t stream) {
    static int grid = 0;
    if (grid == 0) {
        int dev = 0, cus = 0, per_cu = 0;
        hipGetDevice(&dev);
        hipDeviceGetAttribute(&cus, hipDeviceAttributeMultiprocessorCount, dev);
        if (hipFuncSetAttribute((const void*)mega_fwd, hipFuncAttributeMaxDynamicSharedMemorySize, LDS_BYTES) != hipSuccess) fprintf(stderr, "kernel_launch: hipFuncSetAttribute failed\n");
        if (hipOccupancyMaxActiveBlocksPerMultiprocessor(&per_cu, (const void*)mega_fwd, 512, LDS_BYTES) != hipSuccess || per_cu < 1) { fprintf(stderr, "kernel_launch: occupancy query says %d\n", per_cu); per_cu = 1; }
        (void)hipGetLastError();
        grid = cus * 1;
        if (n_in != 16 || ws_size < WS_END) { fprintf(stderr, "kernel_launch: unexpected n_in %d / ws %zu\n", n_in, ws_size); }
    }
    Params p{};
    (void)hipMemsetAsync((unsigned char*)d_ws, 0, WS_CTL + CTL_BYTES, stream);
    for (int i = 0; i < 16; ++i) p.in[i] = (const float*)d_in[i];
    p.out = (float*)d_out; p.ws = (unsigned char*)d_ws;
    if (MK_N_LAUNCHES == 1) {
        p.ph_lo = 0; p.ph_hi = NPHASE;
        void* args[] = {&p};
        hipError_t e = hipLaunchCooperativeKernel((const void*)mega_fwd, dim3(grid), dim3(512), args, LDS_BYTES, stream);
        if (e != hipSuccess) fprintf(stderr, "cooperative launch failed: %s (grid %d)\n", hipGetErrorString(e), grid);
    } else {
        for (int k = 0; k < NPHASE; ++k) { p.ph_lo = k; p.ph_hi = k + 1; hipLaunchKernelGGL(mega_fwd, dim3(grid), dim3(512), LDS_BYTES, stream, p); }
    }
}
```

```cpp
#include <hip/hip_runtime.h>
#include <hip/hip_cooperative_groups.h>
#include <cstdio>
#include <cstdint>
namespace cg = cooperative_groups;

#ifndef MK_N_LAUNCHES
#define MK_N_LAUNCHES 1
#endif

#define LAS __attribute__((address_space(3)))
typedef unsigned short bf16_t;
typedef short bf16x8 __attribute__((ext_vector_type(8)));
typedef float f32x2 __attribute__((ext_vector_type(2)));
typedef float f32x4 __attribute__((ext_vector_type(4)));
typedef float f32x16 __attribute__((ext_vector_type(16)));
typedef unsigned u32x2 __attribute__((ext_vector_type(2)));
typedef unsigned u32x4 __attribute__((ext_vector_type(4)));
typedef __bf16 bf16x2_t __attribute__((ext_vector_type(2)));

constexpr int D = 1024, NP = 8192, NS = 4096, M = NP + NS, SP = 256, SS = 2048, FF = 2816, NH = 16, HD = 64;
constexpr int NPHASE = 16;
constexpr size_t MiB = 1u << 20;
constexpr size_t WS_CTL = 160 * 1024, CTL_BYTES = 16 * 1024;
constexpr size_t WS_MOD = 0, WS_CSCH = 256 * 1024, WS_TP = 512 * 1024, WS_WF = 1 * MiB, WS_WQKV = 3 * MiB,
                 WS_WO = 9 * MiB, WS_WGU = 11 * MiB, WS_WD = 33 * MiB, WS_H = 44 * MiB, WS_MP = 68 * MiB, WS_U = 92 * MiB, WS_R = 158 * MiB;
constexpr size_t WS_YTP = WS_U, WS_YTS = WS_U + 32 * MiB;
constexpr size_t WS_TS = WS_R, WS_F = WS_R + 16 * MiB;
constexpr size_t WS_Q = WS_R, WS_K = WS_R + 24 * MiB, WS_VT = WS_R + 48 * MiB;
constexpr size_t WS_XB = WS_R + 72 * MiB, WS_END = WS_XB + 24 * MiB;
constexpr size_t OUTB_KC = 0, OUTB_VC = 2 * MiB;
constexpr size_t OUT_X = 0, OUT_CK = (size_t)M * D, OUT_CV = OUT_CK + (size_t)NP * D;

struct Params {
    const float* in[16];
    float* out; unsigned char* ws;
    int ph_lo, ph_hi;
};

__device__ __forceinline__ unsigned pk2(float lo, float hi) { f32x2 v = {lo, hi}; bf16x2_t b = __builtin_convertvector(v, bf16x2_t); return __builtin_bit_cast(unsigned, b); }
__device__ __forceinline__ float bf_lo(unsigned w) { return __uint_as_float(w << 16); }
__device__ __forceinline__ float bf_hi(unsigned w) { return __uint_as_float(w & 0xffff0000u); }
template <int CTRL> __device__ __forceinline__ float dpp_mov(float v) { return __builtin_bit_cast(float, __builtin_amdgcn_mov_dpp(__builtin_bit_cast(int, v), CTRL, 0xf, 0xf, true)); }
__device__ __forceinline__ float wave_sum(float v) {
    v += dpp_mov<0xB1>(v); v += dpp_mov<0x4E>(v); v += dpp_mov<0x141>(v); v += dpp_mov<0x140>(v);
    { auto rr = __builtin_amdgcn_permlane16_swap(__float_as_uint(v), __float_as_uint(v), false, false); v = __uint_as_float(rr[0]) + __uint_as_float(rr[1]); }
    { auto rr = __builtin_amdgcn_permlane32_swap(__float_as_uint(v), __float_as_uint(v), false, false); v = __uint_as_float(rr[0]) + __uint_as_float(rr[1]); }
    return v;
}

namespace pg8 {
constexpr int BM = 256, BK = 64, HALF = 128, HTB = HALF * BK * 2, STAGE_BYTES = 8 * HTB;
__device__ __forceinline__ int lds_byte(int r, int c) { const int st = (r >> 4) * 2 + (c >> 5), rr = r & 15, cc = c & 31, ob = rr * 64 + cc * 2; return st * 1024 + (ob ^ (((ob >> 9) & 1) << 5)); }
__device__ __forceinline__ void stage_rc(int b, int& R, int& C) { const int st = b / 1024, sb = b % 1024, swz = sb ^ (((sb >> 9) & 1) << 5); R = (st >> 1) * 16 + swz / 64; C = (st & 1) * 32 + (swz % 64) / 2; }
__device__ __forceinline__ int perm32(int rho) { const int n = rho >> 4, i = rho & 15; return 8 * (i >> 2) + 4 * n + (i & 3); }

struct UnitDesc { const char* A; const char* B; bf16_t* out; int ldc; int aux; };

__device__ __forceinline__ void tile_order(int L, int nM, int nN, int& pm, int& pn) {
    const int nwg = nM * nN; int wgid = L;
    { const int q = nwg / 8, r = nwg % 8, xcd = wgid % 8, off = wgid / 8; wgid = (xcd < r ? xcd * (q + 1) : r * (q + 1) + (xcd - r) * q) + off; }
    const int nig = 8 * nN, gid = wgid / nig, fm = gid * 8, gsz = (nM - fm) < 8 ? (nM - fm) : 8;
    pm = fm + ((wgid % nig) % gsz); pn = (wgid % nig) / gsz;
}

template <class Epi, class Sched, bool ALIGN_EPI>
__device__ __forceinline__ void gemm_phase(LAS unsigned char* lds, const int lda, const int ldb, const int K, const Sched& S, const Epi& E) {
    const int tid = threadIdx.x, wid = __builtin_amdgcn_readfirstlane(tid >> 6), lane = tid & 63, wr = wid >> 2, wc = wid & 3, fr = lane & 15, fq = lane >> 4;
    const int nt = K / BK;
    unsigned voffA[2], voffB[2];
#pragma unroll
    for (int i = 0; i < 2; ++i) { int R, C; stage_rc(tid * 16 + i * 8192, R, C); const int Rb = (R & ~31) + perm32(R & 31);
        voffA[i] = (unsigned)(R * lda + C) * 2u; voffB[i] = (unsigned)(Rb * ldb + C) * 2u; }
    const size_t kstep = (size_t)(BK * 2);
    const size_t hstepA = (size_t)HALF * lda * 2, hstepB = (size_t)HALF * ldb * 2;
    const unsigned ldsw = (unsigned)wid * 1024u;
    const int aoff = lds_byte(wr * 64 + fr, fq * 8), boff = lds_byte(wc * 32 + fr, fq * 8);
#define PG8_SA(b, h) (((b) * 2 + (h)) * HTB)
#define PG8_SB(b, h) ((4 + (b) * 2 + (h)) * HTB)
#define PG8_STAGE(bufoff, gbase, voff) do { _Pragma("unroll") for (int _i = 0; _i < 2; ++_i) \
        __builtin_amdgcn_global_load_lds((const unsigned*)((const char*)(gbase) + (voff)[_i]), (LAS unsigned*)(lds + (bufoff) + ldsw + _i * 8192), 16, 0, 0); } while (0)
#define PG8_LDA(dst, b, h) do { _Pragma("unroll") for (int m = 0; m < 4; ++m) _Pragma("unroll") for (int k = 0; k < 2; ++k) dst[m][k] = *(const LAS bf16x8*)(lds + PG8_SA(b, h) + aoff + m * 2048 + k * 1024); } while (0)
#define PG8_LDB(dst, b, h) do { _Pragma("unroll") for (int n = 0; n < 2; ++n) _Pragma("unroll") for (int k = 0; k < 2; ++k) dst[n][k] = *(const LAS bf16x8*)(lds + PG8_SB(b, h) + boff + n * 2048 + k * 1024); } while (0)
#define PG8_MMA(ai, bj, At, Bt) do { __builtin_amdgcn_s_setprio(1); _Pragma("unroll") for (int m = 0; m < 4; ++m) _Pragma("unroll") for (int n = 0; n < 2; ++n) _Pragma("unroll") for (int k = 0; k < 2; ++k) \
        acc[ai][bj][m][n] = __builtin_amdgcn_mfma_f32_16x16x32_bf16(Bt[n][k], At[m][k], acc[ai][bj][m][n], 0, 0, 0); __builtin_amdgcn_s_setprio(0); } while (0)
#define PG8_WAIT_V(n) asm volatile("s_waitcnt vmcnt(" #n ")" ::: "memory")
#define PG8_WAIT_L(n) asm volatile("s_waitcnt lgkmcnt(" #n ")" ::: "memory")
#define PG8_BAR __builtin_amdgcn_s_barrier()
#define PG8_SCHED __builtin_amdgcn_sched_barrier(0)
    UnitDesc cur, nxt; int ui = 0;
    if (!S.next(0, cur)) return;
    f32x4 acc[2][2][4][2];
#pragma unroll
    for (int a = 0; a < 2; ++a)
#pragma unroll
        for (int b = 0; b < 2; ++b)
#pragma unroll
            for (int m = 0; m < 4; ++m)
#pragma unroll
                for (int n = 0; n < 2; ++n) acc[a][b][m][n] = (f32x4){0.f, 0.f, 0.f, 0.f};
    bf16x8 At[4][2], B0[2][2], B1[2][2];
    const char* cA = cur.A; const char* cB = cur.B;
    PG8_STAGE(PG8_SB(0, 0), cB, voffB); PG8_STAGE(PG8_SB(0, 1), cB + hstepB, voffB); PG8_STAGE(PG8_SA(0, 0), cA, voffA); PG8_STAGE(PG8_SA(0, 1), cA + hstepA, voffA);
    if (wr == 1) PG8_BAR;
    PG8_WAIT_V(2); PG8_BAR;
    PG8_STAGE(PG8_SB(1, 0), cB + kstep, voffB); PG8_STAGE(PG8_SA(1, 0), cA + kstep, voffA); PG8_STAGE(PG8_SB(1, 1), cB + hstepB + kstep, voffB);
    PG8_WAIT_V(6); PG8_BAR;
    for (;;) {
        const bool has_next = S.next(ui + 1, nxt);
        const char* nA = has_next ? nxt.A : cA; const char* nB = has_next ? nxt.B : cB;
#pragma unroll 1
        for (int t = 0; t < nt; t += 2) {
            const bool last = (t == nt - 2);
            const char* a1 = cA + (size_t)(t + 1) * kstep;
            const char* a2 = last ? nA : cA + (size_t)(t + 2) * kstep; const char* b2 = last ? nB : cB + (size_t)(t + 2) * kstep;
            const char* a3 = a2 + kstep; const char* b3 = b2 + kstep;
            PG8_LDB(B0, 0, 0); PG8_LDB(B1, 0, 1); PG8_SCHED; PG8_LDA(At, 0, 0); PG8_STAGE(PG8_SA(1, 1), a1 + hstepA, voffA);
            PG8_WAIT_V(8); PG8_WAIT_L(0); PG8_BAR; PG8_MMA(0, 0, At, B0); PG8_MMA(0, 1, At, B1); PG8_BAR; PG8_SCHED;
            PG8_LDA(At, 0, 1); PG8_STAGE(PG8_SB(0, 0), b2, voffB); PG8_STAGE(PG8_SB(0, 1), b2 + hstepB, voffB); PG8_STAGE(PG8_SA(0, 0), a2, voffA);
            PG8_WAIT_V(8); PG8_WAIT_L(0); PG8_BAR; PG8_MMA(1, 0, At, B0); PG8_MMA(1, 1, At, B1); PG8_BAR; PG8_SCHED;
            PG8_LDB(B0, 1, 0); PG8_LDB(B1, 1, 1); PG8_SCHED; PG8_LDA(At, 1, 0); PG8_STAGE(PG8_SA(0, 1), a2 + hstepA, voffA);
            PG8_WAIT_V(8); PG8_WAIT_L(0); PG8_BAR; PG8_MMA(0, 0, At, B0); PG8_MMA(0, 1, At, B1); PG8_BAR; PG8_SCHED;
            PG8_LDA(At, 1, 1); PG8_STAGE(PG8_SB(1, 0), b3, voffB); PG8_STAGE(PG8_SB(1, 1), b3 + hstepB, voffB); PG8_STAGE(PG8_SA(1, 0), a3, voffA);
            PG8_WAIT_V(8); PG8_WAIT_L(0); PG8_BAR; PG8_MMA(1, 0, At, B0); PG8_MMA(1, 1, At, B1); PG8_BAR; PG8_SCHED;
        }
        if constexpr (ALIGN_EPI) { if (wr == 0) PG8_BAR; }
        E(acc, cur, wr, wc, fr, fq);
        if (!has_next) break;
#pragma unroll
        for (int a = 0; a < 2; ++a)
#pragma unroll
            for (int b = 0; b < 2; ++b)
#pragma unroll
                for (int m = 0; m < 4; ++m)
#pragma unroll
                    for (int n = 0; n < 2; ++n) acc[a][b][m][n] = (f32x4){0.f, 0.f, 0.f, 0.f};
        cur = nxt; cA = nA; cB = nB; ++ui;
        if constexpr (ALIGN_EPI) { if (wr == 1) PG8_BAR; }
    }
    PG8_WAIT_V(0);
    if constexpr (!ALIGN_EPI) { if (wr == 0) PG8_BAR; }
    PG8_BAR;
#undef PG8_SA
#undef PG8_SB
#undef PG8_STAGE
#undef PG8_LDA
#undef PG8_LDB
#undef PG8_MMA
#undef PG8_WAIT_V
#undef PG8_WAIT_L
#undef PG8_BAR
#undef PG8_SCHED
}

struct EpiStore {
    __device__ __forceinline__ void operator()(const f32x4 (&acc)[2][2][4][2], const UnitDesc& u, int wr, int wc, int fr, int fq) const {
#pragma unroll
        for (int ai = 0; ai < 2; ++ai)
#pragma unroll
            for (int m = 0; m < 4; ++m) { bf16_t* rowp = u.out + (size_t)(ai * HALF + wr * 64 + m * 16 + fr) * u.ldc + wc * 32 + 8 * fq;
#pragma unroll
                for (int bj = 0; bj < 2; ++bj) { const f32x4 v0 = acc[ai][bj][m][0], v1 = acc[ai][bj][m][1];
                    u32x4 w; w.x = pk2(v0[0], v0[1]); w.y = pk2(v0[2], v0[3]); w.z = pk2(v1[0], v1[1]); w.w = pk2(v1[2], v1[3]);
                    *(u32x4*)(rowp + bj * HALF) = w; } }
    }
};
__device__ __forceinline__ float swiglu1(float g, float u) { return g * u * __builtin_amdgcn_rcpf(1.0f + __builtin_amdgcn_exp2f(-1.4426950408889634f * g)); }
struct EpiSwiGLU {
    __device__ __forceinline__ void operator()(const f32x4 (&acc)[2][2][4][2], const UnitDesc& u, int wr, int wc, int fr, int fq) const {
#pragma unroll
        for (int ai = 0; ai < 2; ++ai)
#pragma unroll
            for (int m = 0; m < 4; ++m) { bf16_t* rowp = u.out + (size_t)(ai * HALF + wr * 64 + m * 16 + fr) * u.ldc + wc * 32 + 8 * fq;
                const f32x4 g0 = acc[ai][0][m][0], g1 = acc[ai][0][m][1], u0 = acc[ai][1][m][0], u1 = acc[ai][1][m][1];
                u32x4 w; w.x = pk2(swiglu1(g0[0], u0[0]), swiglu1(g0[1], u0[1])); w.y = pk2(swiglu1(g0[2], u0[2]), swiglu1(g0[3], u0[3]));
                w.z = pk2(swiglu1(g1[0], u1[0]), swiglu1(g1[1], u1[1])); w.w = pk2(swiglu1(g1[2], u1[2]), swiglu1(g1[3], u1[3]));
                *(u32x4*)rowp = w; }
    }
};
struct EpiQKV {
    bf16_t* Q; bf16_t* Kb; bf16_t* Vb; float* ck; float* cv;
    __device__ __forceinline__ void operator()(const f32x4 (&acc)[2][2][4][2], const UnitDesc& u, int wr, int wc, int fr, int fq) const {
        const int pm = u.aux & 0xffff, pn = u.aux >> 16, sel = pn >> 2, ct = (pn & 3) * BM;
        const int row0 = pm * BM + wr * 64 + fr, col0 = ct + wc * 32 + 8 * fq;
        bf16_t* base = Q + (size_t)sel * (size_t)(12 * 1024 * 1024); float* cb = ck + (size_t)(sel >= 1 ? sel - 1 : 0) * (size_t)NP * D;
        const bool wc32 = sel >= 1 && pm < NP / BM;
#pragma unroll
        for (int ai = 0; ai < 2; ++ai)
#pragma unroll
            for (int m = 0; m < 4; ++m) { const size_t off = (size_t)(row0 + ai * HALF + m * 16) * D + col0;
#pragma unroll
                for (int bj = 0; bj < 2; ++bj) { const f32x4 v0 = acc[ai][bj][m][0], v1 = acc[ai][bj][m][1];
                    u32x4 w; w.x = pk2(v0[0], v0[1]); w.y = pk2(v0[2], v0[3]); w.z = pk2(v1[0], v1[1]); w.w = pk2(v1[2], v1[3]);
                    *(u32x4*)(base + off + bj * HALF) = w;
                    if (wc32) { *(f32x4*)(cb + off + bj * HALF) = v0; *(f32x4*)(cb + off + bj * HALF + 4) = v1; } } }
    }
};

struct GSched {
    int nM, nN, G, c; const char* A; size_t a_tile; const char* B; size_t b_tile; bf16_t* out; size_t o_pm, o_pn; int ldc;
    __device__ __forceinline__ bool next(int i, UnitDesc& u) const {
        const long L = (long)i * G + c; if (L >= (long)nM * nN) return false;
        int pm, pn; tile_order((int)L, nM, nN, pm, pn);
        u.A = A + (size_t)pm * a_tile; u.B = B + (size_t)pn * b_tile; u.out = out + (size_t)pm * o_pm + (size_t)pn * o_pn; u.ldc = ldc; u.aux = pm | (pn << 16); return true;
    }
};
struct ChDftSched {
    int G, c; const char* cs_tab; const char* H; bf16_t* ytp; bf16_t* yts;
    __device__ __forceinline__ bool next(int i, UnitDesc& u) const {
        const long L = (long)i * G + c; if (L >= 48 * 8) return false;
        int tok, gc; tile_order((int)L, 48, 8, tok, gc); const int g = gc >> 1, cs = gc & 1;
        u.A = cs_tab + (size_t)cs * 256 * 256 * 2; u.B = H + ((size_t)tok * 256 * D + g * 256) * 2;
        if (tok < 32) { u.out = ytp + ((size_t)(tok * D + g * 256) * 512 + cs * 256); u.ldc = 512; }
        else { const int idx = tok - 32, b = idx >> 3, s0 = (idx & 7) * 256; u.out = yts + ((size_t)(b * D + g * 256) * 4096 + cs * 2048 + s0); u.ldc = 4096; }
        u.aux = 0; return true;
    }
};
struct SeqSSched {
    int c; const char* ts; const char* yts; bf16_t* F;
    __device__ __forceinline__ bool next(int i, UnitDesc& u) const {
        if (i > 0 || c >= 64) return false;
        const int b = c >> 5, pm = (c >> 2) & 7, pn = c & 3;
        u.A = ts + (size_t)pm * 256 * 4096 * 2; u.B = yts + (size_t)(b * D + pn * 256) * 4096 * 2;
        u.out = F + ((size_t)(NP + b * SS + pm * 256) * D + pn * 256); u.ldc = D; u.aux = 0; return true;
    }
};
struct SeqPSched {
    int G, c; const char* tp; const char* ytp; bf16_t* F;
    __device__ __forceinline__ bool next(int i, UnitDesc& u) const {
        const int G2 = G - 64; if (c < 64 || G2 <= 0) return false;
        const long L = (long)i * G2 + (c - 64); if (L >= 128) return false;
        const int b = (int)L >> 2, pn = (int)L & 3;
        u.A = tp; u.B = ytp + (size_t)(b * D + pn * 256) * 512 * 2;
        u.out = F + ((size_t)(b * 256) * D + pn * 256); u.ldc = D; u.aux = 0; return true;
    }
};
}

constexpr int TI_L0 = 16 * 32 + 2 * 16 * 88 + 44 * 32, TI_ALL = 16 * 32 + 16 * 96 + 16 * 32 + 4 * 16 * 88 + 2 * 44 * 32;
struct TItem { const float* W; bf16_t* WT; int N, ldt, dst, k0, n0; };
__device__ __forceinline__ bool titem_decode(const Params& p, int it, TItem& t) {
    constexpr int I_F = 16 * 32, I_QKV = 16 * 96, I_O = 16 * 32, I_G = 16 * 88, I_D = 44 * 32;
    constexpr int NITEMS = I_F + I_QKV + I_O + 4 * I_G + 2 * I_D;
    if (it >= NITEMS) return false;
    unsigned char* ws = p.ws; int r = it; int mode = 0;
    if (r < I_F) { t.W = p.in[9]; t.N = D; t.ldt = D; t.WT = (bf16_t*)(ws + WS_WF); }
    else { r -= I_F; int l = 0; if (r >= 2 * I_G + I_D) { r -= 2 * I_G + I_D; l = 1; }
        if (r < I_G) { t.W = p.in[13] + (size_t)l * D * FF; t.N = FF; t.ldt = D; t.WT = (bf16_t*)(ws + WS_WGU) + (size_t)l * 2 * FF * D; mode = 1; }
        else if ((r -= I_G) < I_G) { t.W = p.in[14] + (size_t)l * D * FF; t.N = FF; t.ldt = D; t.WT = (bf16_t*)(ws + WS_WGU) + (size_t)l * 2 * FF * D; mode = 2; }
        else if ((r -= I_G) < I_D) { t.W = p.in[15] + (size_t)l * FF * D; t.N = D; t.ldt = FF; t.WT = (bf16_t*)(ws + WS_WD) + (size_t)l * D * FF; }
        else if ((r -= I_D) < I_QKV) { t.W = p.in[10]; t.N = 3 * D; t.ldt = D; t.WT = (bf16_t*)(ws + WS_WQKV); }
        else { r -= I_QKV; t.W = p.in[12]; t.N = D; t.ldt = D; t.WT = (bf16_t*)(ws + WS_WO); } }
    const int nblk = t.N / 32, kb = r / nblk, nb = r % nblk; t.n0 = nb * 32; t.k0 = kb * 64;
    t.dst = t.n0; if (mode) t.dst = (t.n0 >> 7) * 256 + (t.n0 & 127) + (mode == 2 ? 128 : 0);
    return true;
}
__device__ __forceinline__ void titem_load(const TItem& t, f32x4 (&wv)[8], int lane) {
#pragma unroll
    for (int i = 0; i < 8; ++i) wv[i] = *(const f32x4*)(t.W + (size_t)(t.k0 + 8 * i + (lane >> 3)) * t.N + t.n0 + 4 * (lane & 7));
}
__device__ __forceinline__ void titem_finish(const TItem& t, const f32x4 (&wv)[8], LAS float* scr, int lane) {
#pragma unroll
    for (int i = 0; i < 8; ++i) { LAS float* d = scr + (8 * i + (lane >> 3)) * 33 + 4 * (lane & 7); d[0] = wv[i][0]; d[1] = wv[i][1]; d[2] = wv[i][2]; d[3] = wv[i][3]; }
    asm volatile("s_waitcnt lgkmcnt(0)" ::: "memory");
    const int c = lane & 7;
#pragma unroll
    for (int j = 0; j < 4; ++j) { const int n = (lane >> 3) + 8 * j; const LAS float* s = scr + (8 * c) * 33 + n;
        u32x4 o; o.x = pk2(s[0 * 33], s[1 * 33]); o.y = pk2(s[2 * 33], s[3 * 33]); o.z = pk2(s[4 * 33], s[5 * 33]); o.w = pk2(s[6 * 33], s[7 * 33]);
        *(u32x4*)(t.WT + (size_t)(t.dst + n) * t.ldt + t.k0 + 8 * c) = o; }
    asm volatile("s_waitcnt lgkmcnt(0)" ::: "memory");
}

__device__ __forceinline__ void gemv_layer(const Params& p, LAS unsigned char* lds, const int l, const int rb, const int nb) {
    const int tid = threadIdx.x;
    LAS float* sl = (LAS float*)lds;
    LAS f32x4* red = (LAS f32x4*)(lds + 12288);
    for (int i = tid; i < 3072; i += 512) { const int cond = i >> 10, k = i & 1023; const float v = cond == 0 ? p.in[5][k] : p.in[2][(cond - 1) * D + k]; sl[i] = v / (1.0f + __expf(-v)); }
    __syncthreads();
    float* mod = (float*)(p.ws + WS_MOD);
    for (int item = rb; item < 96; item += nb) {
        const int rem = item, cc = rem >> 4, kc = rem & 15, rpar = tid >> 8, col = cc * 1024 + 4 * (tid & 255);
        const float* W = p.in[6] + ((size_t)l * D + kc * 64 + rpar) * 6144 + col;
        f32x4 a0 = {0.f, 0.f, 0.f, 0.f}, a1 = a0, a2 = a0;
#pragma unroll
        for (int hf = 0; hf < 2; ++hf) {
            f32x4 w[16];
#pragma unroll
            for (int i = 0; i < 16; ++i) w[i] = *(const f32x4*)(W + (size_t)(32 * hf + 2 * i) * 6144);
#pragma unroll
            for (int i = 0; i < 16; ++i) { const int k = kc * 64 + 32 * hf + 2 * i + rpar; a0 += sl[k] * w[i]; a1 += sl[1024 + k] * w[i]; a2 += sl[2048 + k] * w[i]; }
        }
        if (rpar == 1) { red[tid - 256] = a0; red[256 + tid - 256] = a1; red[512 + tid - 256] = a2; }
        __syncthreads();
        if (rpar == 0) {
            a0 += red[tid]; a1 += red[256 + tid]; a2 += red[512 + tid];
            if (kc == 0) { const f32x4 bv = *(const f32x4*)(p.in[7] + l * 6144 + col); a0 += bv; a1 += bv; a2 += bv; }
#pragma unroll
            for (int j = 0; j < 4; ++j) {
                unsafeAtomicAdd(mod + (l * 3 + 0) * 6144 + col + j, a0[j]);
                unsafeAtomicAdd(mod + (l * 3 + 1) * 6144 + col + j, a1[j]);
                unsafeAtomicAdd(mod + (l * 3 + 2) * 6144 + col + j, a2[j]); }
        }
        __syncthreads();
    }
}
__device__ __forceinline__ void transpose_jobs(const Params& p, LAS unsigned char* lds, int gw, int NGW, int it_lo, int it_hi) {
    const int lane = threadIdx.x & 63, wave = threadIdx.x >> 6;
    LAS float* scr = (LAS float*)(lds + wave * 8448);
    TItem cur, nxt; f32x4 wa[8], wb[8];
    int it = it_lo + gw;
    bool have = it < it_hi && titem_decode(p, it, cur);
    if (have) titem_load(cur, wa, lane);
    while (have) {
        const bool hn = it + NGW < it_hi && titem_decode(p, it + NGW, nxt);
        if (hn) titem_load(nxt, wb, lane);
        titem_finish(cur, wa, scr, lane);
        if (!hn) break;
        it += 2 * NGW;
        have = it < it_hi && titem_decode(p, it, cur);
        if (have) titem_load(cur, wa, lane);
        titem_finish(nxt, wb, scr, lane);
    }
}
__device__ __forceinline__ void phase_prologue(const Params& p, LAS unsigned char* lds) {
    const int tid = threadIdx.x, G = gridDim.x, bx = blockIdx.x;
    unsigned char* ws = p.ws;
    LAS float* ct = (LAS float*)(lds + 32768);
    for (int i = tid; i < 2048; i += 512) ct[i] = cospif((float)i * (1.0f / 1024.0f));
    gemv_layer(p, lds, 0, bx, G);
    const int gt = bx * 512 + tid, GT = G * 512;
    for (int i = gt; i < 2 * 2 * 512 * D / 8; i += GT) { const int which = i >= 2 * 512 * D / 8; const int ii = which ? i - 2 * 512 * D / 8 : i;
        const f32x4* src = (const f32x4*)p.in[which ? 4 : 3]; const f32x4 a = src[2 * ii], b = src[2 * ii + 1];
        u32x4 o; o.x = pk2(a[0], a[1]); o.y = pk2(a[2], a[3]); o.z = pk2(b[0], b[1]); o.w = pk2(b[2], b[3]); ((u32x4*)((unsigned char*)p.out + (which ? OUTB_VC : OUTB_KC)))[ii] = o; }
    for (int i = gt; i < 512 * 256 / 8; i += GT) { const int row = i >> 5, c0 = (i & 31) * 8, cs = row >> 8, m = row & 255; float v[8];
#pragma unroll
        for (int j = 0; j < 8; ++j) { const int idx = ((m * (c0 + j)) & 255) * 8; v[j] = ct[(idx - (cs ? 512 : 0)) & 2047]; }
        u32x4 o; o.x = pk2(v[0], v[1]); o.y = pk2(v[2], v[3]); o.z = pk2(v[4], v[5]); o.w = pk2(v[6], v[7]); ((u32x4*)(ws + WS_CSCH))[i] = o; }
    for (int i = gt; i < 256 * 512 / 8; i += GT) { const int k = i >> 6, c0 = (i & 63) * 8; float v[8];
#pragma unroll
        for (int j = 0; j < 8; ++j) { const int kk = c0 + j, sidx = kk & 255; const int idx = ((k * sidx) & 255) * 8; v[j] = kk < 256 ? ct[idx] : -ct[(idx - 512) & 2047]; }
        u32x4 o; o.x = pk2(v[0], v[1]); o.y = pk2(v[2], v[3]); o.z = pk2(v[4], v[5]); o.w = pk2(v[6], v[7]); ((u32x4*)(ws + WS_TP))[i] = o; }
    for (int i = gt; i < 2048 * 4096 / 8; i += GT) { const int k = i >> 9, c0 = (i & 511) * 8; float v[8];
#pragma unroll
        for (int j = 0; j < 8; ++j) { const int kk = c0 + j, sidx = kk & 2047; const int idx = (k * sidx) & 2047; v[j] = kk < 2048 ? ct[idx] : -ct[(idx - 512) & 2047]; }
        u32x4 o; o.x = pk2(v[0], v[1]); o.y = pk2(v[2], v[3]); o.z = pk2(v[4], v[5]); o.w = pk2(v[6], v[7]); ((u32x4*)(ws + WS_TS))[i] = o; }
}
__device__ __forceinline__ void phase_side_jobs(const Params& p, LAS unsigned char* lds, const int which) {
    const int G = gridDim.x, bx = blockIdx.x, first = which == 0 ? 64 : 192;
    const int nb = G > first ? G - first : G, b0 = G > first ? first : 0;
    if (bx < b0) return;
    const int rb = bx - b0;
    if (which == 0) transpose_jobs(p, lds, rb * 8 + (threadIdx.x >> 6), nb * 8, 0, TI_L0);
    else if (which == 1) gemv_layer(p, lds, 1, rb, nb);
    else transpose_jobs(p, lds, rb * 8 + (threadIdx.x >> 6), nb * 8, TI_L0, TI_ALL);
}

#ifndef ROW_WT
#define ROW_WT 0
#endif
__device__ __forceinline__ void store16_wt(void* ptr, u32x4 v) {
#if ROW_WT
    asm volatile("global_store_dwordx4 %0, %1, off sc0 sc1\n\ts_nop 3" :: "v"(ptr), "v"(v) : "memory");
#else
    *(u32x4*)ptr = v;
#endif
}
__device__ __forceinline__ void bf8_to_f32(const u32x4 w, f32x4& a, f32x4& b) { a = (f32x4){bf_lo(w.x), bf_hi(w.x), bf_lo(w.y), bf_hi(w.y)}; b = (f32x4){bf_lo(w.z), bf_hi(w.z), bf_lo(w.w), bf_hi(w.w)}; }
__device__ __forceinline__ u32x4 f32_to_bf8(const f32x4 a, const f32x4 b) { u32x4 w; w.x = pk2(a[0], a[1]); w.y = pk2(a[2], a[3]); w.z = pk2(b[0], b[1]); w.w = pk2(b[2], b[3]); return w; }
template <bool HAS_MP, bool HAS_NEXT, bool XIN_F32>
__device__ __forceinline__ void row_phase(const float* xin_p, const float* xin_s, bf16_t* XB, const bf16_t* mp, float* Yout, bf16_t* Hout,
                                          const float* gate, const float* gA, const float* gB, const float* sc, const float* sh) {
    const int tid = threadIdx.x, lane = tid & 63, gw = blockIdx.x * 8 + (tid >> 6), NGW = gridDim.x * 8;
    constexpr int R = 3, RW = 6;
    int cur_cond = -1;
    f32x4 gga[4], gbs[4], shv[4];
    for (int rowb = gw * RW; rowb < M; rowb += NGW * RW)
    for (int row0 = rowb; row0 < rowb + RW; row0 += R) {
        f32x4 v[R][4]; u32x4 mw[R][2];
#pragma unroll
        for (int q = 0; q < R; ++q) { const int row = row0 + q;
            if constexpr (XIN_F32) { const float* xr = row < NP ? xin_p + (size_t)row * D : xin_s + (size_t)(row - NP) * D;
#pragma unroll
                for (int j = 0; j < 2; ++j) { v[q][2 * j] = *(const f32x4*)(xr + 8 * lane + 512 * j); v[q][2 * j + 1] = *(const f32x4*)(xr + 8 * lane + 512 * j + 4); }
            } else {
#pragma unroll
                for (int j = 0; j < 2; ++j) { const u32x4 w = *(const u32x4*)(XB + (size_t)row * D + 8 * lane + 512 * j); bf8_to_f32(w, v[q][2 * j], v[q][2 * j + 1]); }
            }
            if constexpr (HAS_MP) {
#pragma unroll
                for (int j = 0; j < 2; ++j) mw[q][j] = *(const u32x4*)(mp + (size_t)row * D + 8 * lane + 512 * j);
            } }
        u32x4 xo[R][2], ho[R][2];
#pragma unroll
        for (int q = 0; q < R; ++q) { const int row = row0 + q; const int cond = row < NP ? 0 : (row < NP + SS ? 1 : 2);
            if (cond != cur_cond) { cur_cond = cond;
#pragma unroll
                for (int j = 0; j < 4; ++j) { const int col = 8 * lane + 512 * (j >> 1) + 4 * (j & 1);
                    if constexpr (HAS_MP) gga[j] = *(const f32x4*)(gate + cond * 6144 + col) * *(const f32x4*)(gA + col);
                    if constexpr (HAS_NEXT) { gbs[j] = *(const f32x4*)(gB + col) * (1.0f + *(const f32x4*)(sc + cond * 6144 + col)); shv[j] = *(const f32x4*)(sh + cond * 6144 + col); } } }
            if constexpr (HAS_MP) {
                f32x4 mv[4]; float s = 0.f;
#pragma unroll
                for (int j = 0; j < 2; ++j) bf8_to_f32(mw[q][j], mv[2 * j], mv[2 * j + 1]);
#pragma unroll
                for (int j = 0; j < 4; ++j) s += (mv[j][0] * mv[j][0] + mv[j][1] * mv[j][1]) + (mv[j][2] * mv[j][2] + mv[j][3] * mv[j][3]);
                const float rstd = 1.0f / sqrtf(wave_sum(s) * (1.0f / D) + 1e-6f);
#pragma unroll
                for (int j = 0; j < 4; ++j) v[q][j] = v[q][j] + gga[j] * (mv[j] * rstd);
                if constexpr (HAS_NEXT) {
#pragma unroll
                    for (int j = 0; j < 2; ++j) xo[q][j] = f32_to_bf8(v[q][2 * j], v[q][2 * j + 1]);
                }
            }
            if constexpr (HAS_NEXT) {
                float s = 0.f;
#pragma unroll
                for (int j = 0; j < 4; ++j) s += (v[q][j][0] * v[q][j][0] + v[q][j][1] * v[q][j][1]) + (v[q][j][2] * v[q][j][2] + v[q][j][3] * v[q][j][3]);
                const float rstd = 1.0f / sqrtf(wave_sum(s) * (1.0f / D) + 1e-6f);
                f32x4 hh[4];
#pragma unroll
                for (int j = 0; j < 4; ++j) hh[j] = (v[q][j] * rstd) * gbs[j] + shv[j];
#pragma unroll
                for (int j = 0; j < 2; ++j) ho[q][j] = f32_to_bf8(hh[2 * j], hh[2 * j + 1]);
            } }
#pragma unroll
        for (int q = 0; q < R; ++q) { const int row = row0 + q;
            if constexpr (HAS_MP && !HAS_NEXT) {
#pragma unroll
                for (int j = 0; j < 4; ++j) *(f32x4*)(Yout + (size_t)row * D + 8 * lane + 512 * (j >> 1) + 4 * (j & 1)) = v[q][j];
            }
            if constexpr (HAS_MP && HAS_NEXT) {
#pragma unroll
                for (int j = 0; j < 2; ++j) store16_wt(XB + (size_t)row * D + 8 * lane + 512 * j, xo[q][j]);
            }
            if constexpr (HAS_NEXT) {
#pragma unroll
                for (int j = 0; j < 2; ++j) store16_wt(Hout + (size_t)row * D + 8 * lane + 512 * j, ho[q][j]);
            } }
    }
}

__device__ __forceinline__ void attn_phase(const Params& p, LAS unsigned char* lds) {
    const int tid = threadIdx.x, lane = tid & 63, wave = __builtin_amdgcn_readfirstlane(tid >> 6), r = lane & 31, hh = lane >> 5;
    unsigned char* ws = p.ws;
    const bf16_t* Qb = (const bf16_t*)(ws + WS_Q); const bf16_t* Kb = (const bf16_t*)(ws + WS_K); const bf16_t* Vb = (const bf16_t*)(ws + WS_VT);
    const bf16_t* Kc = (const bf16_t*)((const unsigned char*)p.out + OUTB_KC); const bf16_t* Vc = (const bf16_t*)((const unsigned char*)p.out + OUTB_VC);
    bf16_t* Ob = (bf16_t*)(ws + WS_H);
    LAS float* Bl = (LAS float*)(lds + 36864 + 512);
    const int srow = tid >> 3, sch = tid & 7, krho = (srow & ~12) | ((srow & 4) << 1) | ((srow & 8) >> 1);
    const float c2 = 0.125f * 1.4426950408889634f;
    for (int unit = blockIdx.x; unit < 768; unit += gridDim.x) {
        const bool is_na = unit < 256;
        int b, h, qtok, nt, jmin = 0, nloc = 0, rq = 0, half = 0, ktok0;
        if (is_na) { b = unit >> 7; h = (unit >> 3) & 15; const int r0 = (unit & 7) * 4; rq = r0 + (wave >> 1); half = wave & 1;
            jmin = min(max(r0 - 4, 0), 24); const int jmax = min(max(r0 - 1, 0), 24) + 7; nloc = jmax - jmin + 1; nt = nloc + 8;
            qtok = NP + b * SS + rq * 64 + half * 32 + r; ktok0 = NP + b * SS; }
        else { const int u2 = unit - 256; b = u2 >> 4; h = u2 & 15; nt = 4; qtok = b * SP + wave * 32 + r; ktok0 = b * SP; }
        const int rs = min(max(rq - 4, 0), 24);
        if (is_na) { for (int i = tid; i < 15 * 32; i += 512) { const int rr = i >> 5, x = i & 31; Bl[i] = x < 31 ? p.in[11][(h * 15 + rr) * 31 + x] * 1.4426950408889634f : 0.f; } }
        bf16x8 qf[4];
#pragma unroll
        for (int d0 = 0; d0 < 4; ++d0) qf[d0] = *(const bf16x8*)(Qb + (size_t)qtok * D + h * HD + d0 * 16 + hh * 8);
        f32x16 o0, o1;
#pragma unroll
        for (int i = 0; i < 16; ++i) { o0[i] = 0.f; o1[i] = 0.f; }
        float m_run = -1e30f, l_run = 0.f;
        u32x4 kreg, vreg;
#define ATT_LOAD(t) do { const int t_ = (t); size_t off_; const bf16_t* kb_; const bf16_t* vb_; \
            if (is_na && t_ >= nloc) { off_ = ((size_t)(b * 512 + (t_ - nloc) * 64 + srow)) * D + h * HD + sch * 8; kb_ = Kc; vb_ = Vc; } \
            else { off_ = (size_t)(ktok0 + (is_na ? (jmin + t_) * 64 : t_ * 64) + srow) * D + h * HD + sch * 8; kb_ = Kb; vb_ = Vb; } \
            kreg = *(const u32x4*)(kb_ + off_); vreg = *(const u32x4*)(vb_ + off_); } while (0)
#define ATT_STORE(buf) do { LAS unsigned char* kl_ = lds + (buf) * 18432; LAS unsigned char* vl_ = kl_ + 9216; \
            *(LAS u32x4*)(kl_ + krho * 144 + sch * 16) = kreg; \
            LAS bf16_t* vd_ = (LAS bf16_t*)(vl_ + (8 * sch) * 144 + srow * 2); \
            vd_[0 * 72] = (bf16_t)vreg.x; vd_[1 * 72] = (bf16_t)(vreg.x >> 16); vd_[2 * 72] = (bf16_t)vreg.y; vd_[3 * 72] = (bf16_t)(vreg.y >> 16); \
            vd_[4 * 72] = (bf16_t)vreg.z; vd_[5 * 72] = (bf16_t)(vreg.z >> 16); vd_[6 * 72] = (bf16_t)vreg.w; vd_[7 * 72] = (bf16_t)(vreg.w >> 16); } while (0)
        ATT_LOAD(0); ATT_STORE(0); if (nt > 1) ATT_LOAD(1);
        __syncthreads();
        for (int t = 0; t < nt; ++t) {
            if (t + 1 < nt) { ATT_STORE((t + 1) & 1); if (t + 2 < nt) ATT_LOAD(t + 2); }
            const bool local = is_na && t < nloc; const int j = jmin + t;
            if (!(local && (j < rs || j >= rs + 8))) {
                const LAS unsigned char* Kl = lds + (t & 1) * 18432; const LAS unsigned char* Vl = Kl + 9216;
                f32x16 p0, p1;
#pragma unroll
                for (int i = 0; i < 16; ++i) { p0[i] = 0.f; p1[i] = 0.f; }
#pragma unroll
                for (int d0 = 0; d0 < 4; ++d0) { const bf16x8 a0 = *(const LAS bf16x8*)(Kl + r * 144 + d0 * 32 + hh * 16), a1 = *(const LAS bf16x8*)(Kl + (32 + r) * 144 + d0 * 32 + hh * 16);
                    p0 = __builtin_amdgcn_mfma_f32_32x32x16_bf16(a0, qf[d0], p0, 0, 0, 0); p1 = __builtin_amdgcn_mfma_f32_32x32x16_bf16(a1, qf[d0], p1, 0, 0, 0); }
                float m_new, alpha;
                if (local) {
                    const int qc = half * 32 + r, cs = min(max(qc - 8, 0), 48);
                    const LAS float* bp = Bl + (j - rq + 7) * 32 + 8 * hh - qc + 15;
                    float bb0[16], bb1[16];
#pragma unroll
                    for (int i = 0; i < 16; ++i) { const int kc = 16 * (i >> 3) + (i & 7); bb0[i] = bp[kc]; bb1[i] = bp[kc + 32]; }
                    asm volatile("" : "+v"(bb0[0]), "+v"(bb0[1]), "+v"(bb0[2]), "+v"(bb0[3]), "+v"(bb0[4]), "+v"(bb0[5]), "+v"(bb0[6]), "+v"(bb0[7]));
                    asm volatile("" : "+v"(bb0[8]), "+v"(bb0[9]), "+v"(bb0[10]), "+v"(bb0[11]), "+v"(bb0[12]), "+v"(bb0[13]), "+v"(bb0[14]), "+v"(bb0[15]));
                    asm volatile("" : "+v"(bb1[0]), "+v"(bb1[1]), "+v"(bb1[2]), "+v"(bb1[3]), "+v"(bb1[4]), "+v"(bb1[5]), "+v"(bb1[6]), "+v"(bb1[7]));
                    asm volatile("" : "+v"(bb1[8]), "+v"(bb1[9]), "+v"(bb1[10]), "+v"(bb1[11]), "+v"(bb1[12]), "+v"(bb1[13]), "+v"(bb1[14]), "+v"(bb1[15]));
                    const unsigned sh0 = (unsigned)(8 * hh - cs);
#pragma unroll
                    for (int i = 0; i < 16; ++i) { const int kc = 16 * (i >> 3) + (i & 7);
                        const float s0 = __builtin_fmaf(p0[i], c2, bb0[i]), s1 = __builtin_fmaf(p1[i], c2, bb1[i]);
                        p0[i] = (sh0 + (unsigned)kc) < 16u ? s0 : -1e30f; p1[i] = (sh0 + (unsigned)(kc + 32)) < 16u ? s1 : -1e30f; }
                    float mt = fmaxf(p0[0], p1[0]);
#pragma unroll
                    for (int i = 1; i < 16; ++i) mt = fmaxf(mt, fmaxf(p0[i], p1[i]));
                    mt = fmaxf(mt, __shfl_xor(mt, 32));
                    m_new = fmaxf(m_run, mt); alpha = __builtin_amdgcn_exp2f(m_run - m_new);
#pragma unroll
                    for (int i = 0; i < 16; ++i) { p0[i] = __builtin_amdgcn_exp2f(p0[i] - m_new); p1[i] = __builtin_amdgcn_exp2f(p1[i] - m_new); }
                } else {
                    float mt = fmaxf(p0[0], p1[0]);
#pragma unroll
                    for (int i = 1; i < 16; ++i) mt = fmaxf(mt, fmaxf(p0[i], p1[i]));
                    mt = fmaxf(mt, __shfl_xor(mt, 32)) * c2;
                    m_new = fmaxf(m_run, mt); alpha = __builtin_amdgcn_exp2f(m_run - m_new);
#pragma unroll
                    for (int i = 0; i < 16; ++i) { p0[i] = __builtin_amdgcn_exp2f(__builtin_fmaf(p0[i], c2, -m_new)); p1[i] = __builtin_amdgcn_exp2f(__builtin_fmaf(p1[i], c2, -m_new)); }
                }
                m_run = m_new;
                float ls = 0.f;
#pragma unroll
                for (int i = 0; i < 16; ++i) ls += p0[i] + p1[i];
                l_run = l_run * alpha + ls;
#pragma unroll
                for (int i = 0; i < 16; ++i) { o0[i] *= alpha; o1[i] *= alpha; }
                bf16x8 pa[4];
#pragma unroll
                for (int s2 = 0; s2 < 2; ++s2) { u32x4 w; w.x = pk2(p0[8 * s2], p0[8 * s2 + 1]); w.y = pk2(p0[8 * s2 + 2], p0[8 * s2 + 3]); w.z = pk2(p0[8 * s2 + 4], p0[8 * s2 + 5]); w.w = pk2(p0[8 * s2 + 6], p0[8 * s2 + 7]); pa[s2] = __builtin_bit_cast(bf16x8, w);
                    u32x4 w2; w2.x = pk2(p1[8 * s2], p1[8 * s2 + 1]); w2.y = pk2(p1[8 * s2 + 2], p1[8 * s2 + 3]); w2.z = pk2(p1[8 * s2 + 4], p1[8 * s2 + 5]); w2.w = pk2(p1[8 * s2 + 6], p1[8 * s2 + 7]); pa[2 + s2] = __builtin_bit_cast(bf16x8, w2); }
#pragma unroll
                for (int s2 = 0; s2 < 4; ++s2) { const bf16x8 v0 = *(const LAS bf16x8*)(Vl + r * 144 + s2 * 32 + hh * 16), v1 = *(const LAS bf16x8*)(Vl + (32 + r) * 144 + s2 * 32 + hh * 16);
                    o0 = __builtin_amdgcn_mfma_f32_32x32x16_bf16(v0, pa[s2], o0, 0, 0, 0); o1 = __builtin_amdgcn_mfma_f32_32x32x16_bf16(v1, pa[s2], o1, 0, 0, 0); }
            }
            __syncthreads();
        }
#undef ATT_LOAD
#undef ATT_STORE
        const float inv = 1.0f / (l_run + __shfl_xor(l_run, 32));
        bf16_t* orow = Ob + (size_t)qtok * D + h * HD + 4 * hh;
#pragma unroll
        for (int g = 0; g < 4; ++g) { u32x2 w; w.x = pk2(o0[4 * g] * inv, o0[4 * g + 1] * inv); w.y = pk2(o0[4 * g + 2] * inv, o0[4 * g + 3] * inv); *(u32x2*)(orow + 8 * g) = w;
            u32x2 w2; w2.x = pk2(o1[4 * g] * inv, o1[4 * g + 1] * inv); w2.y = pk2(o1[4 * g + 2] * inv, o1[4 * g + 3] * inv); *(u32x2*)(orow + 32 + 8 * g) = w2; }
    }
    __syncthreads();
}

#define XB_TMO      128
#define XB_XCNT(j)  (256  + 64 * (j))
#define XB_XSUB(j)  (1280 + 64 * (j))
#define XB_XGEN(j)  (2304 + 64 * (j))
#define XB_TOP      3328
#define XB_TOPGEN   3392
#define XCD_BAR_WORDS 3456
#define XB_SPIN_CAP (1u << 18)
__device__ __forceinline__ unsigned xb_ld(unsigned* p)              { return __hip_atomic_load(p, __ATOMIC_RELAXED, __HIP_MEMORY_SCOPE_AGENT); }
__device__ __forceinline__ unsigned xb_add(unsigned* p, unsigned v) { return __hip_atomic_fetch_add(p, v, __ATOMIC_RELAXED, __HIP_MEMORY_SCOPE_AGENT); }
__device__ __forceinline__ unsigned xb_xcc_id() { return (unsigned)__builtin_amdgcn_s_getreg((3 << 11) | 20) & 0xFu; }
#define XB_SPIN(cond, bar) do { unsigned _sp = 0; while (cond) { __builtin_amdgcn_s_sleep(1); \
    if ((++_sp & 255u) == 0u) { if (xb_ld(&(bar)[XB_TMO])) break; if (_sp > XB_SPIN_CAP) { atomicAdd(&(bar)[XB_TMO], 1u); break; } } } } while (0)
struct XcdBarrier { unsigned* bar; unsigned x; volatile LAS unsigned* st; };
__device__ __forceinline__ XcdBarrier xcd_barrier_post(unsigned* bar, volatile LAS unsigned* st) {
    XcdBarrier b; b.bar = bar; b.x = xb_xcc_id(); b.st = st;
    if (threadIdx.x == 0) (void)xb_add(&bar[XB_XCNT(b.x)], 1u);
    return b;
}
__device__ __forceinline__ void xcd_barrier_complete(unsigned* bar, unsigned x, unsigned& nloc, unsigned& nx) {
    const unsigned G = gridDim.x * gridDim.y * gridDim.z;
    unsigned sum, cnt, mine, sp = 0u;
    for (;;) {
        sum = 0u; cnt = 0u; mine = 0u;
#pragma unroll
        for (unsigned j = 0; j < 16; ++j) { const unsigned c = xb_ld(&bar[XB_XCNT(j)]); sum += c; cnt += (c > 0u) ? 1u : 0u; mine = (j == x) ? c : mine; }
        if (sum == G) break;
        __builtin_amdgcn_s_sleep(1);
        if ((++sp & 255u) == 0u) { if (xb_ld(&bar[XB_TMO])) break; if (sp > XB_SPIN_CAP) { atomicAdd(&bar[XB_TMO], 1u); break; } }
    }
    nloc = mine > 0u ? mine : 1u; nx = cnt > 0u ? cnt : 1u;
}
__device__ __forceinline__ void xcd_barrier(const XcdBarrier& b) {
    asm volatile("s_waitcnt vmcnt(0)" ::: "memory");
    __syncthreads();
    if (threadIdx.x == 0) {
        unsigned* bar = b.bar;
        __builtin_amdgcn_s_waitcnt(0);
        unsigned nloc = b.st[0], nx = b.st[1];
        if (nloc == 0u) { xcd_barrier_complete(bar, b.x, nloc, nx); b.st[0] = nloc; b.st[1] = nx; }
        const unsigned old = xb_add(&bar[XB_XSUB(b.x)], 1u);
        const unsigned gen = old / nloc;
        if (old + 1u == (gen + 1u) * nloc) {
            __builtin_amdgcn_fence(__ATOMIC_RELEASE, "agent");
            asm volatile("s_waitcnt vmcnt(0)" ::: "memory");
            const unsigned og = xb_add(&bar[XB_TOP], 1u);
            const unsigned tg = og / nx;
            if (og + 1u == (tg + 1u) * nx) xb_add(&bar[XB_TOPGEN], 1u);
            else XB_SPIN(xb_ld(&bar[XB_TOPGEN]) == tg, bar);
            __builtin_amdgcn_fence(__ATOMIC_ACQUIRE, "agent");
            xb_add(&bar[XB_XGEN(b.x)], 1u);
            asm volatile("s_waitcnt vmcnt(0)" ::: "memory");
        } else {
            XB_SPIN(xb_ld(&bar[XB_XGEN(b.x)]) == gen, bar);
            __builtin_amdgcn_fence(__ATOMIC_ACQUIRE, "agent");
            asm volatile("s_waitcnt vmcnt(0)" ::: "memory");
        }
    }
    __syncthreads();
}

__global__ void __launch_bounds__(512, 2) mega_fwd(Params p) {
    extern __shared__ __attribute__((aligned(16))) unsigned char lds_raw[];
    LAS unsigned char* lds = (LAS unsigned char*)lds_raw;
    unsigned char* ws = p.ws;
    const int G = gridDim.x, c = blockIdx.x, lo = p.ph_lo, hi = p.ph_hi;
    const float* mod = (const float*)(ws + WS_MOD);
    const float* norm_g = p.in[8];
    bf16_t* H = (bf16_t*)(ws + WS_H); bf16_t* MPb = (bf16_t*)(ws + WS_MP); bf16_t* U = (bf16_t*)(ws + WS_U);
    float* X = p.out + OUT_X; bf16_t* XB = (bf16_t*)(ws + WS_XB);
    volatile LAS unsigned* MISC = (volatile LAS unsigned*)(lds + 131072 + 320);
    if (threadIdx.x < 32) MISC[threadIdx.x] = 0u;
    __syncthreads();
    XcdBarrier bar; bar.bar = (unsigned*)(ws + WS_CTL); bar.x = 0; bar.st = nullptr;
    if (hi - lo > 1) bar = xcd_barrier_post((unsigned*)(ws + WS_CTL), MISC + 8);
    if (hi > 1000) cg::this_grid().sync();
#ifndef PH_MASK
#define PH_MASK 0xffff
#endif
#define IN(k) (((PH_MASK >> (k)) & 1) && lo <= (k) && (k) < hi)
#ifndef PROBE_REP
#define PROBE_REP -1
#endif
#ifndef PROBE_SYNC2
#define PROBE_SYNC2 0
#endif
#define REPS(k) for (int rep_ = 0; rep_ < ((k) == PROBE_REP ? 2 : 1); ++rep_)
#ifndef PROBE_PHASE
#define PROBE_PHASE -1
#endif
    unsigned long long pt0 = 0, pt1 = 0;
    if (PROBE_PHASE == 0) pt0 = __builtin_amdgcn_s_memrealtime();
#define SEAM(k) do { if ((k) + 1 < hi) { xcd_barrier(bar); if (PROBE_SYNC2) xcd_barrier(bar); } \
        if ((k) == PROBE_PHASE) pt1 = __builtin_amdgcn_s_memrealtime(); if ((k) + 1 == PROBE_PHASE) pt0 = __builtin_amdgcn_s_memrealtime(); } while (0)

    if (IN(0)) { REPS(0) { phase_prologue(p, lds); } SEAM(0); }
    if (IN(1)) { REPS(1) {
        row_phase<false, true, true>(p.in[0], p.in[1], nullptr, nullptr, nullptr, H, nullptr, nullptr, norm_g, mod + 1 * D, mod + 0 * D);
        } SEAM(1);
    }
    if (IN(2)) { REPS(2) {
        pg8::ChDftSched S{G, c, (const char*)(ws + WS_CSCH), (const char*)H, (bf16_t*)(ws + WS_YTP), (bf16_t*)(ws + WS_YTS)};
        pg8::gemm_phase<pg8::EpiStore, pg8::ChDftSched, true>(lds, 256, D, 256, S, pg8::EpiStore{});
        } SEAM(2);
    }
    if (IN(3)) { REPS(3) {
        { pg8::SeqSSched S{c, (const char*)(ws + WS_TS), (const char*)(ws + WS_YTS), (bf16_t*)(ws + WS_F)};
          pg8::gemm_phase<pg8::EpiStore, pg8::SeqSSched, true>(lds, 4096, 4096, 4096, S, pg8::EpiStore{}); }
        { pg8::SeqPSched S{G, c, (const char*)(ws + WS_TP), (const char*)(ws + WS_YTP), (bf16_t*)(ws + WS_F)};
          pg8::gemm_phase<pg8::EpiStore, pg8::SeqPSched, true>(lds, 512, 512, 512, S, pg8::EpiStore{}); }
        phase_side_jobs(p, lds, 0);
        } SEAM(3);
    }
    if (IN(4)) { REPS(4) {
        pg8::GSched S{48, 4, G, c, (const char*)(ws + WS_F), (size_t)256 * D * 2, (const char*)(ws + WS_WF), (size_t)256 * D * 2, MPb, (size_t)256 * D, 256, D};
        pg8::gemm_phase<pg8::EpiStore, pg8::GSched, true>(lds, D, D, D, S, pg8::EpiStore{});
        phase_side_jobs(p, lds, 1);
        } SEAM(4);
    }
    if (IN(5)) { REPS(5) {
        row_phase<true, true, true>(p.in[0], p.in[1], XB, MPb, nullptr, H, mod + 2 * D, norm_g + 1 * D, norm_g + 2 * D, mod + 4 * D, mod + 3 * D);
        } SEAM(5);
    }
    if (IN(6)) { REPS(6) {
        pg8::GSched S{48, 22, G, c, (const char*)H, (size_t)256 * D * 2, (const char*)(ws + WS_WGU), (size_t)256 * D * 2, U, (size_t)256 * FF, 128, FF};
        pg8::gemm_phase<pg8::EpiSwiGLU, pg8::GSched, true>(lds, D, D, D, S, pg8::EpiSwiGLU{});
        } SEAM(6);
    }
    if (IN(7)) { REPS(7) {
        pg8::GSched S{48, 4, G, c, (const char*)U, (size_t)256 * FF * 2, (const char*)(ws + WS_WD), (size_t)256 * FF * 2, MPb, (size_t)256 * D, 256, D};
        pg8::gemm_phase<pg8::EpiStore, pg8::GSched, true>(lds, FF, FF, FF, S, pg8::EpiStore{});
        phase_side_jobs(p, lds, 2);
        } SEAM(7);
    }
    if (IN(8)) { REPS(8) {
        row_phase<true, true, false>(nullptr, nullptr, XB, MPb, nullptr, H, mod + 5 * D, norm_g + 3 * D, norm_g + 4 * D, mod + 3 * 6144 + 1 * D, mod + 3 * 6144 + 0 * D);
        } SEAM(8);
    }
    if (IN(9)) { REPS(9) {
        pg8::GSched S{48, 12, G, c, (const char*)H, (size_t)256 * D * 2, (const char*)(ws + WS_WQKV), (size_t)256 * D * 2, nullptr, 0, 0, D};
        pg8::EpiQKV E{(bf16_t*)(ws + WS_Q), (bf16_t*)(ws + WS_K), (bf16_t*)(ws + WS_VT), p.out + OUT_CK, p.out + OUT_CV};
        pg8::gemm_phase<pg8::EpiQKV, pg8::GSched, true>(lds, D, D, D, S, E);
        } SEAM(9);
    }
    if (IN(10)) { REPS(10) { attn_phase(p, lds); } SEAM(10); }
    if (IN(11)) { REPS(11) {
        pg8::GSched S{48, 4, G, c, (const char*)H, (size_t)256 * D * 2, (const char*)(ws + WS_WO), (size_t)256 * D * 2, MPb, (size_t)256 * D, 256, D};
        pg8::gemm_phase<pg8::EpiStore, pg8::GSched, true>(lds, D, D, D, S, pg8::EpiStore{});
        } SEAM(11);
    }
    if (IN(12)) { REPS(12) {
        row_phase<true, true, false>(nullptr, nullptr, XB, MPb, nullptr, H, mod + 3 * 6144 + 2 * D, norm_g + 5 * D, norm_g + 6 * D, mod + 3 * 6144 + 4 * D, mod + 3 * 6144 + 3 * D);
        } SEAM(12);
    }
    if (IN(13)) { REPS(13) {
        pg8::GSched S{48, 22, G, c, (const char*)H, (size_t)256 * D * 2, (const char*)(ws + WS_WGU) + (size_t)2 * FF * D * 2, (size_t)256 * D * 2, U, (size_t)256 * FF, 128, FF};
        pg8::gemm_phase<pg8::EpiSwiGLU, pg8::GSched, true>(lds, D, D, D, S, pg8::EpiSwiGLU{});
        } SEAM(13);
    }
    if (IN(14)) { REPS(14) {
        pg8::GSched S{48, 4, G, c, (const char*)U, (size_t)256 * FF * 2, (const char*)(ws + WS_WD) + (size_t)D * FF * 2, (size_t)256 * FF * 2, MPb, (size_t)256 * D, 256, D};
        pg8::gemm_phase<pg8::EpiStore, pg8::GSched, true>(lds, FF, FF, FF, S, pg8::EpiStore{});
        } SEAM(14);
    }
    if (IN(15)) { REPS(15) {
        row_phase<true, false, false>(nullptr, nullptr, XB, MPb, X, nullptr, mod + 3 * 6144 + 5 * D, norm_g + 7 * D, nullptr, nullptr, nullptr); }
    }
    if (PROBE_PHASE >= 0 && blockIdx.x == 0) { if (PROBE_PHASE == 15) pt1 = __builtin_amdgcn_s_memrealtime();
        const unsigned long long tend = __builtin_amdgcn_s_memrealtime(), wait = 9ull * (pt1 - pt0);
        while (__builtin_amdgcn_s_memrealtime() - tend < wait) __builtin_amdgcn_s_sleep(8); }
#undef IN
#undef SEAM
}

constexpr int LDS_BYTES = 147456;
extern "C" void kernel_launch(void* const* d_in, const int* in_sizes, int n_in, void* d_out, int out_size, void* d_ws, size_t ws_size, hipStream_t stream) {
    static int grid = 0;
    if (grid == 0) {
        int dev = 0, cus = 0, per_cu = 0;
        hipGetDevice(&dev);
        hipDeviceGetAttribute(&cus, hipDeviceAttributeMultiprocessorCount, dev);
        if (hipFuncSetAttribute((const void*)mega_fwd, hipFuncAttributeMaxDynamicSharedMemorySize, LDS_BYTES) != hipSuccess) fprintf(stderr, "kernel_launch: hipFuncSetAttribute failed\n");
        if (hipOccupancyMaxActiveBlocksPerMultiprocessor(&per_cu, (const void*)mega_fwd, 512, LDS_BYTES) != hipSuccess || per_cu < 1) { fprintf(stderr, "kernel_launch: occupancy query says %d\n", per_cu); per_cu = 1; }
        (void)hipGetLastError();
        grid = cus * 1;
        if (n_in != 16 || ws_size < WS_END) { fprintf(stderr, "kernel_launch: unexpected n_in %d / ws %zu\n", n_in, ws_size); }
    }
    Params p{};
    (void)hipMemsetAsync((unsigned char*)d_ws, 0, WS_CTL + CTL_BYTES, stream);
    for (int i = 0; i < 16; ++i) p.in[i] = (const float*)d_in[i];
    p.out = (float*)d_out; p.ws = (unsigned char*)d_ws;
    if (MK_N_LAUNCHES == 1) {
        p.ph_lo = 0; p.ph_hi = NPHASE;
        void* args[] = {&p};
        hipError_t e = hipLaunchCooperativeKernel((const void*)mega_fwd, dim3(grid), dim3(512), args, LDS_BYTES, stream);
        if (e != hipSuccess) fprintf(stderr, "cooperative launch failed: %s (grid %d)\n", hipGetErrorString(e), grid);
    } else {
        for (int k = 0; k < NPHASE; ++k) { p.ph_lo = k; p.ph_hi = k + 1; hipLaunchKernelGGL(mega_fwd, dim3(grid), dim3(512), LDS_BYTES, stream, p); }
    }
}
```

```cpp
#include <hip/hip_runtime.h>
#include <hip/hip_cooperative_groups.h>
#include <cstdio>
#include <cstdint>
namespace cg = cooperative_groups;

#ifndef MK_N_LAUNCHES
#define MK_N_LAUNCHES 1
#endif

#define LAS __attribute__((address_space(3)))
typedef unsigned short bf16_t;
typedef short bf16x8 __attribute__((ext_vector_type(8)));
typedef float f32x2 __attribute__((ext_vector_type(2)));
typedef float f32x4 __attribute__((ext_vector_type(4)));
typedef float f32x16 __attribute__((ext_vector_type(16)));
typedef unsigned u32x2 __attribute__((ext_vector_type(2)));
typedef unsigned u32x4 __attribute__((ext_vector_type(4)));
typedef __bf16 bf16x2_t __attribute__((ext_vector_type(2)));

constexpr int D = 1024, NP = 8192, NS = 4096, M = NP + NS, SP = 256, SS = 2048, FF = 2816, NH = 16, HD = 64;
constexpr int NPHASE = 16;
constexpr size_t MiB = 1u << 20;
constexpr size_t WS_CTL = 160 * 1024, CTL_BYTES = 16 * 1024;
constexpr size_t WS_MOD = 0, WS_CSCH = 256 * 1024, WS_TP = 512 * 1024, WS_WF = 1 * MiB, WS_WQKV = 3 * MiB,
                 WS_WO = 9 * MiB, WS_WGU = 11 * MiB, WS_WD = 33 * MiB, WS_H = 44 * MiB, WS_MP = 68 * MiB, WS_U = 92 * MiB, WS_R = 158 * MiB;
constexpr size_t WS_YTP = WS_U, WS_YTS = WS_U + 32 * MiB;
constexpr size_t WS_TS = WS_R, WS_F = WS_R + 16 * MiB;
constexpr size_t WS_Q = WS_R, WS_K = WS_R + 24 * MiB, WS_VT = WS_R + 48 * MiB;
constexpr size_t WS_XB = WS_R + 72 * MiB, WS_END = WS_XB + 24 * MiB;
constexpr size_t OUTB_KC = 0, OUTB_VC = 2 * MiB;
constexpr size_t OUT_X = 0, OUT_CK = (size_t)M * D, OUT_CV = OUT_CK + (size_t)NP * D;

struct Params {
    const float* in[16];
    float* out; unsigned char* ws;
    int ph_lo, ph_hi;
};

__device__ __forceinline__ unsigned pk2(float lo, float hi) { f32x2 v = {lo, hi}; bf16x2_t b = __builtin_convertvector(v, bf16x2_t); return __builtin_bit_cast(unsigned, b); }
__device__ __forceinline__ float bf_lo(unsigned w) { return __uint_as_float(w << 16); }
__device__ __forceinline__ float bf_hi(unsigned w) { return __uint_as_float(w & 0xffff0000u); }
template <int CTRL> __device__ __forceinline__ float dpp_mov(float v) { return __builtin_bit_cast(float, __builtin_amdgcn_mov_dpp(__builtin_bit_cast(int, v), CTRL, 0xf, 0xf, true)); }
__device__ __forceinline__ float wave_sum(float v) {
    v += dpp_mov<0xB1>(v); v += dpp_mov<0x4E>(v); v += dpp_mov<0x141>(v); v += dpp_mov<0x140>(v);
    { auto rr = __builtin_amdgcn_permlane16_swap(__float_as_uint(v), __float_as_uint(v), false, false); v = __uint_as_float(rr[0]) + __uint_as_float(rr[1]); }
    { auto rr = __builtin_amdgcn_permlane32_swap(__float_as_uint(v), __float_as_uint(v), false, false); v = __uint_as_float(rr[0]) + __uint_as_float(rr[1]); }
    return v;
}

namespace pg8 {
constexpr int BM = 256, BK = 64, HALF = 128, HTB = HALF * BK * 2, STAGE_BYTES = 8 * HTB;
__device__ __forceinline__ int lds_byte(int r, int c) { const int st = (r >> 4) * 2 + (c >> 5), rr = r & 15, cc = c & 31, ob = rr * 64 + cc * 2; return st * 1024 + (ob ^ (((ob >> 9) & 1) << 5)); }
__device__ __forceinline__ void stage_rc(int b, int& R, int& C) { const int st = b / 1024, sb = b % 1024, swz = sb ^ (((sb >> 9) & 1) << 5); R = (st >> 1) * 16 + swz / 64; C = (st & 1) * 32 + (swz % 64) / 2; }
__device__ __forceinline__ int perm32(int rho) { const int n = rho >> 4, i = rho & 15; return 8 * (i >> 2) + 4 * n + (i & 3); }

struct UnitDesc { const char* A; const char* B; bf16_t* out; int ldc; int aux; };

__device__ __forceinline__ void tile_order(int L, int nM, int nN, int& pm, int& pn) {
    const int nwg = nM * nN; int wgid = L;
    { const int q = nwg / 8, r = nwg % 8, xcd = wgid % 8, off = wgid / 8; wgid = (xcd < r ? xcd * (q + 1) : r * (q + 1) + (xcd - r) * q) + off; }
    const int nig = 8 * nN, gid = wgid / nig, fm = gid * 8, gsz = (nM - fm) < 8 ? (nM - fm) : 8;
    pm = fm + ((wgid % nig) % gsz); pn = (wgid % nig) / gsz;
}

template <class Epi, class Sched, bool ALIGN_EPI>
__device__ __forceinline__ void gemm_phase(LAS unsigned char* lds, const int lda, const int ldb, const int K, const Sched& S, const Epi& E) {
    const int tid = threadIdx.x, wid = __builtin_amdgcn_readfirstlane(tid >> 6), lane = tid & 63, wr = wid >> 2, wc = wid & 3, fr = lane & 15, fq = lane >> 4;
    const int nt = K / BK;
    unsigned voffA[2], voffB[2];
#pragma unroll
    for (int i = 0; i < 2; ++i) { int R, C; stage_rc(tid * 16 + i * 8192, R, C); const int Rb = (R & ~31) + perm32(R & 31);
        voffA[i] = (unsigned)(R * lda + C) * 2u; voffB[i] = (unsigned)(Rb * ldb + C) * 2u; }
    const size_t kstep = (size_t)(BK * 2);
    const size_t hstepA = (size_t)HALF * lda * 2, hstepB = (size_t)HALF * ldb * 2;
    const unsigned ldsw = (unsigned)wid * 1024u;
    const int aoff = lds_byte(wr * 64 + fr, fq * 8), boff = lds_byte(wc * 32 + fr, fq * 8);
#define PG8_SA(b, h) (((b) * 2 + (h)) * HTB)
#define PG8_SB(b, h) ((4 + (b) * 2 + (h)) * HTB)
#define PG8_STAGE(bufoff, gbase, voff) do { _Pragma("unroll") for (int _i = 0; _i < 2; ++_i) \
        __builtin_amdgcn_global_load_lds((const unsigned*)((const char*)(gbase) + (voff)[_i]), (LAS unsigned*)(lds + (bufoff) + ldsw + _i * 8192), 16, 0, 0); } while (0)
#define PG8_LDA(dst, b, h) do { _Pragma("unroll") for (int m = 0; m < 4; ++m) _Pragma("unroll") for (int k = 0; k < 2; ++k) dst[m][k] = *(const LAS bf16x8*)(lds + PG8_SA(b, h) + aoff + m * 2048 + k * 1024); } while (0)
#define PG8_LDB(dst, b, h) do { _Pragma("unroll") for (int n = 0; n < 2; ++n) _Pragma("unroll") for (int k = 0; k < 2; ++k) dst[n][k] = *(const LAS bf16x8*)(lds + PG8_SB(b, h) + boff + n * 2048 + k * 1024); } while (0)
#define PG8_MMA(ai, bj, At, Bt) do { __builtin_amdgcn_s_setprio(1); _Pragma("unroll") for (int m = 0; m < 4; ++m) _Pragma("unroll") for (int n = 0; n < 2; ++n) _Pragma("unroll") for (int k = 0; k < 2; ++k) \
        acc[ai][bj][m][n] = __builtin_amdgcn_mfma_f32_16x16x32_bf16(Bt[n][k], At[m][k], acc[ai][bj][m][n], 0, 0, 0); __builtin_amdgcn_s_setprio(0); } while (0)
#define PG8_WAIT_V(n) asm volatile("s_waitcnt vmcnt(" #n ")" ::: "memory")
#define PG8_WAIT_L(n) asm volatile("s_waitcnt lgkmcnt(" #n ")" ::: "memory")
#define PG8_BAR __builtin_amdgcn_s_barrier()
#define PG8_SCHED __builtin_amdgcn_sched_barrier(0)
    UnitDesc cur, nxt; int ui = 0;
    if (!S.next(0, cur)) return;
    f32x4 acc[2][2][4][2];
#pragma unroll
    for (int a = 0; a < 2; ++a)
#pragma unroll
        for (int b = 0; b < 2; ++b)
#pragma unroll
            for (int m = 0; m < 4; ++m)
#pragma unroll
                for (int n = 0; n < 2; ++n) acc[a][b][m][n] = (f32x4){0.f, 0.f, 0.f, 0.f};
    bf16x8 At[4][2], B0[2][2], B1[2][2];
    const char* cA = cur.A; const char* cB = cur.B;
    PG8_STAGE(PG8_SB(0, 0), cB, voffB); PG8_STAGE(PG8_SB(0, 1), cB + hstepB, voffB); PG8_STAGE(PG8_SA(0, 0), cA, voffA); PG8_STAGE(PG8_SA(0, 1), cA + hstepA, voffA);
    if (wr == 1) PG8_BAR;
    PG8_WAIT_V(2); PG8_BAR;
    PG8_STAGE(PG8_SB(1, 0), cB + kstep, voffB); PG8_STAGE(PG8_SA(1, 0), cA + kstep, voffA); PG8_STAGE(PG8_SB(1, 1), cB + hstepB + kstep, voffB);
    PG8_WAIT_V(6); PG8_BAR;
    for (;;) {
        const bool has_next = S.next(ui + 1, nxt);
        const char* nA = has_next ? nxt.A : cA; const char* nB = has_next ? nxt.B : cB;
#pragma unroll 1
        for (int t = 0; t < nt; t += 2) {
            const bool last = (t == nt - 2);
            const char* a1 = cA + (size_t)(t + 1) * kstep;
            const char* a2 = last ? nA : cA + (size_t)(t + 2) * kstep; const char* b2 = last ? nB : cB + (size_t)(t + 2) * kstep;
            const char* a3 = a2 + kstep; const char* b3 = b2 + kstep;
            PG8_LDB(B0, 0, 0); PG8_LDB(B1, 0, 1); PG8_SCHED; PG8_LDA(At, 0, 0); PG8_STAGE(PG8_SA(1, 1), a1 + hstepA, voffA);
            PG8_WAIT_V(8); PG8_WAIT_L(0); PG8_BAR; PG8_MMA(0, 0, At, B0); PG8_MMA(0, 1, At, B1); PG8_BAR; PG8_SCHED;
            PG8_LDA(At, 0, 1); PG8_STAGE(PG8_SB(0, 0), b2, voffB); PG8_STAGE(PG8_SB(0, 1), b2 + hstepB, voffB); PG8_STAGE(PG8_SA(0, 0), a2, voffA);
            PG8_WAIT_V(8); PG8_WAIT_L(0); PG8_BAR; PG8_MMA(1, 0, At, B0); PG8_MMA(1, 1, At, B1); PG8_BAR; PG8_SCHED;
            PG8_LDB(B0, 1, 0); PG8_LDB(B1, 1, 1); PG8_SCHED; PG8_LDA(At, 1, 0); PG8_STAGE(PG8_SA(0, 1), a2 + hstepA, voffA);
            PG8_WAIT_V(8); PG8_WAIT_L(0); PG8_BAR; PG8_MMA(0, 0, At, B0); PG8_MMA(0, 1, At, B1); PG8_BAR; PG8_SCHED;
            PG8_LDA(At, 1, 1); PG8_STAGE(PG8_SB(1, 0), b3, voffB); PG8_STAGE(PG8_SB(1, 1), b3 + hstepB, voffB); PG8_STAGE(PG8_SA(1, 0), a3, voffA);
            PG8_WAIT_V(8); PG8_WAIT_L(0); PG8_BAR; PG8_MMA(1, 0, At, B0); PG8_MMA(1, 1, At, B1); PG8_BAR; PG8_SCHED;
        }
        if constexpr (ALIGN_EPI) { if (wr == 0) PG8_BAR; }
        E(acc, cur, wr, wc, fr, fq);
        if (!has_next) break;
#pragma unroll
        for (int a = 0; a < 2; ++a)
#pragma unroll
            for (int b = 0; b < 2; ++b)
#pragma unroll
                for (int m = 0; m < 4; ++m)
#pragma unroll
                    for (int n = 0; n < 2; ++n) acc[a][b][m][n] = (f32x4){0.f, 0.f, 0.f, 0.f};
        cur = nxt; cA = nA; cB = nB; ++ui;
        if constexpr (ALIGN_EPI) { if (wr == 1) PG8_BAR; }
    }
    PG8_WAIT_V(0);
    if constexpr (!ALIGN_EPI) { if (wr == 0) PG8_BAR; }
    PG8_BAR;
#undef PG8_SA
#undef PG8_SB
#undef PG8_STAGE
#undef PG8_LDA
#undef PG8_LDB
#undef PG8_MMA
#undef PG8_WAIT_V
#undef PG8_WAIT_L
#undef PG8_BAR
#undef PG8_SCHED
}

struct EpiStore {
    __device__ __forceinline__ void operator()(const f32x4 (&acc)[2][2][4][2], const UnitDesc& u, int wr, int wc, int fr, int fq) const {
#pragma unroll
        for (int ai = 0; ai < 2; ++ai)
#pragma unroll
            for (int m = 0; m < 4; ++m) { bf16_t* rowp = u.out + (size_t)(ai * HALF + wr * 64 + m * 16 + fr) * u.ldc + wc * 32 + 8 * fq;
#pragma unroll
                for (int bj = 0; bj < 2; ++bj) { const f32x4 v0 = acc[ai][bj][m][0], v1 = acc[ai][bj][m][1];
                    u32x4 w; w.x = pk2(v0[0], v0[1]); w.y = pk2(v0[2], v0[3]); w.z = pk2(v1[0], v1[1]); w.w = pk2(v1[2], v1[3]);
                    *(u32x4*)(rowp + bj * HALF) = w; } }
    }
};
__device__ __forceinline__ float swiglu1(float g, float u) { return g * u * __builtin_amdgcn_rcpf(1.0f + __builtin_amdgcn_exp2f(-1.4426950408889634f * g)); }
struct EpiSwiGLU {
    __device__ __forceinline__ void operator()(const f32x4 (&acc)[2][2][4][2], const UnitDesc& u, int wr, int wc, int fr, int fq) const {
#pragma unroll
        for (int ai = 0; ai < 2; ++ai)
#pragma unroll
            for (int m = 0; m < 4; ++m) { bf16_t* rowp = u.out + (size_t)(ai * HALF + wr * 64 + m * 16 + fr) * u.ldc + wc * 32 + 8 * fq;
                const f32x4 g0 = acc[ai][0][m][0], g1 = acc[ai][0][m][1], u0 = acc[ai][1][m][0], u1 = acc[ai][1][m][1];
                u32x4 w; w.x = pk2(swiglu1(g0[0], u0[0]), swiglu1(g0[1], u0[1])); w.y = pk2(swiglu1(g0[2], u0[2]), swiglu1(g0[3], u0[3]));
                w.z = pk2(swiglu1(g1[0], u1[0]), swiglu1(g1[1], u1[1])); w.w = pk2(swiglu1(g1[2], u1[2]), swiglu1(g1[3], u1[3]));
                *(u32x4*)rowp = w; }
    }
};
struct EpiQKV {
    bf16_t* Q; bf16_t* Kb; bf16_t* Vb; float* ck; float* cv;
    __device__ __forceinline__ void operator()(const f32x4 (&acc)[2][2][4][2], const UnitDesc& u, int wr, int wc, int fr, int fq) const {
        const int pm = u.aux & 0xffff, pn = u.aux >> 16, sel = pn >> 2, ct = (pn & 3) * BM;
        const int row0 = pm * BM + wr * 64 + fr, col0 = ct + wc * 32 + 8 * fq;
        bf16_t* base = Q + (size_t)sel * (size_t)(12 * 1024 * 1024); float* cb = ck + (size_t)(sel >= 1 ? sel - 1 : 0) * (size_t)NP * D;
        const bool wc32 = sel >= 1 && pm < NP / BM;
#pragma unroll
        for (int ai = 0; ai < 2; ++ai)
#pragma unroll
            for (int m = 0; m < 4; ++m) { const size_t off = (size_t)(row0 + ai * HALF + m * 16) * D + col0;
#pragma unroll
                for (int bj = 0; bj < 2; ++bj) { const f32x4 v0 = acc[ai][bj][m][0], v1 = acc[ai][bj][m][1];
                    u32x4 w; w.x = pk2(v0[0], v0[1]); w.y = pk2(v0[2], v0[3]); w.z = pk2(v1[0], v1[1]); w.w = pk2(v1[2], v1[3]);
                    *(u32x4*)(base + off + bj * HALF) = w;
                    if (wc32) { *(f32x4*)(cb + off + bj * HALF) = v0; *(f32x4*)(cb + off + bj * HALF + 4) = v1; } } }
    }
};

struct GSched {
    int nM, nN, G, c; const char* A; size_t a_tile; const char* B; size_t b_tile; bf16_t* out; size_t o_pm, o_pn; int ldc;
    __device__ __forceinline__ bool next(int i, UnitDesc& u) const {
        const long L = (long)i * G + c; if (L >= (long)nM * nN) return false;
        int pm, pn; tile_order((int)L, nM, nN, pm, pn);
        u.A = A + (size_t)pm * a_tile; u.B = B + (size_t)pn * b_tile; u.out = out + (size_t)pm * o_pm + (size_t)pn * o_pn; u.ldc = ldc; u.aux = pm | (pn << 16); return true;
    }
};
struct ChDftSched {
    int G, c; const char* cs_tab; const char* H; bf16_t* ytp; bf16_t* yts;
    __device__ __forceinline__ bool next(int i, UnitDesc& u) const {
        const long L = (long)i * G + c; if (L >= 48 * 8) return false;
        int tok, gc; tile_order((int)L, 48, 8, tok, gc); const int g = gc >> 1, cs = gc & 1;
        u.A = cs_tab + (size_t)cs * 256 * 256 * 2; u.B = H + ((size_t)tok * 256 * D + g * 256) * 2;
        if (tok < 32) { u.out = ytp + ((size_t)(tok * D + g * 256) * 512 + cs * 256); u.ldc = 512; }
        else { const int idx = tok - 32, b = idx >> 3, s0 = (idx & 7) * 256; u.out = yts + ((size_t)(b * D + g * 256) * 4096 + cs * 2048 + s0); u.ldc = 4096; }
        u.aux = 0; return true;
    }
};
struct SeqSSched {
    int c; const char* ts; const char* yts; bf16_t* F;
    __device__ __forceinline__ bool next(int i, UnitDesc& u) const {
        if (i > 0 || c >= 64) return false;
        const int b = c >> 5, pm = (c >> 2) & 7, pn = c & 3;
        u.A = ts + (size_t)pm * 256 * 4096 * 2; u.B = yts + (size_t)(b * D + pn * 256) * 4096 * 2;
        u.out = F + ((size_t)(NP + b * SS + pm * 256) * D + pn * 256); u.ldc = D; u.aux = 0; return true;
    }
};
struct SeqPSched {
    int G, c; const char* tp; const char* ytp; bf16_t* F;
    __device__ __forceinline__ bool next(int i, UnitDesc& u) const {
        const int G2 = G - 64; if (c < 64 || G2 <= 0) return false;
        const long L = (long)i * G2 + (c - 64); if (L >= 128) return false;
        const int b = (int)L >> 2, pn = (int)L & 3;
        u.A = tp; u.B = ytp + (size_t)(b * D + pn * 256) * 512 * 2;
        u.out = F + ((size_t)(b * 256) * D + pn * 256); u.ldc = D; u.aux = 0; return true;
    }
};
}

constexpr int TI_L0 = 16 * 32 + 2 * 16 * 88 + 44 * 32, TI_ALL = 16 * 32 + 16 * 96 + 16 * 32 + 4 * 16 * 88 + 2 * 44 * 32;
struct TItem { const float* W; bf16_t* WT; int N, ldt, dst, k0, n0; };
__device__ __forceinline__ bool titem_decode(const Params& p, int it, TItem& t) {
    constexpr int I_F = 16 * 32, I_QKV = 16 * 96, I_O = 16 * 32, I_G = 16 * 88, I_D = 44 * 32;
    constexpr int NITEMS = I_F + I_QKV + I_O + 4 * I_G + 2 * I_D;
    if (it >= NITEMS) return false;
    unsigned char* ws = p.ws; int r = it; int mode = 0;
    if (r < I_F) { t.W = p.in[9]; t.N = D; t.ldt = D; t.WT = (bf16_t*)(ws + WS_WF); }
    else { r -= I_F; int l = 0; if (r >= 2 * I_G + I_D) { r -= 2 * I_G + I_D; l = 1; }
        if (r < I_G) { t.W = p.in[13] + (size_t)l * D * FF; t.N = FF; t.ldt = D; t.WT = (bf16_t*)(ws + WS_WGU) + (size_t)l * 2 * FF * D; mode = 1; }
        else if ((r -= I_G) < I_G) { t.W = p.in[14] + (size_t)l * D * FF; t.N = FF; t.ldt = D; t.WT = (bf16_t*)(ws + WS_WGU) + (size_t)l * 2 * FF * D; mode = 2; }
        else if ((r -= I_G) < I_D) { t.W = p.in[15] + (size_t)l * FF * D; t.N = D; t.ldt = FF; t.WT = (bf16_t*)(ws + WS_WD) + (size_t)l * D * FF; }
        else if ((r -= I_D) < I_QKV) { t.W = p.in[10]; t.N = 3 * D; t.ldt = D; t.WT = (bf16_t*)(ws + WS_WQKV); }
        else { r -= I_QKV; t.W = p.in[12]; t.N = D; t.ldt = D; t.WT = (bf16_t*)(ws + WS_WO); } }
    const int nblk = t.N / 32, kb = r / nblk, nb = r % nblk; t.n0 = nb * 32; t.k0 = kb * 64;
    t.dst = t.n0; if (mode) t.dst = (t.n0 >> 7) * 256 + (t.n0 & 127) + (mode == 2 ? 128 : 0);
    return true;
}
__device__ __forceinline__ void titem_load(const TItem& t, f32x4 (&wv)[8], int lane) {
#pragma unroll
    for (int i = 0; i < 8; ++i) wv[i] = *(const f32x4*)(t.W + (size_t)(t.k0 + 8 * i + (lane >> 3)) * t.N + t.n0 + 4 * (lane & 7));
}
__device__ __forceinline__ void titem_finish(const TItem& t, const f32x4 (&wv)[8], LAS float* scr, int lane) {
#pragma unroll
    for (int i = 0; i < 8; ++i) { LAS float* d = scr + (8 * i + (lane >> 3)) * 33 + 4 * (lane & 7); d[0] = wv[i][0]; d[1] = wv[i][1]; d[2] = wv[i][2]; d[3] = wv[i][3]; }
    asm volatile("s_waitcnt lgkmcnt(0)" ::: "memory");
    const int c = lane & 7;
#pragma unroll
    for (int j = 0; j < 4; ++j) { const int n = (lane >> 3) + 8 * j; const LAS float* s = scr + (8 * c) * 33 + n;
        u32x4 o; o.x = pk2(s[0 * 33], s[1 * 33]); o.y = pk2(s[2 * 33], s[3 * 33]); o.z = pk2(s[4 * 33], s[5 * 33]); o.w = pk2(s[6 * 33], s[7 * 33]);
        *(u32x4*)(t.WT + (size_t)(t.dst + n) * t.ldt + t.k0 + 8 * c) = o; }
    asm volatile("s_waitcnt lgkmcnt(0)" ::: "memory");
}

__device__ __forceinline__ void gemv_layer(const Params& p, LAS unsigned char* lds, const int l, const int rb, const int nb) {
    const int tid = threadIdx.x;
    LAS float* sl = (LAS float*)lds;
    LAS f32x4* red = (LAS f32x4*)(lds + 12288);
    for (int i = tid; i < 3072; i += 512) { const int cond = i >> 10, k = i & 1023; const float v = cond == 0 ? p.in[5][k] : p.in[2][(cond - 1) * D + k]; sl[i] = v / (1.0f + __expf(-v)); }
    __syncthreads();
    float* mod = (float*)(p.ws + WS_MOD);
    for (int item = rb; item < 96; item += nb) {
        const int rem = item, cc = rem >> 4, kc = rem & 15, rpar = tid >> 8, col = cc * 1024 + 4 * (tid & 255);
        const float* W = p.in[6] + ((size_t)l * D + kc * 64 + rpar) * 6144 + col;
        f32x4 a0 = {0.f, 0.f, 0.f, 0.f}, a1 = a0, a2 = a0;
#pragma unroll
        for (int hf = 0; hf < 2; ++hf) {
            f32x4 w[16];
#pragma unroll
            for (int i = 0; i < 16; ++i) w[i] = *(const f32x4*)(W + (size_t)(32 * hf + 2 * i) * 6144);
#pragma unroll
            for (int i = 0; i < 16; ++i) { const int k = kc * 64 + 32 * hf + 2 * i + rpar; a0 += sl[k] * w[i]; a1 += sl[1024 + k] * w[i]; a2 += sl[2048 + k] * w[i]; }
        }
        if (rpar == 1) { red[tid - 256] = a0; red[256 + tid - 256] = a1; red[512 + tid - 256] = a2; }
        __syncthreads();
        if (rpar == 0) {
            a0 += red[tid]; a1 += red[256 + tid]; a2 += red[512 + tid];
            if (kc == 0) { const f32x4 bv = *(const f32x4*)(p.in[7] + l * 6144 + col); a0 += bv; a1 += bv; a2 += bv; }
#pragma unroll
            for (int j = 0; j < 4; ++j) {
                unsafeAtomicAdd(mod + (l * 3 + 0) * 6144 + col + j, a0[j]);
                unsafeAtomicAdd(mod + (l * 3 + 1) * 6144 + col + j, a1[j]);
                unsafeAtomicAdd(mod + (l * 3 + 2) * 6144 + col + j, a2[j]); }
        }
        __syncthreads();
    }
}
__device__ __forceinline__ void transpose_jobs(const Params& p, LAS unsigned char* lds, int gw, int NGW, int it_lo, int it_hi) {
    const int lane = threadIdx.x & 63, wave = threadIdx.x >> 6;
    LAS float* scr = (LAS float*)(lds + wave * 8448);
    TItem cur, nxt; f32x4 wa[8], wb[8];
    int it = it_lo + gw;
    bool have = it < it_hi && titem_decode(p, it, cur);
    if (have) titem_load(cur, wa, lane);
    while (have) {
        const bool hn = it + NGW < it_hi && titem_decode(p, it + NGW, nxt);
        if (hn) titem_load(nxt, wb, lane);
        titem_finish(cur, wa, scr, lane);
        if (!hn) break;
        it += 2 * NGW;
        have = it < it_hi && titem_decode(p, it, cur);
        if (have) titem_load(cur, wa, lane);
        titem_finish(nxt, wb, scr, lane);
    }
}
__device__ __forceinline__ void phase_prologue(const Params& p, LAS unsigned char* lds) {
    const int tid = threadIdx.x, G = gridDim.x, bx = blockIdx.x;
    unsigned char* ws = p.ws;
    LAS float* ct = (LAS float*)(lds + 32768);
    for (int i = tid; i < 2048; i += 512) ct[i] = cospif((float)i * (1.0f / 1024.0f));
    const bool sep = G >= 192;
    if (!sep || bx < 96) gemv_layer(p, lds, 0, bx, sep ? 96 : G);
    if (sep && bx < 96) return;
    const int gt = (sep ? bx - 96 : bx) * 512 + tid, GT = (sep ? G - 96 : G) * 512;
    for (int i = gt; i < 2 * 2 * 512 * D / 8; i += GT) { const int which = i >= 2 * 512 * D / 8; const int ii = which ? i - 2 * 512 * D / 8 : i;
        const f32x4* src = (const f32x4*)p.in[which ? 4 : 3]; const f32x4 a = src[2 * ii], b = src[2 * ii + 1];
        u32x4 o; o.x = pk2(a[0], a[1]); o.y = pk2(a[2], a[3]); o.z = pk2(b[0], b[1]); o.w = pk2(b[2], b[3]); ((u32x4*)((unsigned char*)p.out + (which ? OUTB_VC : OUTB_KC)))[ii] = o; }
    for (int i = gt; i < 512 * 256 / 8; i += GT) { const int row = i >> 5, c0 = (i & 31) * 8, cs = row >> 8, m = row & 255; float v[8];
#pragma unroll
        for (int j = 0; j < 8; ++j) { const int idx = ((m * (c0 + j)) & 255) * 8; v[j] = ct[(idx - (cs ? 512 : 0)) & 2047]; }
        u32x4 o; o.x = pk2(v[0], v[1]); o.y = pk2(v[2], v[3]); o.z = pk2(v[4], v[5]); o.w = pk2(v[6], v[7]); ((u32x4*)(ws + WS_CSCH))[i] = o; }
    for (int i = gt; i < 256 * 512 / 8; i += GT) { const int k = i >> 6, c0 = (i & 63) * 8; float v[8];
#pragma unroll
        for (int j = 0; j < 8; ++j) { const int kk = c0 + j, sidx = kk & 255; const int idx = ((k * sidx) & 255) * 8; v[j] = kk < 256 ? ct[idx] : -ct[(idx - 512) & 2047]; }
        u32x4 o; o.x = pk2(v[0], v[1]); o.y = pk2(v[2], v[3]); o.z = pk2(v[4], v[5]); o.w = pk2(v[6], v[7]); ((u32x4*)(ws + WS_TP))[i] = o; }
    for (int i = gt; i < 2048 * 4096 / 8; i += GT) { const int k = i >> 9, c0 = (i & 511) * 8; float v[8];
#pragma unroll
        for (int j = 0; j < 8; ++j) { const int kk = c0 + j, sidx = kk & 2047; const int idx = (k * sidx) & 2047; v[j] = kk < 2048 ? ct[idx] : -ct[(idx - 512) & 2047]; }
        u32x4 o; o.x = pk2(v[0], v[1]); o.y = pk2(v[2], v[3]); o.z = pk2(v[4], v[5]); o.w = pk2(v[6], v[7]); ((u32x4*)(ws + WS_TS))[i] = o; }
}
__device__ __forceinline__ void phase_side_jobs(const Params& p, LAS unsigned char* lds, const int which) {
    const int G = gridDim.x, bx = blockIdx.x, first = which == 0 ? 64 : 192;
    const int nb = G > first ? G - first : G, b0 = G > first ? first : 0;
    if (bx < b0) return;
    const int rb = bx - b0;
    if (which == 0) transpose_jobs(p, lds, rb * 8 + (threadIdx.x >> 6), nb * 8, 0, TI_L0);
    else if (which == 1) gemv_layer(p, lds, 1, rb, nb);
    else transpose_jobs(p, lds, rb * 8 + (threadIdx.x >> 6), nb * 8, TI_L0, TI_ALL);
}

#ifndef ROW_WT
#define ROW_WT 0
#endif
__device__ __forceinline__ void store16_wt(void* ptr, u32x4 v) {
#if ROW_WT
    asm volatile("global_store_dwordx4 %0, %1, off sc0 sc1\n\ts_nop 3" :: "v"(ptr), "v"(v) : "memory");
#else
    *(u32x4*)ptr = v;
#endif
}
__device__ __forceinline__ void bf8_to_f32(const u32x4 w, f32x4& a, f32x4& b) { a = (f32x4){bf_lo(w.x), bf_hi(w.x), bf_lo(w.y), bf_hi(w.y)}; b = (f32x4){bf_lo(w.z), bf_hi(w.z), bf_lo(w.w), bf_hi(w.w)}; }
__device__ __forceinline__ u32x4 f32_to_bf8(const f32x4 a, const f32x4 b) { u32x4 w; w.x = pk2(a[0], a[1]); w.y = pk2(a[2], a[3]); w.z = pk2(b[0], b[1]); w.w = pk2(b[2], b[3]); return w; }
template <bool HAS_MP, bool HAS_NEXT, bool XIN_F32>
__device__ __forceinline__ void row_phase(const float* xin_p, const float* xin_s, bf16_t* XB, const bf16_t* mp, float* Yout, bf16_t* Hout,
                                          const float* gate, const float* gA, const float* gB, const float* sc, const float* sh) {
    const int tid = threadIdx.x, lane = tid & 63, gw = blockIdx.x * 8 + (tid >> 6), NGW = gridDim.x * 8;
    constexpr int R = 3, RW = 6;
    int cur_cond = -1;
    f32x4 gga[4], gbs[4], shv[4];
    for (int rowb = gw * RW; rowb < M; rowb += NGW * RW)
    for (int row0 = rowb; row0 < rowb + RW; row0 += R) {
        f32x4 v[R][4]; u32x4 mw[R][2];
#pragma unroll
        for (int q = 0; q < R; ++q) { const int row = row0 + q;
            if constexpr (XIN_F32) { const float* xr = row < NP ? xin_p + (size_t)row * D : xin_s + (size_t)(row - NP) * D;
#pragma unroll
                for (int j = 0; j < 2; ++j) { v[q][2 * j] = *(const f32x4*)(xr + 8 * lane + 512 * j); v[q][2 * j + 1] = *(const f32x4*)(xr + 8 * lane + 512 * j + 4); }
            } else {
#pragma unroll
                for (int j = 0; j < 2; ++j) { const u32x4 w = *(const u32x4*)(XB + (size_t)row * D + 8 * lane + 512 * j); bf8_to_f32(w, v[q][2 * j], v[q][2 * j + 1]); }
            }
            if constexpr (HAS_MP) {
#pragma unroll
                for (int j = 0; j < 2; ++j) mw[q][j] = *(const u32x4*)(mp + (size_t)row * D + 8 * lane + 512 * j);
            } }
        u32x4 xo[R][2], ho[R][2];
#pragma unroll
        for (int q = 0; q < R; ++q) { const int row = row0 + q; const int cond = row < NP ? 0 : (row < NP + SS ? 1 : 2);
            if (cond != cur_cond) { cur_cond = cond;
#pragma unroll
                for (int j = 0; j < 4; ++j) { const int col = 8 * lane + 512 * (j >> 1) + 4 * (j & 1);
                    if constexpr (HAS_MP) gga[j] = *(const f32x4*)(gate + cond * 6144 + col) * *(const f32x4*)(gA + col);
                    if constexpr (HAS_NEXT) { gbs[j] = *(const f32x4*)(gB + col) * (1.0f + *(const f32x4*)(sc + cond * 6144 + col)); shv[j] = *(const f32x4*)(sh + cond * 6144 + col); } } }
            if constexpr (HAS_MP) {
                f32x4 mv[4]; float s = 0.f;
#pragma unroll
                for (int j = 0; j < 2; ++j) bf8_to_f32(mw[q][j], mv[2 * j], mv[2 * j + 1]);
#pragma unroll
                for (int j = 0; j < 4; ++j) s += (mv[j][0] * mv[j][0] + mv[j][1] * mv[j][1]) + (mv[j][2] * mv[j][2] + mv[j][3] * mv[j][3]);
                const float rstd = 1.0f / sqrtf(wave_sum(s) * (1.0f / D) + 1e-6f);
#pragma unroll
                for (int j = 0; j < 4; ++j) v[q][j] = v[q][j] + gga[j] * (mv[j] * rstd);
                if constexpr (HAS_NEXT) {
#pragma unroll
                    for (int j = 0; j < 2; ++j) xo[q][j] = f32_to_bf8(v[q][2 * j], v[q][2 * j + 1]);
                }
            }
            if constexpr (HAS_NEXT) {
                float s = 0.f;
#pragma unroll
                for (int j = 0; j < 4; ++j) s += (v[q][j][0] * v[q][j][0] + v[q][j][1] * v[q][j][1]) + (v[q][j][2] * v[q][j][2] + v[q][j][3] * v[q][j][3]);
                const float rstd = 1.0f / sqrtf(wave_sum(s) * (1.0f / D) + 1e-6f);
                f32x4 hh[4];
#pragma unroll
                for (int j = 0; j < 4; ++j) hh[j] = (v[q][j] * rstd) * gbs[j] + shv[j];
#pragma unroll
                for (int j = 0; j < 2; ++j) ho[q][j] = f32_to_bf8(hh[2 * j], hh[2 * j + 1]);
            } }
#pragma unroll
        for (int q = 0; q < R; ++q) { const int row = row0 + q;
            if constexpr (HAS_MP && !HAS_NEXT) {
#pragma unroll
                for (int j = 0; j < 4; ++j) *(f32x4*)(Yout + (size_t)row * D + 8 * lane + 512 * (j >> 1) + 4 * (j & 1)) = v[q][j];
            }
            if constexpr (HAS_MP && HAS_NEXT) {
#pragma unroll
                for (int j = 0; j < 2; ++j) store16_wt(XB + (size_t)row * D + 8 * lane + 512 * j, xo[q][j]);
            }
            if constexpr (HAS_NEXT) {
#pragma unroll
                for (int j = 0; j < 2; ++j) store16_wt(Hout + (size_t)row * D + 8 * lane + 512 * j, ho[q][j]);
            } }
    }
}

__device__ __forceinline__ void attn_phase(const Params& p, LAS unsigned char* lds) {
    const int tid = threadIdx.x, lane = tid & 63, wave = __builtin_amdgcn_readfirstlane(tid >> 6), r = lane & 31, hh = lane >> 5;
    unsigned char* ws = p.ws;
    const bf16_t* Qb = (const bf16_t*)(ws + WS_Q); const bf16_t* Kb = (const bf16_t*)(ws + WS_K); const bf16_t* Vb = (const bf16_t*)(ws + WS_VT);
    const bf16_t* Kc = (const bf16_t*)((const unsigned char*)p.out + OUTB_KC); const bf16_t* Vc = (const bf16_t*)((const unsigned char*)p.out + OUTB_VC);
    bf16_t* Ob = (bf16_t*)(ws + WS_H);
    LAS float* Bl = (LAS float*)(lds + 36864 + 512);
    const int srow = tid >> 3, sch = tid & 7, krho = (srow & ~12) | ((srow & 4) << 1) | ((srow & 8) >> 1);
    const float c2 = 0.125f * 1.4426950408889634f;
    for (int unit = blockIdx.x; unit < 768; unit += gridDim.x) {
        const bool is_na = unit < 256;
        int b, h, qtok, nt, jmin = 0, nloc = 0, rq = 0, half = 0, ktok0;
        if (is_na) { b = unit >> 7; h = (unit >> 3) & 15; const int r0 = (unit & 7) * 4; rq = r0 + (wave >> 1); half = wave & 1;
            jmin = min(max(r0 - 4, 0), 24); const int jmax = min(max(r0 - 1, 0), 24) + 7; nloc = jmax - jmin + 1; nt = nloc + 8;
            qtok = NP + b * SS + rq * 64 + half * 32 + r; ktok0 = NP + b * SS; }
        else { const int u2 = unit - 256; b = u2 >> 4; h = u2 & 15; nt = 4; qtok = b * SP + wave * 32 + r; ktok0 = b * SP; }
        const int rs = min(max(rq - 4, 0), 24);
        if (is_na) { for (int i = tid; i < 15 * 32; i += 512) { const int rr = i >> 5, x = i & 31; Bl[i] = x < 31 ? p.in[11][(h * 15 + rr) * 31 + x] * 1.4426950408889634f : 0.f; } }
        bf16x8 qf[4];
#pragma unroll
        for (int d0 = 0; d0 < 4; ++d0) qf[d0] = *(const bf16x8*)(Qb + (size_t)qtok * D + h * HD + d0 * 16 + hh * 8);
        f32x16 o0, o1;
#pragma unroll
        for (int i = 0; i < 16; ++i) { o0[i] = 0.f; o1[i] = 0.f; }
        float m_run = -1e30f, l_run = 0.f;
        u32x4 kreg, vreg;
#define ATT_LOAD(t) do { const int t_ = (t); size_t off_; const bf16_t* kb_; const bf16_t* vb_; \
            if (is_na && t_ >= nloc) { off_ = ((size_t)(b * 512 + (t_ - nloc) * 64 + srow)) * D + h * HD + sch * 8; kb_ = Kc; vb_ = Vc; } \
            else { off_ = (size_t)(ktok0 + (is_na ? (jmin + t_) * 64 : t_ * 64) + srow) * D + h * HD + sch * 8; kb_ = Kb; vb_ = Vb; } \
            kreg = *(const u32x4*)(kb_ + off_); vreg = *(const u32x4*)(vb_ + off_); } while (0)
#define ATT_STORE(buf) do { LAS unsigned char* kl_ = lds + (buf) * 18432; LAS unsigned char* vl_ = kl_ + 9216; \
            *(LAS u32x4*)(kl_ + krho * 144 + sch * 16) = kreg; \
            LAS bf16_t* vd_ = (LAS bf16_t*)(vl_ + (8 * sch) * 144 + srow * 2); \
            vd_[0 * 72] = (bf16_t)vreg.x; vd_[1 * 72] = (bf16_t)(vreg.x >> 16); vd_[2 * 72] = (bf16_t)vreg.y; vd_[3 * 72] = (bf16_t)(vreg.y >> 16); \
            vd_[4 * 72] = (bf16_t)vreg.z; vd_[5 * 72] = (bf16_t)(vreg.z >> 16); vd_[6 * 72] = (bf16_t)vreg.w; vd_[7 * 72] = (bf16_t)(vreg.w >> 16); } while (0)
        ATT_LOAD(0); ATT_STORE(0); if (nt > 1) ATT_LOAD(1);
        __syncthreads();
        for (int t = 0; t < nt; ++t) {
            if (t + 1 < nt) { ATT_STORE((t + 1) & 1); if (t + 2 < nt) ATT_LOAD(t + 2); }
            const bool local = is_na && t < nloc; const int j = jmin + t;
            if (!(local && (j < rs || j >= rs + 8))) {
                const LAS unsigned char* Kl = lds + (t & 1) * 18432; const LAS unsigned char* Vl = Kl + 9216;
                f32x16 p0, p1;
#pragma unroll
                for (int i = 0; i < 16; ++i) { p0[i] = 0.f; p1[i] = 0.f; }
#pragma unroll
                for (int d0 = 0; d0 < 4; ++d0) { const bf16x8 a0 = *(const LAS bf16x8*)(Kl + r * 144 + d0 * 32 + hh * 16), a1 = *(const LAS bf16x8*)(Kl + (32 + r) * 144 + d0 * 32 + hh * 16);
                    p0 = __builtin_amdgcn_mfma_f32_32x32x16_bf16(a0, qf[d0], p0, 0, 0, 0); p1 = __builtin_amdgcn_mfma_f32_32x32x16_bf16(a1, qf[d0], p1, 0, 0, 0); }
                float m_new, alpha;
                if (local) {
                    const int qc = half * 32 + r, cs = min(max(qc - 8, 0), 48);
                    const LAS float* bp = Bl + (j - rq + 7) * 32 + 8 * hh - qc + 15;
                    float bb0[16], bb1[16];
#pragma unroll
                    for (int i = 0; i < 16; ++i) { const int kc = 16 * (i >> 3) + (i & 7); bb0[i] = bp[kc]; bb1[i] = bp[kc + 32]; }
                    asm volatile("" : "+v"(bb0[0]), "+v"(bb0[1]), "+v"(bb0[2]), "+v"(bb0[3]), "+v"(bb0[4]), "+v"(bb0[5]), "+v"(bb0[6]), "+v"(bb0[7]));
                    asm volatile("" : "+v"(bb0[8]), "+v"(bb0[9]), "+v"(bb0[10]), "+v"(bb0[11]), "+v"(bb0[12]), "+v"(bb0[13]), "+v"(bb0[14]), "+v"(bb0[15]));
                    asm volatile("" : "+v"(bb1[0]), "+v"(bb1[1]), "+v"(bb1[2]), "+v"(bb1[3]), "+v"(bb1[4]), "+v"(bb1[5]), "+v"(bb1[6]), "+v"(bb1[7]));
                    asm volatile("" : "+v"(bb1[8]), "+v"(bb1[9]), "+v"(bb1[10]), "+v"(bb1[11]), "+v"(bb1[12]), "+v"(bb1[13]), "+v"(bb1[14]), "+v"(bb1[15]));
                    const unsigned sh0 = (unsigned)(8 * hh - cs);
#pragma unroll
                    for (int i = 0; i < 16; ++i) { const int kc = 16 * (i >> 3) + (i & 7);
                        const float s0 = __builtin_fmaf(p0[i], c2, bb0[i]), s1 = __builtin_fmaf(p1[i], c2, bb1[i]);
                        p0[i] = (sh0 + (unsigned)kc) < 16u ? s0 : -1e30f; p1[i] = (sh0 + (unsigned)(kc + 32)) < 16u ? s1 : -1e30f; }
                    float mt = fmaxf(p0[0], p1[0]);
#pragma unroll
                    for (int i = 1; i < 16; ++i) mt = fmaxf(mt, fmaxf(p0[i], p1[i]));
                    mt = fmaxf(mt, __shfl_xor(mt, 32));
                    m_new = fmaxf(m_run, mt); alpha = __builtin_amdgcn_exp2f(m_run - m_new);
#pragma unroll
                    for (int i = 0; i < 16; ++i) { p0[i] = __builtin_amdgcn_exp2f(p0[i] - m_new); p1[i] = __builtin_amdgcn_exp2f(p1[i] - m_new); }
                } else {
                    float mt = fmaxf(p0[0], p1[0]);
#pragma unroll
                    for (int i = 1; i < 16; ++i) mt = fmaxf(mt, fmaxf(p0[i], p1[i]));
                    mt = fmaxf(mt, __shfl_xor(mt, 32)) * c2;
                    m_new = fmaxf(m_run, mt); alpha = __builtin_amdgcn_exp2f(m_run - m_new);
#pragma unroll
                    for (int i = 0; i < 16; ++i) { p0[i] = __builtin_amdgcn_exp2f(__builtin_fmaf(p0[i], c2, -m_new)); p1[i] = __builtin_amdgcn_exp2f(__builtin_fmaf(p1[i], c2, -m_new)); }
                }
                m_run = m_new;
                float ls = 0.f;
#pragma unroll
                for (int i = 0; i < 16; ++i) ls += p0[i] + p1[i];
                l_run = l_run * alpha + ls;
#pragma unroll
                for (int i = 0; i < 16; ++i) { o0[i] *= alpha; o1[i] *= alpha; }
                bf16x8 pa[4];
#pragma unroll
                for (int s2 = 0; s2 < 2; ++s2) { u32x4 w; w.x = pk2(p0[8 * s2], p0[8 * s2 + 1]); w.y = pk2(p0[8 * s2 + 2], p0[8 * s2 + 3]); w.z = pk2(p0[8 * s2 + 4], p0[8 * s2 + 5]); w.w = pk2(p0[8 * s2 + 6], p0[8 * s2 + 7]); pa[s2] = __builtin_bit_cast(bf16x8, w);
                    u32x4 w2; w2.x = pk2(p1[8 * s2], p1[8 * s2 + 1]); w2.y = pk2(p1[8 * s2 + 2], p1[8 * s2 + 3]); w2.z = pk2(p1[8 * s2 + 4], p1[8 * s2 + 5]); w2.w = pk2(p1[8 * s2 + 6], p1[8 * s2 + 7]); pa[2 + s2] = __builtin_bit_cast(bf16x8, w2); }
#pragma unroll
                for (int s2 = 0; s2 < 4; ++s2) { const bf16x8 v0 = *(const LAS bf16x8*)(Vl + r * 144 + s2 * 32 + hh * 16), v1 = *(const LAS bf16x8*)(Vl + (32 + r) * 144 + s2 * 32 + hh * 16);
                    o0 = __builtin_amdgcn_mfma_f32_32x32x16_bf16(v0, pa[s2], o0, 0, 0, 0); o1 = __builtin_amdgcn_mfma_f32_32x32x16_bf16(v1, pa[s2], o1, 0, 0, 0); }
            }
            __syncthreads();
        }
#undef ATT_LOAD
#undef ATT_STORE
        const float inv = 1.0f / (l_run + __shfl_xor(l_run, 32));
        bf16_t* orow = Ob + (size_t)qtok * D + h * HD + 4 * hh;
#pragma unroll
        for (int g = 0; g < 4; ++g) { u32x2 w; w.x = pk2(o0[4 * g] * inv, o0[4 * g + 1] * inv); w.y = pk2(o0[4 * g + 2] * inv, o0[4 * g + 3] * inv); *(u32x2*)(orow + 8 * g) = w;
            u32x2 w2; w2.x = pk2(o1[4 * g] * inv, o1[4 * g + 1] * inv); w2.y = pk2(o1[4 * g + 2] * inv, o1[4 * g + 3] * inv); *(u32x2*)(orow + 32 + 8 * g) = w2; }
    }
    __syncthreads();
}

#define XB_TMO      128
#define XB_XCNT(j)  (256  + 64 * (j))
#define XB_XSUB(j)  (1280 + 64 * (j))
#define XB_XGEN(j)  (2304 + 64 * (j))
#define XB_TOP      3328
#define XB_TOPGEN   3392
#define XCD_BAR_WORDS 3456
#define XB_SPIN_CAP (1u << 18)
__device__ __forceinline__ unsigned xb_ld(unsigned* p)              { return __hip_atomic_load(p, __ATOMIC_RELAXED, __HIP_MEMORY_SCOPE_AGENT); }
__device__ __forceinline__ unsigned xb_add(unsigned* p, unsigned v) { return __hip_atomic_fetch_add(p, v, __ATOMIC_RELAXED, __HIP_MEMORY_SCOPE_AGENT); }
__device__ __forceinline__ unsigned xb_xcc_id() { return (unsigned)__builtin_amdgcn_s_getreg((3 << 11) | 20) & 0xFu; }
#define XB_SPIN(cond, bar) do { unsigned _sp = 0; while (cond) { __builtin_amdgcn_s_sleep(1); \
    if ((++_sp & 255u) == 0u) { if (xb_ld(&(bar)[XB_TMO])) break; if (_sp > XB_SPIN_CAP) { atomicAdd(&(bar)[XB_TMO], 1u); break; } } } } while (0)
struct XcdBarrier { unsigned* bar; unsigned x; volatile LAS unsigned* st; };
__device__ __forceinline__ XcdBarrier xcd_barrier_post(unsigned* bar, volatile LAS unsigned* st) {
    XcdBarrier b; b.bar = bar; b.x = xb_xcc_id(); b.st = st;
    if (threadIdx.x == 0) (void)xb_add(&bar[XB_XCNT(b.x)], 1u);
    return b;
}
__device__ __forceinline__ void xcd_barrier_complete(unsigned* bar, unsigned x, unsigned& nloc, unsigned& nx) {
    const unsigned G = gridDim.x * gridDim.y * gridDim.z;
    unsigned sum, cnt, mine, sp = 0u;
    for (;;) {
        sum = 0u; cnt = 0u; mine = 0u;
#pragma unroll
        for (unsigned j = 0; j < 16; ++j) { const unsigned c = xb_ld(&bar[XB_XCNT(j)]); sum += c; cnt += (c > 0u) ? 1u : 0u; mine = (j == x) ? c : mine; }
        if (sum == G) break;
        __builtin_amdgcn_s_sleep(1);
        if ((++sp & 255u) == 0u) { if (xb_ld(&bar[XB_TMO])) break; if (sp > XB_SPIN_CAP) { atomicAdd(&bar[XB_TMO], 1u); break; } }
    }
    nloc = mine > 0u ? mine : 1u; nx = cnt > 0u ? cnt : 1u;
}
__device__ __forceinline__ void xcd_barrier(const XcdBarrier& b) {
    asm volatile("s_waitcnt vmcnt(0)" ::: "memory");
    __syncthreads();
    if (threadIdx.x == 0) {
        unsigned* bar = b.bar;
        __builtin_amdgcn_s_waitcnt(0);
        unsigned nloc = b.st[0], nx = b.st[1];
        if (nloc == 0u) { xcd_barrier_complete(bar, b.x, nloc, nx); b.st[0] = nloc; b.st[1] = nx; }
        const unsigned old = xb_add(&bar[XB_XSUB(b.x)], 1u);
        const unsigned gen = old / nloc;
        if (old + 1u == (gen + 1u) * nloc) {
            __builtin_amdgcn_fence(__ATOMIC_RELEASE, "agent");
            asm volatile("s_waitcnt vmcnt(0)" ::: "memory");
            const unsigned og = xb_add(&bar[XB_TOP], 1u);
            const unsigned tg = og / nx;
            if (og + 1u == (tg + 1u) * nx) xb_add(&bar[XB_TOPGEN], 1u);
            else XB_SPIN(xb_ld(&bar[XB_TOPGEN]) == tg, bar);
            __builtin_amdgcn_fence(__ATOMIC_ACQUIRE, "agent");
            xb_add(&bar[XB_XGEN(b.x)], 1u);
            asm volatile("s_waitcnt vmcnt(0)" ::: "memory");
        } else {
            XB_SPIN(xb_ld(&bar[XB_XGEN(b.x)]) == gen, bar);
            __builtin_amdgcn_fence(__ATOMIC_ACQUIRE, "agent");
            asm volatile("s_waitcnt vmcnt(0)" ::: "memory");
        }
    }
    __syncthreads();
}

__global__ void __launch_bounds__(512, 2) mega_fwd(Params p) {
    extern __shared__ __attribute__((aligned(16))) unsigned char lds_raw[];
    LAS unsigned char* lds = (LAS unsigned char*)lds_raw;
    unsigned char* ws = p.ws;
    const int G = gridDim.x, c = blockIdx.x, lo = p.ph_lo, hi = p.ph_hi;
    const float* mod = (const float*)(ws + WS_MOD);
    const float* norm_g = p.in[8];
    bf16_t* H = (bf16_t*)(ws + WS_H); bf16_t* MPb = (bf16_t*)(ws + WS_MP); bf16_t* U = (bf16_t*)(ws + WS_U);
    float* X = p.out + OUT_X; bf16_t* XB = (bf16_t*)(ws + WS_XB);
    volatile LAS unsigned* MISC = (volatile LAS unsigned*)(lds + 131072 + 320);
    if (threadIdx.x < 32) MISC[threadIdx.x] = 0u;
    __syncthreads();
    XcdBarrier bar; bar.bar = (unsigned*)(ws + WS_CTL); bar.x = 0; bar.st = nullptr;
    if (hi - lo > 1) bar = xcd_barrier_post((unsigned*)(ws + WS_CTL), MISC + 8);
    if (hi > 1000) cg::this_grid().sync();
#ifndef PH_MASK
#define PH_MASK 0xffff
#endif
#define IN(k) (((PH_MASK >> (k)) & 1) && lo <= (k) && (k) < hi)
#ifndef PROBE_REP
#define PROBE_REP -1
#endif
#ifndef PROBE_SYNC2
#define PROBE_SYNC2 0
#endif
#define REPS(k) for (int rep_ = 0; rep_ < ((k) == PROBE_REP ? 2 : 1); ++rep_)
#ifndef PROBE_PHASE
#define PROBE_PHASE -1
#endif
    unsigned long long pt0 = 0, pt1 = 0;
    if (PROBE_PHASE == 0) pt0 = __builtin_amdgcn_s_memrealtime();
#define SEAM(k) do { if ((k) + 1 < hi) { xcd_barrier(bar); if (PROBE_SYNC2) xcd_barrier(bar); } \
        if ((k) == PROBE_PHASE) pt1 = __builtin_amdgcn_s_memrealtime(); if ((k) + 1 == PROBE_PHASE) pt0 = __builtin_amdgcn_s_memrealtime(); } while (0)

    if (IN(0)) { REPS(0) { phase_prologue(p, lds); } SEAM(0); }
    if (IN(1)) { REPS(1) {
        row_phase<false, true, true>(p.in[0], p.in[1], nullptr, nullptr, nullptr, H, nullptr, nullptr, norm_g, mod + 1 * D, mod + 0 * D);
        } SEAM(1);
    }
    if (IN(2)) { REPS(2) {
        pg8::ChDftSched S{G, c, (const char*)(ws + WS_CSCH), (const char*)H, (bf16_t*)(ws + WS_YTP), (bf16_t*)(ws + WS_YTS)};
        pg8::gemm_phase<pg8::EpiStore, pg8::ChDftSched, true>(lds, 256, D, 256, S, pg8::EpiStore{});
        } SEAM(2);
    }
    if (IN(3)) { REPS(3) {
        { pg8::SeqSSched S{c, (const char*)(ws + WS_TS), (const char*)(ws + WS_YTS), (bf16_t*)(ws + WS_F)};
          pg8::gemm_phase<pg8::EpiStore, pg8::SeqSSched, true>(lds, 4096, 4096, 4096, S, pg8::EpiStore{}); }
        { pg8::SeqPSched S{G, c, (const char*)(ws + WS_TP), (const char*)(ws + WS_YTP), (bf16_t*)(ws + WS_F)};
          pg8::gemm_phase<pg8::EpiStore, pg8::SeqPSched, true>(lds, 512, 512, 512, S, pg8::EpiStore{}); }
        phase_side_jobs(p, lds, 0);
        } SEAM(3);
    }
    if (IN(4)) { REPS(4) {
        pg8::GSched S{48, 4, G, c, (const char*)(ws + WS_F), (size_t)256 * D * 2, (const char*)(ws + WS_WF), (size_t)256 * D * 2, MPb, (size_t)256 * D, 256, D};
        pg8::gemm_phase<pg8::EpiStore, pg8::GSched, true>(lds, D, D, D, S, pg8::EpiStore{});
        phase_side_jobs(p, lds, 1);
        } SEAM(4);
    }
    if (IN(5)) { REPS(5) {
        row_phase<true, true, true>(p.in[0], p.in[1], XB, MPb, nullptr, H, mod + 2 * D, norm_g + 1 * D, norm_g + 2 * D, mod + 4 * D, mod + 3 * D);
        } SEAM(5);
    }
    if (IN(6)) { REPS(6) {
        pg8::GSched S{48, 22, G, c, (const char*)H, (size_t)256 * D * 2, (const char*)(ws + WS_WGU), (size_t)256 * D * 2, U, (size_t)256 * FF, 128, FF};
        pg8::gemm_phase<pg8::EpiSwiGLU, pg8::GSched, true>(lds, D, D, D, S, pg8::EpiSwiGLU{});
        } SEAM(6);
    }
    if (IN(7)) { REPS(7) {
        pg8::GSched S{48, 4, G, c, (const char*)U, (size_t)256 * FF * 2, (const char*)(ws + WS_WD), (size_t)256 * FF * 2, MPb, (size_t)256 * D, 256, D};
        pg8::gemm_phase<pg8::EpiStore, pg8::GSched, true>(lds, FF, FF, FF, S, pg8::EpiStore{});
        phase_side_jobs(p, lds, 2);
        } SEAM(7);
    }
    if (IN(8)) { REPS(8) {
        row_phase<true, true, false>(nullptr, nullptr, XB, MPb, nullptr, H, mod + 5 * D, norm_g + 3 * D, norm_g + 4 * D, mod + 3 * 6144 + 1 * D, mod + 3 * 6144 + 0 * D);
        } SEAM(8);
    }
    if (IN(9)) { REPS(9) {
        pg8::GSched S{48, 12, G, c, (const char*)H, (size_t)256 * D * 2, (const char*)(ws + WS_WQKV), (size_t)256 * D * 2, nullptr, 0, 0, D};
        pg8::EpiQKV E{(bf16_t*)(ws + WS_Q), (bf16_t*)(ws + WS_K), (bf16_t*)(ws + WS_VT), p.out + OUT_CK, p.out + OUT_CV};
        pg8::gemm_phase<pg8::EpiQKV, pg8::GSched, true>(lds, D, D, D, S, E);
        } SEAM(9);
    }
    if (IN(10)) { REPS(10) { attn_phase(p, lds); } SEAM(10); }
    if (IN(11)) { REPS(11) {
        pg8::GSched S{48, 4, G, c, (const char*)H, (size_t)256 * D * 2, (const char*)(ws + WS_WO), (size_t)256 * D * 2, MPb, (size_t)256 * D, 256, D};
        pg8::gemm_phase<pg8::EpiStore, pg8::GSched, true>(lds, D, D, D, S, pg8::EpiStore{});
        } SEAM(11);
    }
    if (IN(12)) { REPS(12) {
        row_phase<true, true, false>(nullptr, nullptr, XB, MPb, nullptr, H, mod + 3 * 6144 + 2 * D, norm_g + 5 * D, norm_g + 6 * D, mod + 3 * 6144 + 4 * D, mod + 3 * 6144 + 3 * D);
        } SEAM(12);
    }
    if (IN(13)) { REPS(13) {
        pg8::GSched S{48, 22, G, c, (const char*)H, (size_t)256 * D * 2, (const char*)(ws + WS_WGU) + (size_t)2 * FF * D * 2, (size_t)256 * D * 2, U, (size_t)256 * FF, 128, FF};
        pg8::gemm_phase<pg8::EpiSwiGLU, pg8::GSched, true>(lds, D, D, D, S, pg8::EpiSwiGLU{});
        } SEAM(13);
    }
    if (IN(14)) { REPS(14) {
        pg8::GSched S{48, 4, G, c, (const char*)U, (size_t)256 * FF * 2, (const char*)(ws + WS_WD) + (size_t)D * FF * 2, (size_t)256 * FF * 2, MPb, (size_t)256 * D, 256, D};
        pg8::gemm_phase<pg8::EpiStore, pg8::GSched, true>(lds, FF, FF, FF, S, pg8::EpiStore{});
        } SEAM(14);
    }
    if (IN(15)) { REPS(15) {
        row_phase<true, false, false>(nullptr, nullptr, XB, MPb, X, nullptr, mod + 3 * 6144 + 5 * D, norm_g + 7 * D, nullptr, nullptr, nullptr); }
    }
    if (PROBE_PHASE >= 0 && blockIdx.x == 0) { if (PROBE_PHASE == 15) pt1 = __builtin_amdgcn_s_memrealtime();
        const unsigned long long tend = __builtin_amdgcn_s_memrealtime(), wait = 9ull * (pt1 - pt0);
        while (__builtin_amdgcn_s_memrealtime() - tend < wait) __builtin_amdgcn_s_sleep(8); }
#undef IN
#undef SEAM
}

constexpr int LDS_BYTES = 147456;
extern "C" void kernel_launch(void* const* d_in, const int* in_sizes, int n_in, void* d_out, int out_size, void* d_ws, size_t ws_size, hipStream_t stream) {
    static int grid = 0;
    if (grid == 0) {
        int dev = 0, cus = 0, per_cu = 0;
        hipGetDevice(&dev);
        hipDeviceGetAttribute(&cus, hipDeviceAttributeMultiprocessorCount, dev);
        if (hipFuncSetAttribute((const void*)mega_fwd, hipFuncAttributeMaxDynamicSharedMemorySize, LDS_BYTES) != hipSuccess) fprintf(stderr, "kernel_launch: hipFuncSetAttribute failed\n");
        if (hipOccupancyMaxActiveBlocksPerMultiprocessor(&per_cu, (const void*)mega_fwd, 512, LDS_BYTES) != hipSuccess || per_cu < 1) { fprintf(stderr, "kernel_launch: occupancy query says %d\n", per_cu); per_cu = 1; }
        (void)hipGetLastError();
        grid = cus * 1;
        if (n_in != 16 || ws_size < WS_END) { fprintf(stderr, "kernel_launch: unexpected n_in %d / ws %zu\n", n_in, ws_size); }
    }
    Params p{};
    (void)hipMemsetAsync((unsigned char*)d_ws, 0, WS_CTL + CTL_BYTES, stream);
    for (int i = 0; i < 16; ++i) p.in[i] = (const float*)d_in[i];
    p.out = (float*)d_out; p.ws = (unsigned char*)d_ws;
    if (MK_N_LAUNCHES == 1) {
        p.ph_lo = 0; p.ph_hi = NPHASE;
        void* args[] = {&p};
        hipError_t e = hipLaunchCooperativeKernel((const void*)mega_fwd, dim3(grid), dim3(512), args, LDS_BYTES, stream);
        if (e != hipSuccess) fprintf(stderr, "cooperative launch failed: %s (grid %d)\n", hipGetErrorString(e), grid);
    } else {
        for (int k = 0; k < NPHASE; ++k) { p.ph_lo = k; p.ph_hi = k + 1; hipLaunchKernelGGL(mega_fwd, dim3(grid), dim3(512), LDS_BYTES, stream, p); }
    }
}
```

```cpp
#include <hip/hip_runtime.h>
#include <hip/hip_cooperative_groups.h>
#include <cstdio>
#include <cstdint>
namespace cg = cooperative_groups;

#ifndef MK_N_LAUNCHES
#define MK_N_LAUNCHES 1
#endif

#define LAS __attribute__((address_space(3)))
typedef unsigned short bf16_t;
typedef short bf16x8 __attribute__((ext_vector_type(8)));
typedef float f32x2 __attribute__((ext_vector_type(2)));
typedef float f32x4 __attribute__((ext_vector_type(4)));
typedef float f32x16 __attribute__((ext_vector_type(16)));
typedef unsigned u32x2 __attribute__((ext_vector_type(2)));
typedef unsigned u32x4 __attribute__((ext_vector_type(4)));
typedef __bf16 bf16x2_t __attribute__((ext_vector_type(2)));

constexpr int D = 1024, NP = 8192, NS = 4096, M = NP + NS, SP = 256, SS = 2048, FF = 2816, NH = 16, HD = 64;
constexpr int NPHASE = 16;
constexpr size_t MiB = 1u << 20;
constexpr size_t WS_CTL = 160 * 1024, CTL_BYTES = 80 * 1024;
constexpr int CW_CNT = 4096, CNT_SEAM = 48 * 64;
constexpr size_t WS_MOD = 0, WS_CSCH = 256 * 1024, WS_TP = 512 * 1024, WS_WF = 1 * MiB, WS_WQKV = 3 * MiB,
                 WS_WO = 9 * MiB, WS_WGU = 11 * MiB, WS_WD = 33 * MiB, WS_H = 44 * MiB, WS_MP = 68 * MiB, WS_U = 92 * MiB, WS_R = 158 * MiB;
constexpr size_t WS_YTP = WS_U, WS_YTS = WS_U + 32 * MiB;
constexpr size_t WS_TS = WS_R, WS_F = WS_R + 16 * MiB;
constexpr size_t WS_Q = WS_R, WS_K = WS_R + 24 * MiB, WS_VT = WS_R + 48 * MiB;
constexpr size_t WS_XB = WS_R + 72 * MiB, WS_END = WS_XB + 24 * MiB;
constexpr size_t OUTB_KC = 0, OUTB_VC = 2 * MiB;
constexpr size_t OUT_X = 0, OUT_CK = (size_t)M * D, OUT_CV = OUT_CK + (size_t)NP * D;

struct Params {
    const float* in[16];
    float* out; unsigned char* ws;
    int ph_lo, ph_hi;
};

__device__ __forceinline__ unsigned pk2(float lo, float hi) { f32x2 v = {lo, hi}; bf16x2_t b = __builtin_convertvector(v, bf16x2_t); return __builtin_bit_cast(unsigned, b); }
__device__ __forceinline__ float bf_lo(unsigned w) { return __uint_as_float(w << 16); }
__device__ __forceinline__ float bf_hi(unsigned w) { return __uint_as_float(w & 0xffff0000u); }
template <int CTRL> __device__ __forceinline__ float dpp_mov(float v) { return __builtin_bit_cast(float, __builtin_amdgcn_mov_dpp(__builtin_bit_cast(int, v), CTRL, 0xf, 0xf, true)); }
__device__ __forceinline__ float wave_sum(float v) {
    v += dpp_mov<0xB1>(v); v += dpp_mov<0x4E>(v); v += dpp_mov<0x141>(v); v += dpp_mov<0x140>(v);
    { auto rr = __builtin_amdgcn_permlane16_swap(__float_as_uint(v), __float_as_uint(v), false, false); v = __uint_as_float(rr[0]) + __uint_as_float(rr[1]); }
    { auto rr = __builtin_amdgcn_permlane32_swap(__float_as_uint(v), __float_as_uint(v), false, false); v = __uint_as_float(rr[0]) + __uint_as_float(rr[1]); }
    return v;
}

namespace pg8 {
constexpr int BM = 256, BK = 64, HALF = 128, HTB = HALF * BK * 2, STAGE_BYTES = 8 * HTB;
__device__ __forceinline__ int lds_byte(int r, int c) { const int st = (r >> 4) * 2 + (c >> 5), rr = r & 15, cc = c & 31, ob = rr * 64 + cc * 2; return st * 1024 + (ob ^ (((ob >> 9) & 1) << 5)); }
__device__ __forceinline__ void stage_rc(int b, int& R, int& C) { const int st = b / 1024, sb = b % 1024, swz = sb ^ (((sb >> 9) & 1) << 5); R = (st >> 1) * 16 + swz / 64; C = (st & 1) * 32 + (swz % 64) / 2; }
__device__ __forceinline__ int perm32(int rho) { const int n = rho >> 4, i = rho & 15; return 8 * (i >> 2) + 4 * n + (i & 3); }

struct UnitDesc { const char* A; const char* B; bf16_t* out; int ldc; int aux; };

__device__ __forceinline__ void tile_order(int L, int nM, int nN, int& pm, int& pn) {
    const int nwg = nM * nN; int wgid = L;
    { const int q = nwg / 8, r = nwg % 8, xcd = wgid % 8, off = wgid / 8; wgid = (xcd < r ? xcd * (q + 1) : r * (q + 1) + (xcd - r) * q) + off; }
    const int nig = 8 * nN, gid = wgid / nig, fm = gid * 8, gsz = (nM - fm) < 8 ? (nM - fm) : 8;
    pm = fm + ((wgid % nig) % gsz); pn = (wgid % nig) / gsz;
}

template <class Epi, class Sched, bool ALIGN_EPI>
__device__ __forceinline__ void gemm_phase(LAS unsigned char* lds, const int lda, const int ldb, const int K, const Sched& S, const Epi& E) {
    const int tid = threadIdx.x, wid = __builtin_amdgcn_readfirstlane(tid >> 6), lane = tid & 63, wr = wid >> 2, wc = wid & 3, fr = lane & 15, fq = lane >> 4;
    const int nt = K / BK;
    unsigned voffA[2], voffB[2];
#pragma unroll
    for (int i = 0; i < 2; ++i) { int R, C; stage_rc(tid * 16 + i * 8192, R, C); const int Rb = (R & ~31) + perm32(R & 31);
        voffA[i] = (unsigned)(R * lda + C) * 2u; voffB[i] = (unsigned)(Rb * ldb + C) * 2u; }
    const size_t kstep = (size_t)(BK * 2);
    const size_t hstepA = (size_t)HALF * lda * 2, hstepB = (size_t)HALF * ldb * 2;
    const unsigned ldsw = (unsigned)wid * 1024u;
    const int aoff = lds_byte(wr * 64 + fr, fq * 8), boff = lds_byte(wc * 32 + fr, fq * 8);
#define PG8_SA(b, h) (((b) * 2 + (h)) * HTB)
#define PG8_SB(b, h) ((4 + (b) * 2 + (h)) * HTB)
#define PG8_STAGE(bufoff, gbase, voff) do { _Pragma("unroll") for (int _i = 0; _i < 2; ++_i) \
        __builtin_amdgcn_global_load_lds((const unsigned*)((const char*)(gbase) + (voff)[_i]), (LAS unsigned*)(lds + (bufoff) + ldsw + _i * 8192), 16, 0, 0); } while (0)
#define PG8_LDA(dst, b, h) do { _Pragma("unroll") for (int m = 0; m < 4; ++m) _Pragma("unroll") for (int k = 0; k < 2; ++k) dst[m][k] = *(const LAS bf16x8*)(lds + PG8_SA(b, h) + aoff + m * 2048 + k * 1024); } while (0)
#define PG8_LDB(dst, b, h) do { _Pragma("unroll") for (int n = 0; n < 2; ++n) _Pragma("unroll") for (int k = 0; k < 2; ++k) dst[n][k] = *(const LAS bf16x8*)(lds + PG8_SB(b, h) + boff + n * 2048 + k * 1024); } while (0)
#define PG8_MMA(ai, bj, At, Bt) do { __builtin_amdgcn_s_setprio(1); _Pragma("unroll") for (int m = 0; m < 4; ++m) _Pragma("unroll") for (int n = 0; n < 2; ++n) _Pragma("unroll") for (int k = 0; k < 2; ++k) \
        acc[ai][bj][m][n] = __builtin_amdgcn_mfma_f32_16x16x32_bf16(Bt[n][k], At[m][k], acc[ai][bj][m][n], 0, 0, 0); __builtin_amdgcn_s_setprio(0); } while (0)
#define PG8_WAIT_V(n) asm volatile("s_waitcnt vmcnt(" #n ")" ::: "memory")
#define PG8_WAIT_L(n) asm volatile("s_waitcnt lgkmcnt(" #n ")" ::: "memory")
#define PG8_BAR __builtin_amdgcn_s_barrier()
#define PG8_SCHED __builtin_amdgcn_sched_barrier(0)
    UnitDesc cur, nxt; int ui = 0;
    if (!S.next(0, cur)) return;
    f32x4 acc[2][2][4][2];
#pragma unroll
    for (int a = 0; a < 2; ++a)
#pragma unroll
        for (int b = 0; b < 2; ++b)
#pragma unroll
            for (int m = 0; m < 4; ++m)
#pragma unroll
                for (int n = 0; n < 2; ++n) acc[a][b][m][n] = (f32x4){0.f, 0.f, 0.f, 0.f};
    bf16x8 At[4][2], B0[2][2], B1[2][2];
    const char* cA = cur.A; const char* cB = cur.B;
    PG8_STAGE(PG8_SB(0, 0), cB, voffB); PG8_STAGE(PG8_SB(0, 1), cB + hstepB, voffB); PG8_STAGE(PG8_SA(0, 0), cA, voffA); PG8_STAGE(PG8_SA(0, 1), cA + hstepA, voffA);
    if (wr == 1) PG8_BAR;
    PG8_WAIT_V(2); PG8_BAR;
    PG8_STAGE(PG8_SB(1, 0), cB + kstep, voffB); PG8_STAGE(PG8_SA(1, 0), cA + kstep, voffA); PG8_STAGE(PG8_SB(1, 1), cB + hstepB + kstep, voffB);
    PG8_WAIT_V(6); PG8_BAR;
    for (;;) {
        const bool has_next = S.next(ui + 1, nxt);
        const char* nA = has_next ? nxt.A : cA; const char* nB = has_next ? nxt.B : cB;
#pragma unroll 1
        for (int t = 0; t < nt; t += 2) {
            const bool last = (t == nt - 2);
            const char* a1 = cA + (size_t)(t + 1) * kstep;
            const char* a2 = last ? nA : cA + (size_t)(t + 2) * kstep; const char* b2 = last ? nB : cB + (size_t)(t + 2) * kstep;
            const char* a3 = a2 + kstep; const char* b3 = b2 + kstep;
            PG8_LDB(B0, 0, 0); PG8_LDB(B1, 0, 1); PG8_SCHED; PG8_LDA(At, 0, 0); PG8_STAGE(PG8_SA(1, 1), a1 + hstepA, voffA);
            PG8_WAIT_V(8); PG8_WAIT_L(0); PG8_BAR; PG8_MMA(0, 0, At, B0); PG8_MMA(0, 1, At, B1); PG8_BAR; PG8_SCHED;
            PG8_LDA(At, 0, 1); PG8_STAGE(PG8_SB(0, 0), b2, voffB); PG8_STAGE(PG8_SB(0, 1), b2 + hstepB, voffB); PG8_STAGE(PG8_SA(0, 0), a2, voffA);
            PG8_WAIT_V(8); PG8_WAIT_L(0); PG8_BAR; PG8_MMA(1, 0, At, B0); PG8_MMA(1, 1, At, B1); PG8_BAR; PG8_SCHED;
            PG8_LDB(B0, 1, 0); PG8_LDB(B1, 1, 1); PG8_SCHED; PG8_LDA(At, 1, 0); PG8_STAGE(PG8_SA(0, 1), a2 + hstepA, voffA);
            PG8_WAIT_V(8); PG8_WAIT_L(0); PG8_BAR; PG8_MMA(0, 0, At, B0); PG8_MMA(0, 1, At, B1); PG8_BAR; PG8_SCHED;
            PG8_LDA(At, 1, 1); PG8_STAGE(PG8_SB(1, 0), b3, voffB); PG8_STAGE(PG8_SB(1, 1), b3 + hstepB, voffB); PG8_STAGE(PG8_SA(1, 0), a3, voffA);
            PG8_WAIT_V(8); PG8_WAIT_L(0); PG8_BAR; PG8_MMA(1, 0, At, B0); PG8_MMA(1, 1, At, B1); PG8_BAR; PG8_SCHED;
        }
        if constexpr (ALIGN_EPI) { if (wr == 0) PG8_BAR; }
        E(acc, cur, wr, wc, fr, fq);
        if (!has_next) break;
#pragma unroll
        for (int a = 0; a < 2; ++a)
#pragma unroll
            for (int b = 0; b < 2; ++b)
#pragma unroll
                for (int m = 0; m < 4; ++m)
#pragma unroll
                    for (int n = 0; n < 2; ++n) acc[a][b][m][n] = (f32x4){0.f, 0.f, 0.f, 0.f};
        cur = nxt; cA = nA; cB = nB; ++ui;
        if constexpr (ALIGN_EPI) { if (wr == 1) PG8_BAR; }
    }
    PG8_WAIT_V(0);
    if constexpr (!ALIGN_EPI) { if (wr == 0) PG8_BAR; }
    PG8_BAR;
#undef PG8_SA
#undef PG8_SB
#undef PG8_STAGE
#undef PG8_LDA
#undef PG8_LDB
#undef PG8_MMA
#undef PG8_WAIT_V
#undef PG8_WAIT_L
#undef PG8_BAR
#undef PG8_SCHED
}

struct EpiStore {
    __device__ __forceinline__ void operator()(const f32x4 (&acc)[2][2][4][2], const UnitDesc& u, int wr, int wc, int fr, int fq) const {
#pragma unroll
        for (int ai = 0; ai < 2; ++ai)
#pragma unroll
            for (int m = 0; m < 4; ++m) { bf16_t* rowp = u.out + (size_t)(ai * HALF + wr * 64 + m * 16 + fr) * u.ldc + wc * 32 + 8 * fq;
#pragma unroll
                for (int bj = 0; bj < 2; ++bj) { const f32x4 v0 = acc[ai][bj][m][0], v1 = acc[ai][bj][m][1];
                    u32x4 w; w.x = pk2(v0[0], v0[1]); w.y = pk2(v0[2], v0[3]); w.z = pk2(v1[0], v1[1]); w.w = pk2(v1[2], v1[3]);
                    *(u32x4*)(rowp + bj * HALF) = w; } }
    }
};
__device__ __forceinline__ void store16_sc1(void* ptr, u32x4 v) { asm volatile("global_store_dwordx4 %0, %1, off sc0 sc1\n\ts_nop 3" :: "v"(ptr), "v"(v) : "memory"); }
struct EpiStoreSig {
    unsigned* cnt;
    __device__ __forceinline__ void operator()(const f32x4 (&acc)[2][2][4][2], const UnitDesc& u, int wr, int wc, int fr, int fq) const {
#pragma unroll
        for (int ai = 0; ai < 2; ++ai)
#pragma unroll
            for (int m = 0; m < 4; ++m) { bf16_t* rowp = u.out + (size_t)(ai * HALF + wr * 64 + m * 16 + fr) * u.ldc + wc * 32 + 8 * fq;
#pragma unroll
                for (int bj = 0; bj < 2; ++bj) { const f32x4 v0 = acc[ai][bj][m][0], v1 = acc[ai][bj][m][1];
                    u32x4 w; w.x = pk2(v0[0], v0[1]); w.y = pk2(v0[2], v0[3]); w.z = pk2(v1[0], v1[1]); w.w = pk2(v1[2], v1[3]);
                    if (cnt) store16_sc1(rowp + bj * HALF, w); else *(u32x4*)(rowp + bj * HALF) = w; } }
        if (cnt) { asm volatile("s_waitcnt vmcnt(0)" ::: "memory");
            if ((threadIdx.x & 63) == 0) __hip_atomic_fetch_add(cnt + (u.aux & 0xffff) * 64, 1u, __ATOMIC_RELAXED, __HIP_MEMORY_SCOPE_AGENT); }
    }
};
__device__ __forceinline__ float swiglu1(float g, float u) { return g * u * __builtin_amdgcn_rcpf(1.0f + __builtin_amdgcn_exp2f(-1.4426950408889634f * g)); }
struct EpiSwiGLU {
    __device__ __forceinline__ void operator()(const f32x4 (&acc)[2][2][4][2], const UnitDesc& u, int wr, int wc, int fr, int fq) const {
#pragma unroll
        for (int ai = 0; ai < 2; ++ai)
#pragma unroll
            for (int m = 0; m < 4; ++m) { bf16_t* rowp = u.out + (size_t)(ai * HALF + wr * 64 + m * 16 + fr) * u.ldc + wc * 32 + 8 * fq;
                const f32x4 g0 = acc[ai][0][m][0], g1 = acc[ai][0][m][1], u0 = acc[ai][1][m][0], u1 = acc[ai][1][m][1];
                u32x4 w; w.x = pk2(swiglu1(g0[0], u0[0]), swiglu1(g0[1], u0[1])); w.y = pk2(swiglu1(g0[2], u0[2]), swiglu1(g0[3], u0[3]));
                w.z = pk2(swiglu1(g1[0], u1[0]), swiglu1(g1[1], u1[1])); w.w = pk2(swiglu1(g1[2], u1[2]), swiglu1(g1[3], u1[3]));
                *(u32x4*)rowp = w; }
    }
};
struct EpiQKV {
    bf16_t* Q; bf16_t* Kb; bf16_t* Vb; float* ck; float* cv;
    __device__ __forceinline__ void operator()(const f32x4 (&acc)[2][2][4][2], const UnitDesc& u, int wr, int wc, int fr, int fq) const {
        const int pm = u.aux & 0xffff, pn = u.aux >> 16, sel = pn >> 2, ct = (pn & 3) * BM;
        const int row0 = pm * BM + wr * 64 + fr, col0 = ct + wc * 32 + 8 * fq;
        bf16_t* base = Q + (size_t)sel * (size_t)(12 * 1024 * 1024); float* cb = ck + (size_t)(sel >= 1 ? sel - 1 : 0) * (size_t)NP * D;
        const bool wc32 = sel >= 1 && pm < NP / BM;
#pragma unroll
        for (int ai = 0; ai < 2; ++ai)
#pragma unroll
            for (int m = 0; m < 4; ++m) { const size_t off = (size_t)(row0 + ai * HALF + m * 16) * D + col0;
#pragma unroll
                for (int bj = 0; bj < 2; ++bj) { const f32x4 v0 = acc[ai][bj][m][0], v1 = acc[ai][bj][m][1];
                    u32x4 w; w.x = pk2(v0[0], v0[1]); w.y = pk2(v0[2], v0[3]); w.z = pk2(v1[0], v1[1]); w.w = pk2(v1[2], v1[3]);
                    *(u32x4*)(base + off + bj * HALF) = w;
                    if (wc32) { *(f32x4*)(cb + off + bj * HALF) = v0; *(f32x4*)(cb + off + bj * HALF + 4) = v1; } } }
    }
};

struct GSched {
    int nM, nN, G, c; const char* A; size_t a_tile; const char* B; size_t b_tile; bf16_t* out; size_t o_pm, o_pn; int ldc;
    __device__ __forceinline__ bool next(int i, UnitDesc& u) const {
        const long L = (long)i * G + c; if (L >= (long)nM * nN) return false;
        int pm, pn; tile_order((int)L, nM, nN, pm, pn);
        u.A = A + (size_t)pm * a_tile; u.B = B + (size_t)pn * b_tile; u.out = out + (size_t)pm * o_pm + (size_t)pn * o_pn; u.ldc = ldc; u.aux = pm | (pn << 16); return true;
    }
};
struct ChDftSched {
    int G, c; const char* cs_tab; const char* H; bf16_t* ytp; bf16_t* yts;
    __device__ __forceinline__ bool next(int i, UnitDesc& u) const {
        const long L = (long)i * G + c; if (L >= 48 * 8) return false;
        int tok, gc; tile_order((int)L, 48, 8, tok, gc); const int g = gc >> 1, cs = gc & 1;
        u.A = cs_tab + (size_t)cs * 256 * 256 * 2; u.B = H + ((size_t)tok * 256 * D + g * 256) * 2;
        if (tok < 32) { u.out = ytp + ((size_t)(tok * D + g * 256) * 512 + cs * 256); u.ldc = 512; }
        else { const int idx = tok - 32, b = idx >> 3, s0 = (idx & 7) * 256; u.out = yts + ((size_t)(b * D + g * 256) * 4096 + cs * 2048 + s0); u.ldc = 4096; }
        u.aux = 0; return true;
    }
};
struct SeqSSched {
    int c; const char* ts; const char* yts; bf16_t* F;
    __device__ __forceinline__ bool next(int i, UnitDesc& u) const {
        if (i > 0 || c >= 64) return false;
        const int b = c >> 5, pm = (c >> 2) & 7, pn = c & 3;
        u.A = ts + (size_t)pm * 256 * 4096 * 2; u.B = yts + (size_t)(b * D + pn * 256) * 4096 * 2;
        u.out = F + ((size_t)(NP + b * SS + pm * 256) * D + pn * 256); u.ldc = D; u.aux = 0; return true;
    }
};
struct SeqPSched {
    int G, c; const char* tp; const char* ytp; bf16_t* F;
    __device__ __forceinline__ bool next(int i, UnitDesc& u) const {
        const int G2 = G - 64; if (c < 64 || G2 <= 0) return false;
        const long L = (long)i * G2 + (c - 64); if (L >= 128) return false;
        const int b = (int)L >> 2, pn = (int)L & 3;
        u.A = tp; u.B = ytp + (size_t)(b * D + pn * 256) * 512 * 2;
        u.out = F + ((size_t)(b * 256) * D + pn * 256); u.ldc = D; u.aux = 0; return true;
    }
};
}

constexpr int TI_L0 = 16 * 32 + 2 * 16 * 88 + 44 * 32, TI_ALL = 16 * 32 + 16 * 96 + 16 * 32 + 4 * 16 * 88 + 2 * 44 * 32;
struct TItem { const float* W; bf16_t* WT; int N, ldt, dst, k0, n0; };
__device__ __forceinline__ bool titem_decode(const Params& p, int it, TItem& t) {
    constexpr int I_F = 16 * 32, I_QKV = 16 * 96, I_O = 16 * 32, I_G = 16 * 88, I_D = 44 * 32;
    constexpr int NITEMS = I_F + I_QKV + I_O + 4 * I_G + 2 * I_D;
    if (it >= NITEMS) return false;
    unsigned char* ws = p.ws; int r = it; int mode = 0;
    if (r < I_F) { t.W = p.in[9]; t.N = D; t.ldt = D; t.WT = (bf16_t*)(ws + WS_WF); }
    else { r -= I_F; int l = 0; if (r >= 2 * I_G + I_D) { r -= 2 * I_G + I_D; l = 1; }
        if (r < I_G) { t.W = p.in[13] + (size_t)l * D * FF; t.N = FF; t.ldt = D; t.WT = (bf16_t*)(ws + WS_WGU) + (size_t)l * 2 * FF * D; mode = 1; }
        else if ((r -= I_G) < I_G) { t.W = p.in[14] + (size_t)l * D * FF; t.N = FF; t.ldt = D; t.WT = (bf16_t*)(ws + WS_WGU) + (size_t)l * 2 * FF * D; mode = 2; }
        else if ((r -= I_G) < I_D) { t.W = p.in[15] + (size_t)l * FF * D; t.N = D; t.ldt = FF; t.WT = (bf16_t*)(ws + WS_WD) + (size_t)l * D * FF; }
        else if ((r -= I_D) < I_QKV) { t.W = p.in[10]; t.N = 3 * D; t.ldt = D; t.WT = (bf16_t*)(ws + WS_WQKV); }
        else { r -= I_QKV; t.W = p.in[12]; t.N = D; t.ldt = D; t.WT = (bf16_t*)(ws + WS_WO); } }
    const int nblk = t.N / 32, kb = r / nblk, nb = r % nblk; t.n0 = nb * 32; t.k0 = kb * 64;
    t.dst = t.n0; if (mode) t.dst = (t.n0 >> 7) * 256 + (t.n0 & 127) + (mode == 2 ? 128 : 0);
    return true;
}
__device__ __forceinline__ void titem_load(const TItem& t, f32x4 (&wv)[8], int lane) {
#pragma unroll
    for (int i = 0; i < 8; ++i) wv[i] = *(const f32x4*)(t.W + (size_t)(t.k0 + 8 * i + (lane >> 3)) * t.N + t.n0 + 4 * (lane & 7));
}
__device__ __forceinline__ void titem_finish(const TItem& t, const f32x4 (&wv)[8], LAS float* scr, int lane) {
#pragma unroll
    for (int i = 0; i < 8; ++i) { LAS float* d = scr + (8 * i + (lane >> 3)) * 33 + 4 * (lane & 7); d[0] = wv[i][0]; d[1] = wv[i][1]; d[2] = wv[i][2]; d[3] = wv[i][3]; }
    asm volatile("s_waitcnt lgkmcnt(0)" ::: "memory");
    const int c = lane & 7;
#pragma unroll
    for (int j = 0; j < 4; ++j) { const int n = (lane >> 3) + 8 * j; const LAS float* s = scr + (8 * c) * 33 + n;
        u32x4 o; o.x = pk2(s[0 * 33], s[1 * 33]); o.y = pk2(s[2 * 33], s[3 * 33]); o.z = pk2(s[4 * 33], s[5 * 33]); o.w = pk2(s[6 * 33], s[7 * 33]);
        *(u32x4*)(t.WT + (size_t)(t.dst + n) * t.ldt + t.k0 + 8 * c) = o; }
    asm volatile("s_waitcnt lgkmcnt(0)" ::: "memory");
}

__device__ __forceinline__ void gemv_layer(const Params& p, LAS unsigned char* lds, const int l, const int rb, const int nb) {
    const int tid = threadIdx.x;
    LAS float* sl = (LAS float*)lds;
    LAS f32x4* red = (LAS f32x4*)(lds + 12288);
    for (int i = tid; i < 3072; i += 512) { const int cond = i >> 10, k = i & 1023; const float v = cond == 0 ? p.in[5][k] : p.in[2][(cond - 1) * D + k]; sl[i] = v / (1.0f + __expf(-v)); }
    __syncthreads();
    float* mod = (float*)(p.ws + WS_MOD);
    for (int item = rb; item < 96; item += nb) {
        const int rem = item, cc = rem >> 4, kc = rem & 15, rpar = tid >> 8, col = cc * 1024 + 4 * (tid & 255);
        const float* W = p.in[6] + ((size_t)l * D + kc * 64 + rpar) * 6144 + col;
        f32x4 a0 = {0.f, 0.f, 0.f, 0.f}, a1 = a0, a2 = a0;
#pragma unroll
        for (int hf = 0; hf < 2; ++hf) {
            f32x4 w[16];
#pragma unroll
            for (int i = 0; i < 16; ++i) w[i] = *(const f32x4*)(W + (size_t)(32 * hf + 2 * i) * 6144);
#pragma unroll
            for (int i = 0; i < 16; ++i) { const int k = kc * 64 + 32 * hf + 2 * i + rpar; a0 += sl[k] * w[i]; a1 += sl[1024 + k] * w[i]; a2 += sl[2048 + k] * w[i]; }
        }
        if (rpar == 1) { red[tid - 256] = a0; red[256 + tid - 256] = a1; red[512 + tid - 256] = a2; }
        __syncthreads();
        if (rpar == 0) {
            a0 += red[tid]; a1 += red[256 + tid]; a2 += red[512 + tid];
            if (kc == 0) { const f32x4 bv = *(const f32x4*)(p.in[7] + l * 6144 + col); a0 += bv; a1 += bv; a2 += bv; }
#pragma unroll
            for (int j = 0; j < 4; ++j) {
                unsafeAtomicAdd(mod + (l * 3 + 0) * 6144 + col + j, a0[j]);
                unsafeAtomicAdd(mod + (l * 3 + 1) * 6144 + col + j, a1[j]);
                unsafeAtomicAdd(mod + (l * 3 + 2) * 6144 + col + j, a2[j]); }
        }
        __syncthreads();
    }
}
__device__ __forceinline__ void transpose_jobs(const Params& p, LAS unsigned char* lds, int gw, int NGW, int it_lo, int it_hi) {
    const int lane = threadIdx.x & 63, wave = threadIdx.x >> 6;
    LAS float* scr = (LAS float*)(lds + wave * 8448);
    TItem cur, nxt; f32x4 wa[8], wb[8];
    int it = it_lo + gw;
    bool have = it < it_hi && titem_decode(p, it, cur);
    if (have) titem_load(cur, wa, lane);
    while (have) {
        const bool hn = it + NGW < it_hi && titem_decode(p, it + NGW, nxt);
        if (hn) titem_load(nxt, wb, lane);
        titem_finish(cur, wa, scr, lane);
        if (!hn) break;
        it += 2 * NGW;
        have = it < it_hi && titem_decode(p, it, cur);
        if (have) titem_load(cur, wa, lane);
        titem_finish(nxt, wb, scr, lane);
    }
}
__device__ __forceinline__ void phase_prologue(const Params& p, LAS unsigned char* lds) {
    const int tid = threadIdx.x, G = gridDim.x, bx = blockIdx.x;
    unsigned char* ws = p.ws;
    LAS float* ct = (LAS float*)(lds + 32768);
    for (int i = tid; i < 2048; i += 512) ct[i] = cospif((float)i * (1.0f / 1024.0f));
    const bool sep = G >= 192;
    if (!sep || bx < 96) gemv_layer(p, lds, 0, bx, sep ? 96 : G);
    if (sep && bx < 96) return;
    const int gt = (sep ? bx - 96 : bx) * 512 + tid, GT = (sep ? G - 96 : G) * 512;
    for (int i = gt; i < 2 * 2 * 512 * D / 8; i += GT) { const int which = i >= 2 * 512 * D / 8; const int ii = which ? i - 2 * 512 * D / 8 : i;
        const f32x4* src = (const f32x4*)p.in[which ? 4 : 3]; const f32x4 a = src[2 * ii], b = src[2 * ii + 1];
        u32x4 o; o.x = pk2(a[0], a[1]); o.y = pk2(a[2], a[3]); o.z = pk2(b[0], b[1]); o.w = pk2(b[2], b[3]); ((u32x4*)((unsigned char*)p.out + (which ? OUTB_VC : OUTB_KC)))[ii] = o; }
    for (int i = gt; i < 512 * 256 / 8; i += GT) { const int row = i >> 5, c0 = (i & 31) * 8, cs = row >> 8, m = row & 255; float v[8];
#pragma unroll
        for (int j = 0; j < 8; ++j) { const int idx = ((m * (c0 + j)) & 255) * 8; v[j] = ct[(idx - (cs ? 512 : 0)) & 2047]; }
        u32x4 o; o.x = pk2(v[0], v[1]); o.y = pk2(v[2], v[3]); o.z = pk2(v[4], v[5]); o.w = pk2(v[6], v[7]); ((u32x4*)(ws + WS_CSCH))[i] = o; }
    for (int i = gt; i < 256 * 512 / 8; i += GT) { const int k = i >> 6, c0 = (i & 63) * 8; float v[8];
#pragma unroll
        for (int j = 0; j < 8; ++j) { const int kk = c0 + j, sidx = kk & 255; const int idx = ((k * sidx) & 255) * 8; v[j] = kk < 256 ? ct[idx] : -ct[(idx - 512) & 2047]; }
        u32x4 o; o.x = pk2(v[0], v[1]); o.y = pk2(v[2], v[3]); o.z = pk2(v[4], v[5]); o.w = pk2(v[6], v[7]); ((u32x4*)(ws + WS_TP))[i] = o; }
    for (int i = gt; i < 2048 * 4096 / 8; i += GT) { const int k = i >> 9, c0 = (i & 511) * 8; float v[8];
#pragma unroll
        for (int j = 0; j < 8; ++j) { const int kk = c0 + j, sidx = kk & 2047; const int idx = (k * sidx) & 2047; v[j] = kk < 2048 ? ct[idx] : -ct[(idx - 512) & 2047]; }
        u32x4 o; o.x = pk2(v[0], v[1]); o.y = pk2(v[2], v[3]); o.z = pk2(v[4], v[5]); o.w = pk2(v[6], v[7]); ((u32x4*)(ws + WS_TS))[i] = o; }
}
__device__ __forceinline__ void phase_side_jobs(const Params& p, LAS unsigned char* lds, const int which) {
    const int G = gridDim.x, bx = blockIdx.x, first = which == 0 ? 64 : 192;
    const int nb = G > first ? G - first : G, b0 = G > first ? first : 0;
    if (bx < b0) return;
    const int rb = bx - b0;
    if (which == 0) transpose_jobs(p, lds, rb * 8 + (threadIdx.x >> 6), nb * 8, 0, TI_L0);
    else if (which == 1) gemv_layer(p, lds, 1, rb, nb);
    else transpose_jobs(p, lds, rb * 8 + (threadIdx.x >> 6), nb * 8, TI_L0, TI_ALL);
}

#ifndef ROW_WT
#define ROW_WT 0
#endif
__device__ __forceinline__ void store16_wt(void* ptr, u32x4 v) {
#if ROW_WT
    asm volatile("global_store_dwordx4 %0, %1, off sc0 sc1\n\ts_nop 3" :: "v"(ptr), "v"(v) : "memory");
#else
    *(u32x4*)ptr = v;
#endif
}
__device__ __forceinline__ void bf8_to_f32(const u32x4 w, f32x4& a, f32x4& b) { a = (f32x4){bf_lo(w.x), bf_hi(w.x), bf_lo(w.y), bf_hi(w.y)}; b = (f32x4){bf_lo(w.z), bf_hi(w.z), bf_lo(w.w), bf_hi(w.w)}; }
__device__ __forceinline__ u32x4 f32_to_bf8(const f32x4 a, const f32x4 b) { u32x4 w; w.x = pk2(a[0], a[1]); w.y = pk2(a[2], a[3]); w.z = pk2(b[0], b[1]); w.w = pk2(b[2], b[3]); return w; }
template <bool HAS_MP, bool HAS_NEXT, bool XIN_F32>
__device__ __forceinline__ void row_phase(const float* xin_p, const float* xin_s, bf16_t* XB, const bf16_t* mp, float* Yout, bf16_t* Hout,
                                          const float* gate, const float* gA, const float* gB, const float* sc, const float* sh, unsigned* cnt = nullptr) {
    const int tid = threadIdx.x, lane = tid & 63, gw = blockIdx.x * 8 + (tid >> 6), NGW = gridDim.x * 8;
    if (cnt) {
        if (tid == 0) { const int p0 = (blockIdx.x * 48) >> 8, p1 = (blockIdx.x * 48 + 47) >> 8;
            for (int pp = p0; pp <= p1; ++pp) { unsigned sp = 0; while (__hip_atomic_load(cnt + pp * 64, __ATOMIC_RELAXED, __HIP_MEMORY_SCOPE_AGENT) < 32u) { __builtin_amdgcn_s_sleep(2); if (++sp > (1u << 22)) break; } }
            __builtin_amdgcn_fence(__ATOMIC_ACQUIRE, "agent"); asm volatile("s_waitcnt vmcnt(0)" ::: "memory"); }
        __syncthreads();
    }
    constexpr int R = 3, RW = 6;
    int cur_cond = -1;
    f32x4 gga[4], gbs[4], shv[4];
    for (int rowb = gw * RW; rowb < M; rowb += NGW * RW)
    for (int row0 = rowb; row0 < rowb + RW; row0 += R) {
        f32x4 v[R][4]; u32x4 mw[R][2];
#pragma unroll
        for (int q = 0; q < R; ++q) { const int row = row0 + q;
            if constexpr (XIN_F32) { const float* xr = row < NP ? xin_p + (size_t)row * D : xin_s + (size_t)(row - NP) * D;
#pragma unroll
                for (int j = 0; j < 2; ++j) { v[q][2 * j] = *(const f32x4*)(xr + 8 * lane + 512 * j); v[q][2 * j + 1] = *(const f32x4*)(xr + 8 * lane + 512 * j + 4); }
            } else {
#pragma unroll
                for (int j = 0; j < 2; ++j) { const u32x4 w = *(const u32x4*)(XB + (size_t)row * D + 8 * lane + 512 * j); bf8_to_f32(w, v[q][2 * j], v[q][2 * j + 1]); }
            }
            if constexpr (HAS_MP) {
#pragma unroll
                for (int j = 0; j < 2; ++j) mw[q][j] = *(const u32x4*)(mp + (size_t)row * D + 8 * lane + 512 * j);
            } }
        u32x4 xo[R][2], ho[R][2];
#pragma unroll
        for (int q = 0; q < R; ++q) { const int row = row0 + q; const int cond = row < NP ? 0 : (row < NP + SS ? 1 : 2);
            if (cond != cur_cond) { cur_cond = cond;
#pragma unroll
                for (int j = 0; j < 4; ++j) { const int col = 8 * lane + 512 * (j >> 1) + 4 * (j & 1);
                    if constexpr (HAS_MP) gga[j] = *(const f32x4*)(gate + cond * 6144 + col) * *(const f32x4*)(gA + col);
                    if constexpr (HAS_NEXT) { gbs[j] = *(const f32x4*)(gB + col) * (1.0f + *(const f32x4*)(sc + cond * 6144 + col)); shv[j] = *(const f32x4*)(sh + cond * 6144 + col); } } }
            if constexpr (HAS_MP) {
                f32x4 mv[4]; float s = 0.f;
#pragma unroll
                for (int j = 0; j < 2; ++j) bf8_to_f32(mw[q][j], mv[2 * j], mv[2 * j + 1]);
#pragma unroll
                for (int j = 0; j < 4; ++j) s += (mv[j][0] * mv[j][0] + mv[j][1] * mv[j][1]) + (mv[j][2] * mv[j][2] + mv[j][3] * mv[j][3]);
                const float rstd = 1.0f / sqrtf(wave_sum(s) * (1.0f / D) + 1e-6f);
#pragma unroll
                for (int j = 0; j < 4; ++j) v[q][j] = v[q][j] + gga[j] * (mv[j] * rstd);
                if constexpr (HAS_NEXT) {
#pragma unroll
                    for (int j = 0; j < 2; ++j) xo[q][j] = f32_to_bf8(v[q][2 * j], v[q][2 * j + 1]);
                }
            }
            if constexpr (HAS_NEXT) {
                float s = 0.f;
#pragma unroll
                for (int j = 0; j < 4; ++j) s += (v[q][j][0] * v[q][j][0] + v[q][j][1] * v[q][j][1]) + (v[q][j][2] * v[q][j][2] + v[q][j][3] * v[q][j][3]);
                const float rstd = 1.0f / sqrtf(wave_sum(s) * (1.0f / D) + 1e-6f);
                f32x4 hh[4];
#pragma unroll
                for (int j = 0; j < 4; ++j) hh[j] = (v[q][j] * rstd) * gbs[j] + shv[j];
#pragma unroll
                for (int j = 0; j < 2; ++j) ho[q][j] = f32_to_bf8(hh[2 * j], hh[2 * j + 1]);
            } }
#pragma unroll
        for (int q = 0; q < R; ++q) { const int row = row0 + q;
            if constexpr (HAS_MP && !HAS_NEXT) {
#pragma unroll
                for (int j = 0; j < 4; ++j) *(f32x4*)(Yout + (size_t)row * D + 8 * lane + 512 * (j >> 1) + 4 * (j & 1)) = v[q][j];
            }
            if constexpr (HAS_MP && HAS_NEXT) {
#pragma unroll
                for (int j = 0; j < 2; ++j) store16_wt(XB + (size_t)row * D + 8 * lane + 512 * j, xo[q][j]);
            }
            if constexpr (HAS_NEXT) {
#pragma unroll
                for (int j = 0; j < 2; ++j) store16_wt(Hout + (size_t)row * D + 8 * lane + 512 * j, ho[q][j]);
            } }
    }
}

__device__ __forceinline__ void attn_phase(const Params& p, LAS unsigned char* lds) {
    const int tid = threadIdx.x, lane = tid & 63, wave = __builtin_amdgcn_readfirstlane(tid >> 6), r = lane & 31, hh = lane >> 5;
    unsigned char* ws = p.ws;
    const bf16_t* Qb = (const bf16_t*)(ws + WS_Q); const bf16_t* Kb = (const bf16_t*)(ws + WS_K); const bf16_t* Vb = (const bf16_t*)(ws + WS_VT);
    const bf16_t* Kc = (const bf16_t*)((const unsigned char*)p.out + OUTB_KC); const bf16_t* Vc = (const bf16_t*)((const unsigned char*)p.out + OUTB_VC);
    bf16_t* Ob = (bf16_t*)(ws + WS_H);
    LAS float* Bl = (LAS float*)(lds + 36864 + 512);
    const int srow = tid >> 3, sch = tid & 7, krho = (srow & ~12) | ((srow & 4) << 1) | ((srow & 8) >> 1);
    const float c2 = 0.125f * 1.4426950408889634f;
    for (int unit = blockIdx.x; unit < 768; unit += gridDim.x) {
        const bool is_na = unit < 256;
        int b, h, qtok, nt, jmin = 0, nloc = 0, rq = 0, half = 0, ktok0;
        if (is_na) { b = unit >> 7; h = (unit >> 3) & 15; const int r0 = (unit & 7) * 4; rq = r0 + (wave >> 1); half = wave & 1;
            jmin = min(max(r0 - 4, 0), 24); const int jmax = min(max(r0 - 1, 0), 24) + 7; nloc = jmax - jmin + 1; nt = nloc + 8;
            qtok = NP + b * SS + rq * 64 + half * 32 + r; ktok0 = NP + b * SS; }
        else { const int u2 = unit - 256; b = u2 >> 4; h = u2 & 15; nt = 4; qtok = b * SP + wave * 32 + r; ktok0 = b * SP; }
        const int rs = min(max(rq - 4, 0), 24);
        if (is_na) { for (int i = tid; i < 15 * 32; i += 512) { const int rr = i >> 5, x = i & 31; Bl[i] = x < 31 ? p.in[11][(h * 15 + rr) * 31 + x] * 1.4426950408889634f : 0.f; } }
        bf16x8 qf[4];
#pragma unroll
        for (int d0 = 0; d0 < 4; ++d0) qf[d0] = *(const bf16x8*)(Qb + (size_t)qtok * D + h * HD + d0 * 16 + hh * 8);
        f32x16 o0, o1;
#pragma unroll
        for (int i = 0; i < 16; ++i) { o0[i] = 0.f; o1[i] = 0.f; }
        float m_run = -1e30f, l_run = 0.f;
        u32x4 kreg, vreg;
#define ATT_LOAD(t) do { const int t_ = (t); size_t off_; const bf16_t* kb_; const bf16_t* vb_; \
            if (is_na && t_ >= nloc) { off_ = ((size_t)(b * 512 + (t_ - nloc) * 64 + srow)) * D + h * HD + sch * 8; kb_ = Kc; vb_ = Vc; } \
            else { off_ = (size_t)(ktok0 + (is_na ? (jmin + t_) * 64 : t_ * 64) + srow) * D + h * HD + sch * 8; kb_ = Kb; vb_ = Vb; } \
            kreg = *(const u32x4*)(kb_ + off_); vreg = *(const u32x4*)(vb_ + off_); } while (0)
#define ATT_STORE(buf) do { LAS unsigned char* kl_ = lds + (buf) * 18432; LAS unsigned char* vl_ = kl_ + 9216; \
            *(LAS u32x4*)(kl_ + krho * 144 + sch * 16) = kreg; \
            LAS bf16_t* vd_ = (LAS bf16_t*)(vl_ + (8 * sch) * 144 + srow * 2); \
            vd_[0 * 72] = (bf16_t)vreg.x; vd_[1 * 72] = (bf16_t)(vreg.x >> 16); vd_[2 * 72] = (bf16_t)vreg.y; vd_[3 * 72] = (bf16_t)(vreg.y >> 16); \
            vd_[4 * 72] = (bf16_t)vreg.z; vd_[5 * 72] = (bf16_t)(vreg.z >> 16); vd_[6 * 72] = (bf16_t)vreg.w; vd_[7 * 72] = (bf16_t)(vreg.w >> 16); } while (0)
        ATT_LOAD(0); ATT_STORE(0); if (nt > 1) ATT_LOAD(1);
        __syncthreads();
        for (int t = 0; t < nt; ++t) {
            if (t + 1 < nt) { ATT_STORE((t + 1) & 1); if (t + 2 < nt) ATT_LOAD(t + 2); }
            const bool local = is_na && t < nloc; const int j = jmin + t;
            if (!(local && (j < rs || j >= rs + 8))) {
                const LAS unsigned char* Kl = lds + (t & 1) * 18432; const LAS unsigned char* Vl = Kl + 9216;
                f32x16 p0, p1;
#pragma unroll
                for (int i = 0; i < 16; ++i) { p0[i] = 0.f; p1[i] = 0.f; }
#pragma unroll
                for (int d0 = 0; d0 < 4; ++d0) { const bf16x8 a0 = *(const LAS bf16x8*)(Kl + r * 144 + d0 * 32 + hh * 16), a1 = *(const LAS bf16x8*)(Kl + (32 + r) * 144 + d0 * 32 + hh * 16);
                    p0 = __builtin_amdgcn_mfma_f32_32x32x16_bf16(a0, qf[d0], p0, 0, 0, 0); p1 = __builtin_amdgcn_mfma_f32_32x32x16_bf16(a1, qf[d0], p1, 0, 0, 0); }
                float m_new, alpha;
                if (local) {
                    const int qc = half * 32 + r, cs = min(max(qc - 8, 0), 48);
                    const LAS float* bp = Bl + (j - rq + 7) * 32 + 8 * hh - qc + 15;
                    float bb0[16], bb1[16];
#pragma unroll
                    for (int i = 0; i < 16; ++i) { const int kc = 16 * (i >> 3) + (i & 7); bb0[i] = bp[kc]; bb1[i] = bp[kc + 32]; }
                    asm volatile("" : "+v"(bb0[0]), "+v"(bb0[1]), "+v"(bb0[2]), "+v"(bb0[3]), "+v"(bb0[4]), "+v"(bb0[5]), "+v"(bb0[6]), "+v"(bb0[7]));
                    asm volatile("" : "+v"(bb0[8]), "+v"(bb0[9]), "+v"(bb0[10]), "+v"(bb0[11]), "+v"(bb0[12]), "+v"(bb0[13]), "+v"(bb0[14]), "+v"(bb0[15]));
                    asm volatile("" : "+v"(bb1[0]), "+v"(bb1[1]), "+v"(bb1[2]), "+v"(bb1[3]), "+v"(bb1[4]), "+v"(bb1[5]), "+v"(bb1[6]), "+v"(bb1[7]));
                    asm volatile("" : "+v"(bb1[8]), "+v"(bb1[9]), "+v"(bb1[10]), "+v"(bb1[11]), "+v"(bb1[12]), "+v"(bb1[13]), "+v"(bb1[14]), "+v"(bb1[15]));
                    const unsigned sh0 = (unsigned)(8 * hh - cs);
#pragma unroll
                    for (int i = 0; i < 16; ++i) { const int kc = 16 * (i >> 3) + (i & 7);
                        const float s0 = __builtin_fmaf(p0[i], c2, bb0[i]), s1 = __builtin_fmaf(p1[i], c2, bb1[i]);
                        p0[i] = (sh0 + (unsigned)kc) < 16u ? s0 : -1e30f; p1[i] = (sh0 + (unsigned)(kc + 32)) < 16u ? s1 : -1e30f; }
                    float mt = fmaxf(p0[0], p1[0]);
#pragma unroll
                    for (int i = 1; i < 16; ++i) mt = fmaxf(mt, fmaxf(p0[i], p1[i]));
                    mt = fmaxf(mt, __shfl_xor(mt, 32));
                    m_new = fmaxf(m_run, mt); alpha = __builtin_amdgcn_exp2f(m_run - m_new);
#pragma unroll
                    for (int i = 0; i < 16; ++i) { p0[i] = __builtin_amdgcn_exp2f(p0[i] - m_new); p1[i] = __builtin_amdgcn_exp2f(p1[i] - m_new); }
                } else {
                    float mt = fmaxf(p0[0], p1[0]);
#pragma unroll
                    for (int i = 1; i < 16; ++i) mt = fmaxf(mt, fmaxf(p0[i], p1[i]));
                    mt = fmaxf(mt, __shfl_xor(mt, 32)) * c2;
                    m_new = fmaxf(m_run, mt); alpha = __builtin_amdgcn_exp2f(m_run - m_new);
#pragma unroll
                    for (int i = 0; i < 16; ++i) { p0[i] = __builtin_amdgcn_exp2f(__builtin_fmaf(p0[i], c2, -m_new)); p1[i] = __builtin_amdgcn_exp2f(__builtin_fmaf(p1[i], c2, -m_new)); }
                }
                m_run = m_new;
                float ls = 0.f;
#pragma unroll
                for (int i = 0; i < 16; ++i) ls += p0[i] + p1[i];
                l_run = l_run * alpha + ls;
#pragma unroll
                for (int i = 0; i < 16; ++i) { o0[i] *= alpha; o1[i] *= alpha; }
                bf16x8 pa[4];
#pragma unroll
                for (int s2 = 0; s2 < 2; ++s2) { u32x4 w; w.x = pk2(p0[8 * s2], p0[8 * s2 + 1]); w.y = pk2(p0[8 * s2 + 2], p0[8 * s2 + 3]); w.z = pk2(p0[8 * s2 + 4], p0[8 * s2 + 5]); w.w = pk2(p0[8 * s2 + 6], p0[8 * s2 + 7]); pa[s2] = __builtin_bit_cast(bf16x8, w);
                    u32x4 w2; w2.x = pk2(p1[8 * s2], p1[8 * s2 + 1]); w2.y = pk2(p1[8 * s2 + 2], p1[8 * s2 + 3]); w2.z = pk2(p1[8 * s2 + 4], p1[8 * s2 + 5]); w2.w = pk2(p1[8 * s2 + 6], p1[8 * s2 + 7]); pa[2 + s2] = __builtin_bit_cast(bf16x8, w2); }
#pragma unroll
                for (int s2 = 0; s2 < 4; ++s2) { const bf16x8 v0 = *(const LAS bf16x8*)(Vl + r * 144 + s2 * 32 + hh * 16), v1 = *(const LAS bf16x8*)(Vl + (32 + r) * 144 + s2 * 32 + hh * 16);
                    o0 = __builtin_amdgcn_mfma_f32_32x32x16_bf16(v0, pa[s2], o0, 0, 0, 0); o1 = __builtin_amdgcn_mfma_f32_32x32x16_bf16(v1, pa[s2], o1, 0, 0, 0); }
            }
            __syncthreads();
        }
#undef ATT_LOAD
#undef ATT_STORE
        const float inv = 1.0f / (l_run + __shfl_xor(l_run, 32));
        bf16_t* orow = Ob + (size_t)qtok * D + h * HD + 4 * hh;
#pragma unroll
        for (int g = 0; g < 4; ++g) { u32x2 w; w.x = pk2(o0[4 * g] * inv, o0[4 * g + 1] * inv); w.y = pk2(o0[4 * g + 2] * inv, o0[4 * g + 3] * inv); *(u32x2*)(orow + 8 * g) = w;
            u32x2 w2; w2.x = pk2(o1[4 * g] * inv, o1[4 * g + 1] * inv); w2.y = pk2(o1[4 * g + 2] * inv, o1[4 * g + 3] * inv); *(u32x2*)(orow + 32 + 8 * g) = w2; }
    }
    __syncthreads();
}

#define XB_TMO      128
#define XB_XCNT(j)  (256  + 64 * (j))
#define XB_XSUB(j)  (1280 + 64 * (j))
#define XB_XGEN(j)  (2304 + 64 * (j))
#define XB_TOP      3328
#define XB_TOPGEN   3392
#define XCD_BAR_WORDS 3456
#define XB_SPIN_CAP (1u << 18)
__device__ __forceinline__ unsigned xb_ld(unsigned* p)              { return __hip_atomic_load(p, __ATOMIC_RELAXED, __HIP_MEMORY_SCOPE_AGENT); }
__device__ __forceinline__ unsigned xb_add(unsigned* p, unsigned v) { return __hip_atomic_fetch_add(p, v, __ATOMIC_RELAXED, __HIP_MEMORY_SCOPE_AGENT); }
__device__ __forceinline__ unsigned xb_xcc_id() { return (unsigned)__builtin_amdgcn_s_getreg((3 << 11) | 20) & 0xFu; }
#define XB_SPIN(cond, bar) do { unsigned _sp = 0; while (cond) { __builtin_amdgcn_s_sleep(1); \
    if ((++_sp & 255u) == 0u) { if (xb_ld(&(bar)[XB_TMO])) break; if (_sp > XB_SPIN_CAP) { atomicAdd(&(bar)[XB_TMO], 1u); break; } } } } while (0)
struct XcdBarrier { unsigned* bar; unsigned x; volatile LAS unsigned* st; };
__device__ __forceinline__ XcdBarrier xcd_barrier_post(unsigned* bar, volatile LAS unsigned* st) {
    XcdBarrier b; b.bar = bar; b.x = xb_xcc_id(); b.st = st;
    if (threadIdx.x == 0) (void)xb_add(&bar[XB_XCNT(b.x)], 1u);
    return b;
}
__device__ __forceinline__ void xcd_barrier_complete(unsigned* bar, unsigned x, unsigned& nloc, unsigned& nx) {
    const unsigned G = gridDim.x * gridDim.y * gridDim.z;
    unsigned sum, cnt, mine, sp = 0u;
    for (;;) {
        sum = 0u; cnt = 0u; mine = 0u;
#pragma unroll
        for (unsigned j = 0; j < 16; ++j) { const unsigned c = xb_ld(&bar[XB_XCNT(j)]); sum += c; cnt += (c > 0u) ? 1u : 0u; mine = (j == x) ? c : mine; }
        if (sum == G) break;
        __builtin_amdgcn_s_sleep(1);
        if ((++sp & 255u) == 0u) { if (xb_ld(&bar[XB_TMO])) break; if (sp > XB_SPIN_CAP) { atomicAdd(&bar[XB_TMO], 1u); break; } }
    }
    nloc = mine > 0u ? mine : 1u; nx = cnt > 0u ? cnt : 1u;
}
__device__ __forceinline__ void xcd_barrier(const XcdBarrier& b) {
    asm volatile("s_waitcnt vmcnt(0)" ::: "memory");
    __syncthreads();
    if (threadIdx.x == 0) {
        unsigned* bar = b.bar;
        __builtin_amdgcn_s_waitcnt(0);
        unsigned nloc = b.st[0], nx = b.st[1];
        if (nloc == 0u) { xcd_barrier_complete(bar, b.x, nloc, nx); b.st[0] = nloc; b.st[1] = nx; }
        const unsigned old = xb_add(&bar[XB_XSUB(b.x)], 1u);
        const unsigned gen = old / nloc;
        if (old + 1u == (gen + 1u) * nloc) {
            __builtin_amdgcn_fence(__ATOMIC_RELEASE, "agent");
            asm volatile("s_waitcnt vmcnt(0)" ::: "memory");
            const unsigned og = xb_add(&bar[XB_TOP], 1u);
            const unsigned tg = og / nx;
            if (og + 1u == (tg + 1u) * nx) xb_add(&bar[XB_TOPGEN], 1u);
            else XB_SPIN(xb_ld(&bar[XB_TOPGEN]) == tg, bar);
            __builtin_amdgcn_fence(__ATOMIC_ACQUIRE, "agent");
            xb_add(&bar[XB_XGEN(b.x)], 1u);
            asm volatile("s_waitcnt vmcnt(0)" ::: "memory");
        } else {
            XB_SPIN(xb_ld(&bar[XB_XGEN(b.x)]) == gen, bar);
            __builtin_amdgcn_fence(__ATOMIC_ACQUIRE, "agent");
            asm volatile("s_waitcnt vmcnt(0)" ::: "memory");
        }
    }
    __syncthreads();
}

__global__ void __launch_bounds__(512, 2) mega_fwd(Params p) {
    extern __shared__ __attribute__((aligned(16))) unsigned char lds_raw[];
    LAS unsigned char* lds = (LAS unsigned char*)lds_raw;
    unsigned char* ws = p.ws;
    const int G = gridDim.x, c = blockIdx.x, lo = p.ph_lo, hi = p.ph_hi;
    const float* mod = (const float*)(ws + WS_MOD);
    const float* norm_g = p.in[8];
    bf16_t* H = (bf16_t*)(ws + WS_H); bf16_t* MPb = (bf16_t*)(ws + WS_MP); bf16_t* U = (bf16_t*)(ws + WS_U);
    float* X = p.out + OUT_X; bf16_t* XB = (bf16_t*)(ws + WS_XB);
    volatile LAS unsigned* MISC = (volatile LAS unsigned*)(lds + 131072 + 320);
    if (threadIdx.x < 32) MISC[threadIdx.x] = 0u;
    __syncthreads();
    XcdBarrier bar; bar.bar = (unsigned*)(ws + WS_CTL); bar.x = 0; bar.st = nullptr;
    if (hi - lo > 1) bar = xcd_barrier_post((unsigned*)(ws + WS_CTL), MISC + 8);
    if (hi > 1000) cg::this_grid().sync();
#ifndef PH_MASK
#define PH_MASK 0xffff
#endif
#define IN(k) (((PH_MASK >> (k)) & 1) && lo <= (k) && (k) < hi)
    const bool handoff = (G == 256) && (hi - lo > 1);
    unsigned* const cntb = (unsigned*)(ws + WS_CTL) + CW_CNT;
#ifndef PROBE_REP
#define PROBE_REP -1
#endif
#ifndef PROBE_SYNC2
#define PROBE_SYNC2 0
#endif
#define REPS(k) for (int rep_ = 0; rep_ < ((k) == PROBE_REP ? 2 : 1); ++rep_)
#ifndef PROBE_PHASE
#define PROBE_PHASE -1
#endif
    unsigned long long pt0 = 0, pt1 = 0;
    if (PROBE_PHASE == 0) pt0 = __builtin_amdgcn_s_memrealtime();
#define SEAM(k) SEAMX(k, false)
#define SEAMX(k, skip) do { if ((k) + 1 < hi && !(skip)) { xcd_barrier(bar); if (PROBE_SYNC2) xcd_barrier(bar); } \
        if ((k) == PROBE_PHASE) pt1 = __builtin_amdgcn_s_memrealtime(); if ((k) + 1 == PROBE_PHASE) pt0 = __builtin_amdgcn_s_memrealtime(); } while (0)

    if (IN(0)) { REPS(0) { phase_prologue(p, lds); } SEAM(0); }
    if (IN(1)) { REPS(1) {
        row_phase<false, true, true>(p.in[0], p.in[1], nullptr, nullptr, nullptr, H, nullptr, nullptr, norm_g, mod + 1 * D, mod + 0 * D);
        } SEAM(1);
    }
    if (IN(2)) { REPS(2) {
        pg8::ChDftSched S{G, c, (const char*)(ws + WS_CSCH), (const char*)H, (bf16_t*)(ws + WS_YTP), (bf16_t*)(ws + WS_YTS)};
        pg8::gemm_phase<pg8::EpiStore, pg8::ChDftSched, true>(lds, 256, D, 256, S, pg8::EpiStore{});
        } SEAM(2);
    }
    if (IN(3)) { REPS(3) {
        { pg8::SeqSSched S{c, (const char*)(ws + WS_TS), (const char*)(ws + WS_YTS), (bf16_t*)(ws + WS_F)};
          pg8::gemm_phase<pg8::EpiStore, pg8::SeqSSched, true>(lds, 4096, 4096, 4096, S, pg8::EpiStore{}); }
        { pg8::SeqPSched S{G, c, (const char*)(ws + WS_TP), (const char*)(ws + WS_YTP), (bf16_t*)(ws + WS_F)};
          pg8::gemm_phase<pg8::EpiStore, pg8::SeqPSched, true>(lds, 512, 512, 512, S, pg8::EpiStore{}); }
        phase_side_jobs(p, lds, 0);
        } SEAM(3);
    }
    if (IN(4)) { REPS(4) {
        pg8::GSched S{48, 4, G, c, (const char*)(ws + WS_F), (size_t)256 * D * 2, (const char*)(ws + WS_WF), (size_t)256 * D * 2, MPb, (size_t)256 * D, 256, D};
        pg8::gemm_phase<pg8::EpiStoreSig, pg8::GSched, true>(lds, D, D, D, S, pg8::EpiStoreSig{handoff ? cntb + 0 * CNT_SEAM : nullptr});
        phase_side_jobs(p, lds, 1);
        } SEAMX(4, handoff);
    }
    if (IN(5)) { REPS(5) {
        row_phase<true, true, true>(p.in[0], p.in[1], XB, MPb, nullptr, H, mod + 2 * D, norm_g + 1 * D, norm_g + 2 * D, mod + 4 * D, mod + 3 * D, handoff ? cntb + 0 * CNT_SEAM : nullptr);
        } SEAM(5);
    }
    if (IN(6)) { REPS(6) {
        pg8::GSched S{48, 22, G, c, (const char*)H, (size_t)256 * D * 2, (const char*)(ws + WS_WGU), (size_t)256 * D * 2, U, (size_t)256 * FF, 128, FF};
        pg8::gemm_phase<pg8::EpiSwiGLU, pg8::GSched, true>(lds, D, D, D, S, pg8::EpiSwiGLU{});
        } SEAM(6);
    }
    if (IN(7)) { REPS(7) {
        pg8::GSched S{48, 4, G, c, (const char*)U, (size_t)256 * FF * 2, (const char*)(ws + WS_WD), (size_t)256 * FF * 2, MPb, (size_t)256 * D, 256, D};
        pg8::gemm_phase<pg8::EpiStoreSig, pg8::GSched, true>(lds, FF, FF, FF, S, pg8::EpiStoreSig{handoff ? cntb + 1 * CNT_SEAM : nullptr});
        phase_side_jobs(p, lds, 2);
        } SEAMX(7, handoff);
    }
    if (IN(8)) { REPS(8) {
        row_phase<true, true, false>(nullptr, nullptr, XB, MPb, nullptr, H, mod + 5 * D, norm_g + 3 * D, norm_g + 4 * D, mod + 3 * 6144 + 1 * D, mod + 3 * 6144 + 0 * D, handoff ? cntb + 1 * CNT_SEAM : nullptr);
        } SEAM(8);
    }
    if (IN(9)) { REPS(9) {
        pg8::GSched S{48, 12, G, c, (const char*)H, (size_t)256 * D * 2, (const char*)(ws + WS_WQKV), (size_t)256 * D * 2, nullptr, 0, 0, D};
        pg8::EpiQKV E{(bf16_t*)(ws + WS_Q), (bf16_t*)(ws + WS_K), (bf16_t*)(ws + WS_VT), p.out + OUT_CK, p.out + OUT_CV};
        pg8::gemm_phase<pg8::EpiQKV, pg8::GSched, true>(lds, D, D, D, S, E);
        } SEAM(9);
    }
    if (IN(10)) { REPS(10) { attn_phase(p, lds); } SEAM(10); }
    if (IN(11)) { REPS(11) {
        pg8::GSched S{48, 4, G, c, (const char*)H, (size_t)256 * D * 2, (const char*)(ws + WS_WO), (size_t)256 * D * 2, MPb, (size_t)256 * D, 256, D};
        pg8::gemm_phase<pg8::EpiStoreSig, pg8::GSched, true>(lds, D, D, D, S, pg8::EpiStoreSig{handoff ? cntb + 2 * CNT_SEAM : nullptr});
        } SEAMX(11, handoff);
    }
    if (IN(12)) { REPS(12) {
        row_phase<true, true, false>(nullptr, nullptr, XB, MPb, nullptr, H, mod + 3 * 6144 + 2 * D, norm_g + 5 * D, norm_g + 6 * D, mod + 3 * 6144 + 4 * D, mod + 3 * 6144 + 3 * D, handoff ? cntb + 2 * CNT_SEAM : nullptr);
        } SEAM(12);
    }
    if (IN(13)) { REPS(13) {
        pg8::GSched S{48, 22, G, c, (const char*)H, (size_t)256 * D * 2, (const char*)(ws + WS_WGU) + (size_t)2 * FF * D * 2, (size_t)256 * D * 2, U, (size_t)256 * FF, 128, FF};
        pg8::gemm_phase<pg8::EpiSwiGLU, pg8::GSched, true>(lds, D, D, D, S, pg8::EpiSwiGLU{});
        } SEAM(13);
    }
    if (IN(14)) { REPS(14) {
        pg8::GSched S{48, 4, G, c, (const char*)U, (size_t)256 * FF * 2, (const char*)(ws + WS_WD) + (size_t)D * FF * 2, (size_t)256 * FF * 2, MPb, (size_t)256 * D, 256, D};
        pg8::gemm_phase<pg8::EpiStoreSig, pg8::GSched, true>(lds, FF, FF, FF, S, pg8::EpiStoreSig{handoff ? cntb + 3 * CNT_SEAM : nullptr});
        } SEAMX(14, handoff);
    }
    if (IN(15)) { REPS(15) {
        row_phase<true, false, false>(nullptr, nullptr, XB, MPb, X, nullptr, mod + 3 * 6144 + 5 * D, norm_g + 7 * D, nullptr, nullptr, nullptr, handoff ? cntb + 3 * CNT_SEAM : nullptr); }
    }
    if (PROBE_PHASE >= 0 && blockIdx.x == 0) { if (PROBE_PHASE == 15) pt1 = __builtin_amdgcn_s_memrealtime();
        const unsigned long long tend = __builtin_amdgcn_s_memrealtime(), wait = 9ull * (pt1 - pt0);
        while (__builtin_amdgcn_s_memrealtime() - tend < wait) __builtin_amdgcn_s_sleep(8); }
#undef IN
#undef SEAM
}

constexpr int LDS_BYTES = 147456;
extern "C" void kernel_launch(void* const* d_in, const int* in_sizes, int n_in, void* d_out, int out_size, void* d_ws, size_t ws_size, hipStream_t stream) {
    static int grid = 0;
    if (grid == 0) {
        int dev = 0, cus = 0, per_cu = 0;
        hipGetDevice(&dev);
        hipDeviceGetAttribute(&cus, hipDeviceAttributeMultiprocessorCount, dev);
        if (hipFuncSetAttribute((const void*)mega_fwd, hipFuncAttributeMaxDynamicSharedMemorySize, LDS_BYTES) != hipSuccess) fprintf(stderr, "kernel_launch: hipFuncSetAttribute failed\n");
        if (hipOccupancyMaxActiveBlocksPerMultiprocessor(&per_cu, (const void*)mega_fwd, 512, LDS_BYTES) != hipSuccess || per_cu < 1) { fprintf(stderr, "kernel_launch: occupancy query says %d\n", per_cu); per_cu = 1; }
        (void)hipGetLastError();
        grid = cus * 1;
        if (n_in != 16 || ws_size < WS_END) { fprintf(stderr, "kernel_launch: unexpected n_in %d / ws %zu\n", n_in, ws_size); }
    }
    Params p{};
    (void)hipMemsetAsync((unsigned char*)d_ws, 0, WS_CTL + CTL_BYTES, stream);
    for (int i = 0; i < 16; ++i) p.in[i] = (const float*)d_in[i];
    p.out = (float*)d_out; p.ws = (unsigned char*)d_ws;
    if (MK_N_LAUNCHES == 1) {
        p.ph_lo = 0; p.ph_hi = NPHASE;
        void* args[] = {&p};
        hipError_t e = hipLaunchCooperativeKernel((const void*)mega_fwd, dim3(grid), dim3(512), args, LDS_BYTES, stream);
        if (e != hipSuccess) fprintf(stderr, "cooperative launch failed: %s (grid %d)\n", hipGetErrorString(e), grid);
    } else {
        for (int k = 0; k < NPHASE; ++k) { p.ph_lo = k; p.ph_hi = k + 1; hipLaunchKernelGGL(mega_fwd, dim3(grid), dim3(512), LDS_BYTES, stream, p); }
    }
}
```

```cpp
#include <hip/hip_runtime.h>
#include <hip/hip_cooperative_groups.h>
#include <cstdio>
#include <cstdint>
namespace cg = cooperative_groups;

#ifndef MK_N_LAUNCHES
#define MK_N_LAUNCHES 1
#endif

#define LAS __attribute__((address_space(3)))
typedef unsigned short bf16_t;
typedef short bf16x8 __attribute__((ext_vector_type(8)));
typedef float f32x2 __attribute__((ext_vector_type(2)));
typedef float f32x4 __attribute__((ext_vector_type(4)));
typedef float f32x16 __attribute__((ext_vector_type(16)));
typedef unsigned u32x2 __attribute__((ext_vector_type(2)));
typedef unsigned u32x4 __attribute__((ext_vector_type(4)));
typedef __bf16 bf16x2_t __attribute__((ext_vector_type(2)));

constexpr int D = 1024, NP = 8192, NS = 4096, M = NP + NS, SP = 256, SS = 2048, FF = 2816, NH = 16, HD = 64;
constexpr int NPHASE = 16;
constexpr size_t MiB = 1u << 20;
constexpr size_t WS_CTL = 160 * 1024, CTL_BYTES = 96 * 1024;
constexpr int CW_CNT = 4096, CNT_SEAM = 48 * 64;
constexpr size_t WS_MOD = 0, WS_CSCH = 256 * 1024, WS_TP = 512 * 1024, WS_WF = 1 * MiB, WS_WQKV = 3 * MiB,
                 WS_WO = 9 * MiB, WS_WGU = 11 * MiB, WS_WD = 33 * MiB, WS_H = 44 * MiB, WS_MP = 68 * MiB, WS_U = 92 * MiB, WS_R = 158 * MiB;
constexpr size_t WS_YTP = WS_U, WS_YTS = WS_U + 32 * MiB;
constexpr size_t WS_TS = WS_R, WS_F = WS_R + 16 * MiB;
constexpr size_t WS_Q = WS_R, WS_K = WS_R + 24 * MiB, WS_VT = WS_R + 48 * MiB;
constexpr size_t WS_XB = WS_R + 72 * MiB, WS_END = WS_XB + 24 * MiB;
constexpr size_t OUTB_KC = 0, OUTB_VC = 2 * MiB;
constexpr size_t OUT_X = 0, OUT_CK = (size_t)M * D, OUT_CV = OUT_CK + (size_t)NP * D;

struct Params {
    const float* in[16];
    float* out; unsigned char* ws;
    int ph_lo, ph_hi;
};

__device__ __forceinline__ unsigned pk2(float lo, float hi) { f32x2 v = {lo, hi}; bf16x2_t b = __builtin_convertvector(v, bf16x2_t); return __builtin_bit_cast(unsigned, b); }
__device__ __forceinline__ float bf_lo(unsigned w) { return __uint_as_float(w << 16); }
__device__ __forceinline__ float bf_hi(unsigned w) { return __uint_as_float(w & 0xffff0000u); }
template <int CTRL> __device__ __forceinline__ float dpp_mov(float v) { return __builtin_bit_cast(float, __builtin_amdgcn_mov_dpp(__builtin_bit_cast(int, v), CTRL, 0xf, 0xf, true)); }
__device__ __forceinline__ float wave_sum(float v) {
    v += dpp_mov<0xB1>(v); v += dpp_mov<0x4E>(v); v += dpp_mov<0x141>(v); v += dpp_mov<0x140>(v);
    { auto rr = __builtin_amdgcn_permlane16_swap(__float_as_uint(v), __float_as_uint(v), false, false); v = __uint_as_float(rr[0]) + __uint_as_float(rr[1]); }
    { auto rr = __builtin_amdgcn_permlane32_swap(__float_as_uint(v), __float_as_uint(v), false, false); v = __uint_as_float(rr[0]) + __uint_as_float(rr[1]); }
    return v;
}

namespace pg8 {
constexpr int BM = 256, BK = 64, HALF = 128, HTB = HALF * BK * 2, STAGE_BYTES = 8 * HTB;
__device__ __forceinline__ int lds_byte(int r, int c) { const int st = (r >> 4) * 2 + (c >> 5), rr = r & 15, cc = c & 31, ob = rr * 64 + cc * 2; return st * 1024 + (ob ^ (((ob >> 9) & 1) << 5)); }
__device__ __forceinline__ void stage_rc(int b, int& R, int& C) { const int st = b / 1024, sb = b % 1024, swz = sb ^ (((sb >> 9) & 1) << 5); R = (st >> 1) * 16 + swz / 64; C = (st & 1) * 32 + (swz % 64) / 2; }
__device__ __forceinline__ int perm32(int rho) { const int n = rho >> 4, i = rho & 15; return 8 * (i >> 2) + 4 * n + (i & 3); }

struct UnitDesc { const char* A; const char* B; bf16_t* out; int ldc; int aux; };

__device__ __forceinline__ void tile_order(int L, int nM, int nN, int& pm, int& pn) {
    const int nwg = nM * nN; int wgid = L;
    { const int q = nwg / 8, r = nwg % 8, xcd = wgid % 8, off = wgid / 8; wgid = (xcd < r ? xcd * (q + 1) : r * (q + 1) + (xcd - r) * q) + off; }
    const int nig = 8 * nN, gid = wgid / nig, fm = gid * 8, gsz = (nM - fm) < 8 ? (nM - fm) : 8;
    pm = fm + ((wgid % nig) % gsz); pn = (wgid % nig) / gsz;
}

template <class Epi, class Sched, bool ALIGN_EPI>
__device__ __forceinline__ void gemm_phase(LAS unsigned char* lds, const int lda, const int ldb, const int K, const Sched& S, const Epi& E) {
    const int tid = threadIdx.x, wid = __builtin_amdgcn_readfirstlane(tid >> 6), lane = tid & 63, wr = wid >> 2, wc = wid & 3, fr = lane & 15, fq = lane >> 4;
    const int nt = K / BK;
    unsigned voffA[2], voffB[2];
#pragma unroll
    for (int i = 0; i < 2; ++i) { int R, C; stage_rc(tid * 16 + i * 8192, R, C); const int Rb = (R & ~31) + perm32(R & 31);
        voffA[i] = (unsigned)(R * lda + C) * 2u; voffB[i] = (unsigned)(Rb * ldb + C) * 2u; }
    const size_t kstep = (size_t)(BK * 2);
    const size_t hstepA = (size_t)HALF * lda * 2, hstepB = (size_t)HALF * ldb * 2;
    const unsigned ldsw = (unsigned)wid * 1024u;
    const int aoff = lds_byte(wr * 64 + fr, fq * 8), boff = lds_byte(wc * 32 + fr, fq * 8);
#define PG8_SA(b, h) (((b) * 2 + (h)) * HTB)
#define PG8_SB(b, h) ((4 + (b) * 2 + (h)) * HTB)
#define PG8_STAGE(bufoff, gbase, voff) do { _Pragma("unroll") for (int _i = 0; _i < 2; ++_i) \
        __builtin_amdgcn_global_load_lds((const unsigned*)((const char*)(gbase) + (voff)[_i]), (LAS unsigned*)(lds + (bufoff) + ldsw + _i * 8192), 16, 0, 0); } while (0)
#define PG8_LDA(dst, b, h) do { _Pragma("unroll") for (int m = 0; m < 4; ++m) _Pragma("unroll") for (int k = 0; k < 2; ++k) dst[m][k] = *(const LAS bf16x8*)(lds + PG8_SA(b, h) + aoff + m * 2048 + k * 1024); } while (0)
#define PG8_LDB(dst, b, h) do { _Pragma("unroll") for (int n = 0; n < 2; ++n) _Pragma("unroll") for (int k = 0; k < 2; ++k) dst[n][k] = *(const LAS bf16x8*)(lds + PG8_SB(b, h) + boff + n * 2048 + k * 1024); } while (0)
#define PG8_MMA(ai, bj, At, Bt) do { __builtin_amdgcn_s_setprio(1); _Pragma("unroll") for (int m = 0; m < 4; ++m) _Pragma("unroll") for (int n = 0; n < 2; ++n) _Pragma("unroll") for (int k = 0; k < 2; ++k) \
        acc[ai][bj][m][n] = __builtin_amdgcn_mfma_f32_16x16x32_bf16(Bt[n][k], At[m][k], acc[ai][bj][m][n], 0, 0, 0); __builtin_amdgcn_s_setprio(0); } while (0)
#define PG8_WAIT_V(n) asm volatile("s_waitcnt vmcnt(" #n ")" ::: "memory")
#define PG8_WAIT_L(n) asm volatile("s_waitcnt lgkmcnt(" #n ")" ::: "memory")
#define PG8_BAR __builtin_amdgcn_s_barrier()
#define PG8_SCHED __builtin_amdgcn_sched_barrier(0)
    UnitDesc cur, nxt; int ui = 0;
    if (!S.next(0, cur)) return;
    f32x4 acc[2][2][4][2];
#pragma unroll
    for (int a = 0; a < 2; ++a)
#pragma unroll
        for (int b = 0; b < 2; ++b)
#pragma unroll
            for (int m = 0; m < 4; ++m)
#pragma unroll
                for (int n = 0; n < 2; ++n) acc[a][b][m][n] = (f32x4){0.f, 0.f, 0.f, 0.f};
    bf16x8 At[4][2], B0[2][2], B1[2][2];
    const char* cA = cur.A; const char* cB = cur.B;
    PG8_STAGE(PG8_SB(0, 0), cB, voffB); PG8_STAGE(PG8_SB(0, 1), cB + hstepB, voffB); PG8_STAGE(PG8_SA(0, 0), cA, voffA); PG8_STAGE(PG8_SA(0, 1), cA + hstepA, voffA);
    if (wr == 1) PG8_BAR;
    PG8_WAIT_V(2); PG8_BAR;
    PG8_STAGE(PG8_SB(1, 0), cB + kstep, voffB); PG8_STAGE(PG8_SA(1, 0), cA + kstep, voffA); PG8_STAGE(PG8_SB(1, 1), cB + hstepB + kstep, voffB);
    PG8_WAIT_V(6); PG8_BAR;
    for (;;) {
        const bool has_next = S.next(ui + 1, nxt);
        const char* nA = has_next ? nxt.A : cA; const char* nB = has_next ? nxt.B : cB;
#pragma unroll 1
        for (int t = 0; t < nt; t += 2) {
            const bool last = (t == nt - 2);
            const char* a1 = cA + (size_t)(t + 1) * kstep;
            const char* a2 = last ? nA : cA + (size_t)(t + 2) * kstep; const char* b2 = last ? nB : cB + (size_t)(t + 2) * kstep;
            const char* a3 = a2 + kstep; const char* b3 = b2 + kstep;
            PG8_LDB(B0, 0, 0); PG8_LDB(B1, 0, 1); PG8_SCHED; PG8_LDA(At, 0, 0); PG8_STAGE(PG8_SA(1, 1), a1 + hstepA, voffA);
            PG8_WAIT_V(8); PG8_WAIT_L(0); PG8_BAR; PG8_MMA(0, 0, At, B0); PG8_MMA(0, 1, At, B1); PG8_BAR; PG8_SCHED;
            PG8_LDA(At, 0, 1); PG8_STAGE(PG8_SB(0, 0), b2, voffB); PG8_STAGE(PG8_SB(0, 1), b2 + hstepB, voffB); PG8_STAGE(PG8_SA(0, 0), a2, voffA);
            PG8_WAIT_V(8); PG8_WAIT_L(0); PG8_BAR; PG8_MMA(1, 0, At, B0); PG8_MMA(1, 1, At, B1); PG8_BAR; PG8_SCHED;
            PG8_LDB(B0, 1, 0); PG8_LDB(B1, 1, 1); PG8_SCHED; PG8_LDA(At, 1, 0); PG8_STAGE(PG8_SA(0, 1), a2 + hstepA, voffA);
            PG8_WAIT_V(8); PG8_WAIT_L(0); PG8_BAR; PG8_MMA(0, 0, At, B0); PG8_MMA(0, 1, At, B1); PG8_BAR; PG8_SCHED;
            PG8_LDA(At, 1, 1); PG8_STAGE(PG8_SB(1, 0), b3, voffB); PG8_STAGE(PG8_SB(1, 1), b3 + hstepB, voffB); PG8_STAGE(PG8_SA(1, 0), a3, voffA);
            PG8_WAIT_V(8); PG8_WAIT_L(0); PG8_BAR; PG8_MMA(1, 0, At, B0); PG8_MMA(1, 1, At, B1); PG8_BAR; PG8_SCHED;
        }
        if constexpr (ALIGN_EPI) { if (wr == 0) PG8_BAR; }
        E(acc, cur, wr, wc, fr, fq);
        if (!has_next) break;
#pragma unroll
        for (int a = 0; a < 2; ++a)
#pragma unroll
            for (int b = 0; b < 2; ++b)
#pragma unroll
                for (int m = 0; m < 4; ++m)
#pragma unroll
                    for (int n = 0; n < 2; ++n) acc[a][b][m][n] = (f32x4){0.f, 0.f, 0.f, 0.f};
        cur = nxt; cA = nA; cB = nB; ++ui;
        if constexpr (ALIGN_EPI) { if (wr == 1) PG8_BAR; }
    }
    PG8_WAIT_V(0);
    if constexpr (!ALIGN_EPI) { if (wr == 0) PG8_BAR; }
    PG8_BAR;
#undef PG8_SA
#undef PG8_SB
#undef PG8_STAGE
#undef PG8_LDA
#undef PG8_LDB
#undef PG8_MMA
#undef PG8_WAIT_V
#undef PG8_WAIT_L
#undef PG8_BAR
#undef PG8_SCHED
}

struct EpiStore {
    __device__ __forceinline__ void operator()(const f32x4 (&acc)[2][2][4][2], const UnitDesc& u, int wr, int wc, int fr, int fq) const {
#pragma unroll
        for (int ai = 0; ai < 2; ++ai)
#pragma unroll
            for (int m = 0; m < 4; ++m) { bf16_t* rowp = u.out + (size_t)(ai * HALF + wr * 64 + m * 16 + fr) * u.ldc + wc * 32 + 8 * fq;
#pragma unroll
                for (int bj = 0; bj < 2; ++bj) { const f32x4 v0 = acc[ai][bj][m][0], v1 = acc[ai][bj][m][1];
                    u32x4 w; w.x = pk2(v0[0], v0[1]); w.y = pk2(v0[2], v0[3]); w.z = pk2(v1[0], v1[1]); w.w = pk2(v1[2], v1[3]);
                    *(u32x4*)(rowp + bj * HALF) = w; } }
    }
};
__device__ __forceinline__ void store16_sc1(void* ptr, u32x4 v) { asm volatile("global_store_dwordx4 %0, %1, off sc0 sc1\n\ts_nop 3" :: "v"(ptr), "v"(v) : "memory"); }
struct EpiStoreSig {
    unsigned* cnt;
    __device__ __forceinline__ void operator()(const f32x4 (&acc)[2][2][4][2], const UnitDesc& u, int wr, int wc, int fr, int fq) const {
#pragma unroll
        for (int ai = 0; ai < 2; ++ai)
#pragma unroll
            for (int m = 0; m < 4; ++m) { bf16_t* rowp = u.out + (size_t)(ai * HALF + wr * 64 + m * 16 + fr) * u.ldc + wc * 32 + 8 * fq;
#pragma unroll
                for (int bj = 0; bj < 2; ++bj) { const f32x4 v0 = acc[ai][bj][m][0], v1 = acc[ai][bj][m][1];
                    u32x4 w; w.x = pk2(v0[0], v0[1]); w.y = pk2(v0[2], v0[3]); w.z = pk2(v1[0], v1[1]); w.w = pk2(v1[2], v1[3]);
                    if (cnt) store16_sc1(rowp + bj * HALF, w); else *(u32x4*)(rowp + bj * HALF) = w; } }
        if (cnt) { asm volatile("s_waitcnt vmcnt(0)" ::: "memory");
            if ((threadIdx.x & 63) == 0) __hip_atomic_fetch_add(cnt + (u.aux & 0xffff) * 64, 1u, __ATOMIC_RELAXED, __HIP_MEMORY_SCOPE_AGENT); }
    }
};
__device__ __forceinline__ float swiglu1(float g, float u) { return g * u * __builtin_amdgcn_rcpf(1.0f + __builtin_amdgcn_exp2f(-1.4426950408889634f * g)); }
struct EpiSwiGLU {
    unsigned* cnt;
    __device__ __forceinline__ void operator()(const f32x4 (&acc)[2][2][4][2], const UnitDesc& u, int wr, int wc, int fr, int fq) const {
#pragma unroll
        for (int ai = 0; ai < 2; ++ai)
#pragma unroll
            for (int m = 0; m < 4; ++m) { bf16_t* rowp = u.out + (size_t)(ai * HALF + wr * 64 + m * 16 + fr) * u.ldc + wc * 32 + 8 * fq;
                const f32x4 g0 = acc[ai][0][m][0], g1 = acc[ai][0][m][1], u0 = acc[ai][1][m][0], u1 = acc[ai][1][m][1];
                u32x4 w; w.x = pk2(swiglu1(g0[0], u0[0]), swiglu1(g0[1], u0[1])); w.y = pk2(swiglu1(g0[2], u0[2]), swiglu1(g0[3], u0[3]));
                w.z = pk2(swiglu1(g1[0], u1[0]), swiglu1(g1[1], u1[1])); w.w = pk2(swiglu1(g1[2], u1[2]), swiglu1(g1[3], u1[3]));
                if (cnt) store16_sc1(rowp, w); else *(u32x4*)rowp = w; }
        if (cnt) { asm volatile("s_waitcnt vmcnt(0)" ::: "memory");
            if ((threadIdx.x & 63) == 0) __hip_atomic_fetch_add(cnt + (u.aux & 0xffff) * 64, 1u, __ATOMIC_RELAXED, __HIP_MEMORY_SCOPE_AGENT); }
    }
};
struct EpiQKV {
    bf16_t* Q; bf16_t* Kb; bf16_t* Vb; float* ck; float* cv;
    __device__ __forceinline__ void operator()(const f32x4 (&acc)[2][2][4][2], const UnitDesc& u, int wr, int wc, int fr, int fq) const {
        const int pm = u.aux & 0xffff, pn = u.aux >> 16, sel = pn >> 2, ct = (pn & 3) * BM;
        const int row0 = pm * BM + wr * 64 + fr, col0 = ct + wc * 32 + 8 * fq;
        bf16_t* base = Q + (size_t)sel * (size_t)(12 * 1024 * 1024); float* cb = ck + (size_t)(sel >= 1 ? sel - 1 : 0) * (size_t)NP * D;
        const bool wc32 = sel >= 1 && pm < NP / BM;
#pragma unroll
        for (int ai = 0; ai < 2; ++ai)
#pragma unroll
            for (int m = 0; m < 4; ++m) { const size_t off = (size_t)(row0 + ai * HALF + m * 16) * D + col0;
#pragma unroll
                for (int bj = 0; bj < 2; ++bj) { const f32x4 v0 = acc[ai][bj][m][0], v1 = acc[ai][bj][m][1];
                    u32x4 w; w.x = pk2(v0[0], v0[1]); w.y = pk2(v0[2], v0[3]); w.z = pk2(v1[0], v1[1]); w.w = pk2(v1[2], v1[3]);
                    *(u32x4*)(base + off + bj * HALF) = w;
                    if (wc32) { *(f32x4*)(cb + off + bj * HALF) = v0; *(f32x4*)(cb + off + bj * HALF + 4) = v1; } } }
    }
};

struct GSched {
    int nM, nN, G, c; const char* A; size_t a_tile; const char* B; size_t b_tile; bf16_t* out; size_t o_pm, o_pn; int ldc;
    __device__ __forceinline__ bool next(int i, UnitDesc& u) const {
        const long L = (long)i * G + c; if (L >= (long)nM * nN) return false;
        int pm, pn; tile_order((int)L, nM, nN, pm, pn);
        u.A = A + (size_t)pm * a_tile; u.B = B + (size_t)pn * b_tile; u.out = out + (size_t)pm * o_pm + (size_t)pn * o_pn; u.ldc = ldc; u.aux = pm | (pn << 16); return true;
    }
};
struct ChDftSched {
    int G, c; const char* cs_tab; const char* H; bf16_t* ytp; bf16_t* yts;
    __device__ __forceinline__ bool next(int i, UnitDesc& u) const {
        const long L = (long)i * G + c; if (L >= 48 * 8) return false;
        int tok, gc; tile_order((int)L, 48, 8, tok, gc); const int g = gc >> 1, cs = gc & 1;
        u.A = cs_tab + (size_t)cs * 256 * 256 * 2; u.B = H + ((size_t)tok * 256 * D + g * 256) * 2;
        if (tok < 32) { u.out = ytp + ((size_t)(tok * D + g * 256) * 512 + cs * 256); u.ldc = 512; }
        else { const int idx = tok - 32, b = idx >> 3, s0 = (idx & 7) * 256; u.out = yts + ((size_t)(b * D + g * 256) * 4096 + cs * 2048 + s0); u.ldc = 4096; }
        u.aux = 0; return true;
    }
};
struct SeqSSched {
    int c; const char* ts; const char* yts; bf16_t* F;
    __device__ __forceinline__ bool next(int i, UnitDesc& u) const {
        if (i > 0 || c >= 64) return false;
        const int b = c >> 5, pm = (c >> 2) & 7, pn = c & 3;
        u.A = ts + (size_t)pm * 256 * 4096 * 2; u.B = yts + (size_t)(b * D + pn * 256) * 4096 * 2;
        u.out = F + ((size_t)(NP + b * SS + pm * 256) * D + pn * 256); u.ldc = D; u.aux = 0; return true;
    }
};
struct SeqPSched {
    int G, c; const char* tp; const char* ytp; bf16_t* F;
    __device__ __forceinline__ bool next(int i, UnitDesc& u) const {
        const int G2 = G - 64; if (c < 64 || G2 <= 0) return false;
        const long L = (long)i * G2 + (c - 64); if (L >= 128) return false;
        const int b = (int)L >> 2, pn = (int)L & 3;
        u.A = tp; u.B = ytp + (size_t)(b * D + pn * 256) * 512 * 2;
        u.out = F + ((size_t)(b * 256) * D + pn * 256); u.ldc = D; u.aux = 0; return true;
    }
};
struct GuSched {
    int G, c; const char* A; const char* B; bf16_t* out;
    __device__ __forceinline__ bool next(int i, UnitDesc& u) const {
        const long L = (long)i * G + c; if (L >= 1056) return false;
        int pm, pn; if (L < 1012) tile_order((int)L, 46, 22, pm, pn); else { const int j = (int)L - 1012; pm = 46 + j / 22; pn = j % 22; }
        u.A = A + (size_t)pm * 256 * D * 2; u.B = B + (size_t)pn * 256 * D * 2; u.out = out + (size_t)pm * 256 * FF + (size_t)pn * 128; u.ldc = FF; u.aux = pm | (pn << 16); return true;
    }
};
struct DownSched {
    int d; const char* A; const char* B; bf16_t* out;
    __device__ __forceinline__ void unit(int& pm, int& pn) const { if (d < 184) tile_order(d, 46, 4, pm, pn); else { const int j = d - 184; pm = 46 + j / 4; pn = j % 4; } }
    __device__ __forceinline__ bool next(int i, UnitDesc& u) const {
        if (i > 0 || d < 0 || d >= 192) return false;
        int pm, pn; unit(pm, pn);
        u.A = A + (size_t)pm * 256 * FF * 2; u.B = B + (size_t)pn * 256 * FF * 2; u.out = out + (size_t)pm * 256 * D + (size_t)pn * 256; u.ldc = D; u.aux = pm | (pn << 16); return true;
    }
};
}

constexpr int TI_L0 = 16 * 32 + 2 * 16 * 88 + 44 * 32, TI_ALL = 16 * 32 + 16 * 96 + 16 * 32 + 4 * 16 * 88 + 2 * 44 * 32;
struct TItem { const float* W; bf16_t* WT; int N, ldt, dst, k0, n0; };
__device__ __forceinline__ bool titem_decode(const Params& p, int it, TItem& t) {
    constexpr int I_F = 16 * 32, I_QKV = 16 * 96, I_O = 16 * 32, I_G = 16 * 88, I_D = 44 * 32;
    constexpr int NITEMS = I_F + I_QKV + I_O + 4 * I_G + 2 * I_D;
    if (it >= NITEMS) return false;
    unsigned char* ws = p.ws; int r = it; int mode = 0;
    if (r < I_F) { t.W = p.in[9]; t.N = D; t.ldt = D; t.WT = (bf16_t*)(ws + WS_WF); }
    else { r -= I_F; int l = 0; if (r >= 2 * I_G + I_D) { r -= 2 * I_G + I_D; l = 1; }
        if (r < I_G) { t.W = p.in[13] + (size_t)l * D * FF; t.N = FF; t.ldt = D; t.WT = (bf16_t*)(ws + WS_WGU) + (size_t)l * 2 * FF * D; mode = 1; }
        else if ((r -= I_G) < I_G) { t.W = p.in[14] + (size_t)l * D * FF; t.N = FF; t.ldt = D; t.WT = (bf16_t*)(ws + WS_WGU) + (size_t)l * 2 * FF * D; mode = 2; }
        else if ((r -= I_G) < I_D) { t.W = p.in[15] + (size_t)l * FF * D; t.N = D; t.ldt = FF; t.WT = (bf16_t*)(ws + WS_WD) + (size_t)l * D * FF; }
        else if ((r -= I_D) < I_QKV) { t.W = p.in[10]; t.N = 3 * D; t.ldt = D; t.WT = (bf16_t*)(ws + WS_WQKV); }
        else { r -= I_QKV; t.W = p.in[12]; t.N = D; t.ldt = D; t.WT = (bf16_t*)(ws + WS_WO); } }
    const int nblk = t.N / 32, kb = r / nblk, nb = r % nblk; t.n0 = nb * 32; t.k0 = kb * 64;
    t.dst = t.n0; if (mode) t.dst = (t.n0 >> 7) * 256 + (t.n0 & 127) + (mode == 2 ? 128 : 0);
    return true;
}
__device__ __forceinline__ void titem_load(const TItem& t, f32x4 (&wv)[8], int lane) {
#pragma unroll
    for (int i = 0; i < 8; ++i) wv[i] = *(const f32x4*)(t.W + (size_t)(t.k0 + 8 * i + (lane >> 3)) * t.N + t.n0 + 4 * (lane & 7));
}
__device__ __forceinline__ void titem_finish(const TItem& t, const f32x4 (&wv)[8], LAS float* scr, int lane) {
#pragma unroll
    for (int i = 0; i < 8; ++i) { LAS float* d = scr + (8 * i + (lane >> 3)) * 33 + 4 * (lane & 7); d[0] = wv[i][0]; d[1] = wv[i][1]; d[2] = wv[i][2]; d[3] = wv[i][3]; }
    asm volatile("s_waitcnt lgkmcnt(0)" ::: "memory");
    const int c = lane & 7;
#pragma unroll
    for (int j = 0; j < 4; ++j) { const int n = (lane >> 3) + 8 * j; const LAS float* s = scr + (8 * c) * 33 + n;
        u32x4 o; o.x = pk2(s[0 * 33], s[1 * 33]); o.y = pk2(s[2 * 33], s[3 * 33]); o.z = pk2(s[4 * 33], s[5 * 33]); o.w = pk2(s[6 * 33], s[7 * 33]);
        *(u32x4*)(t.WT + (size_t)(t.dst + n) * t.ldt + t.k0 + 8 * c) = o; }
    asm volatile("s_waitcnt lgkmcnt(0)" ::: "memory");
}

__device__ __forceinline__ void gemv_layer(const Params& p, LAS unsigned char* lds, const int l, const int rb, const int nb) {
    const int tid = threadIdx.x;
    LAS float* sl = (LAS float*)lds;
    LAS f32x4* red = (LAS f32x4*)(lds + 12288);
    for (int i = tid; i < 3072; i += 512) { const int cond = i >> 10, k = i & 1023; const float v = cond == 0 ? p.in[5][k] : p.in[2][(cond - 1) * D + k]; sl[i] = v / (1.0f + __expf(-v)); }
    __syncthreads();
    float* mod = (float*)(p.ws + WS_MOD);
    for (int item = rb; item < 96; item += nb) {
        const int rem = item, cc = rem >> 4, kc = rem & 15, rpar = tid >> 8, col = cc * 1024 + 4 * (tid & 255);
        const float* W = p.in[6] + ((size_t)l * D + kc * 64 + rpar) * 6144 + col;
        f32x4 a0 = {0.f, 0.f, 0.f, 0.f}, a1 = a0, a2 = a0;
#pragma unroll
        for (int hf = 0; hf < 2; ++hf) {
            f32x4 w[16];
#pragma unroll
            for (int i = 0; i < 16; ++i) w[i] = *(const f32x4*)(W + (size_t)(32 * hf + 2 * i) * 6144);
#pragma unroll
            for (int i = 0; i < 16; ++i) { const int k = kc * 64 + 32 * hf + 2 * i + rpar; a0 += sl[k] * w[i]; a1 += sl[1024 + k] * w[i]; a2 += sl[2048 + k] * w[i]; }
        }
        if (rpar == 1) { red[tid - 256] = a0; red[256 + tid - 256] = a1; red[512 + tid - 256] = a2; }
        __syncthreads();
        if (rpar == 0) {
            a0 += red[tid]; a1 += red[256 + tid]; a2 += red[512 + tid];
            if (kc == 0) { const f32x4 bv = *(const f32x4*)(p.in[7] + l * 6144 + col); a0 += bv; a1 += bv; a2 += bv; }
#pragma unroll
            for (int j = 0; j < 4; ++j) {
                unsafeAtomicAdd(mod + (l * 3 + 0) * 6144 + col + j, a0[j]);
                unsafeAtomicAdd(mod + (l * 3 + 1) * 6144 + col + j, a1[j]);
                unsafeAtomicAdd(mod + (l * 3 + 2) * 6144 + col + j, a2[j]); }
        }
        __syncthreads();
    }
}
__device__ __forceinline__ void transpose_jobs(const Params& p, LAS unsigned char* lds, int gw, int NGW, int it_lo, int it_hi) {
    const int lane = threadIdx.x & 63, wave = threadIdx.x >> 6;
    LAS float* scr = (LAS float*)(lds + wave * 8448);
    TItem cur, nxt; f32x4 wa[8], wb[8];
    int it = it_lo + gw;
    bool have = it < it_hi && titem_decode(p, it, cur);
    if (have) titem_load(cur, wa, lane);
    while (have) {
        const bool hn = it + NGW < it_hi && titem_decode(p, it + NGW, nxt);
        if (hn) titem_load(nxt, wb, lane);
        titem_finish(cur, wa, scr, lane);
        if (!hn) break;
        it += 2 * NGW;
        have = it < it_hi && titem_decode(p, it, cur);
        if (have) titem_load(cur, wa, lane);
        titem_finish(nxt, wb, scr, lane);
    }
}
__device__ __forceinline__ void phase_prologue(const Params& p, LAS unsigned char* lds) {
    const int tid = threadIdx.x, G = gridDim.x, bx = blockIdx.x;
    unsigned char* ws = p.ws;
    LAS float* ct = (LAS float*)(lds + 32768);
    for (int i = tid; i < 2048; i += 512) ct[i] = cospif((float)i * (1.0f / 1024.0f));
    const bool sep = G >= 192;
    if (!sep || bx < 96) gemv_layer(p, lds, 0, bx, sep ? 96 : G);
    if (sep && bx < 96) return;
    const int gt = (sep ? bx - 96 : bx) * 512 + tid, GT = (sep ? G - 96 : G) * 512;
    for (int i = gt; i < 2 * 2 * 512 * D / 8; i += GT) { const int which = i >= 2 * 512 * D / 8; const int ii = which ? i - 2 * 512 * D / 8 : i;
        const f32x4* src = (const f32x4*)p.in[which ? 4 : 3]; const f32x4 a = src[2 * ii], b = src[2 * ii + 1];
        u32x4 o; o.x = pk2(a[0], a[1]); o.y = pk2(a[2], a[3]); o.z = pk2(b[0], b[1]); o.w = pk2(b[2], b[3]); ((u32x4*)((unsigned char*)p.out + (which ? OUTB_VC : OUTB_KC)))[ii] = o; }
    for (int i = gt; i < 512 * 256 / 8; i += GT) { const int row = i >> 5, c0 = (i & 31) * 8, cs = row >> 8, m = row & 255; float v[8];
#pragma unroll
        for (int j = 0; j < 8; ++j) { const int idx = ((m * (c0 + j)) & 255) * 8; v[j] = ct[(idx - (cs ? 512 : 0)) & 2047]; }
        u32x4 o; o.x = pk2(v[0], v[1]); o.y = pk2(v[2], v[3]); o.z = pk2(v[4], v[5]); o.w = pk2(v[6], v[7]); ((u32x4*)(ws + WS_CSCH))[i] = o; }
    for (int i = gt; i < 256 * 512 / 8; i += GT) { const int k = i >> 6, c0 = (i & 63) * 8; float v[8];
#pragma unroll
        for (int j = 0; j < 8; ++j) { const int kk = c0 + j, sidx = kk & 255; const int idx = ((k * sidx) & 255) * 8; v[j] = kk < 256 ? ct[idx] : -ct[(idx - 512) & 2047]; }
        u32x4 o; o.x = pk2(v[0], v[1]); o.y = pk2(v[2], v[3]); o.z = pk2(v[4], v[5]); o.w = pk2(v[6], v[7]); ((u32x4*)(ws + WS_TP))[i] = o; }
    for (int i = gt; i < 2048 * 4096 / 8; i += GT) { const int k = i >> 9, c0 = (i & 511) * 8; float v[8];
#pragma unroll
        for (int j = 0; j < 8; ++j) { const int kk = c0 + j, sidx = kk & 2047; const int idx = (k * sidx) & 2047; v[j] = kk < 2048 ? ct[idx] : -ct[(idx - 512) & 2047]; }
        u32x4 o; o.x = pk2(v[0], v[1]); o.y = pk2(v[2], v[3]); o.z = pk2(v[4], v[5]); o.w = pk2(v[6], v[7]); ((u32x4*)(ws + WS_TS))[i] = o; }
}
__device__ __forceinline__ void phase_side_jobs(const Params& p, LAS unsigned char* lds, const int which) {
    if (which == 5) { if (blockIdx.x < 64) transpose_jobs(p, lds, blockIdx.x * 8 + (threadIdx.x >> 6), 64 * 8, TI_L0, TI_ALL); return; }
    const int G = gridDim.x, bx = blockIdx.x, first = which == 0 ? 64 : 192;
    const int nb = G > first ? G - first : G, b0 = G > first ? first : 0;
    if (bx < b0) return;
    const int rb = bx - b0;
    if (which == 0) transpose_jobs(p, lds, rb * 8 + (threadIdx.x >> 6), nb * 8, 0, TI_L0);
    else if (which == 1) gemv_layer(p, lds, 1, rb, nb);
    else transpose_jobs(p, lds, rb * 8 + (threadIdx.x >> 6), nb * 8, TI_L0, TI_ALL);
}

#ifndef ROW_WT
#define ROW_WT 0
#endif
__device__ __forceinline__ void store16_wt(void* ptr, u32x4 v) {
#if ROW_WT
    asm volatile("global_store_dwordx4 %0, %1, off sc0 sc1\n\ts_nop 3" :: "v"(ptr), "v"(v) : "memory");
#else
    *(u32x4*)ptr = v;
#endif
}
__device__ __forceinline__ void bf8_to_f32(const u32x4 w, f32x4& a, f32x4& b) { a = (f32x4){bf_lo(w.x), bf_hi(w.x), bf_lo(w.y), bf_hi(w.y)}; b = (f32x4){bf_lo(w.z), bf_hi(w.z), bf_lo(w.w), bf_hi(w.w)}; }
__device__ __forceinline__ u32x4 f32_to_bf8(const f32x4 a, const f32x4 b) { u32x4 w; w.x = pk2(a[0], a[1]); w.y = pk2(a[2], a[3]); w.z = pk2(b[0], b[1]); w.w = pk2(b[2], b[3]); return w; }
template <bool HAS_MP, bool HAS_NEXT, bool XIN_F32>
__device__ __forceinline__ void row_phase(const float* xin_p, const float* xin_s, bf16_t* XB, const bf16_t* mp, float* Yout, bf16_t* Hout,
                                          const float* gate, const float* gA, const float* gB, const float* sc, const float* sh, unsigned* cnt = nullptr) {
    const int tid = threadIdx.x, lane = tid & 63, gw = blockIdx.x * 8 + (tid >> 6), NGW = gridDim.x * 8;
    if (cnt) {
        if (tid == 0) { const int p0 = (blockIdx.x * 48) >> 8, p1 = (blockIdx.x * 48 + 47) >> 8;
            for (int pp = p0; pp <= p1; ++pp) { unsigned sp = 0; while (__hip_atomic_load(cnt + pp * 64, __ATOMIC_RELAXED, __HIP_MEMORY_SCOPE_AGENT) < 32u) { __builtin_amdgcn_s_sleep(2); if (++sp > (1u << 22)) break; } }
            __builtin_amdgcn_fence(__ATOMIC_ACQUIRE, "agent"); asm volatile("s_waitcnt vmcnt(0)" ::: "memory"); }
        __syncthreads();
    }
    constexpr int R = 3, RW = 6;
    int cur_cond = -1;
    f32x4 gga[4], gbs[4], shv[4];
    for (int rowb = gw * RW; rowb < M; rowb += NGW * RW)
    for (int row0 = rowb; row0 < rowb + RW; row0 += R) {
        f32x4 v[R][4]; u32x4 mw[R][2];
#pragma unroll
        for (int q = 0; q < R; ++q) { const int row = row0 + q;
            if constexpr (XIN_F32) { const float* xr = row < NP ? xin_p + (size_t)row * D : xin_s + (size_t)(row - NP) * D;
#pragma unroll
                for (int j = 0; j < 2; ++j) { v[q][2 * j] = *(const f32x4*)(xr + 8 * lane + 512 * j); v[q][2 * j + 1] = *(const f32x4*)(xr + 8 * lane + 512 * j + 4); }
            } else {
#pragma unroll
                for (int j = 0; j < 2; ++j) { const u32x4 w = *(const u32x4*)(XB + (size_t)row * D + 8 * lane + 512 * j); bf8_to_f32(w, v[q][2 * j], v[q][2 * j + 1]); }
            }
            if constexpr (HAS_MP) {
#pragma unroll
                for (int j = 0; j < 2; ++j) mw[q][j] = *(const u32x4*)(mp + (size_t)row * D + 8 * lane + 512 * j);
            } }
        u32x4 xo[R][2], ho[R][2];
#pragma unroll
        for (int q = 0; q < R; ++q) { const int row = row0 + q; const int cond = row < NP ? 0 : (row < NP + SS ? 1 : 2);
            if (cond != cur_cond) { cur_cond = cond;
#pragma unroll
                for (int j = 0; j < 4; ++j) { const int col = 8 * lane + 512 * (j >> 1) + 4 * (j & 1);
                    if constexpr (HAS_MP) gga[j] = *(const f32x4*)(gate + cond * 6144 + col) * *(const f32x4*)(gA + col);
                    if constexpr (HAS_NEXT) { gbs[j] = *(const f32x4*)(gB + col) * (1.0f + *(const f32x4*)(sc + cond * 6144 + col)); shv[j] = *(const f32x4*)(sh + cond * 6144 + col); } } }
            if constexpr (HAS_MP) {
                f32x4 mv[4]; float s = 0.f;
#pragma unroll
                for (int j = 0; j < 2; ++j) bf8_to_f32(mw[q][j], mv[2 * j], mv[2 * j + 1]);
#pragma unroll
                for (int j = 0; j < 4; ++j) s += (mv[j][0] * mv[j][0] + mv[j][1] * mv[j][1]) + (mv[j][2] * mv[j][2] + mv[j][3] * mv[j][3]);
                const float rstd = 1.0f / sqrtf(wave_sum(s) * (1.0f / D) + 1e-6f);
#pragma unroll
                for (int j = 0; j < 4; ++j) v[q][j] = v[q][j] + gga[j] * (mv[j] * rstd);
                if constexpr (HAS_NEXT) {
#pragma unroll
                    for (int j = 0; j < 2; ++j) xo[q][j] = f32_to_bf8(v[q][2 * j], v[q][2 * j + 1]);
                }
            }
            if constexpr (HAS_NEXT) {
                float s = 0.f;
#pragma unroll
                for (int j = 0; j < 4; ++j) s += (v[q][j][0] * v[q][j][0] + v[q][j][1] * v[q][j][1]) + (v[q][j][2] * v[q][j][2] + v[q][j][3] * v[q][j][3]);
                const float rstd = 1.0f / sqrtf(wave_sum(s) * (1.0f / D) + 1e-6f);
                f32x4 hh[4];
#pragma unroll
                for (int j = 0; j < 4; ++j) hh[j] = (v[q][j] * rstd) * gbs[j] + shv[j];
#pragma unroll
                for (int j = 0; j < 2; ++j) ho[q][j] = f32_to_bf8(hh[2 * j], hh[2 * j + 1]);
            } }
#pragma unroll
        for (int q = 0; q < R; ++q) { const int row = row0 + q;
            if constexpr (HAS_MP && !HAS_NEXT) {
#pragma unroll
                for (int j = 0; j < 4; ++j) *(f32x4*)(Yout + (size_t)row * D + 8 * lane + 512 * (j >> 1) + 4 * (j & 1)) = v[q][j];
            }
            if constexpr (HAS_MP && HAS_NEXT) {
#pragma unroll
                for (int j = 0; j < 2; ++j) store16_wt(XB + (size_t)row * D + 8 * lane + 512 * j, xo[q][j]);
            }
            if constexpr (HAS_NEXT) {
#pragma unroll
                for (int j = 0; j < 2; ++j) store16_wt(Hout + (size_t)row * D + 8 * lane + 512 * j, ho[q][j]);
            } }
    }
}

__device__ __forceinline__ void attn_phase(const Params& p, LAS unsigned char* lds) {
    const int tid = threadIdx.x, lane = tid & 63, wave = __builtin_amdgcn_readfirstlane(tid >> 6), r = lane & 31, hh = lane >> 5;
    unsigned char* ws = p.ws;
    const bf16_t* Qb = (const bf16_t*)(ws + WS_Q); const bf16_t* Kb = (const bf16_t*)(ws + WS_K); const bf16_t* Vb = (const bf16_t*)(ws + WS_VT);
    const bf16_t* Kc = (const bf16_t*)((const unsigned char*)p.out + OUTB_KC); const bf16_t* Vc = (const bf16_t*)((const unsigned char*)p.out + OUTB_VC);
    bf16_t* Ob = (bf16_t*)(ws + WS_H);
    LAS float* Bl = (LAS float*)(lds + 36864 + 512);
    const int srow = tid >> 3, sch = tid & 7, krho = (srow & ~12) | ((srow & 4) << 1) | ((srow & 8) >> 1);
    const float c2 = 0.125f * 1.4426950408889634f;
    for (int unit = blockIdx.x; unit < 768; unit += gridDim.x) {
        const bool is_na = unit < 256;
        int b, h, qtok, nt, jmin = 0, nloc = 0, rq = 0, half = 0, ktok0;
        if (is_na) { b = unit >> 7; h = (unit >> 3) & 15; const int r0 = (unit & 7) * 4; rq = r0 + (wave >> 1); half = wave & 1;
            jmin = min(max(r0 - 4, 0), 24); const int jmax = min(max(r0 - 1, 0), 24) + 7; nloc = jmax - jmin + 1; nt = nloc + 8;
            qtok = NP + b * SS + rq * 64 + half * 32 + r; ktok0 = NP + b * SS; }
        else { const int u2 = unit - 256; b = u2 >> 4; h = u2 & 15; nt = 4; qtok = b * SP + wave * 32 + r; ktok0 = b * SP; }
        const int rs = min(max(rq - 4, 0), 24);
        if (is_na) { for (int i = tid; i < 15 * 32; i += 512) { const int rr = i >> 5, x = i & 31; Bl[i] = x < 31 ? p.in[11][(h * 15 + rr) * 31 + x] * 1.4426950408889634f : 0.f; } }
        bf16x8 qf[4];
#pragma unroll
        for (int d0 = 0; d0 < 4; ++d0) qf[d0] = *(const bf16x8*)(Qb + (size_t)qtok * D + h * HD + d0 * 16 + hh * 8);
        f32x16 o0, o1;
#pragma unroll
        for (int i = 0; i < 16; ++i) { o0[i] = 0.f; o1[i] = 0.f; }
        float m_run = -1e30f, l_run = 0.f;
        u32x4 kreg, vreg;
#define ATT_LOAD(t) do { const int t_ = (t); size_t off_; const bf16_t* kb_; const bf16_t* vb_; \
            if (is_na && t_ >= nloc) { off_ = ((size_t)(b * 512 + (t_ - nloc) * 64 + srow)) * D + h * HD + sch * 8; kb_ = Kc; vb_ = Vc; } \
            else { off_ = (size_t)(ktok0 + (is_na ? (jmin + t_) * 64 : t_ * 64) + srow) * D + h * HD + sch * 8; kb_ = Kb; vb_ = Vb; } \
            kreg = *(const u32x4*)(kb_ + off_); vreg = *(const u32x4*)(vb_ + off_); } while (0)
#define ATT_STORE(buf) do { LAS unsigned char* kl_ = lds + (buf) * 18432; LAS unsigned char* vl_ = kl_ + 9216; \
            *(LAS u32x4*)(kl_ + krho * 144 + sch * 16) = kreg; \
            LAS bf16_t* vd_ = (LAS bf16_t*)(vl_ + (8 * sch) * 144 + srow * 2); \
            vd_[0 * 72] = (bf16_t)vreg.x; vd_[1 * 72] = (bf16_t)(vreg.x >> 16); vd_[2 * 72] = (bf16_t)vreg.y; vd_[3 * 72] = (bf16_t)(vreg.y >> 16); \
            vd_[4 * 72] = (bf16_t)vreg.z; vd_[5 * 72] = (bf16_t)(vreg.z >> 16); vd_[6 * 72] = (bf16_t)vreg.w; vd_[7 * 72] = (bf16_t)(vreg.w >> 16); } while (0)
        ATT_LOAD(0); ATT_STORE(0); if (nt > 1) ATT_LOAD(1);
        __syncthreads();
        for (int t = 0; t < nt; ++t) {
            if (t + 1 < nt) { ATT_STORE((t + 1) & 1); if (t + 2 < nt) ATT_LOAD(t + 2); }
            const bool local = is_na && t < nloc; const int j = jmin + t;
            if (!(local && (j < rs || j >= rs + 8))) {
                const LAS unsigned char* Kl = lds + (t & 1) * 18432; const LAS unsigned char* Vl = Kl + 9216;
                f32x16 p0, p1;
#pragma unroll
                for (int i = 0; i < 16; ++i) { p0[i] = 0.f; p1[i] = 0.f; }
#pragma unroll
                for (int d0 = 0; d0 < 4; ++d0) { const bf16x8 a0 = *(const LAS bf16x8*)(Kl + r * 144 + d0 * 32 + hh * 16), a1 = *(const LAS bf16x8*)(Kl + (32 + r) * 144 + d0 * 32 + hh * 16);
                    p0 = __builtin_amdgcn_mfma_f32_32x32x16_bf16(a0, qf[d0], p0, 0, 0, 0); p1 = __builtin_amdgcn_mfma_f32_32x32x16_bf16(a1, qf[d0], p1, 0, 0, 0); }
                float m_new, alpha;
                if (local) {
                    const int qc = half * 32 + r, cs = min(max(qc - 8, 0), 48);
                    const LAS float* bp = Bl + (j - rq + 7) * 32 + 8 * hh - qc + 15;
                    float bb0[16], bb1[16];
#pragma unroll
                    for (int i = 0; i < 16; ++i) { const int kc = 16 * (i >> 3) + (i & 7); bb0[i] = bp[kc]; bb1[i] = bp[kc + 32]; }
                    asm volatile("" : "+v"(bb0[0]), "+v"(bb0[1]), "+v"(bb0[2]), "+v"(bb0[3]), "+v"(bb0[4]), "+v"(bb0[5]), "+v"(bb0[6]), "+v"(bb0[7]));
                    asm volatile("" : "+v"(bb0[8]), "+v"(bb0[9]), "+v"(bb0[10]), "+v"(bb0[11]), "+v"(bb0[12]), "+v"(bb0[13]), "+v"(bb0[14]), "+v"(bb0[15]));
                    asm volatile("" : "+v"(bb1[0]), "+v"(bb1[1]), "+v"(bb1[2]), "+v"(bb1[3]), "+v"(bb1[4]), "+v"(bb1[5]), "+v"(bb1[6]), "+v"(bb1[7]));
                    asm volatile("" : "+v"(bb1[8]), "+v"(bb1[9]), "+v"(bb1[10]), "+v"(bb1[11]), "+v"(bb1[12]), "+v"(bb1[13]), "+v"(bb1[14]), "+v"(bb1[15]));
                    const unsigned sh0 = (unsigned)(8 * hh - cs);
#pragma unroll
                    for (int i = 0; i < 16; ++i) { const int kc = 16 * (i >> 3) + (i & 7);
                        const float s0 = __builtin_fmaf(p0[i], c2, bb0[i]), s1 = __builtin_fmaf(p1[i], c2, bb1[i]);
                        p0[i] = (sh0 + (unsigned)kc) < 16u ? s0 : -1e30f; p1[i] = (sh0 + (unsigned)(kc + 32)) < 16u ? s1 : -1e30f; }
                    float mt = fmaxf(p0[0], p1[0]);
#pragma unroll
                    for (int i = 1; i < 16; ++i) mt = fmaxf(mt, fmaxf(p0[i], p1[i]));
                    mt = fmaxf(mt, __shfl_xor(mt, 32));
                    m_new = fmaxf(m_run, mt); alpha = __builtin_amdgcn_exp2f(m_run - m_new);
#pragma unroll
                    for (int i = 0; i < 16; ++i) { p0[i] = __builtin_amdgcn_exp2f(p0[i] - m_new); p1[i] = __builtin_amdgcn_exp2f(p1[i] - m_new); }
                } else {
                    float mt = fmaxf(p0[0], p1[0]);
#pragma unroll
                    for (int i = 1; i < 16; ++i) mt = fmaxf(mt, fmaxf(p0[i], p1[i]));
                    mt = fmaxf(mt, __shfl_xor(mt, 32)) * c2;
                    m_new = fmaxf(m_run, mt); alpha = __builtin_amdgcn_exp2f(m_run - m_new);
#pragma unroll
                    for (int i = 0; i < 16; ++i) { p0[i] = __builtin_amdgcn_exp2f(__builtin_fmaf(p0[i], c2, -m_new)); p1[i] = __builtin_amdgcn_exp2f(__builtin_fmaf(p1[i], c2, -m_new)); }
                }
                m_run = m_new;
                float ls = 0.f;
#pragma unroll
                for (int i = 0; i < 16; ++i) ls += p0[i] + p1[i];
                l_run = l_run * alpha + ls;
#pragma unroll
                for (int i = 0; i < 16; ++i) { o0[i] *= alpha; o1[i] *= alpha; }
                bf16x8 pa[4];
#pragma unroll
                for (int s2 = 0; s2 < 2; ++s2) { u32x4 w; w.x = pk2(p0[8 * s2], p0[8 * s2 + 1]); w.y = pk2(p0[8 * s2 + 2], p0[8 * s2 + 3]); w.z = pk2(p0[8 * s2 + 4], p0[8 * s2 + 5]); w.w = pk2(p0[8 * s2 + 6], p0[8 * s2 + 7]); pa[s2] = __builtin_bit_cast(bf16x8, w);
                    u32x4 w2; w2.x = pk2(p1[8 * s2], p1[8 * s2 + 1]); w2.y = pk2(p1[8 * s2 + 2], p1[8 * s2 + 3]); w2.z = pk2(p1[8 * s2 + 4], p1[8 * s2 + 5]); w2.w = pk2(p1[8 * s2 + 6], p1[8 * s2 + 7]); pa[2 + s2] = __builtin_bit_cast(bf16x8, w2); }
#pragma unroll
                for (int s2 = 0; s2 < 4; ++s2) { const bf16x8 v0 = *(const LAS bf16x8*)(Vl + r * 144 + s2 * 32 + hh * 16), v1 = *(const LAS bf16x8*)(Vl + (32 + r) * 144 + s2 * 32 + hh * 16);
                    o0 = __builtin_amdgcn_mfma_f32_32x32x16_bf16(v0, pa[s2], o0, 0, 0, 0); o1 = __builtin_amdgcn_mfma_f32_32x32x16_bf16(v1, pa[s2], o1, 0, 0, 0); }
            }
            __syncthreads();
        }
#undef ATT_LOAD
#undef ATT_STORE
        const float inv = 1.0f / (l_run + __shfl_xor(l_run, 32));
        bf16_t* orow = Ob + (size_t)qtok * D + h * HD + 4 * hh;
#pragma unroll
        for (int g = 0; g < 4; ++g) { u32x2 w; w.x = pk2(o0[4 * g] * inv, o0[4 * g + 1] * inv); w.y = pk2(o0[4 * g + 2] * inv, o0[4 * g + 3] * inv); *(u32x2*)(orow + 8 * g) = w;
            u32x2 w2; w2.x = pk2(o1[4 * g] * inv, o1[4 * g + 1] * inv); w2.y = pk2(o1[4 * g + 2] * inv, o1[4 * g + 3] * inv); *(u32x2*)(orow + 32 + 8 * g) = w2; }
    }
    __syncthreads();
}

#define XB_TMO      128
#define XB_XCNT(j)  (256  + 64 * (j))
#define XB_XSUB(j)  (1280 + 64 * (j))
#define XB_XGEN(j)  (2304 + 64 * (j))
#define XB_TOP      3328
#define XB_TOPGEN   3392
#define XCD_BAR_WORDS 3456
#define XB_SPIN_CAP (1u << 18)
__device__ __forceinline__ unsigned xb_ld(unsigned* p)              { return __hip_atomic_load(p, __ATOMIC_RELAXED, __HIP_MEMORY_SCOPE_AGENT); }
__device__ __forceinline__ unsigned xb_add(unsigned* p, unsigned v) { return __hip_atomic_fetch_add(p, v, __ATOMIC_RELAXED, __HIP_MEMORY_SCOPE_AGENT); }
__device__ __forceinline__ unsigned xb_xcc_id() { return (unsigned)__builtin_amdgcn_s_getreg((3 << 11) | 20) & 0xFu; }
#define XB_SPIN(cond, bar) do { unsigned _sp = 0; while (cond) { __builtin_amdgcn_s_sleep(1); \
    if ((++_sp & 255u) == 0u) { if (xb_ld(&(bar)[XB_TMO])) break; if (_sp > XB_SPIN_CAP) { atomicAdd(&(bar)[XB_TMO], 1u); break; } } } } while (0)
struct XcdBarrier { unsigned* bar; unsigned x; volatile LAS unsigned* st; };
__device__ __forceinline__ XcdBarrier xcd_barrier_post(unsigned* bar, volatile LAS unsigned* st) {
    XcdBarrier b; b.bar = bar; b.x = xb_xcc_id(); b.st = st;
    if (threadIdx.x == 0) (void)xb_add(&bar[XB_XCNT(b.x)], 1u);
    return b;
}
__device__ __forceinline__ void xcd_barrier_complete(unsigned* bar, unsigned x, unsigned& nloc, unsigned& nx) {
    const unsigned G = gridDim.x * gridDim.y * gridDim.z;
    unsigned sum, cnt, mine, sp = 0u;
    for (;;) {
        sum = 0u; cnt = 0u; mine = 0u;
#pragma unroll
        for (unsigned j = 0; j < 16; ++j) { const unsigned c = xb_ld(&bar[XB_XCNT(j)]); sum += c; cnt += (c > 0u) ? 1u : 0u; mine = (j == x) ? c : mine; }
        if (sum == G) break;
        __builtin_amdgcn_s_sleep(1);
        if ((++sp & 255u) == 0u) { if (xb_ld(&bar[XB_TMO])) break; if (sp > XB_SPIN_CAP) { atomicAdd(&bar[XB_TMO], 1u); break; } }
    }
    nloc = mine > 0u ? mine : 1u; nx = cnt > 0u ? cnt : 1u;
}
__device__ __forceinline__ void xcd_barrier(const XcdBarrier& b) {
    asm volatile("s_waitcnt vmcnt(0)" ::: "memory");
    __syncthreads();
    if (threadIdx.x == 0) {
        unsigned* bar = b.bar;
        __builtin_amdgcn_s_waitcnt(0);
        unsigned nloc = b.st[0], nx = b.st[1];
        if (nloc == 0u) { xcd_barrier_complete(bar, b.x, nloc, nx); b.st[0] = nloc; b.st[1] = nx; }
        const unsigned old = xb_add(&bar[XB_XSUB(b.x)], 1u);
        const unsigned gen = old / nloc;
        if (old + 1u == (gen + 1u) * nloc) {
            __builtin_amdgcn_fence(__ATOMIC_RELEASE, "agent");
            asm volatile("s_waitcnt vmcnt(0)" ::: "memory");
            const unsigned og = xb_add(&bar[XB_TOP], 1u);
            const unsigned tg = og / nx;
            if (og + 1u == (tg + 1u) * nx) xb_add(&bar[XB_TOPGEN], 1u);
            else XB_SPIN(xb_ld(&bar[XB_TOPGEN]) == tg, bar);
            __builtin_amdgcn_fence(__ATOMIC_ACQUIRE, "agent");
            xb_add(&bar[XB_XGEN(b.x)], 1u);
            asm volatile("s_waitcnt vmcnt(0)" ::: "memory");
        } else {
            XB_SPIN(xb_ld(&bar[XB_XGEN(b.x)]) == gen, bar);
            __builtin_amdgcn_fence(__ATOMIC_ACQUIRE, "agent");
            asm volatile("s_waitcnt vmcnt(0)" ::: "memory");
        }
    }
    __syncthreads();
}

__global__ void __launch_bounds__(512, 2) mega_fwd(Params p) {
    extern __shared__ __attribute__((aligned(16))) unsigned char lds_raw[];
    LAS unsigned char* lds = (LAS unsigned char*)lds_raw;
    unsigned char* ws = p.ws;
    const int G = gridDim.x, c = blockIdx.x, lo = p.ph_lo, hi = p.ph_hi;
    const float* mod = (const float*)(ws + WS_MOD);
    const float* norm_g = p.in[8];
    bf16_t* H = (bf16_t*)(ws + WS_H); bf16_t* MPb = (bf16_t*)(ws + WS_MP); bf16_t* U = (bf16_t*)(ws + WS_U);
    float* X = p.out + OUT_X; bf16_t* XB = (bf16_t*)(ws + WS_XB);
    volatile LAS unsigned* MISC = (volatile LAS unsigned*)(lds + 131072 + 320);
    if (threadIdx.x < 32) MISC[threadIdx.x] = 0u;
    __syncthreads();
    XcdBarrier bar; bar.bar = (unsigned*)(ws + WS_CTL); bar.x = 0; bar.st = nullptr;
    if (hi - lo > 1) bar = xcd_barrier_post((unsigned*)(ws + WS_CTL), MISC + 8);
    if (hi > 1000) cg::this_grid().sync();
#ifndef PH_MASK
#define PH_MASK 0xffff
#endif
#define IN(k) (((PH_MASK >> (k)) & 1) && lo <= (k) && (k) < hi)
    const bool handoff = (G == 256) && (hi - lo > 1);
    unsigned* const cntb = (unsigned*)(ws + WS_CTL) + CW_CNT;
#ifndef PROBE_REP
#define PROBE_REP -1
#endif
#ifndef PROBE_SYNC2
#define PROBE_SYNC2 0
#endif
#define REPS(k) for (int rep_ = 0; rep_ < ((k) == PROBE_REP ? 2 : 1); ++rep_)
#ifndef PROBE_PHASE
#define PROBE_PHASE -1
#endif
    unsigned long long pt0 = 0, pt1 = 0;
    if (PROBE_PHASE == 0) pt0 = __builtin_amdgcn_s_memrealtime();
#define SEAM(k) SEAMX(k, false)
#define SEAMX(k, skip) do { if ((k) + 1 < hi && !(skip)) { xcd_barrier(bar); if (PROBE_SYNC2) xcd_barrier(bar); } \
        if ((k) == PROBE_PHASE) pt1 = __builtin_amdgcn_s_memrealtime(); if ((k) + 1 == PROBE_PHASE) pt0 = __builtin_amdgcn_s_memrealtime(); } while (0)

    if (IN(0)) { REPS(0) { phase_prologue(p, lds); } SEAM(0); }
    if (IN(1)) { REPS(1) {
        row_phase<false, true, true>(p.in[0], p.in[1], nullptr, nullptr, nullptr, H, nullptr, nullptr, norm_g, mod + 1 * D, mod + 0 * D);
        } SEAM(1);
    }
    if (IN(2)) { REPS(2) {
        pg8::ChDftSched S{G, c, (const char*)(ws + WS_CSCH), (const char*)H, (bf16_t*)(ws + WS_YTP), (bf16_t*)(ws + WS_YTS)};
        pg8::gemm_phase<pg8::EpiStore, pg8::ChDftSched, true>(lds, 256, D, 256, S, pg8::EpiStore{});
        } SEAM(2);
    }
    if (IN(3)) { REPS(3) {
        { pg8::SeqSSched S{c, (const char*)(ws + WS_TS), (const char*)(ws + WS_YTS), (bf16_t*)(ws + WS_F)};
          pg8::gemm_phase<pg8::EpiStore, pg8::SeqSSched, true>(lds, 4096, 4096, 4096, S, pg8::EpiStore{}); }
        { pg8::SeqPSched S{G, c, (const char*)(ws + WS_TP), (const char*)(ws + WS_YTP), (bf16_t*)(ws + WS_F)};
          pg8::gemm_phase<pg8::EpiStore, pg8::SeqPSched, true>(lds, 512, 512, 512, S, pg8::EpiStore{}); }
        phase_side_jobs(p, lds, 0);
        } SEAM(3);
    }
    if (IN(4)) { REPS(4) {
        pg8::GSched S{48, 4, G, c, (const char*)(ws + WS_F), (size_t)256 * D * 2, (const char*)(ws + WS_WF), (size_t)256 * D * 2, MPb, (size_t)256 * D, 256, D};
        pg8::gemm_phase<pg8::EpiStoreSig, pg8::GSched, true>(lds, D, D, D, S, pg8::EpiStoreSig{handoff ? cntb + 0 * CNT_SEAM : nullptr});
        phase_side_jobs(p, lds, 1);
        } SEAMX(4, handoff);
    }
    if (IN(5)) { REPS(5) {
        row_phase<true, true, true>(p.in[0], p.in[1], XB, MPb, nullptr, H, mod + 2 * D, norm_g + 1 * D, norm_g + 2 * D, mod + 4 * D, mod + 3 * D, handoff ? cntb + 0 * CNT_SEAM : nullptr);
        } SEAM(5);
    }
    if (IN(6)) {
        if (handoff) { pg8::GuSched S{G, c, (const char*)H, (const char*)(ws + WS_WGU), U};
            pg8::gemm_phase<pg8::EpiSwiGLU, pg8::GuSched, true>(lds, D, D, D, S, pg8::EpiSwiGLU{cntb + 4 * CNT_SEAM}); }
        else { pg8::GSched S{48, 22, G, c, (const char*)H, (size_t)256 * D * 2, (const char*)(ws + WS_WGU), (size_t)256 * D * 2, U, (size_t)256 * FF, 128, FF};
            pg8::gemm_phase<pg8::EpiSwiGLU, pg8::GSched, true>(lds, D, D, D, S, pg8::EpiSwiGLU{nullptr}); }
        SEAMX(6, handoff);
    }
    if (IN(7)) {
        if (handoff) {
            if (c >= 64) { pg8::DownSched S{c - 64, (const char*)U, (const char*)(ws + WS_WD), MPb};
                if (threadIdx.x == 0) { int pm, pn; S.unit(pm, pn); unsigned* w = cntb + 4 * CNT_SEAM + pm * 64; unsigned sp = 0;
                    while (__hip_atomic_load(w, __ATOMIC_RELAXED, __HIP_MEMORY_SCOPE_AGENT) < 176u) { __builtin_amdgcn_s_sleep(4); if (++sp > (1u << 22)) break; }
                    __builtin_amdgcn_fence(__ATOMIC_ACQUIRE, "agent"); asm volatile("s_waitcnt vmcnt(0)" ::: "memory"); }
                __syncthreads();
                pg8::gemm_phase<pg8::EpiStoreSig, pg8::DownSched, true>(lds, FF, FF, FF, S, pg8::EpiStoreSig{cntb + 1 * CNT_SEAM}); }
            else { phase_side_jobs(p, lds, 5); }
        } else { pg8::GSched S{48, 4, G, c, (const char*)U, (size_t)256 * FF * 2, (const char*)(ws + WS_WD), (size_t)256 * FF * 2, MPb, (size_t)256 * D, 256, D};
            pg8::gemm_phase<pg8::EpiStoreSig, pg8::GSched, true>(lds, FF, FF, FF, S, pg8::EpiStoreSig{nullptr});
            phase_side_jobs(p, lds, 2); }
        SEAMX(7, handoff);
    }
    if (IN(8)) { REPS(8) {
        row_phase<true, true, false>(nullptr, nullptr, XB, MPb, nullptr, H, mod + 5 * D, norm_g + 3 * D, norm_g + 4 * D, mod + 3 * 6144 + 1 * D, mod + 3 * 6144 + 0 * D, handoff ? cntb + 1 * CNT_SEAM : nullptr);
        } SEAM(8);
    }
    if (IN(9)) { REPS(9) {
        pg8::GSched S{48, 12, G, c, (const char*)H, (size_t)256 * D * 2, (const char*)(ws + WS_WQKV), (size_t)256 * D * 2, nullptr, 0, 0, D};
        pg8::EpiQKV E{(bf16_t*)(ws + WS_Q), (bf16_t*)(ws + WS_K), (bf16_t*)(ws + WS_VT), p.out + OUT_CK, p.out + OUT_CV};
        pg8::gemm_phase<pg8::EpiQKV, pg8::GSched, true>(lds, D, D, D, S, E);
        } SEAM(9);
    }
    if (IN(10)) { REPS(10) { attn_phase(p, lds); } SEAM(10); }
    if (IN(11)) { REPS(11) {
        pg8::GSched S{48, 4, G, c, (const char*)H, (size_t)256 * D * 2, (const char*)(ws + WS_WO), (size_t)256 * D * 2, MPb, (size_t)256 * D, 256, D};
        pg8::gemm_phase<pg8::EpiStoreSig, pg8::GSched, true>(lds, D, D, D, S, pg8::EpiStoreSig{handoff ? cntb + 2 * CNT_SEAM : nullptr});
        } SEAMX(11, handoff);
    }
    if (IN(12)) { REPS(12) {
        row_phase<true, true, false>(nullptr, nullptr, XB, MPb, nullptr, H, mod + 3 * 6144 + 2 * D, norm_g + 5 * D, norm_g + 6 * D, mod + 3 * 6144 + 4 * D, mod + 3 * 6144 + 3 * D, handoff ? cntb + 2 * CNT_SEAM : nullptr);
        } SEAM(12);
    }
    if (IN(13)) {
        if (handoff) { pg8::GuSched S{G, c, (const char*)H, (const char*)(ws + WS_WGU) + (size_t)2 * FF * D * 2, U};
            pg8::gemm_phase<pg8::EpiSwiGLU, pg8::GuSched, true>(lds, D, D, D, S, pg8::EpiSwiGLU{cntb + 5 * CNT_SEAM}); }
        else { pg8::GSched S{48, 22, G, c, (const char*)H, (size_t)256 * D * 2, (const char*)(ws + WS_WGU) + (size_t)2 * FF * D * 2, (size_t)256 * D * 2, U, (size_t)256 * FF, 128, FF};
            pg8::gemm_phase<pg8::EpiSwiGLU, pg8::GSched, true>(lds, D, D, D, S, pg8::EpiSwiGLU{nullptr}); }
        SEAMX(13, handoff);
    }
    if (IN(14)) {
        if (handoff) {
            if (c >= 64) { pg8::DownSched S{c - 64, (const char*)U, (const char*)(ws + WS_WD) + (size_t)D * FF * 2, MPb};
                if (threadIdx.x == 0) { int pm, pn; S.unit(pm, pn); unsigned* w = cntb + 5 * CNT_SEAM + pm * 64; unsigned sp = 0;
                    while (__hip_atomic_load(w, __ATOMIC_RELAXED, __HIP_MEMORY_SCOPE_AGENT) < 176u) { __builtin_amdgcn_s_sleep(4); if (++sp > (1u << 22)) break; }
                    __builtin_amdgcn_fence(__ATOMIC_ACQUIRE, "agent"); asm volatile("s_waitcnt vmcnt(0)" ::: "memory"); }
                __syncthreads();
                pg8::gemm_phase<pg8::EpiStoreSig, pg8::DownSched, true>(lds, FF, FF, FF, S, pg8::EpiStoreSig{cntb + 3 * CNT_SEAM}); }
            else {  }
        } else { pg8::GSched S{48, 4, G, c, (const char*)U, (size_t)256 * FF * 2, (const char*)(ws + WS_WD) + (size_t)D * FF * 2, (size_t)256 * FF * 2, MPb, (size_t)256 * D, 256, D};
            pg8::gemm_phase<pg8::EpiStoreSig, pg8::GSched, true>(lds, FF, FF, FF, S, pg8::EpiStoreSig{nullptr});
             }
        SEAMX(14, handoff);
    }
    if (IN(15)) { REPS(15) {
        row_phase<true, false, false>(nullptr, nullptr, XB, MPb, X, nullptr, mod + 3 * 6144 + 5 * D, norm_g + 7 * D, nullptr, nullptr, nullptr, handoff ? cntb + 3 * CNT_SEAM : nullptr); }
    }
    if (PROBE_PHASE >= 0 && blockIdx.x == 0) { if (PROBE_PHASE == 15) pt1 = __builtin_amdgcn_s_memrealtime();
        const unsigned long long tend = __builtin_amdgcn_s_memrealtime(), wait = 9ull * (pt1 - pt0);
        while (__builtin_amdgcn_s_memrealtime() - tend < wait) __builtin_amdgcn_s_sleep(8); }
#undef IN
#undef SEAM
}

constexpr int LDS_BYTES = 147456;
extern "C" void kernel_launch(void* const* d_in, const int* in_sizes, int n_in, void* d_out, int out_size, void* d_ws, size_t ws_size, hipStream_t stream) {
    static int grid = 0;
    if (grid == 0) {
        int dev = 0, cus = 0, per_cu = 0;
        hipGetDevice(&dev);
        hipDeviceGetAttribute(&cus, hipDeviceAttributeMultiprocessorCount, dev);
        if (hipFuncSetAttribute((const void*)mega_fwd, hipFuncAttributeMaxDynamicSharedMemorySize, LDS_BYTES) != hipSuccess) fprintf(stderr, "kernel_launch: hipFuncSetAttribute failed\n");
        if (hipOccupancyMaxActiveBlocksPerMultiprocessor(&per_cu, (const void*)mega_fwd, 512, LDS_BYTES) != hipSuccess || per_cu < 1) { fprintf(stderr, "kernel_launch: occupancy query says %d\n", per_cu); per_cu = 1; }
        (void)hipGetLastError();
        grid = cus * 1;
        if (n_in != 16 || ws_size < WS_END) { fprintf(stderr, "kernel_launch: unexpected n_in %d / ws %zu\n", n_in, ws_size); }
    }
    Params p{};
    (void)hipMemsetAsync((unsigned char*)d_ws, 0, WS_CTL + CTL_BYTES, stream);
    for (int i = 0; i < 16; ++i) p.in[i] = (const float*)d_in[i];
    p.out = (float*)d_out; p.ws = (unsigned char*)d_ws;
    if (MK_N_LAUNCHES == 1) {
        p.ph_lo = 0; p.ph_hi = NPHASE;
        void* args[] = {&p};
        hipError_t e = hipLaunchCooperativeKernel((const void*)mega_fwd, dim3(grid), dim3(512), args, LDS_BYTES, stream);
        if (e != hipSuccess) fprintf(stderr, "cooperative launch failed: %s (grid %d)\n", hipGetErrorString(e), grid);
    } else {
        for (int k = 0; k < NPHASE; ++k) { p.ph_lo = k; p.ph_hi = k + 1; hipLaunchKernelGGL(mega_fwd, dim3(grid), dim3(512), LDS_BYTES, stream, p); }
    }
}
```

```cpp
#include <hip/hip_runtime.h>
#include <hip/hip_cooperative_groups.h>
#include <cstdio>
#include <cstdint>
namespace cg = cooperative_groups;

#ifndef MK_N_LAUNCHES
#define MK_N_LAUNCHES 1
#endif

#define LAS __attribute__((address_space(3)))
typedef unsigned short bf16_t;
typedef short bf16x8 __attribute__((ext_vector_type(8)));
typedef float f32x2 __attribute__((ext_vector_type(2)));
typedef float f32x4 __attribute__((ext_vector_type(4)));
typedef float f32x16 __attribute__((ext_vector_type(16)));
typedef unsigned u32x2 __attribute__((ext_vector_type(2)));
typedef unsigned u32x4 __attribute__((ext_vector_type(4)));
typedef __bf16 bf16x2_t __attribute__((ext_vector_type(2)));

constexpr int D = 1024, NP = 8192, NS = 4096, M = NP + NS, SP = 256, SS = 2048, FF = 2816, NH = 16, HD = 64;
constexpr int NPHASE = 16;
constexpr size_t MiB = 1u << 20;
constexpr size_t WS_CTL = 160 * 1024, CTL_BYTES = 96 * 1024;
constexpr int CW_CNT = 4096, CNT_SEAM = 48 * 64;
constexpr size_t WS_MOD = 0, WS_CSCH = 256 * 1024, WS_TP = 512 * 1024, WS_WF = 1 * MiB, WS_WQKV = 3 * MiB,
                 WS_WO = 9 * MiB, WS_WGU = 11 * MiB, WS_WD = 33 * MiB, WS_H = 44 * MiB, WS_MP = 68 * MiB, WS_U = 92 * MiB, WS_R = 158 * MiB;
constexpr size_t WS_YTP = WS_U, WS_YTS = WS_U + 32 * MiB;
constexpr size_t WS_TS = WS_R, WS_F = WS_R + 16 * MiB;
constexpr size_t WS_Q = WS_R, WS_K = WS_R + 24 * MiB, WS_VT = WS_R + 48 * MiB;
constexpr size_t WS_XB = WS_R + 72 * MiB, WS_MP2 = WS_XB + 24 * MiB, WS_END = WS_MP2 + 1 * MiB;
constexpr size_t OUTB_KC = 0, OUTB_VC = 2 * MiB;
constexpr size_t OUT_X = 0, OUT_CK = (size_t)M * D, OUT_CV = OUT_CK + (size_t)NP * D;

struct Params {
    const float* in[16];
    float* out; unsigned char* ws;
    int ph_lo, ph_hi;
};

__device__ __forceinline__ unsigned pk2(float lo, float hi) { f32x2 v = {lo, hi}; bf16x2_t b = __builtin_convertvector(v, bf16x2_t); return __builtin_bit_cast(unsigned, b); }
__device__ __forceinline__ float bf_lo(unsigned w) { return __uint_as_float(w << 16); }
__device__ __forceinline__ float bf_hi(unsigned w) { return __uint_as_float(w & 0xffff0000u); }
template <int CTRL> __device__ __forceinline__ float dpp_mov(float v) { return __builtin_bit_cast(float, __builtin_amdgcn_mov_dpp(__builtin_bit_cast(int, v), CTRL, 0xf, 0xf, true)); }
__device__ __forceinline__ float wave_sum(float v) {
    v += dpp_mov<0xB1>(v); v += dpp_mov<0x4E>(v); v += dpp_mov<0x141>(v); v += dpp_mov<0x140>(v);
    { auto rr = __builtin_amdgcn_permlane16_swap(__float_as_uint(v), __float_as_uint(v), false, false); v = __uint_as_float(rr[0]) + __uint_as_float(rr[1]); }
    { auto rr = __builtin_amdgcn_permlane32_swap(__float_as_uint(v), __float_as_uint(v), false, false); v = __uint_as_float(rr[0]) + __uint_as_float(rr[1]); }
    return v;
}

namespace pg8 {
constexpr int BM = 256, BK = 64, HALF = 128, HTB = HALF * BK * 2, STAGE_BYTES = 8 * HTB;
__device__ __forceinline__ int lds_byte(int r, int c) { const int st = (r >> 4) * 2 + (c >> 5), rr = r & 15, cc = c & 31, ob = rr * 64 + cc * 2; return st * 1024 + (ob ^ (((ob >> 9) & 1) << 5)); }
__device__ __forceinline__ void stage_rc(int b, int& R, int& C) { const int st = b / 1024, sb = b % 1024, swz = sb ^ (((sb >> 9) & 1) << 5); R = (st >> 1) * 16 + swz / 64; C = (st & 1) * 32 + (swz % 64) / 2; }
__device__ __forceinline__ int perm32(int rho) { const int n = rho >> 4, i = rho & 15; return 8 * (i >> 2) + 4 * n + (i & 3); }

struct UnitDesc { const char* A; const char* B; bf16_t* out; int ldc; int aux; };

__device__ __forceinline__ void tile_order(int L, int nM, int nN, int& pm, int& pn) {
    const int nwg = nM * nN; int wgid = L;
    { const int q = nwg / 8, r = nwg % 8, xcd = wgid % 8, off = wgid / 8; wgid = (xcd < r ? xcd * (q + 1) : r * (q + 1) + (xcd - r) * q) + off; }
    const int nig = 8 * nN, gid = wgid / nig, fm = gid * 8, gsz = (nM - fm) < 8 ? (nM - fm) : 8;
    pm = fm + ((wgid % nig) % gsz); pn = (wgid % nig) / gsz;
}

template <class Epi, class Sched, bool ALIGN_EPI>
__device__ __forceinline__ void gemm_phase(LAS unsigned char* lds, const int lda, const int ldb, const int K, const Sched& S, const Epi& E) {
    const int tid = threadIdx.x, wid = __builtin_amdgcn_readfirstlane(tid >> 6), lane = tid & 63, wr = wid >> 2, wc = wid & 3, fr = lane & 15, fq = lane >> 4;
    const int nt = K / BK;
    unsigned voffA[2], voffB[2];
#pragma unroll
    for (int i = 0; i < 2; ++i) { int R, C; stage_rc(tid * 16 + i * 8192, R, C); const int Rb = (R & ~31) + perm32(R & 31);
        voffA[i] = (unsigned)(R * lda + C) * 2u; voffB[i] = (unsigned)(Rb * ldb + C) * 2u; }
    const size_t kstep = (size_t)(BK * 2);
    const size_t hstepA = (size_t)HALF * lda * 2, hstepB = (size_t)HALF * ldb * 2;
    const unsigned ldsw = (unsigned)wid * 1024u;
    const int aoff = lds_byte(wr * 64 + fr, fq * 8), boff = lds_byte(wc * 32 + fr, fq * 8);
#define PG8_SA(b, h) (((b) * 2 + (h)) * HTB)
#define PG8_SB(b, h) ((4 + (b) * 2 + (h)) * HTB)
#define PG8_STAGE(bufoff, gbase, voff) do { _Pragma("unroll") for (int _i = 0; _i < 2; ++_i) \
        __builtin_amdgcn_global_load_lds((const unsigned*)((const char*)(gbase) + (voff)[_i]), (LAS unsigned*)(lds + (bufoff) + ldsw + _i * 8192), 16, 0, 0); } while (0)
#define PG8_LDA(dst, b, h) do { _Pragma("unroll") for (int m = 0; m < 4; ++m) _Pragma("unroll") for (int k = 0; k < 2; ++k) dst[m][k] = *(const LAS bf16x8*)(lds + PG8_SA(b, h) + aoff + m * 2048 + k * 1024); } while (0)
#define PG8_LDB(dst, b, h) do { _Pragma("unroll") for (int n = 0; n < 2; ++n) _Pragma("unroll") for (int k = 0; k < 2; ++k) dst[n][k] = *(const LAS bf16x8*)(lds + PG8_SB(b, h) + boff + n * 2048 + k * 1024); } while (0)
#define PG8_MMA(ai, bj, At, Bt) do { __builtin_amdgcn_s_setprio(1); _Pragma("unroll") for (int m = 0; m < 4; ++m) _Pragma("unroll") for (int n = 0; n < 2; ++n) _Pragma("unroll") for (int k = 0; k < 2; ++k) \
        acc[ai][bj][m][n] = __builtin_amdgcn_mfma_f32_16x16x32_bf16(Bt[n][k], At[m][k], acc[ai][bj][m][n], 0, 0, 0); __builtin_amdgcn_s_setprio(0); } while (0)
#define PG8_WAIT_V(n) asm volatile("s_waitcnt vmcnt(" #n ")" ::: "memory")
#define PG8_WAIT_L(n) asm volatile("s_waitcnt lgkmcnt(" #n ")" ::: "memory")
#define PG8_BAR __builtin_amdgcn_s_barrier()
#define PG8_SCHED __builtin_amdgcn_sched_barrier(0)
    UnitDesc cur, nxt; int ui = 0;
    if (!S.next(0, cur)) return;
    f32x4 acc[2][2][4][2];
#pragma unroll
    for (int a = 0; a < 2; ++a)
#pragma unroll
        for (int b = 0; b < 2; ++b)
#pragma unroll
            for (int m = 0; m < 4; ++m)
#pragma unroll
                for (int n = 0; n < 2; ++n) acc[a][b][m][n] = (f32x4){0.f, 0.f, 0.f, 0.f};
    bf16x8 At[4][2], B0[2][2], B1[2][2];
    const char* cA = cur.A; const char* cB = cur.B;
    PG8_STAGE(PG8_SB(0, 0), cB, voffB); PG8_STAGE(PG8_SB(0, 1), cB + hstepB, voffB); PG8_STAGE(PG8_SA(0, 0), cA, voffA); PG8_STAGE(PG8_SA(0, 1), cA + hstepA, voffA);
    if (wr == 1) PG8_BAR;
    PG8_WAIT_V(2); PG8_BAR;
    PG8_STAGE(PG8_SB(1, 0), cB + kstep, voffB); PG8_STAGE(PG8_SA(1, 0), cA + kstep, voffA); PG8_STAGE(PG8_SB(1, 1), cB + hstepB + kstep, voffB);
    PG8_WAIT_V(6); PG8_BAR;
    for (;;) {
        const bool has_next = S.next(ui + 1, nxt);
        const char* nA = has_next ? nxt.A : cA; const char* nB = has_next ? nxt.B : cB;
#pragma unroll 1
        for (int t = 0; t < nt; t += 2) {
            const bool last = (t == nt - 2);
            const char* a1 = cA + (size_t)(t + 1) * kstep;
            const char* a2 = last ? nA : cA + (size_t)(t + 2) * kstep; const char* b2 = last ? nB : cB + (size_t)(t + 2) * kstep;
            const char* a3 = a2 + kstep; const char* b3 = b2 + kstep;
            PG8_LDB(B0, 0, 0); PG8_LDB(B1, 0, 1); PG8_SCHED; PG8_LDA(At, 0, 0); PG8_STAGE(PG8_SA(1, 1), a1 + hstepA, voffA);
            PG8_WAIT_V(8); PG8_WAIT_L(0); PG8_BAR; PG8_MMA(0, 0, At, B0); PG8_MMA(0, 1, At, B1); PG8_BAR; PG8_SCHED;
            PG8_LDA(At, 0, 1); PG8_STAGE(PG8_SB(0, 0), b2, voffB); PG8_STAGE(PG8_SB(0, 1), b2 + hstepB, voffB); PG8_STAGE(PG8_SA(0, 0), a2, voffA);
            PG8_WAIT_V(8); PG8_WAIT_L(0); PG8_BAR; PG8_MMA(1, 0, At, B0); PG8_MMA(1, 1, At, B1); PG8_BAR; PG8_SCHED;
            PG8_LDB(B0, 1, 0); PG8_LDB(B1, 1, 1); PG8_SCHED; PG8_LDA(At, 1, 0); PG8_STAGE(PG8_SA(0, 1), a2 + hstepA, voffA);
            PG8_WAIT_V(8); PG8_WAIT_L(0); PG8_BAR; PG8_MMA(0, 0, At, B0); PG8_MMA(0, 1, At, B1); PG8_BAR; PG8_SCHED;
            PG8_LDA(At, 1, 1); PG8_STAGE(PG8_SB(1, 0), b3, voffB); PG8_STAGE(PG8_SB(1, 1), b3 + hstepB, voffB); PG8_STAGE(PG8_SA(1, 0), a3, voffA);
            PG8_WAIT_V(8); PG8_WAIT_L(0); PG8_BAR; PG8_MMA(1, 0, At, B0); PG8_MMA(1, 1, At, B1); PG8_BAR; PG8_SCHED;
        }
        if constexpr (ALIGN_EPI) { if (wr == 0) PG8_BAR; }
        E(acc, cur, wr, wc, fr, fq);
        if (!has_next) break;
#pragma unroll
        for (int a = 0; a < 2; ++a)
#pragma unroll
            for (int b = 0; b < 2; ++b)
#pragma unroll
                for (int m = 0; m < 4; ++m)
#pragma unroll
                    for (int n = 0; n < 2; ++n) acc[a][b][m][n] = (f32x4){0.f, 0.f, 0.f, 0.f};
        cur = nxt; cA = nA; cB = nB; ++ui;
        if constexpr (ALIGN_EPI) { if (wr == 1) PG8_BAR; }
    }
    PG8_WAIT_V(0);
    if constexpr (!ALIGN_EPI) { if (wr == 0) PG8_BAR; }
    PG8_BAR;
#undef PG8_SA
#undef PG8_SB
#undef PG8_STAGE
#undef PG8_LDA
#undef PG8_LDB
#undef PG8_MMA
#undef PG8_WAIT_V
#undef PG8_WAIT_L
#undef PG8_BAR
#undef PG8_SCHED
}

struct EpiStore {
    __device__ __forceinline__ void operator()(const f32x4 (&acc)[2][2][4][2], const UnitDesc& u, int wr, int wc, int fr, int fq) const {
#pragma unroll
        for (int ai = 0; ai < 2; ++ai)
#pragma unroll
            for (int m = 0; m < 4; ++m) { bf16_t* rowp = u.out + (size_t)(ai * HALF + wr * 64 + m * 16 + fr) * u.ldc + wc * 32 + 8 * fq;
#pragma unroll
                for (int bj = 0; bj < 2; ++bj) { const f32x4 v0 = acc[ai][bj][m][0], v1 = acc[ai][bj][m][1];
                    u32x4 w; w.x = pk2(v0[0], v0[1]); w.y = pk2(v0[2], v0[3]); w.z = pk2(v1[0], v1[1]); w.w = pk2(v1[2], v1[3]);
                    *(u32x4*)(rowp + bj * HALF) = w; } }
    }
};
__device__ __forceinline__ void store16_sc1(void* ptr, u32x4 v) { asm volatile("global_store_dwordx4 %0, %1, off sc0 sc1\n\ts_nop 3" :: "v"(ptr), "v"(v) : "memory"); }
struct EpiStoreSig {
    unsigned* cnt;
    __device__ __forceinline__ void operator()(const f32x4 (&acc)[2][2][4][2], const UnitDesc& u, int wr, int wc, int fr, int fq) const {
#pragma unroll
        for (int ai = 0; ai < 2; ++ai)
#pragma unroll
            for (int m = 0; m < 4; ++m) { bf16_t* rowp = u.out + (size_t)(ai * HALF + wr * 64 + m * 16 + fr) * u.ldc + wc * 32 + 8 * fq;
#pragma unroll
                for (int bj = 0; bj < 2; ++bj) { const f32x4 v0 = acc[ai][bj][m][0], v1 = acc[ai][bj][m][1];
                    u32x4 w; w.x = pk2(v0[0], v0[1]); w.y = pk2(v0[2], v0[3]); w.z = pk2(v1[0], v1[1]); w.w = pk2(v1[2], v1[3]);
                    if (cnt) store16_sc1(rowp + bj * HALF, w); else *(u32x4*)(rowp + bj * HALF) = w; } }
        if (cnt) { asm volatile("s_waitcnt vmcnt(0)" ::: "memory");
            if ((threadIdx.x & 63) == 0) __hip_atomic_fetch_add(cnt + (u.aux & 0xffff) * 64, 1u, __ATOMIC_RELAXED, __HIP_MEMORY_SCOPE_AGENT); }
    }
};
__device__ __forceinline__ float swiglu1(float g, float u) { return g * u * __builtin_amdgcn_rcpf(1.0f + __builtin_amdgcn_exp2f(-1.4426950408889634f * g)); }
struct EpiSwiGLU {
    unsigned* cnt;
    __device__ __forceinline__ void operator()(const f32x4 (&acc)[2][2][4][2], const UnitDesc& u, int wr, int wc, int fr, int fq) const {
#pragma unroll
        for (int ai = 0; ai < 2; ++ai)
#pragma unroll
            for (int m = 0; m < 4; ++m) { bf16_t* rowp = u.out + (size_t)(ai * HALF + wr * 64 + m * 16 + fr) * u.ldc + wc * 32 + 8 * fq;
                const f32x4 g0 = acc[ai][0][m][0], g1 = acc[ai][0][m][1], u0 = acc[ai][1][m][0], u1 = acc[ai][1][m][1];
                u32x4 w; w.x = pk2(swiglu1(g0[0], u0[0]), swiglu1(g0[1], u0[1])); w.y = pk2(swiglu1(g0[2], u0[2]), swiglu1(g0[3], u0[3]));
                w.z = pk2(swiglu1(g1[0], u1[0]), swiglu1(g1[1], u1[1])); w.w = pk2(swiglu1(g1[2], u1[2]), swiglu1(g1[3], u1[3]));
                if (cnt) store16_sc1(rowp, w); else *(u32x4*)rowp = w; }
        if (cnt) { asm volatile("s_waitcnt vmcnt(0)" ::: "memory");
            if ((threadIdx.x & 63) == 0) __hip_atomic_fetch_add(cnt + (u.aux & 0xffff) * 64, 1u, __ATOMIC_RELAXED, __HIP_MEMORY_SCOPE_AGENT); }
    }
};
struct EpiQKV {
    bf16_t* Q; bf16_t* Kb; bf16_t* Vb; float* ck; float* cv;
    __device__ __forceinline__ void operator()(const f32x4 (&acc)[2][2][4][2], const UnitDesc& u, int wr, int wc, int fr, int fq) const {
        const int pm = u.aux & 0xffff, pn = u.aux >> 16, sel = pn >> 2, ct = (pn & 3) * BM;
        const int row0 = pm * BM + wr * 64 + fr, col0 = ct + wc * 32 + 8 * fq;
        bf16_t* base = Q + (size_t)sel * (size_t)(12 * 1024 * 1024); float* cb = ck + (size_t)(sel >= 1 ? sel - 1 : 0) * (size_t)NP * D;
        const bool wc32 = sel >= 1 && pm < NP / BM;
#pragma unroll
        for (int ai = 0; ai < 2; ++ai)
#pragma unroll
            for (int m = 0; m < 4; ++m) { const size_t off = (size_t)(row0 + ai * HALF + m * 16) * D + col0;
#pragma unroll
                for (int bj = 0; bj < 2; ++bj) { const f32x4 v0 = acc[ai][bj][m][0], v1 = acc[ai][bj][m][1];
                    u32x4 w; w.x = pk2(v0[0], v0[1]); w.y = pk2(v0[2], v0[3]); w.z = pk2(v1[0], v1[1]); w.w = pk2(v1[2], v1[3]);
                    *(u32x4*)(base + off + bj * HALF) = w;
                    if (wc32) { *(f32x4*)(cb + off + bj * HALF) = v0; *(f32x4*)(cb + off + bj * HALF + 4) = v1; } } }
    }
};

struct GSched {
    int nM, nN, G, c; const char* A; size_t a_tile; const char* B; size_t b_tile; bf16_t* out; size_t o_pm, o_pn; int ldc;
    __device__ __forceinline__ bool next(int i, UnitDesc& u) const {
        const long L = (long)i * G + c; if (L >= (long)nM * nN) return false;
        int pm, pn; tile_order((int)L, nM, nN, pm, pn);
        u.A = A + (size_t)pm * a_tile; u.B = B + (size_t)pn * b_tile; u.out = out + (size_t)pm * o_pm + (size_t)pn * o_pn; u.ldc = ldc; u.aux = pm | (pn << 16); return true;
    }
};
struct ChDftSched {
    int G, c; const char* cs_tab; const char* H; bf16_t* ytp; bf16_t* yts;
    __device__ __forceinline__ bool next(int i, UnitDesc& u) const {
        const long L = (long)i * G + c; if (L >= 48 * 8) return false;
        int tok, gc; tile_order((int)L, 48, 8, tok, gc); const int g = gc >> 1, cs = gc & 1;
        u.A = cs_tab + (size_t)cs * 256 * 256 * 2; u.B = H + ((size_t)tok * 256 * D + g * 256) * 2;
        if (tok < 32) { u.out = ytp + ((size_t)(tok * D + g * 256) * 512 + cs * 256); u.ldc = 512; }
        else { const int idx = tok - 32, b = idx >> 3, s0 = (idx & 7) * 256; u.out = yts + ((size_t)(b * D + g * 256) * 4096 + cs * 2048 + s0); u.ldc = 4096; }
        u.aux = 0; return true;
    }
};
struct SeqSSched {
    int c; const char* ts; const char* yts; bf16_t* F;
    __device__ __forceinline__ bool next(int i, UnitDesc& u) const {
        if (i > 0 || c >= 64) return false;
        const int b = c >> 5, pm = (c >> 2) & 7, pn = c & 3;
        u.A = ts + (size_t)pm * 256 * 4096 * 2; u.B = yts + (size_t)(b * D + pn * 256) * 4096 * 2;
        u.out = F + ((size_t)(NP + b * SS + pm * 256) * D + pn * 256); u.ldc = D; u.aux = 0; return true;
    }
};
struct SeqPSched {
    int G, c; const char* tp; const char* ytp; bf16_t* F;
    __device__ __forceinline__ bool next(int i, UnitDesc& u) const {
        const int G2 = G - 64; if (c < 64 || G2 <= 0) return false;
        const long L = (long)i * G2 + (c - 64); if (L >= 128) return false;
        const int b = (int)L >> 2, pn = (int)L & 3;
        u.A = tp; u.B = ytp + (size_t)(b * D + pn * 256) * 512 * 2;
        u.out = F + ((size_t)(b * 256) * D + pn * 256); u.ldc = D; u.aux = 0; return true;
    }
};
struct GuSched {
    int G, c; const char* A; const char* B; bf16_t* out;
    __device__ __forceinline__ bool next(int i, UnitDesc& u) const {
        const long L = (long)i * G + c; if (L >= 1056) return false;
        int pm, pn; if (L < 1012) tile_order((int)L, 46, 22, pm, pn); else { const int j = (int)L - 1012; pm = 46 + j / 22; pn = j % 22; }
        u.A = A + (size_t)pm * 256 * D * 2; u.B = B + (size_t)pn * 256 * D * 2; u.out = out + (size_t)pm * 256 * FF + (size_t)pn * 128; u.ldc = FF; u.aux = pm | (pn << 16); return true;
    }
};
struct DownSched {
    int d; const char* A; const char* B; bf16_t* out; bf16_t* out2;
    __device__ __forceinline__ void unit(int& pm, int& pn, int& kh) const { kh = 0; if (d < 184) tile_order(d, 46, 4, pm, pn); else { const int j = d - 184, un = j >> 1; kh = j & 1; pm = 46 + un / 4; pn = un % 4; } }
    __device__ __forceinline__ bool next(int i, UnitDesc& u) const {
        if (i > 0 || d < 0 || d >= 200) return false;
        int pm, pn, kh; unit(pm, pn, kh);
        u.A = A + (size_t)pm * 256 * FF * 2 + (size_t)kh * (FF / 2) * 2; u.B = B + (size_t)pn * 256 * FF * 2 + (size_t)kh * (FF / 2) * 2;
        u.out = kh ? out2 + (size_t)(pm - 46) * 256 * D + (size_t)pn * 256 : out + (size_t)pm * 256 * D + (size_t)pn * 256; u.ldc = D; u.aux = pm | (pn << 16); return true;
    }
};
}

constexpr int TI_L0 = 16 * 32 + 2 * 16 * 88 + 44 * 32, TI_ALL = 16 * 32 + 16 * 96 + 16 * 32 + 4 * 16 * 88 + 2 * 44 * 32;
struct TItem { const float* W; bf16_t* WT; int N, ldt, dst, k0, n0; };
__device__ __forceinline__ bool titem_decode(const Params& p, int it, TItem& t) {
    constexpr int I_F = 16 * 32, I_QKV = 16 * 96, I_O = 16 * 32, I_G = 16 * 88, I_D = 44 * 32;
    constexpr int NITEMS = I_F + I_QKV + I_O + 4 * I_G + 2 * I_D;
    if (it >= NITEMS) return false;
    unsigned char* ws = p.ws; int r = it; int mode = 0;
    if (r < I_F) { t.W = p.in[9]; t.N = D; t.ldt = D; t.WT = (bf16_t*)(ws + WS_WF); }
    else { r -= I_F; int l = 0; if (r >= 2 * I_G + I_D) { r -= 2 * I_G + I_D; l = 1; }
        if (r < I_G) { t.W = p.in[13] + (size_t)l * D * FF; t.N = FF; t.ldt = D; t.WT = (bf16_t*)(ws + WS_WGU) + (size_t)l * 2 * FF * D; mode = 1; }
        else if ((r -= I_G) < I_G) { t.W = p.in[14] + (size_t)l * D * FF; t.N = FF; t.ldt = D; t.WT = (bf16_t*)(ws + WS_WGU) + (size_t)l * 2 * FF * D; mode = 2; }
        else if ((r -= I_G) < I_D) { t.W = p.in[15] + (size_t)l * FF * D; t.N = D; t.ldt = FF; t.WT = (bf16_t*)(ws + WS_WD) + (size_t)l * D * FF; }
        else if ((r -= I_D) < I_QKV) { t.W = p.in[10]; t.N = 3 * D; t.ldt = D; t.WT = (bf16_t*)(ws + WS_WQKV); }
        else { r -= I_QKV; t.W = p.in[12]; t.N = D; t.ldt = D; t.WT = (bf16_t*)(ws + WS_WO); } }
    const int nblk = t.N / 32, kb = r / nblk, nb = r % nblk; t.n0 = nb * 32; t.k0 = kb * 64;
    t.dst = t.n0; if (mode) t.dst = (t.n0 >> 7) * 256 + (t.n0 & 127) + (mode == 2 ? 128 : 0);
    return true;
}
__device__ __forceinline__ void titem_load(const TItem& t, f32x4 (&wv)[8], int lane) {
#pragma unroll
    for (int i = 0; i < 8; ++i) wv[i] = *(const f32x4*)(t.W + (size_t)(t.k0 + 8 * i + (lane >> 3)) * t.N + t.n0 + 4 * (lane & 7));
}
__device__ __forceinline__ void titem_finish(const TItem& t, const f32x4 (&wv)[8], LAS float* scr, int lane) {
#pragma unroll
    for (int i = 0; i < 8; ++i) { LAS float* d = scr + (8 * i + (lane >> 3)) * 33 + 4 * (lane & 7); d[0] = wv[i][0]; d[1] = wv[i][1]; d[2] = wv[i][2]; d[3] = wv[i][3]; }
    asm volatile("s_waitcnt lgkmcnt(0)" ::: "memory");
    const int c = lane & 7;
#pragma unroll
    for (int j = 0; j < 4; ++j) { const int n = (lane >> 3) + 8 * j; const LAS float* s = scr + (8 * c) * 33 + n;
        u32x4 o; o.x = pk2(s[0 * 33], s[1 * 33]); o.y = pk2(s[2 * 33], s[3 * 33]); o.z = pk2(s[4 * 33], s[5 * 33]); o.w = pk2(s[6 * 33], s[7 * 33]);
        *(u32x4*)(t.WT + (size_t)(t.dst + n) * t.ldt + t.k0 + 8 * c) = o; }
    asm volatile("s_waitcnt lgkmcnt(0)" ::: "memory");
}

__device__ __forceinline__ void gemv_layer(const Params& p, LAS unsigned char* lds, const int l, const int rb, const int nb) {
    const int tid = threadIdx.x;
    LAS float* sl = (LAS float*)lds;
    LAS f32x4* red = (LAS f32x4*)(lds + 12288);
    for (int i = tid; i < 3072; i += 512) { const int cond = i >> 10, k = i & 1023; const float v = cond == 0 ? p.in[5][k] : p.in[2][(cond - 1) * D + k]; sl[i] = v / (1.0f + __expf(-v)); }
    __syncthreads();
    float* mod = (float*)(p.ws + WS_MOD);
    for (int item = rb; item < 96; item += nb) {
        const int rem = item, cc = rem >> 4, kc = rem & 15, rpar = tid >> 8, col = cc * 1024 + 4 * (tid & 255);
        const float* W = p.in[6] + ((size_t)l * D + kc * 64 + rpar) * 6144 + col;
        f32x4 a0 = {0.f, 0.f, 0.f, 0.f}, a1 = a0, a2 = a0;
#pragma unroll
        for (int hf = 0; hf < 2; ++hf) {
            f32x4 w[16];
#pragma unroll
            for (int i = 0; i < 16; ++i) w[i] = *(const f32x4*)(W + (size_t)(32 * hf + 2 * i) * 6144);
#pragma unroll
            for (int i = 0; i < 16; ++i) { const int k = kc * 64 + 32 * hf + 2 * i + rpar; a0 += sl[k] * w[i]; a1 += sl[1024 + k] * w[i]; a2 += sl[2048 + k] * w[i]; }
        }
        if (rpar == 1) { red[tid - 256] = a0; red[256 + tid - 256] = a1; red[512 + tid - 256] = a2; }
        __syncthreads();
        if (rpar == 0) {
            a0 += red[tid]; a1 += red[256 + tid]; a2 += red[512 + tid];
            if (kc == 0) { const f32x4 bv = *(const f32x4*)(p.in[7] + l * 6144 + col); a0 += bv; a1 += bv; a2 += bv; }
#pragma unroll
            for (int j = 0; j < 4; ++j) {
                unsafeAtomicAdd(mod + (l * 3 + 0) * 6144 + col + j, a0[j]);
                unsafeAtomicAdd(mod + (l * 3 + 1) * 6144 + col + j, a1[j]);
                unsafeAtomicAdd(mod + (l * 3 + 2) * 6144 + col + j, a2[j]); }
        }
        __syncthreads();
    }
}
__device__ __forceinline__ void transpose_jobs(const Params& p, LAS unsigned char* lds, int gw, int NGW, int it_lo, int it_hi) {
    const int lane = threadIdx.x & 63, wave = threadIdx.x >> 6;
    LAS float* scr = (LAS float*)(lds + wave * 8448);
    TItem cur, nxt; f32x4 wa[8], wb[8];
    int it = it_lo + gw;
    bool have = it < it_hi && titem_decode(p, it, cur);
    if (have) titem_load(cur, wa, lane);
    while (have) {
        const bool hn = it + NGW < it_hi && titem_decode(p, it + NGW, nxt);
        if (hn) titem_load(nxt, wb, lane);
        titem_finish(cur, wa, scr, lane);
        if (!hn) break;
        it += 2 * NGW;
        have = it < it_hi && titem_decode(p, it, cur);
        if (have) titem_load(cur, wa, lane);
        titem_finish(nxt, wb, scr, lane);
    }
}
__device__ __forceinline__ void phase_prologue(const Params& p, LAS unsigned char* lds) {
    const int tid = threadIdx.x, G = gridDim.x, bx = blockIdx.x;
    unsigned char* ws = p.ws;
    LAS float* ct = (LAS float*)(lds + 32768);
    for (int i = tid; i < 2048; i += 512) ct[i] = cospif((float)i * (1.0f / 1024.0f));
    const bool sep = G >= 192;
    if (!sep || bx < 96) gemv_layer(p, lds, 0, bx, sep ? 96 : G);
    if (sep && bx < 96) return;
    const int gt = (sep ? bx - 96 : bx) * 512 + tid, GT = (sep ? G - 96 : G) * 512;
    for (int i = gt; i < 2 * 2 * 512 * D / 8; i += GT) { const int which = i >= 2 * 512 * D / 8; const int ii = which ? i - 2 * 512 * D / 8 : i;
        const f32x4* src = (const f32x4*)p.in[which ? 4 : 3]; const f32x4 a = src[2 * ii], b = src[2 * ii + 1];
        u32x4 o; o.x = pk2(a[0], a[1]); o.y = pk2(a[2], a[3]); o.z = pk2(b[0], b[1]); o.w = pk2(b[2], b[3]); ((u32x4*)((unsigned char*)p.out + (which ? OUTB_VC : OUTB_KC)))[ii] = o; }
    for (int i = gt; i < 512 * 256 / 8; i += GT) { const int row = i >> 5, c0 = (i & 31) * 8, cs = row >> 8, m = row & 255; float v[8];
#pragma unroll
        for (int j = 0; j < 8; ++j) { const int idx = ((m * (c0 + j)) & 255) * 8; v[j] = ct[(idx - (cs ? 512 : 0)) & 2047]; }
        u32x4 o; o.x = pk2(v[0], v[1]); o.y = pk2(v[2], v[3]); o.z = pk2(v[4], v[5]); o.w = pk2(v[6], v[7]); ((u32x4*)(ws + WS_CSCH))[i] = o; }
    for (int i = gt; i < 256 * 512 / 8; i += GT) { const int k = i >> 6, c0 = (i & 63) * 8; float v[8];
#pragma unroll
        for (int j = 0; j < 8; ++j) { const int kk = c0 + j, sidx = kk & 255; const int idx = ((k * sidx) & 255) * 8; v[j] = kk < 256 ? ct[idx] : -ct[(idx - 512) & 2047]; }
        u32x4 o; o.x = pk2(v[0], v[1]); o.y = pk2(v[2], v[3]); o.z = pk2(v[4], v[5]); o.w = pk2(v[6], v[7]); ((u32x4*)(ws + WS_TP))[i] = o; }
    for (int i = gt; i < 2048 * 4096 / 8; i += GT) { const int k = i >> 9, c0 = (i & 511) * 8; float v[8];
#pragma unroll
        for (int j = 0; j < 8; ++j) { const int kk = c0 + j, sidx = kk & 2047; const int idx = (k * sidx) & 2047; v[j] = kk < 2048 ? ct[idx] : -ct[(idx - 512) & 2047]; }
        u32x4 o; o.x = pk2(v[0], v[1]); o.y = pk2(v[2], v[3]); o.z = pk2(v[4], v[5]); o.w = pk2(v[6], v[7]); ((u32x4*)(ws + WS_TS))[i] = o; }
}
__device__ __forceinline__ void phase_side_jobs(const Params& p, LAS unsigned char* lds, const int which) {
    if (which == 5) { if (blockIdx.x < 56) transpose_jobs(p, lds, blockIdx.x * 8 + (threadIdx.x >> 6), 56 * 8, TI_L0 + 3 * 1408, TI_L0 + 3 * 1408 + 1536); return; }
    if (which == 6) { if (blockIdx.x >= 64) { const int gw = (blockIdx.x - 64) * 8 + (threadIdx.x >> 6), ngw = (gridDim.x - 64) * 8;
        transpose_jobs(p, lds, gw, ngw, TI_L0 + 2 * 1408, TI_L0 + 3 * 1408); transpose_jobs(p, lds, gw, ngw, TI_L0 + 3 * 1408 + 1536, TI_ALL); } return; }
    if (which == 7) { if (blockIdx.x >= 192) transpose_jobs(p, lds, (blockIdx.x - 192) * 8 + (threadIdx.x >> 6), (gridDim.x - 192) * 8, TI_L0, TI_L0 + 2 * 1408); return; }
    const int G = gridDim.x, bx = blockIdx.x, first = which == 0 ? 64 : 192;
    const int nb = G > first ? G - first : G, b0 = G > first ? first : 0;
    if (bx < b0) return;
    const int rb = bx - b0;
    if (which == 0) transpose_jobs(p, lds, rb * 8 + (threadIdx.x >> 6), nb * 8, 0, TI_L0);
    else if (which == 1) gemv_layer(p, lds, 1, rb, nb);
    else transpose_jobs(p, lds, rb * 8 + (threadIdx.x >> 6), nb * 8, TI_L0, TI_ALL);
}

#ifndef ROW_WT
#define ROW_WT 0
#endif
__device__ __forceinline__ void store16_wt(void* ptr, u32x4 v) {
#if ROW_WT
    asm volatile("global_store_dwordx4 %0, %1, off sc0 sc1\n\ts_nop 3" :: "v"(ptr), "v"(v) : "memory");
#else
    *(u32x4*)ptr = v;
#endif
}
__device__ __forceinline__ void bf8_to_f32(const u32x4 w, f32x4& a, f32x4& b) { a = (f32x4){bf_lo(w.x), bf_hi(w.x), bf_lo(w.y), bf_hi(w.y)}; b = (f32x4){bf_lo(w.z), bf_hi(w.z), bf_lo(w.w), bf_hi(w.w)}; }
__device__ __forceinline__ u32x4 f32_to_bf8(const f32x4 a, const f32x4 b) { u32x4 w; w.x = pk2(a[0], a[1]); w.y = pk2(a[2], a[3]); w.z = pk2(b[0], b[1]); w.w = pk2(b[2], b[3]); return w; }
template <bool HAS_MP, bool HAS_NEXT, bool XIN_F32>
__device__ __forceinline__ void row_phase(const float* xin_p, const float* xin_s, bf16_t* XB, const bf16_t* mp, float* Yout, bf16_t* Hout,
                                          const float* gate, const float* gA, const float* gB, const float* sc, const float* sh, unsigned* cnt = nullptr, const bf16_t* mp2 = nullptr) {
    const int tid = threadIdx.x, lane = tid & 63, gw = blockIdx.x * 8 + (tid >> 6), NGW = gridDim.x * 8;
    if (cnt) {
        if (tid == 0) { const int p0 = (blockIdx.x * 48) >> 8, p1 = (blockIdx.x * 48 + 47) >> 8;
            for (int pp = p0; pp <= p1; ++pp) { unsigned sp = 0; while (__hip_atomic_load(cnt + pp * 64, __ATOMIC_RELAXED, __HIP_MEMORY_SCOPE_AGENT) < ((mp2 && pp >= 46) ? 64u : 32u)) { __builtin_amdgcn_s_sleep(2); if (++sp > (1u << 22)) break; } }
            __builtin_amdgcn_fence(__ATOMIC_ACQUIRE, "agent"); asm volatile("s_waitcnt vmcnt(0)" ::: "memory"); }
        __syncthreads();
    }
    constexpr int R = 3, RW = 6;
    int cur_cond = -1;
    f32x4 gga[4], gbs[4], shv[4];
    for (int rowb = gw * RW; rowb < M; rowb += NGW * RW)
    for (int row0 = rowb; row0 < rowb + RW; row0 += R) {
        f32x4 v[R][4]; u32x4 mw[R][2];
#pragma unroll
        for (int q = 0; q < R; ++q) { const int row = row0 + q;
            if constexpr (XIN_F32) { const float* xr = row < NP ? xin_p + (size_t)row * D : xin_s + (size_t)(row - NP) * D;
#pragma unroll
                for (int j = 0; j < 2; ++j) { v[q][2 * j] = *(const f32x4*)(xr + 8 * lane + 512 * j); v[q][2 * j + 1] = *(const f32x4*)(xr + 8 * lane + 512 * j + 4); }
            } else {
#pragma unroll
                for (int j = 0; j < 2; ++j) { const u32x4 w = *(const u32x4*)(XB + (size_t)row * D + 8 * lane + 512 * j); bf8_to_f32(w, v[q][2 * j], v[q][2 * j + 1]); }
            }
            if constexpr (HAS_MP) {
#pragma unroll
                for (int j = 0; j < 2; ++j) mw[q][j] = *(const u32x4*)(mp + (size_t)row * D + 8 * lane + 512 * j);
            } }
        u32x4 xo[R][2], ho[R][2];
#pragma unroll
        for (int q = 0; q < R; ++q) { const int row = row0 + q; const int cond = row < NP ? 0 : (row < NP + SS ? 1 : 2);
            if (cond != cur_cond) { cur_cond = cond;
#pragma unroll
                for (int j = 0; j < 4; ++j) { const int col = 8 * lane + 512 * (j >> 1) + 4 * (j & 1);
                    if constexpr (HAS_MP) gga[j] = *(const f32x4*)(gate + cond * 6144 + col) * *(const f32x4*)(gA + col);
                    if constexpr (HAS_NEXT) { gbs[j] = *(const f32x4*)(gB + col) * (1.0f + *(const f32x4*)(sc + cond * 6144 + col)); shv[j] = *(const f32x4*)(sh + cond * 6144 + col); } } }
            if constexpr (HAS_MP) {
                f32x4 mv[4]; float s = 0.f;
#pragma unroll
                for (int j = 0; j < 2; ++j) bf8_to_f32(mw[q][j], mv[2 * j], mv[2 * j + 1]);
                if (mp2 && row >= 46 * 256) {
#pragma unroll
                    for (int j = 0; j < 2; ++j) { f32x4 a, b; bf8_to_f32(*(const u32x4*)(mp2 + (size_t)(row - 46 * 256) * D + 8 * lane + 512 * j), a, b); mv[2 * j] += a; mv[2 * j + 1] += b; } }
#pragma unroll
                for (int j = 0; j < 4; ++j) s += (mv[j][0] * mv[j][0] + mv[j][1] * mv[j][1]) + (mv[j][2] * mv[j][2] + mv[j][3] * mv[j][3]);
                const float rstd = 1.0f / sqrtf(wave_sum(s) * (1.0f / D) + 1e-6f);
#pragma unroll
                for (int j = 0; j < 4; ++j) v[q][j] = v[q][j] + gga[j] * (mv[j] * rstd);
                if constexpr (HAS_NEXT) {
#pragma unroll
                    for (int j = 0; j < 2; ++j) xo[q][j] = f32_to_bf8(v[q][2 * j], v[q][2 * j + 1]);
                }
            }
            if constexpr (HAS_NEXT) {
                float s = 0.f;
#pragma unroll
                for (int j = 0; j < 4; ++j) s += (v[q][j][0] * v[q][j][0] + v[q][j][1] * v[q][j][1]) + (v[q][j][2] * v[q][j][2] + v[q][j][3] * v[q][j][3]);
                const float rstd = 1.0f / sqrtf(wave_sum(s) * (1.0f / D) + 1e-6f);
                f32x4 hh[4];
#pragma unroll
                for (int j = 0; j < 4; ++j) hh[j] = (v[q][j] * rstd) * gbs[j] + shv[j];
#pragma unroll
                for (int j = 0; j < 2; ++j) ho[q][j] = f32_to_bf8(hh[2 * j], hh[2 * j + 1]);
            } }
#pragma unroll
        for (int q = 0; q < R; ++q) { const int row = row0 + q;
            if constexpr (HAS_MP && !HAS_NEXT) {
#pragma unroll
                for (int j = 0; j < 4; ++j) *(f32x4*)(Yout + (size_t)row * D + 8 * lane + 512 * (j >> 1) + 4 * (j & 1)) = v[q][j];
            }
            if constexpr (HAS_MP && HAS_NEXT) {
#pragma unroll
                for (int j = 0; j < 2; ++j) store16_wt(XB + (size_t)row * D + 8 * lane + 512 * j, xo[q][j]);
            }
            if constexpr (HAS_NEXT) {
#pragma unroll
                for (int j = 0; j < 2; ++j) store16_wt(Hout + (size_t)row * D + 8 * lane + 512 * j, ho[q][j]);
            } }
    }
}

__device__ __forceinline__ void attn_phase(const Params& p, LAS unsigned char* lds) {
    const int tid = threadIdx.x, lane = tid & 63, wave = __builtin_amdgcn_readfirstlane(tid >> 6), r = lane & 31, hh = lane >> 5;
    unsigned char* ws = p.ws;
    const bf16_t* Qb = (const bf16_t*)(ws + WS_Q); const bf16_t* Kb = (const bf16_t*)(ws + WS_K); const bf16_t* Vb = (const bf16_t*)(ws + WS_VT);
    const bf16_t* Kc = (const bf16_t*)((const unsigned char*)p.out + OUTB_KC); const bf16_t* Vc = (const bf16_t*)((const unsigned char*)p.out + OUTB_VC);
    bf16_t* Ob = (bf16_t*)(ws + WS_H);
    LAS float* Bl = (LAS float*)(lds + 36864 + 512);
    const int srow = tid >> 3, sch = tid & 7, krho = (srow & ~12) | ((srow & 4) << 1) | ((srow & 8) >> 1);
    const float c2 = 0.125f * 1.4426950408889634f;
    for (int unit = blockIdx.x; unit < 768; unit += gridDim.x) {
        const bool is_na = unit < 256;
        int b, h, qtok, nt, jmin = 0, nloc = 0, rq = 0, half = 0, ktok0;
        if (is_na) { b = unit >> 7; h = (unit >> 3) & 15; const int r0 = (unit & 7) * 4; rq = r0 + (wave >> 1); half = wave & 1;
            jmin = min(max(r0 - 4, 0), 24); const int jmax = min(max(r0 - 1, 0), 24) + 7; nloc = jmax - jmin + 1; nt = nloc + 8;
            qtok = NP + b * SS + rq * 64 + half * 32 + r; ktok0 = NP + b * SS; }
        else { const int u2 = unit - 256; b = u2 >> 4; h = u2 & 15; nt = 4; qtok = b * SP + wave * 32 + r; ktok0 = b * SP; }
        const int rs = min(max(rq - 4, 0), 24);
        if (is_na) { for (int i = tid; i < 15 * 32; i += 512) { const int rr = i >> 5, x = i & 31; Bl[i] = x < 31 ? p.in[11][(h * 15 + rr) * 31 + x] * 1.4426950408889634f : 0.f; } }
        bf16x8 qf[4];
#pragma unroll
        for (int d0 = 0; d0 < 4; ++d0) qf[d0] = *(const bf16x8*)(Qb + (size_t)qtok * D + h * HD + d0 * 16 + hh * 8);
        f32x16 o0, o1;
#pragma unroll
        for (int i = 0; i < 16; ++i) { o0[i] = 0.f; o1[i] = 0.f; }
        float m_run = -1e30f, l_run = 0.f;
        u32x4 kreg, vreg;
#define ATT_LOAD(t) do { const int t_ = (t); size_t off_; const bf16_t* kb_; const bf16_t* vb_; \
            if (is_na && t_ >= nloc) { off_ = ((size_t)(b * 512 + (t_ - nloc) * 64 + srow)) * D + h * HD + sch * 8; kb_ = Kc; vb_ = Vc; } \
            else { off_ = (size_t)(ktok0 + (is_na ? (jmin + t_) * 64 : t_ * 64) + srow) * D + h * HD + sch * 8; kb_ = Kb; vb_ = Vb; } \
            kreg = *(const u32x4*)(kb_ + off_); vreg = *(const u32x4*)(vb_ + off_); } while (0)
#define ATT_STORE(buf) do { LAS unsigned char* kl_ = lds + (buf) * 18432; LAS unsigned char* vl_ = kl_ + 9216; \
            *(LAS u32x4*)(kl_ + krho * 144 + sch * 16) = kreg; \
            LAS bf16_t* vd_ = (LAS bf16_t*)(vl_ + (8 * sch) * 144 + srow * 2); \
            vd_[0 * 72] = (bf16_t)vreg.x; vd_[1 * 72] = (bf16_t)(vreg.x >> 16); vd_[2 * 72] = (bf16_t)vreg.y; vd_[3 * 72] = (bf16_t)(vreg.y >> 16); \
            vd_[4 * 72] = (bf16_t)vreg.z; vd_[5 * 72] = (bf16_t)(vreg.z >> 16); vd_[6 * 72] = (bf16_t)vreg.w; vd_[7 * 72] = (bf16_t)(vreg.w >> 16); } while (0)
        ATT_LOAD(0); ATT_STORE(0); if (nt > 1) ATT_LOAD(1);
        __syncthreads();
        for (int t = 0; t < nt; ++t) {
            if (t + 1 < nt) { ATT_STORE((t + 1) & 1); if (t + 2 < nt) ATT_LOAD(t + 2); }
            const bool local = is_na && t < nloc; const int j = jmin + t;
            if (!(local && (j < rs || j >= rs + 8))) {
                const LAS unsigned char* Kl = lds + (t & 1) * 18432; const LAS unsigned char* Vl = Kl + 9216;
                f32x16 p0, p1;
#pragma unroll
                for (int i = 0; i < 16; ++i) { p0[i] = 0.f; p1[i] = 0.f; }
#pragma unroll
                for (int d0 = 0; d0 < 4; ++d0) { const bf16x8 a0 = *(const LAS bf16x8*)(Kl + r * 144 + d0 * 32 + hh * 16), a1 = *(const LAS bf16x8*)(Kl + (32 + r) * 144 + d0 * 32 + hh * 16);
                    p0 = __builtin_amdgcn_mfma_f32_32x32x16_bf16(a0, qf[d0], p0, 0, 0, 0); p1 = __builtin_amdgcn_mfma_f32_32x32x16_bf16(a1, qf[d0], p1, 0, 0, 0); }
                float m_new, alpha;
                if (local) {
                    const int qc = half * 32 + r, cs = min(max(qc - 8, 0), 48);
                    const LAS float* bp = Bl + (j - rq + 7) * 32 + 8 * hh - qc + 15;
                    float bb0[16], bb1[16];
#pragma unroll
                    for (int i = 0; i < 16; ++i) { const int kc = 16 * (i >> 3) + (i & 7); bb0[i] = bp[kc]; bb1[i] = bp[kc + 32]; }
                    asm volatile("" : "+v"(bb0[0]), "+v"(bb0[1]), "+v"(bb0[2]), "+v"(bb0[3]), "+v"(bb0[4]), "+v"(bb0[5]), "+v"(bb0[6]), "+v"(bb0[7]));
                    asm volatile("" : "+v"(bb0[8]), "+v"(bb0[9]), "+v"(bb0[10]), "+v"(bb0[11]), "+v"(bb0[12]), "+v"(bb0[13]), "+v"(bb0[14]), "+v"(bb0[15]));
                    asm volatile("" : "+v"(bb1[0]), "+v"(bb1[1]), "+v"(bb1[2]), "+v"(bb1[3]), "+v"(bb1[4]), "+v"(bb1[5]), "+v"(bb1[6]), "+v"(bb1[7]));
                    asm volatile("" : "+v"(bb1[8]), "+v"(bb1[9]), "+v"(bb1[10]), "+v"(bb1[11]), "+v"(bb1[12]), "+v"(bb1[13]), "+v"(bb1[14]), "+v"(bb1[15]));
                    const unsigned sh0 = (unsigned)(8 * hh - cs);
#pragma unroll
                    for (int i = 0; i < 16; ++i) { const int kc = 16 * (i >> 3) + (i & 7);
                        const float s0 = __builtin_fmaf(p0[i], c2, bb0[i]), s1 = __builtin_fmaf(p1[i], c2, bb1[i]);
                        p0[i] = (sh0 + (unsigned)kc) < 16u ? s0 : -1e30f; p1[i] = (sh0 + (unsigned)(kc + 32)) < 16u ? s1 : -1e30f; }
                    float mt = fmaxf(p0[0], p1[0]);
#pragma unroll
                    for (int i = 1; i < 16; ++i) mt = fmaxf(mt, fmaxf(p0[i], p1[i]));
                    mt = fmaxf(mt, __shfl_xor(mt, 32));
                    m_new = fmaxf(m_run, mt); alpha = __builtin_amdgcn_exp2f(m_run - m_new);
#pragma unroll
                    for (int i = 0; i < 16; ++i) { p0[i] = __builtin_amdgcn_exp2f(p0[i] - m_new); p1[i] = __builtin_amdgcn_exp2f(p1[i] - m_new); }
                } else {
                    float mt = fmaxf(p0[0], p1[0]);
#pragma unroll
                    for (int i = 1; i < 16; ++i) mt = fmaxf(mt, fmaxf(p0[i], p1[i]));
                    mt = fmaxf(mt, __shfl_xor(mt, 32)) * c2;
                    m_new = fmaxf(m_run, mt); alpha = __builtin_amdgcn_exp2f(m_run - m_new);
#pragma unroll
                    for (int i = 0; i < 16; ++i) { p0[i] = __builtin_amdgcn_exp2f(__builtin_fmaf(p0[i], c2, -m_new)); p1[i] = __builtin_amdgcn_exp2f(__builtin_fmaf(p1[i], c2, -m_new)); }
                }
                m_run = m_new;
                float ls = 0.f;
#pragma unroll
                for (int i = 0; i < 16; ++i) ls += p0[i] + p1[i];
                l_run = l_run * alpha + ls;
#pragma unroll
                for (int i = 0; i < 16; ++i) { o0[i] *= alpha; o1[i] *= alpha; }
                bf16x8 pa[4];
#pragma unroll
                for (int s2 = 0; s2 < 2; ++s2) { u32x4 w; w.x = pk2(p0[8 * s2], p0[8 * s2 + 1]); w.y = pk2(p0[8 * s2 + 2], p0[8 * s2 + 3]); w.z = pk2(p0[8 * s2 + 4], p0[8 * s2 + 5]); w.w = pk2(p0[8 * s2 + 6], p0[8 * s2 + 7]); pa[s2] = __builtin_bit_cast(bf16x8, w);
                    u32x4 w2; w2.x = pk2(p1[8 * s2], p1[8 * s2 + 1]); w2.y = pk2(p1[8 * s2 + 2], p1[8 * s2 + 3]); w2.z = pk2(p1[8 * s2 + 4], p1[8 * s2 + 5]); w2.w = pk2(p1[8 * s2 + 6], p1[8 * s2 + 7]); pa[2 + s2] = __builtin_bit_cast(bf16x8, w2); }
#pragma unroll
                for (int s2 = 0; s2 < 4; ++s2) { const bf16x8 v0 = *(const LAS bf16x8*)(Vl + r * 144 + s2 * 32 + hh * 16), v1 = *(const LAS bf16x8*)(Vl + (32 + r) * 144 + s2 * 32 + hh * 16);
                    o0 = __builtin_amdgcn_mfma_f32_32x32x16_bf16(v0, pa[s2], o0, 0, 0, 0); o1 = __builtin_amdgcn_mfma_f32_32x32x16_bf16(v1, pa[s2], o1, 0, 0, 0); }
            }
            __syncthreads();
        }
#undef ATT_LOAD
#undef ATT_STORE
        const float inv = 1.0f / (l_run + __shfl_xor(l_run, 32));
        bf16_t* orow = Ob + (size_t)qtok * D + h * HD + 4 * hh;
#pragma unroll
        for (int g = 0; g < 4; ++g) { u32x2 w; w.x = pk2(o0[4 * g] * inv, o0[4 * g + 1] * inv); w.y = pk2(o0[4 * g + 2] * inv, o0[4 * g + 3] * inv); *(u32x2*)(orow + 8 * g) = w;
            u32x2 w2; w2.x = pk2(o1[4 * g] * inv, o1[4 * g + 1] * inv); w2.y = pk2(o1[4 * g + 2] * inv, o1[4 * g + 3] * inv); *(u32x2*)(orow + 32 + 8 * g) = w2; }
    }
    __syncthreads();
}

#define XB_TMO      128
#define XB_XCNT(j)  (256  + 64 * (j))
#define XB_XSUB(j)  (1280 + 64 * (j))
#define XB_XGEN(j)  (2304 + 64 * (j))
#define XB_TOP      3328
#define XB_TOPGEN   3392
#define XCD_BAR_WORDS 3456
#define XB_SPIN_CAP (1u << 18)
__device__ __forceinline__ unsigned xb_ld(unsigned* p)              { return __hip_atomic_load(p, __ATOMIC_RELAXED, __HIP_MEMORY_SCOPE_AGENT); }
__device__ __forceinline__ unsigned xb_add(unsigned* p, unsigned v) { return __hip_atomic_fetch_add(p, v, __ATOMIC_RELAXED, __HIP_MEMORY_SCOPE_AGENT); }
__device__ __forceinline__ unsigned xb_xcc_id() { return (unsigned)__builtin_amdgcn_s_getreg((3 << 11) | 20) & 0xFu; }
#define XB_SPIN(cond, bar) do { unsigned _sp = 0; while (cond) { __builtin_amdgcn_s_sleep(1); \
    if ((++_sp & 255u) == 0u) { if (xb_ld(&(bar)[XB_TMO])) break; if (_sp > XB_SPIN_CAP) { atomicAdd(&(bar)[XB_TMO], 1u); break; } } } } while (0)
struct XcdBarrier { unsigned* bar; unsigned x; volatile LAS unsigned* st; };
__device__ __forceinline__ XcdBarrier xcd_barrier_post(unsigned* bar, volatile LAS unsigned* st) {
    XcdBarrier b; b.bar = bar; b.x = xb_xcc_id(); b.st = st;
    if (threadIdx.x == 0) (void)xb_add(&bar[XB_XCNT(b.x)], 1u);
    return b;
}
__device__ __forceinline__ void xcd_barrier_complete(unsigned* bar, unsigned x, unsigned& nloc, unsigned& nx) {
    const unsigned G = gridDim.x * gridDim.y * gridDim.z;
    unsigned sum, cnt, mine, sp = 0u;
    for (;;) {
        sum = 0u; cnt = 0u; mine = 0u;
#pragma unroll
        for (unsigned j = 0; j < 16; ++j) { const unsigned c = xb_ld(&bar[XB_XCNT(j)]); sum += c; cnt += (c > 0u) ? 1u : 0u; mine = (j == x) ? c : mine; }
        if (sum == G) break;
        __builtin_amdgcn_s_sleep(1);
        if ((++sp & 255u) == 0u) { if (xb_ld(&bar[XB_TMO])) break; if (sp > XB_SPIN_CAP) { atomicAdd(&bar[XB_TMO], 1u); break; } }
    }
    nloc = mine > 0u ? mine : 1u; nx = cnt > 0u ? cnt : 1u;
}
__device__ __forceinline__ void xcd_barrier(const XcdBarrier& b) {
    asm volatile("s_waitcnt vmcnt(0)" ::: "memory");
    __syncthreads();
    if (threadIdx.x == 0) {
        unsigned* bar = b.bar;
        __builtin_amdgcn_s_waitcnt(0);
        unsigned nloc = b.st[0], nx = b.st[1];
        if (nloc == 0u) { xcd_barrier_complete(bar, b.x, nloc, nx); b.st[0] = nloc; b.st[1] = nx; }
        const unsigned old = xb_add(&bar[XB_XSUB(b.x)], 1u);
        const unsigned gen = old / nloc;
        if (old + 1u == (gen + 1u) * nloc) {
            __builtin_amdgcn_fence(__ATOMIC_RELEASE, "agent");
            asm volatile("s_waitcnt vmcnt(0)" ::: "memory");
            const unsigned og = xb_add(&bar[XB_TOP], 1u);
            const unsigned tg = og / nx;
            if (og + 1u == (tg + 1u) * nx) xb_add(&bar[XB_TOPGEN], 1u);
            else XB_SPIN(xb_ld(&bar[XB_TOPGEN]) == tg, bar);
            __builtin_amdgcn_fence(__ATOMIC_ACQUIRE, "agent");
            xb_add(&bar[XB_XGEN(b.x)], 1u);
            asm volatile("s_waitcnt vmcnt(0)" ::: "memory");
        } else {
            XB_SPIN(xb_ld(&bar[XB_XGEN(b.x)]) == gen, bar);
            __builtin_amdgcn_fence(__ATOMIC_ACQUIRE, "agent");
            asm volatile("s_waitcnt vmcnt(0)" ::: "memory");
        }
    }
    __syncthreads();
}

__global__ void __launch_bounds__(512, 2) mega_fwd(Params p) {
    extern __shared__ __attribute__((aligned(16))) unsigned char lds_raw[];
    LAS unsigned char* lds = (LAS unsigned char*)lds_raw;
    unsigned char* ws = p.ws;
    const int G = gridDim.x, c = blockIdx.x, lo = p.ph_lo, hi = p.ph_hi;
    const float* mod = (const float*)(ws + WS_MOD);
    const float* norm_g = p.in[8];
    bf16_t* H = (bf16_t*)(ws + WS_H); bf16_t* MPb = (bf16_t*)(ws + WS_MP); bf16_t* U = (bf16_t*)(ws + WS_U);
    float* X = p.out + OUT_X; bf16_t* XB = (bf16_t*)(ws + WS_XB);
    volatile LAS unsigned* MISC = (volatile LAS unsigned*)(lds + 131072 + 320);
    if (threadIdx.x < 32) MISC[threadIdx.x] = 0u;
    __syncthreads();
    XcdBarrier bar; bar.bar = (unsigned*)(ws + WS_CTL); bar.x = 0; bar.st = nullptr;
    if (hi - lo > 1) bar = xcd_barrier_post((unsigned*)(ws + WS_CTL), MISC + 8);
    if (hi > 1000) cg::this_grid().sync();
#ifndef PH_MASK
#define PH_MASK 0xffff
#endif
#define IN(k) (((PH_MASK >> (k)) & 1) && lo <= (k) && (k) < hi)
    const bool handoff = (G == 256) && (hi - lo > 1);
    unsigned* const cntb = (unsigned*)(ws + WS_CTL) + CW_CNT;
#ifndef PROBE_REP
#define PROBE_REP -1
#endif
#ifndef PROBE_SYNC2
#define PROBE_SYNC2 0
#endif
#define REPS(k) for (int rep_ = 0; rep_ < ((k) == PROBE_REP ? 2 : 1); ++rep_)
#ifndef PROBE_PHASE
#define PROBE_PHASE -1
#endif
    unsigned long long pt0 = 0, pt1 = 0;
    if (PROBE_PHASE == 0) pt0 = __builtin_amdgcn_s_memrealtime();
#define SEAM(k) SEAMX(k, false)
#define SEAMX(k, skip) do { if ((k) + 1 < hi && !(skip)) { xcd_barrier(bar); if (PROBE_SYNC2) xcd_barrier(bar); } \
        if ((k) == PROBE_PHASE) pt1 = __builtin_amdgcn_s_memrealtime(); if ((k) + 1 == PROBE_PHASE) pt0 = __builtin_amdgcn_s_memrealtime(); } while (0)

    if (IN(0)) { REPS(0) { phase_prologue(p, lds); } SEAM(0); }
    if (IN(1)) { REPS(1) {
        row_phase<false, true, true>(p.in[0], p.in[1], nullptr, nullptr, nullptr, H, nullptr, nullptr, norm_g, mod + 1 * D, mod + 0 * D);
        } SEAM(1);
    }
    if (IN(2)) { REPS(2) {
        pg8::ChDftSched S{G, c, (const char*)(ws + WS_CSCH), (const char*)H, (bf16_t*)(ws + WS_YTP), (bf16_t*)(ws + WS_YTS)};
        pg8::gemm_phase<pg8::EpiStore, pg8::ChDftSched, true>(lds, 256, D, 256, S, pg8::EpiStore{});
        } SEAM(2);
    }
    if (IN(3)) { REPS(3) {
        { pg8::SeqSSched S{c, (const char*)(ws + WS_TS), (const char*)(ws + WS_YTS), (bf16_t*)(ws + WS_F)};
          pg8::gemm_phase<pg8::EpiStore, pg8::SeqSSched, true>(lds, 4096, 4096, 4096, S, pg8::EpiStore{}); }
        { pg8::SeqPSched S{G, c, (const char*)(ws + WS_TP), (const char*)(ws + WS_YTP), (bf16_t*)(ws + WS_F)};
          pg8::gemm_phase<pg8::EpiStore, pg8::SeqPSched, true>(lds, 512, 512, 512, S, pg8::EpiStore{}); }
        phase_side_jobs(p, lds, 0);
        } SEAM(3);
    }
    if (IN(4)) { REPS(4) {
        pg8::GSched S{48, 4, G, c, (const char*)(ws + WS_F), (size_t)256 * D * 2, (const char*)(ws + WS_WF), (size_t)256 * D * 2, MPb, (size_t)256 * D, 256, D};
        pg8::gemm_phase<pg8::EpiStoreSig, pg8::GSched, true>(lds, D, D, D, S, pg8::EpiStoreSig{handoff ? cntb + 0 * CNT_SEAM : nullptr});
        phase_side_jobs(p, lds, 1);
        } SEAMX(4, handoff);
    }
    if (IN(5)) { REPS(5) {
        row_phase<true, true, true>(p.in[0], p.in[1], XB, MPb, nullptr, H, mod + 2 * D, norm_g + 1 * D, norm_g + 2 * D, mod + 4 * D, mod + 3 * D, handoff ? cntb + 0 * CNT_SEAM : nullptr);
        } SEAM(5);
    }
    if (IN(6)) {
        if (handoff) { pg8::GuSched S{G, c, (const char*)H, (const char*)(ws + WS_WGU), U};
            pg8::gemm_phase<pg8::EpiSwiGLU, pg8::GuSched, true>(lds, D, D, D, S, pg8::EpiSwiGLU{cntb + 4 * CNT_SEAM}); }
        else { pg8::GSched S{48, 22, G, c, (const char*)H, (size_t)256 * D * 2, (const char*)(ws + WS_WGU), (size_t)256 * D * 2, U, (size_t)256 * FF, 128, FF};
            pg8::gemm_phase<pg8::EpiSwiGLU, pg8::GSched, true>(lds, D, D, D, S, pg8::EpiSwiGLU{nullptr}); }
        SEAMX(6, handoff);
    }
    if (IN(7)) {
        if (handoff) {
            const int dd = c >= 248 ? 184 + (c - 248) : (c >= 64 ? c - 64 : (c >= 56 ? 192 + (c - 56) : -1));
            if (dd >= 0) { pg8::DownSched S{dd, (const char*)U, (const char*)(ws + WS_WD), MPb, (bf16_t*)(ws + WS_MP2)};
                if (threadIdx.x == 0) { int pm, pn, kh; S.unit(pm, pn, kh); unsigned* w = cntb + 4 * CNT_SEAM + pm * 64; unsigned sp = 0;
                    while (__hip_atomic_load(w, __ATOMIC_RELAXED, __HIP_MEMORY_SCOPE_AGENT) < 176u) { __builtin_amdgcn_s_sleep(4); if (++sp > (1u << 22)) break; }
                    __builtin_amdgcn_fence(__ATOMIC_ACQUIRE, "agent"); asm volatile("s_waitcnt vmcnt(0)" ::: "memory"); }
                __syncthreads();
                if (dd < 184) pg8::gemm_phase<pg8::EpiStoreSig, pg8::DownSched, true>(lds, FF, FF, FF, S, pg8::EpiStoreSig{cntb + 1 * CNT_SEAM});
                else pg8::gemm_phase<pg8::EpiStoreSig, pg8::DownSched, true>(lds, FF, FF, FF / 2, S, pg8::EpiStoreSig{cntb + 1 * CNT_SEAM}); }
            else { phase_side_jobs(p, lds, 5); }
        } else { pg8::GSched S{48, 4, G, c, (const char*)U, (size_t)256 * FF * 2, (const char*)(ws + WS_WD), (size_t)256 * FF * 2, MPb, (size_t)256 * D, 256, D};
            pg8::gemm_phase<pg8::EpiStoreSig, pg8::GSched, true>(lds, FF, FF, FF, S, pg8::EpiStoreSig{nullptr});
            phase_side_jobs(p, lds, 2); }
        SEAMX(7, handoff);
    }
    if (IN(8)) { REPS(8) {
        row_phase<true, true, false>(nullptr, nullptr, XB, MPb, nullptr, H, mod + 5 * D, norm_g + 3 * D, norm_g + 4 * D, mod + 3 * 6144 + 1 * D, mod + 3 * 6144 + 0 * D, handoff ? cntb + 1 * CNT_SEAM : nullptr, handoff ? (const bf16_t*)(ws + WS_MP2) : nullptr);
        } SEAM(8);
    }
    if (IN(9)) { REPS(9) {
        pg8::GSched S{48, 12, G, c, (const char*)H, (size_t)256 * D * 2, (const char*)(ws + WS_WQKV), (size_t)256 * D * 2, nullptr, 0, 0, D};
        pg8::EpiQKV E{(bf16_t*)(ws + WS_Q), (bf16_t*)(ws + WS_K), (bf16_t*)(ws + WS_VT), p.out + OUT_CK, p.out + OUT_CV};
        pg8::gemm_phase<pg8::EpiQKV, pg8::GSched, true>(lds, D, D, D, S, E);
        if (handoff) phase_side_jobs(p, lds, 6);
        } SEAM(9);
    }
    if (IN(10)) { REPS(10) { attn_phase(p, lds); } SEAM(10); }
    if (IN(11)) { REPS(11) {
        pg8::GSched S{48, 4, G, c, (const char*)H, (size_t)256 * D * 2, (const char*)(ws + WS_WO), (size_t)256 * D * 2, MPb, (size_t)256 * D, 256, D};
        pg8::gemm_phase<pg8::EpiStoreSig, pg8::GSched, true>(lds, D, D, D, S, pg8::EpiStoreSig{handoff ? cntb + 2 * CNT_SEAM : nullptr});
        if (handoff) phase_side_jobs(p, lds, 7);
        } SEAMX(11, handoff);
    }
    if (IN(12)) { REPS(12) {
        row_phase<true, true, false>(nullptr, nullptr, XB, MPb, nullptr, H, mod + 3 * 6144 + 2 * D, norm_g + 5 * D, norm_g + 6 * D, mod + 3 * 6144 + 4 * D, mod + 3 * 6144 + 3 * D, handoff ? cntb + 2 * CNT_SEAM : nullptr);
        } SEAM(12);
    }
    if (IN(13)) {
        if (handoff) { pg8::GuSched S{G, c, (const char*)H, (const char*)(ws + WS_WGU) + (size_t)2 * FF * D * 2, U};
            pg8::gemm_phase<pg8::EpiSwiGLU, pg8::GuSched, true>(lds, D, D, D, S, pg8::EpiSwiGLU{cntb + 5 * CNT_SEAM}); }
        else { pg8::GSched S{48, 22, G, c, (const char*)H, (size_t)256 * D * 2, (const char*)(ws + WS_WGU) + (size_t)2 * FF * D * 2, (size_t)256 * D * 2, U, (size_t)256 * FF, 128, FF};
            pg8::gemm_phase<pg8::EpiSwiGLU, pg8::GSched, true>(lds, D, D, D, S, pg8::EpiSwiGLU{nullptr}); }
        SEAMX(13, handoff);
    }
    if (IN(14)) {
        if (handoff) {
            const int dd = c >= 248 ? 184 + (c - 248) : (c >= 64 ? c - 64 : (c >= 56 ? 192 + (c - 56) : -1));
            if (dd >= 0) { pg8::DownSched S{dd, (const char*)U, (const char*)(ws + WS_WD) + (size_t)D * FF * 2, MPb, (bf16_t*)(ws + WS_MP2)};
                if (threadIdx.x == 0) { int pm, pn, kh; S.unit(pm, pn, kh); unsigned* w = cntb + 5 * CNT_SEAM + pm * 64; unsigned sp = 0;
                    while (__hip_atomic_load(w, __ATOMIC_RELAXED, __HIP_MEMORY_SCOPE_AGENT) < 176u) { __builtin_amdgcn_s_sleep(4); if (++sp > (1u << 22)) break; }
                    __builtin_amdgcn_fence(__ATOMIC_ACQUIRE, "agent"); asm volatile("s_waitcnt vmcnt(0)" ::: "memory"); }
                __syncthreads();
                if (dd < 184) pg8::gemm_phase<pg8::EpiStoreSig, pg8::DownSched, true>(lds, FF, FF, FF, S, pg8::EpiStoreSig{cntb + 3 * CNT_SEAM});
                else pg8::gemm_phase<pg8::EpiStoreSig, pg8::DownSched, true>(lds, FF, FF, FF / 2, S, pg8::EpiStoreSig{cntb + 3 * CNT_SEAM}); }
            else {  }
        } else { pg8::GSched S{48, 4, G, c, (const char*)U, (size_t)256 * FF * 2, (const char*)(ws + WS_WD) + (size_t)D * FF * 2, (size_t)256 * FF * 2, MPb, (size_t)256 * D, 256, D};
            pg8::gemm_phase<pg8::EpiStoreSig, pg8::GSched, true>(lds, FF, FF, FF, S, pg8::EpiStoreSig{nullptr});
             }
        SEAMX(14, handoff);
    }
    if (IN(15)) { REPS(15) {
        row_phase<true, false, false>(nullptr, nullptr, XB, MPb, X, nullptr, mod + 3 * 6144 + 5 * D, norm_g + 7 * D, nullptr, nullptr, nullptr, handoff ? cntb + 3 * CNT_SEAM : nullptr, handoff ? (const bf16_t*)(ws + WS_MP2) : nullptr); }
    }
    if (PROBE_PHASE >= 0 && blockIdx.x == 0) { if (PROBE_PHASE == 15) pt1 = __builtin_amdgcn_s_memrealtime();
        const unsigned long long tend = __builtin_amdgcn_s_memrealtime(), wait = 9ull * (pt1 - pt0);
        while (__builtin_amdgcn_s_memrealtime() - tend < wait) __builtin_amdgcn_s_sleep(8); }
#undef IN
#undef SEAM
}

constexpr int LDS_BYTES = 147456;
extern "C" void kernel_launch(void* const* d_in, const int* in_sizes, int n_in, void* d_out, int out_size, void* d_ws, size_t ws_size, hipStream_t stream) {
    static int grid = 0;
    if (grid == 0) {
        int dev = 0, cus = 0, per_cu = 0;
        hipGetDevice(&dev);
        hipDeviceGetAttribute(&cus, hipDeviceAttributeMultiprocessorCount, dev);
        if (hipFuncSetAttribute((const void*)mega_fwd, hipFuncAttributeMaxDynamicSharedMemorySize, LDS_BYTES) != hipSuccess) fprintf(stderr, "kernel_launch: hipFuncSetAttribute failed\n");
        if (hipOccupancyMaxActiveBlocksPerMultiprocessor(&per_cu, (const void*)mega_fwd, 512, LDS_BYTES) != hipSuccess || per_cu < 1) { fprintf(stderr, "kernel_launch: occupancy query says %d\n", per_cu); per_cu = 1; }
        (void)hipGetLastError();
        grid = cus * 1;
        if (n_in != 16 || ws_size < WS_END) { fprintf(stderr, "kernel_launch: unexpected n_in %d / ws %zu\n", n_in, ws_size); }
    }
    Params p{};
    (void)hipMemsetAsync((unsigned char*)d_ws, 0, WS_CTL + CTL_BYTES, stream);
    for (int i = 0; i < 16; ++i) p.in[i] = (const float*)d_in[i];
    p.out = (float*)d_out; p.ws = (unsigned char*)d_ws;
    if (MK_N_LAUNCHES == 1) {
        p.ph_lo = 0; p.ph_hi = NPHASE;
        void* args[] = {&p};
        hipError_t e = hipLaunchCooperativeKernel((const void*)mega_fwd, dim3(grid), dim3(512), args, LDS_BYTES, stream);
        if (e != hipSuccess) fprintf(stderr, "cooperative launch failed: %s (grid %d)\n", hipGetErrorString(e), grid);
    } else {
        for (int k = 0; k < NPHASE; ++k) { p.ph_lo = k; p.ph_hi = k + 1; hipLaunchKernelGGL(mega_fwd, dim3(grid), dim3(512), LDS_BYTES, stream, p); }
    }
}
```

```cpp
#include <hip/hip_runtime.h>
#include <hip/hip_cooperative_groups.h>
#include <cstdio>
#include <cstdint>
namespace cg = cooperative_groups;

#ifndef MK_N_LAUNCHES
#define MK_N_LAUNCHES 1
#endif

#define LAS __attribute__((address_space(3)))
typedef unsigned short bf16_t;
typedef short bf16x8 __attribute__((ext_vector_type(8)));
typedef float f32x2 __attribute__((ext_vector_type(2)));
typedef float f32x4 __attribute__((ext_vector_type(4)));
typedef float f32x16 __attribute__((ext_vector_type(16)));
typedef unsigned u32x2 __attribute__((ext_vector_type(2)));
typedef unsigned u32x4 __attribute__((ext_vector_type(4)));
typedef __bf16 bf16x2_t __attribute__((ext_vector_type(2)));

constexpr int D = 1024, NP = 8192, NS = 4096, M = NP + NS, SP = 256, SS = 2048, FF = 2816, NH = 16, HD = 64;
constexpr int NPHASE = 16;
constexpr size_t MiB = 1u << 20;
constexpr size_t WS_CTL = 160 * 1024, CTL_BYTES = 96 * 1024;
constexpr int CW_CNT = 4096, CNT_SEAM = 48 * 64;
constexpr size_t WS_MOD = 0, WS_CSCH = 256 * 1024, WS_TP = 512 * 1024, WS_WF = 1 * MiB, WS_WQKV = 3 * MiB,
                 WS_WO = 9 * MiB, WS_WGU = 11 * MiB, WS_WD = 33 * MiB, WS_H = 44 * MiB, WS_MP = 68 * MiB, WS_U = 92 * MiB, WS_R = 158 * MiB;
constexpr size_t WS_YTP = WS_U, WS_YTS = WS_U + 32 * MiB;
constexpr size_t WS_TS = WS_R, WS_F = WS_R + 16 * MiB;
constexpr size_t WS_Q = WS_R, WS_K = WS_R + 24 * MiB, WS_VT = WS_R + 48 * MiB;
constexpr size_t WS_XB = WS_R + 72 * MiB, WS_MP2 = WS_XB + 24 * MiB, WS_END = WS_MP2 + 1 * MiB;
constexpr size_t OUTB_KC = 0, OUTB_VC = 2 * MiB;
constexpr size_t OUT_X = 0, OUT_CK = (size_t)M * D, OUT_CV = OUT_CK + (size_t)NP * D;

struct Params {
    const float* in[16];
    float* out; unsigned char* ws;
    int ph_lo, ph_hi;
};

__device__ __forceinline__ unsigned pk2(float lo, float hi) { f32x2 v = {lo, hi}; bf16x2_t b = __builtin_convertvector(v, bf16x2_t); return __builtin_bit_cast(unsigned, b); }
__device__ __forceinline__ float bf_lo(unsigned w) { return __uint_as_float(w << 16); }
__device__ __forceinline__ float bf_hi(unsigned w) { return __uint_as_float(w & 0xffff0000u); }
template <int CTRL> __device__ __forceinline__ float dpp_mov(float v) { return __builtin_bit_cast(float, __builtin_amdgcn_mov_dpp(__builtin_bit_cast(int, v), CTRL, 0xf, 0xf, true)); }
__device__ __forceinline__ float wave_sum(float v) {
    v += dpp_mov<0xB1>(v); v += dpp_mov<0x4E>(v); v += dpp_mov<0x141>(v); v += dpp_mov<0x140>(v);
    { auto rr = __builtin_amdgcn_permlane16_swap(__float_as_uint(v), __float_as_uint(v), false, false); v = __uint_as_float(rr[0]) + __uint_as_float(rr[1]); }
    { auto rr = __builtin_amdgcn_permlane32_swap(__float_as_uint(v), __float_as_uint(v), false, false); v = __uint_as_float(rr[0]) + __uint_as_float(rr[1]); }
    return v;
}

namespace pg8 {
constexpr int BM = 256, BK = 64, HALF = 128, HTB = HALF * BK * 2, STAGE_BYTES = 8 * HTB;
__device__ __forceinline__ int lds_byte(int r, int c) { const int st = (r >> 4) * 2 + (c >> 5), rr = r & 15, cc = c & 31, ob = rr * 64 + cc * 2; return st * 1024 + (ob ^ (((ob >> 9) & 1) << 5)); }
__device__ __forceinline__ void stage_rc(int b, int& R, int& C) { const int st = b / 1024, sb = b % 1024, swz = sb ^ (((sb >> 9) & 1) << 5); R = (st >> 1) * 16 + swz / 64; C = (st & 1) * 32 + (swz % 64) / 2; }
__device__ __forceinline__ int perm32(int rho) { const int n = rho >> 4, i = rho & 15; return 8 * (i >> 2) + 4 * n + (i & 3); }

struct UnitDesc { const char* A; const char* B; bf16_t* out; int ldc; int aux; };

__device__ __forceinline__ void tile_order(int L, int nM, int nN, int& pm, int& pn) {
    const int nwg = nM * nN; int wgid = L;
    { const int q = nwg / 8, r = nwg % 8, xcd = wgid % 8, off = wgid / 8; wgid = (xcd < r ? xcd * (q + 1) : r * (q + 1) + (xcd - r) * q) + off; }
    const int nig = 8 * nN, gid = wgid / nig, fm = gid * 8, gsz = (nM - fm) < 8 ? (nM - fm) : 8;
    pm = fm + ((wgid % nig) % gsz); pn = (wgid % nig) / gsz;
}

template <class Epi, class Sched, bool ALIGN_EPI>
__device__ __forceinline__ void gemm_phase(LAS unsigned char* lds, const int lda, const int ldb, const int K, const Sched& S, const Epi& E) {
    const int tid = threadIdx.x, wid = __builtin_amdgcn_readfirstlane(tid >> 6), lane = tid & 63, wr = wid >> 2, wc = wid & 3, fr = lane & 15, fq = lane >> 4;
    const int nt = K / BK;
    unsigned voffA[2], voffB[2];
#pragma unroll
    for (int i = 0; i < 2; ++i) { int R, C; stage_rc(tid * 16 + i * 8192, R, C); const int Rb = (R & ~31) + perm32(R & 31);
        voffA[i] = (unsigned)(R * lda + C) * 2u; voffB[i] = (unsigned)(Rb * ldb + C) * 2u; }
    const size_t kstep = (size_t)(BK * 2);
    const size_t hstepA = (size_t)HALF * lda * 2, hstepB = (size_t)HALF * ldb * 2;
    const unsigned ldsw = (unsigned)wid * 1024u;
    const int aoff = lds_byte(wr * 64 + fr, fq * 8), boff = lds_byte(wc * 32 + fr, fq * 8);
#define PG8_SA(b, h) (((b) * 2 + (h)) * HTB)
#define PG8_SB(b, h) ((4 + (b) * 2 + (h)) * HTB)
#define PG8_STAGE(bufoff, gbase, voff) do { _Pragma("unroll") for (int _i = 0; _i < 2; ++_i) \
        __builtin_amdgcn_global_load_lds((const unsigned*)((const char*)(gbase) + (voff)[_i]), (LAS unsigned*)(lds + (bufoff) + ldsw + _i * 8192), 16, 0, 0); } while (0)
#define PG8_LDA(dst, b, h) do { _Pragma("unroll") for (int m = 0; m < 4; ++m) _Pragma("unroll") for (int k = 0; k < 2; ++k) dst[m][k] = *(const LAS bf16x8*)(lds + PG8_SA(b, h) + aoff + m * 2048 + k * 1024); } while (0)
#define PG8_LDB(dst, b, h) do { _Pragma("unroll") for (int n = 0; n < 2; ++n) _Pragma("unroll") for (int k = 0; k < 2; ++k) dst[n][k] = *(const LAS bf16x8*)(lds + PG8_SB(b, h) + boff + n * 2048 + k * 1024); } while (0)
#define PG8_MMA(ai, bj, At, Bt) do { __builtin_amdgcn_s_setprio(1); _Pragma("unroll") for (int m = 0; m < 4; ++m) _Pragma("unroll") for (int n = 0; n < 2; ++n) _Pragma("unroll") for (int k = 0; k < 2; ++k) \
        acc[ai][bj][m][n] = __builtin_amdgcn_mfma_f32_16x16x32_bf16(Bt[n][k], At[m][k], acc[ai][bj][m][n], 0, 0, 0); __builtin_amdgcn_s_setprio(0); } while (0)
#define PG8_WAIT_V(n) asm volatile("s_waitcnt vmcnt(" #n ")" ::: "memory")
#define PG8_WAIT_L(n) asm volatile("s_waitcnt lgkmcnt(" #n ")" ::: "memory")
#define PG8_BAR __builtin_amdgcn_s_barrier()
#define PG8_SCHED __builtin_amdgcn_sched_barrier(0)
    UnitDesc cur, nxt; int ui = 0;
    if (!S.next(0, cur)) return;
    f32x4 acc[2][2][4][2];
#pragma unroll
    for (int a = 0; a < 2; ++a)
#pragma unroll
        for (int b = 0; b < 2; ++b)
#pragma unroll
            for (int m = 0; m < 4; ++m)
#pragma unroll
                for (int n = 0; n < 2; ++n) acc[a][b][m][n] = (f32x4){0.f, 0.f, 0.f, 0.f};
    bf16x8 At[4][2], B0[2][2], B1[2][2];
    const char* cA = cur.A; const char* cB = cur.B;
    PG8_STAGE(PG8_SB(0, 0), cB, voffB); PG8_STAGE(PG8_SB(0, 1), cB + hstepB, voffB); PG8_STAGE(PG8_SA(0, 0), cA, voffA); PG8_STAGE(PG8_SA(0, 1), cA + hstepA, voffA);
    if (wr == 1) PG8_BAR;
    PG8_WAIT_V(2); PG8_BAR;
    PG8_STAGE(PG8_SB(1, 0), cB + kstep, voffB); PG8_STAGE(PG8_SA(1, 0), cA + kstep, voffA); PG8_STAGE(PG8_SB(1, 1), cB + hstepB + kstep, voffB);
    PG8_WAIT_V(6); PG8_BAR;
    for (;;) {
        const bool has_next = S.next(ui + 1, nxt);
        const char* nA = has_next ? nxt.A : cA; const char* nB = has_next ? nxt.B : cB;
#pragma unroll 1
        for (int t = 0; t < nt; t += 2) {
            const bool last = (t == nt - 2);
            const char* a1 = cA + (size_t)(t + 1) * kstep;
            const char* a2 = last ? nA : cA + (size_t)(t + 2) * kstep; const char* b2 = last ? nB : cB + (size_t)(t + 2) * kstep;
            const char* a3 = a2 + kstep; const char* b3 = b2 + kstep;
            PG8_LDB(B0, 0, 0); PG8_LDB(B1, 0, 1); PG8_SCHED; PG8_LDA(At, 0, 0); PG8_STAGE(PG8_SA(1, 1), a1 + hstepA, voffA);
            PG8_WAIT_V(8); PG8_WAIT_L(0); PG8_BAR; PG8_MMA(0, 0, At, B0); PG8_MMA(0, 1, At, B1); PG8_BAR; PG8_SCHED;
            PG8_LDA(At, 0, 1); PG8_STAGE(PG8_SB(0, 0), b2, voffB); PG8_STAGE(PG8_SB(0, 1), b2 + hstepB, voffB); PG8_STAGE(PG8_SA(0, 0), a2, voffA);
            PG8_WAIT_V(8); PG8_WAIT_L(0); PG8_BAR; PG8_MMA(1, 0, At, B0); PG8_MMA(1, 1, At, B1); PG8_BAR; PG8_SCHED;
            PG8_LDB(B0, 1, 0); PG8_LDB(B1, 1, 1); PG8_SCHED; PG8_LDA(At, 1, 0); PG8_STAGE(PG8_SA(0, 1), a2 + hstepA, voffA);
            PG8_WAIT_V(8); PG8_WAIT_L(0); PG8_BAR; PG8_MMA(0, 0, At, B0); PG8_MMA(0, 1, At, B1); PG8_BAR; PG8_SCHED;
            PG8_LDA(At, 1, 1); PG8_STAGE(PG8_SB(1, 0), b3, voffB); PG8_STAGE(PG8_SB(1, 1), b3 + hstepB, voffB); PG8_STAGE(PG8_SA(1, 0), a3, voffA);
            PG8_WAIT_V(8); PG8_WAIT_L(0); PG8_BAR; PG8_MMA(1, 0, At, B0); PG8_MMA(1, 1, At, B1); PG8_BAR; PG8_SCHED;
        }
        if constexpr (ALIGN_EPI) { if (wr == 0) PG8_BAR; }
        E(acc, cur, wr, wc, fr, fq);
        if (!has_next) break;
#pragma unroll
        for (int a = 0; a < 2; ++a)
#pragma unroll
            for (int b = 0; b < 2; ++b)
#pragma unroll
                for (int m = 0; m < 4; ++m)
#pragma unroll
                    for (int n = 0; n < 2; ++n) acc[a][b][m][n] = (f32x4){0.f, 0.f, 0.f, 0.f};
        cur = nxt; cA = nA; cB = nB; ++ui;
        if constexpr (ALIGN_EPI) { if (wr == 1) PG8_BAR; }
    }
    PG8_WAIT_V(0);
    if constexpr (!ALIGN_EPI) { if (wr == 0) PG8_BAR; }
    PG8_BAR;
#undef PG8_SA
#undef PG8_SB
#undef PG8_STAGE
#undef PG8_LDA
#undef PG8_LDB
#undef PG8_MMA
#undef PG8_WAIT_V
#undef PG8_WAIT_L
#undef PG8_BAR
#undef PG8_SCHED
}

struct EpiStore {
    __device__ __forceinline__ void operator()(const f32x4 (&acc)[2][2][4][2], const UnitDesc& u, int wr, int wc, int fr, int fq) const {
#pragma unroll
        for (int ai = 0; ai < 2; ++ai)
#pragma unroll
            for (int m = 0; m < 4; ++m) { bf16_t* rowp = u.out + (size_t)(ai * HALF + wr * 64 + m * 16 + fr) * u.ldc + wc * 32 + 8 * fq;
#pragma unroll
                for (int bj = 0; bj < 2; ++bj) { const f32x4 v0 = acc[ai][bj][m][0], v1 = acc[ai][bj][m][1];
                    u32x4 w; w.x = pk2(v0[0], v0[1]); w.y = pk2(v0[2], v0[3]); w.z = pk2(v1[0], v1[1]); w.w = pk2(v1[2], v1[3]);
                    *(u32x4*)(rowp + bj * HALF) = w; } }
    }
};
__device__ __forceinline__ void store16_sc1(void* ptr, u32x4 v) { asm volatile("global_store_dwordx4 %0, %1, off sc0 sc1\n\ts_nop 3" :: "v"(ptr), "v"(v) : "memory"); }
struct EpiStoreSig {
    unsigned* cnt;
    __device__ __forceinline__ void operator()(const f32x4 (&acc)[2][2][4][2], const UnitDesc& u, int wr, int wc, int fr, int fq) const {
#pragma unroll
        for (int ai = 0; ai < 2; ++ai)
#pragma unroll
            for (int m = 0; m < 4; ++m) { bf16_t* rowp = u.out + (size_t)(ai * HALF + wr * 64 + m * 16 + fr) * u.ldc + wc * 32 + 8 * fq;
#pragma unroll
                for (int bj = 0; bj < 2; ++bj) { const f32x4 v0 = acc[ai][bj][m][0], v1 = acc[ai][bj][m][1];
                    u32x4 w; w.x = pk2(v0[0], v0[1]); w.y = pk2(v0[2], v0[3]); w.z = pk2(v1[0], v1[1]); w.w = pk2(v1[2], v1[3]);
                    if (cnt) store16_sc1(rowp + bj * HALF, w); else *(u32x4*)(rowp + bj * HALF) = w; } }
        if (cnt) { asm volatile("s_waitcnt vmcnt(0)" ::: "memory");
            if ((threadIdx.x & 63) == 0) __hip_atomic_fetch_add(cnt + (u.aux & 0xffff) * 64, 1u, __ATOMIC_RELAXED, __HIP_MEMORY_SCOPE_AGENT); }
    }
};
__device__ __forceinline__ float swiglu1(float g, float u) { return g * u * __builtin_amdgcn_rcpf(1.0f + __builtin_amdgcn_exp2f(-1.4426950408889634f * g)); }
struct EpiSwiGLU {
    unsigned* cnt;
    __device__ __forceinline__ void operator()(const f32x4 (&acc)[2][2][4][2], const UnitDesc& u, int wr, int wc, int fr, int fq) const {
#pragma unroll
        for (int ai = 0; ai < 2; ++ai)
#pragma unroll
            for (int m = 0; m < 4; ++m) { bf16_t* rowp = u.out + (size_t)(ai * HALF + wr * 64 + m * 16 + fr) * u.ldc + wc * 32 + 8 * fq;
                const f32x4 g0 = acc[ai][0][m][0], g1 = acc[ai][0][m][1], u0 = acc[ai][1][m][0], u1 = acc[ai][1][m][1];
                u32x4 w; w.x = pk2(swiglu1(g0[0], u0[0]), swiglu1(g0[1], u0[1])); w.y = pk2(swiglu1(g0[2], u0[2]), swiglu1(g0[3], u0[3]));
                w.z = pk2(swiglu1(g1[0], u1[0]), swiglu1(g1[1], u1[1])); w.w = pk2(swiglu1(g1[2], u1[2]), swiglu1(g1[3], u1[3]));
                if (cnt) store16_sc1(rowp, w); else *(u32x4*)rowp = w; }
        if (cnt) { asm volatile("s_waitcnt vmcnt(0)" ::: "memory");
            if ((threadIdx.x & 63) == 0) __hip_atomic_fetch_add(cnt + (u.aux & 0xffff) * 64, 1u, __ATOMIC_RELAXED, __HIP_MEMORY_SCOPE_AGENT); }
    }
};
struct EpiQKV {
    bf16_t* Q; bf16_t* Kb; bf16_t* Vb; float* ck; float* cv; unsigned* cnt;
    __device__ __forceinline__ void operator()(const f32x4 (&acc)[2][2][4][2], const UnitDesc& u, int wr, int wc, int fr, int fq) const {
        const int pm = u.aux & 0xffff, pn = u.aux >> 16, sel = pn >> 2, ct = (pn & 3) * BM;
        const int row0 = pm * BM + wr * 64 + fr, col0 = ct + wc * 32 + 8 * fq;
        bf16_t* base = Q + (size_t)sel * (size_t)(12 * 1024 * 1024); float* cb = ck + (size_t)(sel >= 1 ? sel - 1 : 0) * (size_t)NP * D;
        const bool wc32 = sel >= 1 && pm < NP / BM;
#pragma unroll
        for (int ai = 0; ai < 2; ++ai)
#pragma unroll
            for (int m = 0; m < 4; ++m) { const size_t off = (size_t)(row0 + ai * HALF + m * 16) * D + col0;
#pragma unroll
                for (int bj = 0; bj < 2; ++bj) { const f32x4 v0 = acc[ai][bj][m][0], v1 = acc[ai][bj][m][1];
                    u32x4 w; w.x = pk2(v0[0], v0[1]); w.y = pk2(v0[2], v0[3]); w.z = pk2(v1[0], v1[1]); w.w = pk2(v1[2], v1[3]);
                    if (cnt) store16_sc1(base + off + bj * HALF, w); else *(u32x4*)(base + off + bj * HALF) = w;
                    if (wc32) { *(f32x4*)(cb + off + bj * HALF) = v0; *(f32x4*)(cb + off + bj * HALF + 4) = v1; } } }
        if (cnt) { asm volatile("s_waitcnt vmcnt(0)" ::: "memory");
            if ((threadIdx.x & 63) == 0) __hip_atomic_fetch_add(cnt + pm * 64, 1u, __ATOMIC_RELAXED, __HIP_MEMORY_SCOPE_AGENT); }
    }
};

struct GSched {
    int nM, nN, G, c; const char* A; size_t a_tile; const char* B; size_t b_tile; bf16_t* out; size_t o_pm, o_pn; int ldc;
    __device__ __forceinline__ bool next(int i, UnitDesc& u) const {
        const long L = (long)i * G + c; if (L >= (long)nM * nN) return false;
        int pm, pn; tile_order((int)L, nM, nN, pm, pn);
        u.A = A + (size_t)pm * a_tile; u.B = B + (size_t)pn * b_tile; u.out = out + (size_t)pm * o_pm + (size_t)pn * o_pn; u.ldc = ldc; u.aux = pm | (pn << 16); return true;
    }
};
struct ChDftSched {
    int G, c; const char* cs_tab; const char* H; bf16_t* ytp; bf16_t* yts;
    __device__ __forceinline__ bool next(int i, UnitDesc& u) const {
        const long L = (long)i * G + c; if (L >= 48 * 8) return false;
        int tok, gc; tile_order((int)L, 48, 8, tok, gc); const int g = gc >> 1, cs = gc & 1;
        u.A = cs_tab + (size_t)cs * 256 * 256 * 2; u.B = H + ((size_t)tok * 256 * D + g * 256) * 2;
        if (tok < 32) { u.out = ytp + ((size_t)(tok * D + g * 256) * 512 + cs * 256); u.ldc = 512; }
        else { const int idx = tok - 32, b = idx >> 3, s0 = (idx & 7) * 256; u.out = yts + ((size_t)(b * D + g * 256) * 4096 + cs * 2048 + s0); u.ldc = 4096; }
        u.aux = 0; return true;
    }
};
struct SeqSSched {
    int c; const char* ts; const char* yts; bf16_t* F;
    __device__ __forceinline__ bool next(int i, UnitDesc& u) const {
        if (i > 0 || c >= 64) return false;
        const int b = c >> 5, pm = (c >> 2) & 7, pn = c & 3;
        u.A = ts + (size_t)pm * 256 * 4096 * 2; u.B = yts + (size_t)(b * D + pn * 256) * 4096 * 2;
        u.out = F + ((size_t)(NP + b * SS + pm * 256) * D + pn * 256); u.ldc = D; u.aux = 0; return true;
    }
};
struct SeqPSched {
    int G, c; const char* tp; const char* ytp; bf16_t* F;
    __device__ __forceinline__ bool next(int i, UnitDesc& u) const {
        const int G2 = G - 64; if (c < 64 || G2 <= 0) return false;
        const long L = (long)i * G2 + (c - 64); if (L >= 128) return false;
        const int b = (int)L >> 2, pn = (int)L & 3;
        u.A = tp; u.B = ytp + (size_t)(b * D + pn * 256) * 512 * 2;
        u.out = F + ((size_t)(b * 256) * D + pn * 256); u.ldc = D; u.aux = 0; return true;
    }
};
struct GuSched {
    int G, c; const char* A; const char* B; bf16_t* out;
    __device__ __forceinline__ bool next(int i, UnitDesc& u) const {
        const long L = (long)i * G + c; if (L >= 1056) return false;
        int pm, pn; if (L < 1012) tile_order((int)L, 46, 22, pm, pn); else { const int j = (int)L - 1012; pm = 46 + j / 22; pn = j % 22; }
        u.A = A + (size_t)pm * 256 * D * 2; u.B = B + (size_t)pn * 256 * D * 2; u.out = out + (size_t)pm * 256 * FF + (size_t)pn * 128; u.ldc = FF; u.aux = pm | (pn << 16); return true;
    }
};
struct DownSched {
    int d; const char* A; const char* B; bf16_t* out; bf16_t* out2;
    __device__ __forceinline__ void unit(int& pm, int& pn, int& kh) const { kh = 0; if (d < 184) tile_order(d, 46, 4, pm, pn); else { const int j = d - 184, un = j >> 1; kh = j & 1; pm = 46 + un / 4; pn = un % 4; } }
    __device__ __forceinline__ bool next(int i, UnitDesc& u) const {
        if (i > 0 || d < 0 || d >= 200) return false;
        int pm, pn, kh; unit(pm, pn, kh);
        u.A = A + (size_t)pm * 256 * FF * 2 + (size_t)kh * (FF / 2) * 2; u.B = B + (size_t)pn * 256 * FF * 2 + (size_t)kh * (FF / 2) * 2;
        u.out = kh ? out2 + (size_t)(pm - 46) * 256 * D + (size_t)pn * 256 : out + (size_t)pm * 256 * D + (size_t)pn * 256; u.ldc = D; u.aux = pm | (pn << 16); return true;
    }
};
struct QkvSched {
    int G, c; const char* A; const char* B;
    __device__ __forceinline__ bool next(int i, UnitDesc& u) const {
        const long L = (long)i * G + c; if (L >= 576) return false;
        int pm, pn; if (L < 384) tile_order((int)L, 32, 12, pm, pn); else { tile_order((int)L - 384, 16, 12, pm, pn); pm += 32; }
        u.A = A + (size_t)pm * 256 * D * 2; u.B = B + (size_t)pn * 256 * D * 2; u.out = nullptr; u.ldc = D; u.aux = pm | (pn << 16); return true;
    }
};
}

constexpr int TI_L0 = 16 * 32 + 2 * 16 * 88 + 44 * 32, TI_ALL = 16 * 32 + 16 * 96 + 16 * 32 + 4 * 16 * 88 + 2 * 44 * 32;
struct TItem { const float* W; bf16_t* WT; int N, ldt, dst, k0, n0; };
__device__ __forceinline__ bool titem_decode(const Params& p, int it, TItem& t) {
    constexpr int I_F = 16 * 32, I_QKV = 16 * 96, I_O = 16 * 32, I_G = 16 * 88, I_D = 44 * 32;
    constexpr int NITEMS = I_F + I_QKV + I_O + 4 * I_G + 2 * I_D;
    if (it >= NITEMS) return false;
    unsigned char* ws = p.ws; int r = it; int mode = 0;
    if (r < I_F) { t.W = p.in[9]; t.N = D; t.ldt = D; t.WT = (bf16_t*)(ws + WS_WF); }
    else { r -= I_F; int l = 0; if (r >= 2 * I_G + I_D) { r -= 2 * I_G + I_D; l = 1; }
        if (r < I_G) { t.W = p.in[13] + (size_t)l * D * FF; t.N = FF; t.ldt = D; t.WT = (bf16_t*)(ws + WS_WGU) + (size_t)l * 2 * FF * D; mode = 1; }
        else if ((r -= I_G) < I_G) { t.W = p.in[14] + (size_t)l * D * FF; t.N = FF; t.ldt = D; t.WT = (bf16_t*)(ws + WS_WGU) + (size_t)l * 2 * FF * D; mode = 2; }
        else if ((r -= I_G) < I_D) { t.W = p.in[15] + (size_t)l * FF * D; t.N = D; t.ldt = FF; t.WT = (bf16_t*)(ws + WS_WD) + (size_t)l * D * FF; }
        else if ((r -= I_D) < I_QKV) { t.W = p.in[10]; t.N = 3 * D; t.ldt = D; t.WT = (bf16_t*)(ws + WS_WQKV); }
        else { r -= I_QKV; t.W = p.in[12]; t.N = D; t.ldt = D; t.WT = (bf16_t*)(ws + WS_WO); } }
    const int nblk = t.N / 32, kb = r / nblk, nb = r % nblk; t.n0 = nb * 32; t.k0 = kb * 64;
    t.dst = t.n0; if (mode) t.dst = (t.n0 >> 7) * 256 + (t.n0 & 127) + (mode == 2 ? 128 : 0);
    return true;
}
__device__ __forceinline__ void titem_load(const TItem& t, f32x4 (&wv)[8], int lane) {
#pragma unroll
    for (int i = 0; i < 8; ++i) wv[i] = *(const f32x4*)(t.W + (size_t)(t.k0 + 8 * i + (lane >> 3)) * t.N + t.n0 + 4 * (lane & 7));
}
__device__ __forceinline__ void titem_finish(const TItem& t, const f32x4 (&wv)[8], LAS float* scr, int lane) {
#pragma unroll
    for (int i = 0; i < 8; ++i) { LAS float* d = scr + (8 * i + (lane >> 3)) * 33 + 4 * (lane & 7); d[0] = wv[i][0]; d[1] = wv[i][1]; d[2] = wv[i][2]; d[3] = wv[i][3]; }
    asm volatile("s_waitcnt lgkmcnt(0)" ::: "memory");
    const int c = lane & 7;
#pragma unroll
    for (int j = 0; j < 4; ++j) { const int n = (lane >> 3) + 8 * j; const LAS float* s = scr + (8 * c) * 33 + n;
        u32x4 o; o.x = pk2(s[0 * 33], s[1 * 33]); o.y = pk2(s[2 * 33], s[3 * 33]); o.z = pk2(s[4 * 33], s[5 * 33]); o.w = pk2(s[6 * 33], s[7 * 33]);
        *(u32x4*)(t.WT + (size_t)(t.dst + n) * t.ldt + t.k0 + 8 * c) = o; }
    asm volatile("s_waitcnt lgkmcnt(0)" ::: "memory");
}

__device__ __forceinline__ void gemv_layer(const Params& p, LAS unsigned char* lds, const int l, const int rb, const int nb) {
    const int tid = threadIdx.x;
    LAS float* sl = (LAS float*)lds;
    LAS f32x4* red = (LAS f32x4*)(lds + 12288);
    for (int i = tid; i < 3072; i += 512) { const int cond = i >> 10, k = i & 1023; const float v = cond == 0 ? p.in[5][k] : p.in[2][(cond - 1) * D + k]; sl[i] = v / (1.0f + __expf(-v)); }
    __syncthreads();
    float* mod = (float*)(p.ws + WS_MOD);
    for (int item = rb; item < 96; item += nb) {
        const int rem = item, cc = rem >> 4, kc = rem & 15, rpar = tid >> 8, col = cc * 1024 + 4 * (tid & 255);
        const float* W = p.in[6] + ((size_t)l * D + kc * 64 + rpar) * 6144 + col;
        f32x4 a0 = {0.f, 0.f, 0.f, 0.f}, a1 = a0, a2 = a0;
#pragma unroll
        for (int hf = 0; hf < 2; ++hf) {
            f32x4 w[16];
#pragma unroll
            for (int i = 0; i < 16; ++i) w[i] = *(const f32x4*)(W + (size_t)(32 * hf + 2 * i) * 6144);
#pragma unroll
            for (int i = 0; i < 16; ++i) { const int k = kc * 64 + 32 * hf + 2 * i + rpar; a0 += sl[k] * w[i]; a1 += sl[1024 + k] * w[i]; a2 += sl[2048 + k] * w[i]; }
        }
        if (rpar == 1) { red[tid - 256] = a0; red[256 + tid - 256] = a1; red[512 + tid - 256] = a2; }
        __syncthreads();
        if (rpar == 0) {
            a0 += red[tid]; a1 += red[256 + tid]; a2 += red[512 + tid];
            if (kc == 0) { const f32x4 bv = *(const f32x4*)(p.in[7] + l * 6144 + col); a0 += bv; a1 += bv; a2 += bv; }
#pragma unroll
            for (int j = 0; j < 4; ++j) {
                unsafeAtomicAdd(mod + (l * 3 + 0) * 6144 + col + j, a0[j]);
                unsafeAtomicAdd(mod + (l * 3 + 1) * 6144 + col + j, a1[j]);
                unsafeAtomicAdd(mod + (l * 3 + 2) * 6144 + col + j, a2[j]); }
        }
        __syncthreads();
    }
}
__device__ __forceinline__ void transpose_jobs(const Params& p, LAS unsigned char* lds, int gw, int NGW, int it_lo, int it_hi) {
    const int lane = threadIdx.x & 63, wave = threadIdx.x >> 6;
    LAS float* scr = (LAS float*)(lds + wave * 8448);
    TItem cur, nxt; f32x4 wa[8], wb[8];
    int it = it_lo + gw;
    bool have = it < it_hi && titem_decode(p, it, cur);
    if (have) titem_load(cur, wa, lane);
    while (have) {
        const bool hn = it + NGW < it_hi && titem_decode(p, it + NGW, nxt);
        if (hn) titem_load(nxt, wb, lane);
        titem_finish(cur, wa, scr, lane);
        if (!hn) break;
        it += 2 * NGW;
        have = it < it_hi && titem_decode(p, it, cur);
        if (have) titem_load(cur, wa, lane);
        titem_finish(nxt, wb, scr, lane);
    }
}
__device__ __forceinline__ void phase_prologue(const Params& p, LAS unsigned char* lds) {
    const int tid = threadIdx.x, G = gridDim.x, bx = blockIdx.x;
    unsigned char* ws = p.ws;
    LAS float* ct = (LAS float*)(lds + 32768);
    for (int i = tid; i < 2048; i += 512) ct[i] = cospif((float)i * (1.0f / 1024.0f));
    const bool sep = G >= 192;
    if (!sep || bx < 96) gemv_layer(p, lds, 0, bx, sep ? 96 : G);
    if (sep && bx < 96) return;
    const int gt = (sep ? bx - 96 : bx) * 512 + tid, GT = (sep ? G - 96 : G) * 512;
    for (int i = gt; i < 2 * 2 * 512 * D / 8; i += GT) { const int which = i >= 2 * 512 * D / 8; const int ii = which ? i - 2 * 512 * D / 8 : i;
        const f32x4* src = (const f32x4*)p.in[which ? 4 : 3]; const f32x4 a = src[2 * ii], b = src[2 * ii + 1];
        u32x4 o; o.x = pk2(a[0], a[1]); o.y = pk2(a[2], a[3]); o.z = pk2(b[0], b[1]); o.w = pk2(b[2], b[3]); ((u32x4*)((unsigned char*)p.out + (which ? OUTB_VC : OUTB_KC)))[ii] = o; }
    for (int i = gt; i < 512 * 256 / 8; i += GT) { const int row = i >> 5, c0 = (i & 31) * 8, cs = row >> 8, m = row & 255; float v[8];
#pragma unroll
        for (int j = 0; j < 8; ++j) { const int idx = ((m * (c0 + j)) & 255) * 8; v[j] = ct[(idx - (cs ? 512 : 0)) & 2047]; }
        u32x4 o; o.x = pk2(v[0], v[1]); o.y = pk2(v[2], v[3]); o.z = pk2(v[4], v[5]); o.w = pk2(v[6], v[7]); ((u32x4*)(ws + WS_CSCH))[i] = o; }
    for (int i = gt; i < 256 * 512 / 8; i += GT) { const int k = i >> 6, c0 = (i & 63) * 8; float v[8];
#pragma unroll
        for (int j = 0; j < 8; ++j) { const int kk = c0 + j, sidx = kk & 255; const int idx = ((k * sidx) & 255) * 8; v[j] = kk < 256 ? ct[idx] : -ct[(idx - 512) & 2047]; }
        u32x4 o; o.x = pk2(v[0], v[1]); o.y = pk2(v[2], v[3]); o.z = pk2(v[4], v[5]); o.w = pk2(v[6], v[7]); ((u32x4*)(ws + WS_TP))[i] = o; }
    for (int i = gt; i < 2048 * 4096 / 8; i += GT) { const int k = i >> 9, c0 = (i & 511) * 8; float v[8];
#pragma unroll
        for (int j = 0; j < 8; ++j) { const int kk = c0 + j, sidx = kk & 2047; const int idx = (k * sidx) & 2047; v[j] = kk < 2048 ? ct[idx] : -ct[(idx - 512) & 2047]; }
        u32x4 o; o.x = pk2(v[0], v[1]); o.y = pk2(v[2], v[3]); o.z = pk2(v[4], v[5]); o.w = pk2(v[6], v[7]); ((u32x4*)(ws + WS_TS))[i] = o; }
}
__device__ __forceinline__ void phase_side_jobs(const Params& p, LAS unsigned char* lds, const int which) {
    if (which == 5) { if (blockIdx.x < 56) transpose_jobs(p, lds, blockIdx.x * 8 + (threadIdx.x >> 6), 56 * 8, TI_L0 + 3 * 1408, TI_L0 + 3 * 1408 + 1536); return; }
    if (which == 6) { if (blockIdx.x >= 64) { const int gw = (blockIdx.x - 64) * 8 + (threadIdx.x >> 6), ngw = (gridDim.x - 64) * 8;
        transpose_jobs(p, lds, gw, ngw, TI_L0 + 2 * 1408, TI_L0 + 3 * 1408); transpose_jobs(p, lds, gw, ngw, TI_L0 + 3 * 1408 + 1536, TI_ALL); } return; }
    if (which == 7) { if (blockIdx.x >= 192) transpose_jobs(p, lds, (blockIdx.x - 192) * 8 + (threadIdx.x >> 6), (gridDim.x - 192) * 8, TI_L0, TI_L0 + 2 * 1408); return; }
    const int G = gridDim.x, bx = blockIdx.x, first = which == 0 ? 64 : 192;
    const int nb = G > first ? G - first : G, b0 = G > first ? first : 0;
    if (bx < b0) return;
    const int rb = bx - b0;
    if (which == 0) transpose_jobs(p, lds, rb * 8 + (threadIdx.x >> 6), nb * 8, 0, TI_L0);
    else if (which == 1) gemv_layer(p, lds, 1, rb, nb);
    else transpose_jobs(p, lds, rb * 8 + (threadIdx.x >> 6), nb * 8, TI_L0, TI_ALL);
}

#ifndef ROW_WT
#define ROW_WT 0
#endif
__device__ __forceinline__ void store16_wt(void* ptr, u32x4 v) {
#if ROW_WT
    asm volatile("global_store_dwordx4 %0, %1, off sc0 sc1\n\ts_nop 3" :: "v"(ptr), "v"(v) : "memory");
#else
    *(u32x4*)ptr = v;
#endif
}
__device__ __forceinline__ void bf8_to_f32(const u32x4 w, f32x4& a, f32x4& b) { a = (f32x4){bf_lo(w.x), bf_hi(w.x), bf_lo(w.y), bf_hi(w.y)}; b = (f32x4){bf_lo(w.z), bf_hi(w.z), bf_lo(w.w), bf_hi(w.w)}; }
__device__ __forceinline__ u32x4 f32_to_bf8(const f32x4 a, const f32x4 b) { u32x4 w; w.x = pk2(a[0], a[1]); w.y = pk2(a[2], a[3]); w.z = pk2(b[0], b[1]); w.w = pk2(b[2], b[3]); return w; }
template <bool HAS_MP, bool HAS_NEXT, bool XIN_F32>
__device__ __forceinline__ void row_phase(const float* xin_p, const float* xin_s, bf16_t* XB, const bf16_t* mp, float* Yout, bf16_t* Hout,
                                          const float* gate, const float* gA, const float* gB, const float* sc, const float* sh, unsigned* cnt = nullptr, const bf16_t* mp2 = nullptr) {
    const int tid = threadIdx.x, lane = tid & 63, gw = blockIdx.x * 8 + (tid >> 6), NGW = gridDim.x * 8;
    if (cnt) {
        if (tid == 0) { const int p0 = (blockIdx.x * 48) >> 8, p1 = (blockIdx.x * 48 + 47) >> 8;
            for (int pp = p0; pp <= p1; ++pp) { unsigned sp = 0; while (__hip_atomic_load(cnt + pp * 64, __ATOMIC_RELAXED, __HIP_MEMORY_SCOPE_AGENT) < ((mp2 && pp >= 46) ? 64u : 32u)) { __builtin_amdgcn_s_sleep(2); if (++sp > (1u << 22)) break; } }
            __builtin_amdgcn_fence(__ATOMIC_ACQUIRE, "agent"); asm volatile("s_waitcnt vmcnt(0)" ::: "memory"); }
        __syncthreads();
    }
    constexpr int R = 3, RW = 6;
    int cur_cond = -1;
    f32x4 gga[4], gbs[4], shv[4];
    for (int rowb = gw * RW; rowb < M; rowb += NGW * RW)
    for (int row0 = rowb; row0 < rowb + RW; row0 += R) {
        f32x4 v[R][4]; u32x4 mw[R][2];
#pragma unroll
        for (int q = 0; q < R; ++q) { const int row = row0 + q;
            if constexpr (XIN_F32) { const float* xr = row < NP ? xin_p + (size_t)row * D : xin_s + (size_t)(row - NP) * D;
#pragma unroll
                for (int j = 0; j < 2; ++j) { v[q][2 * j] = *(const f32x4*)(xr + 8 * lane + 512 * j); v[q][2 * j + 1] = *(const f32x4*)(xr + 8 * lane + 512 * j + 4); }
            } else {
#pragma unroll
                for (int j = 0; j < 2; ++j) { const u32x4 w = *(const u32x4*)(XB + (size_t)row * D + 8 * lane + 512 * j); bf8_to_f32(w, v[q][2 * j], v[q][2 * j + 1]); }
            }
            if constexpr (HAS_MP) {
#pragma unroll
                for (int j = 0; j < 2; ++j) mw[q][j] = *(const u32x4*)(mp + (size_t)row * D + 8 * lane + 512 * j);
            } }
        u32x4 xo[R][2], ho[R][2];
#pragma unroll
        for (int q = 0; q < R; ++q) { const int row = row0 + q; const int cond = row < NP ? 0 : (row < NP + SS ? 1 : 2);
            if (cond != cur_cond) { cur_cond = cond;
#pragma unroll
                for (int j = 0; j < 4; ++j) { const int col = 8 * lane + 512 * (j >> 1) + 4 * (j & 1);
                    if constexpr (HAS_MP) gga[j] = *(const f32x4*)(gate + cond * 6144 + col) * *(const f32x4*)(gA + col);
                    if constexpr (HAS_NEXT) { gbs[j] = *(const f32x4*)(gB + col) * (1.0f + *(const f32x4*)(sc + cond * 6144 + col)); shv[j] = *(const f32x4*)(sh + cond * 6144 + col); } } }
            if constexpr (HAS_MP) {
                f32x4 mv[4]; float s = 0.f;
#pragma unroll
                for (int j = 0; j < 2; ++j) bf8_to_f32(mw[q][j], mv[2 * j], mv[2 * j + 1]);
                if (mp2 && row >= 46 * 256) {
#pragma unroll
                    for (int j = 0; j < 2; ++j) { f32x4 a, b; bf8_to_f32(*(const u32x4*)(mp2 + (size_t)(row - 46 * 256) * D + 8 * lane + 512 * j), a, b); mv[2 * j] += a; mv[2 * j + 1] += b; } }
#pragma unroll
                for (int j = 0; j < 4; ++j) s += (mv[j][0] * mv[j][0] + mv[j][1] * mv[j][1]) + (mv[j][2] * mv[j][2] + mv[j][3] * mv[j][3]);
                const float rstd = 1.0f / sqrtf(wave_sum(s) * (1.0f / D) + 1e-6f);
#pragma unroll
                for (int j = 0; j < 4; ++j) v[q][j] = v[q][j] + gga[j] * (mv[j] * rstd);
                if constexpr (HAS_NEXT) {
#pragma unroll
                    for (int j = 0; j < 2; ++j) xo[q][j] = f32_to_bf8(v[q][2 * j], v[q][2 * j + 1]);
                }
            }
            if constexpr (HAS_NEXT) {
                float s = 0.f;
#pragma unroll
                for (int j = 0; j < 4; ++j) s += (v[q][j][0] * v[q][j][0] + v[q][j][1] * v[q][j][1]) + (v[q][j][2] * v[q][j][2] + v[q][j][3] * v[q][j][3]);
                const float rstd = 1.0f / sqrtf(wave_sum(s) * (1.0f / D) + 1e-6f);
                f32x4 hh[4];
#pragma unroll
                for (int j = 0; j < 4; ++j) hh[j] = (v[q][j] * rstd) * gbs[j] + shv[j];
#pragma unroll
                for (int j = 0; j < 2; ++j) ho[q][j] = f32_to_bf8(hh[2 * j], hh[2 * j + 1]);
            } }
#pragma unroll
        for (int q = 0; q < R; ++q) { const int row = row0 + q;
            if constexpr (HAS_MP && !HAS_NEXT) {
#pragma unroll
                for (int j = 0; j < 4; ++j) *(f32x4*)(Yout + (size_t)row * D + 8 * lane + 512 * (j >> 1) + 4 * (j & 1)) = v[q][j];
            }
            if constexpr (HAS_MP && HAS_NEXT) {
#pragma unroll
                for (int j = 0; j < 2; ++j) store16_wt(XB + (size_t)row * D + 8 * lane + 512 * j, xo[q][j]);
            }
            if constexpr (HAS_NEXT) {
#pragma unroll
                for (int j = 0; j < 2; ++j) store16_wt(Hout + (size_t)row * D + 8 * lane + 512 * j, ho[q][j]);
            } }
    }
}

__device__ __forceinline__ void attn_phase(const Params& p, LAS unsigned char* lds, const int u_lo, const int u_hi, const int rb, const int nb) {
    const int tid = threadIdx.x, lane = tid & 63, wave = __builtin_amdgcn_readfirstlane(tid >> 6), r = lane & 31, hh = lane >> 5;
    unsigned char* ws = p.ws;
    const bf16_t* Qb = (const bf16_t*)(ws + WS_Q); const bf16_t* Kb = (const bf16_t*)(ws + WS_K); const bf16_t* Vb = (const bf16_t*)(ws + WS_VT);
    const bf16_t* Kc = (const bf16_t*)((const unsigned char*)p.out + OUTB_KC); const bf16_t* Vc = (const bf16_t*)((const unsigned char*)p.out + OUTB_VC);
    bf16_t* Ob = (bf16_t*)(ws + WS_H);
    LAS float* Bl = (LAS float*)(lds + 36864 + 512);
    const int srow = tid >> 3, sch = tid & 7, krho = (srow & ~12) | ((srow & 4) << 1) | ((srow & 8) >> 1);
    const float c2 = 0.125f * 1.4426950408889634f;
    for (int unit = u_lo + rb; unit < u_hi; unit += nb) {
        const bool is_na = unit < 256;
        int b, h, qtok, nt, jmin = 0, nloc = 0, rq = 0, half = 0, ktok0;
        if (is_na) { b = unit >> 7; h = (unit >> 3) & 15; const int r0 = (unit & 7) * 4; rq = r0 + (wave >> 1); half = wave & 1;
            jmin = min(max(r0 - 4, 0), 24); const int jmax = min(max(r0 - 1, 0), 24) + 7; nloc = jmax - jmin + 1; nt = nloc + 8;
            qtok = NP + b * SS + rq * 64 + half * 32 + r; ktok0 = NP + b * SS; }
        else { const int u2 = unit - 256; b = u2 >> 4; h = u2 & 15; nt = 4; qtok = b * SP + wave * 32 + r; ktok0 = b * SP; }
        const int rs = min(max(rq - 4, 0), 24);
        if (is_na) { for (int i = tid; i < 15 * 32; i += 512) { const int rr = i >> 5, x = i & 31; Bl[i] = x < 31 ? p.in[11][(h * 15 + rr) * 31 + x] * 1.4426950408889634f : 0.f; } }
        bf16x8 qf[4];
#pragma unroll
        for (int d0 = 0; d0 < 4; ++d0) qf[d0] = *(const bf16x8*)(Qb + (size_t)qtok * D + h * HD + d0 * 16 + hh * 8);
        f32x16 o0, o1;
#pragma unroll
        for (int i = 0; i < 16; ++i) { o0[i] = 0.f; o1[i] = 0.f; }
        float m_run = -1e30f, l_run = 0.f;
        u32x4 kreg, vreg;
#define ATT_LOAD(t) do { const int t_ = (t); size_t off_; const bf16_t* kb_; const bf16_t* vb_; \
            if (is_na && t_ >= nloc) { off_ = ((size_t)(b * 512 + (t_ - nloc) * 64 + srow)) * D + h * HD + sch * 8; kb_ = Kc; vb_ = Vc; } \
            else { off_ = (size_t)(ktok0 + (is_na ? (jmin + t_) * 64 : t_ * 64) + srow) * D + h * HD + sch * 8; kb_ = Kb; vb_ = Vb; } \
            kreg = *(const u32x4*)(kb_ + off_); vreg = *(const u32x4*)(vb_ + off_); } while (0)
#define ATT_STORE(buf) do { LAS unsigned char* kl_ = lds + (buf) * 18432; LAS unsigned char* vl_ = kl_ + 9216; \
            *(LAS u32x4*)(kl_ + krho * 144 + sch * 16) = kreg; \
            LAS bf16_t* vd_ = (LAS bf16_t*)(vl_ + (8 * sch) * 144 + srow * 2); \
            vd_[0 * 72] = (bf16_t)vreg.x; vd_[1 * 72] = (bf16_t)(vreg.x >> 16); vd_[2 * 72] = (bf16_t)vreg.y; vd_[3 * 72] = (bf16_t)(vreg.y >> 16); \
            vd_[4 * 72] = (bf16_t)vreg.z; vd_[5 * 72] = (bf16_t)(vreg.z >> 16); vd_[6 * 72] = (bf16_t)vreg.w; vd_[7 * 72] = (bf16_t)(vreg.w >> 16); } while (0)
        ATT_LOAD(0); ATT_STORE(0); if (nt > 1) ATT_LOAD(1);
        __syncthreads();
        for (int t = 0; t < nt; ++t) {
            if (t + 1 < nt) { ATT_STORE((t + 1) & 1); if (t + 2 < nt) ATT_LOAD(t + 2); }
            const bool local = is_na && t < nloc; const int j = jmin + t;
            if (!(local && (j < rs || j >= rs + 8))) {
                const LAS unsigned char* Kl = lds + (t & 1) * 18432; const LAS unsigned char* Vl = Kl + 9216;
                f32x16 p0, p1;
#pragma unroll
                for (int i = 0; i < 16; ++i) { p0[i] = 0.f; p1[i] = 0.f; }
#pragma unroll
                for (int d0 = 0; d0 < 4; ++d0) { const bf16x8 a0 = *(const LAS bf16x8*)(Kl + r * 144 + d0 * 32 + hh * 16), a1 = *(const LAS bf16x8*)(Kl + (32 + r) * 144 + d0 * 32 + hh * 16);
                    p0 = __builtin_amdgcn_mfma_f32_32x32x16_bf16(a0, qf[d0], p0, 0, 0, 0); p1 = __builtin_amdgcn_mfma_f32_32x32x16_bf16(a1, qf[d0], p1, 0, 0, 0); }
                float m_new, alpha;
                if (local) {
                    const int qc = half * 32 + r, cs = min(max(qc - 8, 0), 48);
                    const LAS float* bp = Bl + (j - rq + 7) * 32 + 8 * hh - qc + 15;
                    float bb0[16], bb1[16];
#pragma unroll
                    for (int i = 0; i < 16; ++i) { const int kc = 16 * (i >> 3) + (i & 7); bb0[i] = bp[kc]; bb1[i] = bp[kc + 32]; }
                    asm volatile("" : "+v"(bb0[0]), "+v"(bb0[1]), "+v"(bb0[2]), "+v"(bb0[3]), "+v"(bb0[4]), "+v"(bb0[5]), "+v"(bb0[6]), "+v"(bb0[7]));
                    asm volatile("" : "+v"(bb0[8]), "+v"(bb0[9]), "+v"(bb0[10]), "+v"(bb0[11]), "+v"(bb0[12]), "+v"(bb0[13]), "+v"(bb0[14]), "+v"(bb0[15]));
                    asm volatile("" : "+v"(bb1[0]), "+v"(bb1[1]), "+v"(bb1[2]), "+v"(bb1[3]), "+v"(bb1[4]), "+v"(bb1[5]), "+v"(bb1[6]), "+v"(bb1[7]));
                    asm volatile("" : "+v"(bb1[8]), "+v"(bb1[9]), "+v"(bb1[10]), "+v"(bb1[11]), "+v"(bb1[12]), "+v"(bb1[13]), "+v"(bb1[14]), "+v"(bb1[15]));
                    const unsigned sh0 = (unsigned)(8 * hh - cs);
#pragma unroll
                    for (int i = 0; i < 16; ++i) { const int kc = 16 * (i >> 3) + (i & 7);
                        const float s0 = __builtin_fmaf(p0[i], c2, bb0[i]), s1 = __builtin_fmaf(p1[i], c2, bb1[i]);
                        p0[i] = (sh0 + (unsigned)kc) < 16u ? s0 : -1e30f; p1[i] = (sh0 + (unsigned)(kc + 32)) < 16u ? s1 : -1e30f; }
                    float mt = fmaxf(p0[0], p1[0]);
#pragma unroll
                    for (int i = 1; i < 16; ++i) mt = fmaxf(mt, fmaxf(p0[i], p1[i]));
                    mt = fmaxf(mt, __shfl_xor(mt, 32));
                    m_new = fmaxf(m_run, mt); alpha = __builtin_amdgcn_exp2f(m_run - m_new);
#pragma unroll
                    for (int i = 0; i < 16; ++i) { p0[i] = __builtin_amdgcn_exp2f(p0[i] - m_new); p1[i] = __builtin_amdgcn_exp2f(p1[i] - m_new); }
                } else {
                    float mt = fmaxf(p0[0], p1[0]);
#pragma unroll
                    for (int i = 1; i < 16; ++i) mt = fmaxf(mt, fmaxf(p0[i], p1[i]));
                    mt = fmaxf(mt, __shfl_xor(mt, 32)) * c2;
                    m_new = fmaxf(m_run, mt); alpha = __builtin_amdgcn_exp2f(m_run - m_new);
#pragma unroll
                    for (int i = 0; i < 16; ++i) { p0[i] = __builtin_amdgcn_exp2f(__builtin_fmaf(p0[i], c2, -m_new)); p1[i] = __builtin_amdgcn_exp2f(__builtin_fmaf(p1[i], c2, -m_new)); }
                }
                m_run = m_new;
                float ls = 0.f;
#pragma unroll
                for (int i = 0; i < 16; ++i) ls += p0[i] + p1[i];
                l_run = l_run * alpha + ls;
#pragma unroll
                for (int i = 0; i < 16; ++i) { o0[i] *= alpha; o1[i] *= alpha; }
                bf16x8 pa[4];
#pragma unroll
                for (int s2 = 0; s2 < 2; ++s2) { u32x4 w; w.x = pk2(p0[8 * s2], p0[8 * s2 + 1]); w.y = pk2(p0[8 * s2 + 2], p0[8 * s2 + 3]); w.z = pk2(p0[8 * s2 + 4], p0[8 * s2 + 5]); w.w = pk2(p0[8 * s2 + 6], p0[8 * s2 + 7]); pa[s2] = __builtin_bit_cast(bf16x8, w);
                    u32x4 w2; w2.x = pk2(p1[8 * s2], p1[8 * s2 + 1]); w2.y = pk2(p1[8 * s2 + 2], p1[8 * s2 + 3]); w2.z = pk2(p1[8 * s2 + 4], p1[8 * s2 + 5]); w2.w = pk2(p1[8 * s2 + 6], p1[8 * s2 + 7]); pa[2 + s2] = __builtin_bit_cast(bf16x8, w2); }
#pragma unroll
                for (int s2 = 0; s2 < 4; ++s2) { const bf16x8 v0 = *(const LAS bf16x8*)(Vl + r * 144 + s2 * 32 + hh * 16), v1 = *(const LAS bf16x8*)(Vl + (32 + r) * 144 + s2 * 32 + hh * 16);
                    o0 = __builtin_amdgcn_mfma_f32_32x32x16_bf16(v0, pa[s2], o0, 0, 0, 0); o1 = __builtin_amdgcn_mfma_f32_32x32x16_bf16(v1, pa[s2], o1, 0, 0, 0); }
            }
            __syncthreads();
        }
#undef ATT_LOAD
#undef ATT_STORE
        const float inv = 1.0f / (l_run + __shfl_xor(l_run, 32));
        bf16_t* orow = Ob + (size_t)qtok * D + h * HD + 4 * hh;
#pragma unroll
        for (int g = 0; g < 4; ++g) { u32x2 w; w.x = pk2(o0[4 * g] * inv, o0[4 * g + 1] * inv); w.y = pk2(o0[4 * g + 2] * inv, o0[4 * g + 3] * inv); *(u32x2*)(orow + 8 * g) = w;
            u32x2 w2; w2.x = pk2(o1[4 * g] * inv, o1[4 * g + 1] * inv); w2.y = pk2(o1[4 * g + 2] * inv, o1[4 * g + 3] * inv); *(u32x2*)(orow + 32 + 8 * g) = w2; }
    }
    __syncthreads();
}

#define XB_TMO      128
#define XB_XCNT(j)  (256  + 64 * (j))
#define XB_XSUB(j)  (1280 + 64 * (j))
#define XB_XGEN(j)  (2304 + 64 * (j))
#define XB_TOP      3328
#define XB_TOPGEN   3392
#define XCD_BAR_WORDS 3456
#define XB_SPIN_CAP (1u << 18)
__device__ __forceinline__ unsigned xb_ld(unsigned* p)              { return __hip_atomic_load(p, __ATOMIC_RELAXED, __HIP_MEMORY_SCOPE_AGENT); }
__device__ __forceinline__ unsigned xb_add(unsigned* p, unsigned v) { return __hip_atomic_fetch_add(p, v, __ATOMIC_RELAXED, __HIP_MEMORY_SCOPE_AGENT); }
__device__ __forceinline__ unsigned xb_xcc_id() { return (unsigned)__builtin_amdgcn_s_getreg((3 << 11) | 20) & 0xFu; }
#define XB_SPIN(cond, bar) do { unsigned _sp = 0; while (cond) { __builtin_amdgcn_s_sleep(1); \
    if ((++_sp & 255u) == 0u) { if (xb_ld(&(bar)[XB_TMO])) break; if (_sp > XB_SPIN_CAP) { atomicAdd(&(bar)[XB_TMO], 1u); break; } } } } while (0)
struct XcdBarrier { unsigned* bar; unsigned x; volatile LAS unsigned* st; };
__device__ __forceinline__ XcdBarrier xcd_barrier_post(unsigned* bar, volatile LAS unsigned* st) {
    XcdBarrier b; b.bar = bar; b.x = xb_xcc_id(); b.st = st;
    if (threadIdx.x == 0) (void)xb_add(&bar[XB_XCNT(b.x)], 1u);
    return b;
}
__device__ __forceinline__ void xcd_barrier_complete(unsigned* bar, unsigned x, unsigned& nloc, unsigned& nx) {
    const unsigned G = gridDim.x * gridDim.y * gridDim.z;
    unsigned sum, cnt, mine, sp = 0u;
    for (;;) {
        sum = 0u; cnt = 0u; mine = 0u;
#pragma unroll
        for (unsigned j = 0; j < 16; ++j) { const unsigned c = xb_ld(&bar[XB_XCNT(j)]); sum += c; cnt += (c > 0u) ? 1u : 0u; mine = (j == x) ? c : mine; }
        if (sum == G) break;
        __builtin_amdgcn_s_sleep(1);
        if ((++sp & 255u) == 0u) { if (xb_ld(&bar[XB_TMO])) break; if (sp > XB_SPIN_CAP) { atomicAdd(&bar[XB_TMO], 1u); break; } }
    }
    nloc = mine > 0u ? mine : 1u; nx = cnt > 0u ? cnt : 1u;
}
__device__ __forceinline__ void xcd_barrier(const XcdBarrier& b) {
    asm volatile("s_waitcnt vmcnt(0)" ::: "memory");
    __syncthreads();
    if (threadIdx.x == 0) {
        unsigned* bar = b.bar;
        __builtin_amdgcn_s_waitcnt(0);
        unsigned nloc = b.st[0], nx = b.st[1];
        if (nloc == 0u) { xcd_barrier_complete(bar, b.x, nloc, nx); b.st[0] = nloc; b.st[1] = nx; }
        const unsigned old = xb_add(&bar[XB_XSUB(b.x)], 1u);
        const unsigned gen = old / nloc;
        if (old + 1u == (gen + 1u) * nloc) {
            __builtin_amdgcn_fence(__ATOMIC_RELEASE, "agent");
            asm volatile("s_waitcnt vmcnt(0)" ::: "memory");
            const unsigned og = xb_add(&bar[XB_TOP], 1u);
            const unsigned tg = og / nx;
            if (og + 1u == (tg + 1u) * nx) xb_add(&bar[XB_TOPGEN], 1u);
            else XB_SPIN(xb_ld(&bar[XB_TOPGEN]) == tg, bar);
            __builtin_amdgcn_fence(__ATOMIC_ACQUIRE, "agent");
            xb_add(&bar[XB_XGEN(b.x)], 1u);
            asm volatile("s_waitcnt vmcnt(0)" ::: "memory");
        } else {
            XB_SPIN(xb_ld(&bar[XB_XGEN(b.x)]) == gen, bar);
            __builtin_amdgcn_fence(__ATOMIC_ACQUIRE, "agent");
            asm volatile("s_waitcnt vmcnt(0)" ::: "memory");
        }
    }
    __syncthreads();
}

__global__ void __launch_bounds__(512, 2) mega_fwd(Params p) {
    extern __shared__ __attribute__((aligned(16))) unsigned char lds_raw[];
    LAS unsigned char* lds = (LAS unsigned char*)lds_raw;
    unsigned char* ws = p.ws;
    const int G = gridDim.x, c = blockIdx.x, lo = p.ph_lo, hi = p.ph_hi;
    const float* mod = (const float*)(ws + WS_MOD);
    const float* norm_g = p.in[8];
    bf16_t* H = (bf16_t*)(ws + WS_H); bf16_t* MPb = (bf16_t*)(ws + WS_MP); bf16_t* U = (bf16_t*)(ws + WS_U);
    float* X = p.out + OUT_X; bf16_t* XB = (bf16_t*)(ws + WS_XB);
    volatile LAS unsigned* MISC = (volatile LAS unsigned*)(lds + 131072 + 320);
    if (threadIdx.x < 32) MISC[threadIdx.x] = 0u;
    __syncthreads();
    XcdBarrier bar; bar.bar = (unsigned*)(ws + WS_CTL); bar.x = 0; bar.st = nullptr;
    if (hi - lo > 1) bar = xcd_barrier_post((unsigned*)(ws + WS_CTL), MISC + 8);
    if (hi > 1000) cg::this_grid().sync();
#ifndef PH_MASK
#define PH_MASK 0xffff
#endif
#define IN(k) (((PH_MASK >> (k)) & 1) && lo <= (k) && (k) < hi)
    const bool handoff = (G == 256) && (hi - lo > 1);
    unsigned* const cntb = (unsigned*)(ws + WS_CTL) + CW_CNT;
#ifndef PROBE_REP
#define PROBE_REP -1
#endif
#ifndef PROBE_SYNC2
#define PROBE_SYNC2 0
#endif
#define REPS(k) for (int rep_ = 0; rep_ < ((k) == PROBE_REP ? 2 : 1); ++rep_)
#ifndef PROBE_PHASE
#define PROBE_PHASE -1
#endif
    unsigned long long pt0 = 0, pt1 = 0;
    if (PROBE_PHASE == 0) pt0 = __builtin_amdgcn_s_memrealtime();
#define SEAM(k) SEAMX(k, false)
#define SEAMX(k, skip) do { if ((k) + 1 < hi && !(skip)) { xcd_barrier(bar); if (PROBE_SYNC2) xcd_barrier(bar); } \
        if ((k) == PROBE_PHASE) pt1 = __builtin_amdgcn_s_memrealtime(); if ((k) + 1 == PROBE_PHASE) pt0 = __builtin_amdgcn_s_memrealtime(); } while (0)

    if (IN(0)) { REPS(0) { phase_prologue(p, lds); } SEAM(0); }
    if (IN(1)) { REPS(1) {
        row_phase<false, true, true>(p.in[0], p.in[1], nullptr, nullptr, nullptr, H, nullptr, nullptr, norm_g, mod + 1 * D, mod + 0 * D);
        } SEAM(1);
    }
    if (IN(2)) { REPS(2) {
        pg8::ChDftSched S{G, c, (const char*)(ws + WS_CSCH), (const char*)H, (bf16_t*)(ws + WS_YTP), (bf16_t*)(ws + WS_YTS)};
        pg8::gemm_phase<pg8::EpiStore, pg8::ChDftSched, true>(lds, 256, D, 256, S, pg8::EpiStore{});
        } SEAM(2);
    }
    if (IN(3)) { REPS(3) {
        { pg8::SeqSSched S{c, (const char*)(ws + WS_TS), (const char*)(ws + WS_YTS), (bf16_t*)(ws + WS_F)};
          pg8::gemm_phase<pg8::EpiStore, pg8::SeqSSched, true>(lds, 4096, 4096, 4096, S, pg8::EpiStore{}); }
        { pg8::SeqPSched S{G, c, (const char*)(ws + WS_TP), (const char*)(ws + WS_YTP), (bf16_t*)(ws + WS_F)};
          pg8::gemm_phase<pg8::EpiStore, pg8::SeqPSched, true>(lds, 512, 512, 512, S, pg8::EpiStore{}); }
        phase_side_jobs(p, lds, 0);
        } SEAM(3);
    }
    if (IN(4)) { REPS(4) {
        pg8::GSched S{48, 4, G, c, (const char*)(ws + WS_F), (size_t)256 * D * 2, (const char*)(ws + WS_WF), (size_t)256 * D * 2, MPb, (size_t)256 * D, 256, D};
        pg8::gemm_phase<pg8::EpiStoreSig, pg8::GSched, true>(lds, D, D, D, S, pg8::EpiStoreSig{handoff ? cntb + 0 * CNT_SEAM : nullptr});
        phase_side_jobs(p, lds, 1);
        } SEAMX(4, handoff);
    }
    if (IN(5)) { REPS(5) {
        row_phase<true, true, true>(p.in[0], p.in[1], XB, MPb, nullptr, H, mod + 2 * D, norm_g + 1 * D, norm_g + 2 * D, mod + 4 * D, mod + 3 * D, handoff ? cntb + 0 * CNT_SEAM : nullptr);
        } SEAM(5);
    }
    if (IN(6)) {
        if (handoff) { pg8::GuSched S{G, c, (const char*)H, (const char*)(ws + WS_WGU), U};
            pg8::gemm_phase<pg8::EpiSwiGLU, pg8::GuSched, true>(lds, D, D, D, S, pg8::EpiSwiGLU{cntb + 4 * CNT_SEAM}); }
        else { pg8::GSched S{48, 22, G, c, (const char*)H, (size_t)256 * D * 2, (const char*)(ws + WS_WGU), (size_t)256 * D * 2, U, (size_t)256 * FF, 128, FF};
            pg8::gemm_phase<pg8::EpiSwiGLU, pg8::GSched, true>(lds, D, D, D, S, pg8::EpiSwiGLU{nullptr}); }
        SEAMX(6, handoff);
    }
    if (IN(7)) {
        if (handoff) {
            const int dd = c >= 248 ? 184 + (c - 248) : (c >= 64 ? c - 64 : (c >= 56 ? 192 + (c - 56) : -1));
            if (dd >= 0) { pg8::DownSched S{dd, (const char*)U, (const char*)(ws + WS_WD), MPb, (bf16_t*)(ws + WS_MP2)};
                if (threadIdx.x == 0) { int pm, pn, kh; S.unit(pm, pn, kh); unsigned* w = cntb + 4 * CNT_SEAM + pm * 64; unsigned sp = 0;
                    while (__hip_atomic_load(w, __ATOMIC_RELAXED, __HIP_MEMORY_SCOPE_AGENT) < 176u) { __builtin_amdgcn_s_sleep(4); if (++sp > (1u << 22)) break; }
                    __builtin_amdgcn_fence(__ATOMIC_ACQUIRE, "agent"); asm volatile("s_waitcnt vmcnt(0)" ::: "memory"); }
                __syncthreads();
                if (dd < 184) pg8::gemm_phase<pg8::EpiStoreSig, pg8::DownSched, true>(lds, FF, FF, FF, S, pg8::EpiStoreSig{cntb + 1 * CNT_SEAM});
                else pg8::gemm_phase<pg8::EpiStoreSig, pg8::DownSched, true>(lds, FF, FF, FF / 2, S, pg8::EpiStoreSig{cntb + 1 * CNT_SEAM}); }
            else { phase_side_jobs(p, lds, 5); }
        } else { pg8::GSched S{48, 4, G, c, (const char*)U, (size_t)256 * FF * 2, (const char*)(ws + WS_WD), (size_t)256 * FF * 2, MPb, (size_t)256 * D, 256, D};
            pg8::gemm_phase<pg8::EpiStoreSig, pg8::GSched, true>(lds, FF, FF, FF, S, pg8::EpiStoreSig{nullptr});
            phase_side_jobs(p, lds, 2); }
        SEAMX(7, handoff);
    }
    if (IN(8)) { REPS(8) {
        row_phase<true, true, false>(nullptr, nullptr, XB, MPb, nullptr, H, mod + 5 * D, norm_g + 3 * D, norm_g + 4 * D, mod + 3 * 6144 + 1 * D, mod + 3 * 6144 + 0 * D, handoff ? cntb + 1 * CNT_SEAM : nullptr, handoff ? (const bf16_t*)(ws + WS_MP2) : nullptr);
        } SEAM(8);
    }
    if (IN(9)) {
        unsigned* const cq = cntb + 16;
        pg8::EpiQKV E{(bf16_t*)(ws + WS_Q), (bf16_t*)(ws + WS_K), (bf16_t*)(ws + WS_VT), p.out + OUT_CK, p.out + OUT_CV, handoff ? cq : nullptr};
        if (handoff) {
            { pg8::QkvSched S{G, c, (const char*)H, (const char*)(ws + WS_WQKV)};
              pg8::gemm_phase<pg8::EpiQKV, pg8::QkvSched, true>(lds, D, D, D, S, E); }
            if (c >= 64) {
                if (threadIdx.x == 0) { for (int u = 256 + (c - 64); u < 768; u += 192) { unsigned* w = cq + ((u - 256) >> 4) * 64; unsigned sp = 0;
                        while (__hip_atomic_load(w, __ATOMIC_RELAXED, __HIP_MEMORY_SCOPE_AGENT) < 96u) { __builtin_amdgcn_s_sleep(4); if (++sp > (1u << 22)) break; } }
                    __builtin_amdgcn_fence(__ATOMIC_ACQUIRE, "agent"); asm volatile("s_waitcnt vmcnt(0)" ::: "memory"); }
                __syncthreads();
                attn_phase(p, lds, 256, 768, c - 64, 192);
            }
            if (threadIdx.x == 0) { for (int pp = 32 + 8 * (c >> 7); pp < 40 + 8 * (c >> 7); ++pp) { unsigned* w = cq + pp * 64; unsigned sp = 0;
                    while (__hip_atomic_load(w, __ATOMIC_RELAXED, __HIP_MEMORY_SCOPE_AGENT) < 96u) { __builtin_amdgcn_s_sleep(4); if (++sp > (1u << 22)) break; } }
                __builtin_amdgcn_fence(__ATOMIC_ACQUIRE, "agent"); asm volatile("s_waitcnt vmcnt(0)" ::: "memory"); }
            __syncthreads();
            attn_phase(p, lds, c, c + 1, 0, 1);
            if (c < 64) { const int gw = c * 8 + (threadIdx.x >> 6);
                transpose_jobs(p, lds, gw, 64 * 8, TI_L0 + 2 * 1408, TI_L0 + 3 * 1408); transpose_jobs(p, lds, gw, 64 * 8, TI_L0 + 3 * 1408 + 1536, TI_ALL); }
        } else {
            pg8::GSched S{48, 12, G, c, (const char*)H, (size_t)256 * D * 2, (const char*)(ws + WS_WQKV), (size_t)256 * D * 2, nullptr, 0, 0, D};
            pg8::gemm_phase<pg8::EpiQKV, pg8::GSched, true>(lds, D, D, D, S, E);
        }
        SEAMX(9, handoff);
    }
    if (IN(10)) { if (!handoff) attn_phase(p, lds, 0, 768, c, G); SEAM(10); }
    if (IN(11)) { REPS(11) {
        pg8::GSched S{48, 4, G, c, (const char*)H, (size_t)256 * D * 2, (const char*)(ws + WS_WO), (size_t)256 * D * 2, MPb, (size_t)256 * D, 256, D};
        pg8::gemm_phase<pg8::EpiStoreSig, pg8::GSched, true>(lds, D, D, D, S, pg8::EpiStoreSig{handoff ? cntb + 2 * CNT_SEAM : nullptr});
        if (handoff) phase_side_jobs(p, lds, 7);
        } SEAMX(11, handoff);
    }
    if (IN(12)) { REPS(12) {
        row_phase<true, true, false>(nullptr, nullptr, XB, MPb, nullptr, H, mod + 3 * 6144 + 2 * D, norm_g + 5 * D, norm_g + 6 * D, mod + 3 * 6144 + 4 * D, mod + 3 * 6144 + 3 * D, handoff ? cntb + 2 * CNT_SEAM : nullptr);
        } SEAM(12);
    }
    if (IN(13)) {
        if (handoff) { pg8::GuSched S{G, c, (const char*)H, (const char*)(ws + WS_WGU) + (size_t)2 * FF * D * 2, U};
            pg8::gemm_phase<pg8::EpiSwiGLU, pg8::GuSched, true>(lds, D, D, D, S, pg8::EpiSwiGLU{cntb + 5 * CNT_SEAM}); }
        else { pg8::GSched S{48, 22, G, c, (const char*)H, (size_t)256 * D * 2, (const char*)(ws + WS_WGU) + (size_t)2 * FF * D * 2, (size_t)256 * D * 2, U, (size_t)256 * FF, 128, FF};
            pg8::gemm_phase<pg8::EpiSwiGLU, pg8::GSched, true>(lds, D, D, D, S, pg8::EpiSwiGLU{nullptr}); }
        SEAMX(13, handoff);
    }
    if (IN(14)) {
        if (handoff) {
            const int dd = c >= 248 ? 184 + (c - 248) : (c >= 64 ? c - 64 : (c >= 56 ? 192 + (c - 56) : -1));
            if (dd >= 0) { pg8::DownSched S{dd, (const char*)U, (const char*)(ws + WS_WD) + (size_t)D * FF * 2, MPb, (bf16_t*)(ws + WS_MP2)};
                if (threadIdx.x == 0) { int pm, pn, kh; S.unit(pm, pn, kh); unsigned* w = cntb + 5 * CNT_SEAM + pm * 64; unsigned sp = 0;
                    while (__hip_atomic_load(w, __ATOMIC_RELAXED, __HIP_MEMORY_SCOPE_AGENT) < 176u) { __builtin_amdgcn_s_sleep(4); if (++sp > (1u << 22)) break; }
                    __builtin_amdgcn_fence(__ATOMIC_ACQUIRE, "agent"); asm volatile("s_waitcnt vmcnt(0)" ::: "memory"); }
                __syncthreads();
                if (dd < 184) pg8::gemm_phase<pg8::EpiStoreSig, pg8::DownSched, true>(lds, FF, FF, FF, S, pg8::EpiStoreSig{cntb + 3 * CNT_SEAM});
                else pg8::gemm_phase<pg8::EpiStoreSig, pg8::DownSched, true>(lds, FF, FF, FF / 2, S, pg8::EpiStoreSig{cntb + 3 * CNT_SEAM}); }
            else {  }
        } else { pg8::GSched S{48, 4, G, c, (const char*)U, (size_t)256 * FF * 2, (const char*)(ws + WS_WD) + (size_t)D * FF * 2, (size_t)256 * FF * 2, MPb, (size_t)256 * D, 256, D};
            pg8::gemm_phase<pg8::EpiStoreSig, pg8::GSched, true>(lds, FF, FF, FF, S, pg8::EpiStoreSig{nullptr});
             }
        SEAMX(14, handoff);
    }
    if (IN(15)) { REPS(15) {
        row_phase<true, false, false>(nullptr, nullptr, XB, MPb, X, nullptr, mod + 3 * 6144 + 5 * D, norm_g + 7 * D, nullptr, nullptr, nullptr, handoff ? cntb + 3 * CNT_SEAM : nullptr, handoff ? (const bf16_t*)(ws + WS_MP2) : nullptr); }
    }
    if (PROBE_PHASE >= 0 && blockIdx.x == 0) { if (PROBE_PHASE == 15) pt1 = __builtin_amdgcn_s_memrealtime();
        const unsigned long long tend = __builtin_amdgcn_s_memrealtime(), wait = 9ull * (pt1 - pt0);
        while (__builtin_amdgcn_s_memrealtime() - tend < wait) __builtin_amdgcn_s_sleep(8); }
#undef IN
#undef SEAM
}

constexpr int LDS_BYTES = 147456;
extern "C" void kernel_launch(void* const* d_in, const int* in_sizes, int n_in, void* d_out, int out_size, void* d_ws, size_t ws_size, hipStream_t stream) {
    static int grid = 0;
    if (grid == 0) {
        int dev = 0, cus = 0, per_cu = 0;
        hipGetDevice(&dev);
        hipDeviceGetAttribute(&cus, hipDeviceAttributeMultiprocessorCount, dev);
        if (hipFuncSetAttribute((const void*)mega_fwd, hipFuncAttributeMaxDynamicSharedMemorySize, LDS_BYTES) != hipSuccess) fprintf(stderr, "kernel_launch: hipFuncSetAttribute failed\n");
        if (hipOccupancyMaxActiveBlocksPerMultiprocessor(&per_cu, (const void*)mega_fwd, 512, LDS_BYTES) != hipSuccess || per_cu < 1) { fprintf(stderr, "kernel_launch: occupancy query says %d\n", per_cu); per_cu = 1; }
        (void)hipGetLastError();
        grid = cus * 1;
        if (n_in != 16 || ws_size < WS_END) { fprintf(stderr, "kernel_launch: unexpected n_in %d / ws %zu\n", n_in, ws_size); }
    }
    Params p{};
    (void)hipMemsetAsync((unsigned char*)d_ws, 0, WS_CTL + CTL_BYTES, stream);
    for (int i = 0; i < 16; ++i) p.in[i] = (const float*)d_in[i];
    p.out = (float*)d_out; p.ws = (unsigned char*)d_ws;
    if (MK_N_LAUNCHES == 1) {
        p.ph_lo = 0; p.ph_hi = NPHASE;
        void* args[] = {&p};
        hipError_t e = hipLaunchCooperativeKernel((const void*)mega_fwd, dim3(grid), dim3(512), args, LDS_BYTES, stream);
        if (e != hipSuccess) fprintf(stderr, "cooperative launch failed: %s (grid %d)\n", hipGetErrorString(e), grid);
    } else {
        for (int k = 0; k < NPHASE; ++k) { p.ph_lo = k; p.ph_hi = k + 1; hipLaunchKernelGGL(mega_fwd, dim3(grid), dim3(512), LDS_BYTES, stream, p); }
    }
}
```

```cpp
#include <hip/hip_runtime.h>
#include <hip/hip_cooperative_groups.h>
#include <cstdio>
#include <cstdint>
namespace cg = cooperative_groups;

#ifndef MK_N_LAUNCHES
#define MK_N_LAUNCHES 1
#endif

#define LAS __attribute__((address_space(3)))
typedef unsigned short bf16_t;
typedef short bf16x8 __attribute__((ext_vector_type(8)));
typedef float f32x2 __attribute__((ext_vector_type(2)));
typedef float f32x4 __attribute__((ext_vector_type(4)));
typedef float f32x16 __attribute__((ext_vector_type(16)));
typedef unsigned u32x2 __attribute__((ext_vector_type(2)));
typedef unsigned u32x4 __attribute__((ext_vector_type(4)));
typedef __bf16 bf16x2_t __attribute__((ext_vector_type(2)));

constexpr int D = 1024, NP = 8192, NS = 4096, M = NP + NS, SP = 256, SS = 2048, FF = 2816, NH = 16, HD = 64;
constexpr int NPHASE = 16;
constexpr size_t MiB = 1u << 20;
constexpr size_t WS_CTL = 160 * 1024, CTL_BYTES = 96 * 1024;
constexpr int CW_CNT = 4096, CNT_SEAM = 48 * 64;
constexpr size_t WS_MOD = 0, WS_CSCH = 256 * 1024, WS_TP = 512 * 1024, WS_WF = 1 * MiB, WS_WQKV = 3 * MiB,
                 WS_WO = 9 * MiB, WS_WGU = 11 * MiB, WS_WD = 33 * MiB, WS_H = 44 * MiB, WS_MP = 68 * MiB, WS_U = 92 * MiB, WS_R = 158 * MiB;
constexpr size_t WS_YTP = WS_U, WS_YTS = WS_U + 32 * MiB;
constexpr size_t WS_TS = WS_R, WS_F = WS_R + 16 * MiB;
constexpr size_t WS_Q = WS_R, WS_K = WS_R + 24 * MiB, WS_VT = WS_R + 48 * MiB;
constexpr size_t WS_XB = WS_R + 72 * MiB, WS_MP2 = WS_XB + 24 * MiB, WS_END = WS_MP2 + 1 * MiB;
constexpr size_t OUTB_KC = 0, OUTB_VC = 2 * MiB;
constexpr size_t OUT_X = 0, OUT_CK = (size_t)M * D, OUT_CV = OUT_CK + (size_t)NP * D;

struct Params {
    const float* in[16];
    float* out; unsigned char* ws;
    int ph_lo, ph_hi;
};

__device__ __forceinline__ unsigned pk2(float lo, float hi) { f32x2 v = {lo, hi}; bf16x2_t b = __builtin_convertvector(v, bf16x2_t); return __builtin_bit_cast(unsigned, b); }
__device__ __forceinline__ float bf_lo(unsigned w) { return __uint_as_float(w << 16); }
__device__ __forceinline__ float bf_hi(unsigned w) { return __uint_as_float(w & 0xffff0000u); }
template <int CTRL> __device__ __forceinline__ float dpp_mov(float v) { return __builtin_bit_cast(float, __builtin_amdgcn_mov_dpp(__builtin_bit_cast(int, v), CTRL, 0xf, 0xf, true)); }
__device__ __forceinline__ float wave_sum(float v) {
    v += dpp_mov<0xB1>(v); v += dpp_mov<0x4E>(v); v += dpp_mov<0x141>(v); v += dpp_mov<0x140>(v);
    { auto rr = __builtin_amdgcn_permlane16_swap(__float_as_uint(v), __float_as_uint(v), false, false); v = __uint_as_float(rr[0]) + __uint_as_float(rr[1]); }
    { auto rr = __builtin_amdgcn_permlane32_swap(__float_as_uint(v), __float_as_uint(v), false, false); v = __uint_as_float(rr[0]) + __uint_as_float(rr[1]); }
    return v;
}

namespace pg8 {
constexpr int BM = 256, BK = 64, HALF = 128, HTB = HALF * BK * 2, STAGE_BYTES = 8 * HTB;
__device__ __forceinline__ int lds_byte(int r, int c) { const int st = (r >> 4) * 2 + (c >> 5), rr = r & 15, cc = c & 31, ob = rr * 64 + cc * 2; return st * 1024 + (ob ^ (((ob >> 9) & 1) << 5)); }
__device__ __forceinline__ void stage_rc(int b, int& R, int& C) { const int st = b / 1024, sb = b % 1024, swz = sb ^ (((sb >> 9) & 1) << 5); R = (st >> 1) * 16 + swz / 64; C = (st & 1) * 32 + (swz % 64) / 2; }
__device__ __forceinline__ int perm32(int rho) { const int n = rho >> 4, i = rho & 15; return 8 * (i >> 2) + 4 * n + (i & 3); }

struct UnitDesc { const char* A; const char* B; bf16_t* out; int ldc; int aux; };

__device__ __forceinline__ void tile_order(int L, int nM, int nN, int& pm, int& pn) {
    const int nwg = nM * nN; int wgid = L;
    { const int q = nwg / 8, r = nwg % 8, xcd = wgid % 8, off = wgid / 8; wgid = (xcd < r ? xcd * (q + 1) : r * (q + 1) + (xcd - r) * q) + off; }
    const int nig = 8 * nN, gid = wgid / nig, fm = gid * 8, gsz = (nM - fm) < 8 ? (nM - fm) : 8;
    pm = fm + ((wgid % nig) % gsz); pn = (wgid % nig) / gsz;
}

template <class Epi, class Sched, bool ALIGN_EPI>
__device__ __forceinline__ void gemm_phase(LAS unsigned char* lds, const int lda, const int ldb, const int K, const Sched& S, const Epi& E) {
    const int tid = threadIdx.x, wid = __builtin_amdgcn_readfirstlane(tid >> 6), lane = tid & 63, wr = wid >> 2, wc = wid & 3, fr = lane & 15, fq = lane >> 4;
    const int nt = K / BK;
    unsigned voffA[2], voffB[2];
#pragma unroll
    for (int i = 0; i < 2; ++i) { int R, C; stage_rc(tid * 16 + i * 8192, R, C); const int Rb = (R & ~31) + perm32(R & 31);
        voffA[i] = (unsigned)(R * lda + C) * 2u; voffB[i] = (unsigned)(Rb * ldb + C) * 2u; }
    const size_t kstep = (size_t)(BK * 2);
    const size_t hstepA = (size_t)HALF * lda * 2, hstepB = (size_t)HALF * ldb * 2;
    const unsigned ldsw = (unsigned)wid * 1024u;
    const int aoff = lds_byte(wr * 64 + fr, fq * 8), boff = lds_byte(wc * 32 + fr, fq * 8);
#define PG8_SA(b, h) (((b) * 2 + (h)) * HTB)
#define PG8_SB(b, h) ((4 + (b) * 2 + (h)) * HTB)
#define PG8_STAGE(bufoff, gbase, voff) do { _Pragma("unroll") for (int _i = 0; _i < 2; ++_i) \
        __builtin_amdgcn_global_load_lds((const unsigned*)((const char*)(gbase) + (voff)[_i]), (LAS unsigned*)(lds + (bufoff) + ldsw + _i * 8192), 16, 0, 0); } while (0)
#define PG8_LDA(dst, b, h) do { _Pragma("unroll") for (int m = 0; m < 4; ++m) _Pragma("unroll") for (int k = 0; k < 2; ++k) dst[m][k] = *(const LAS bf16x8*)(lds + PG8_SA(b, h) + aoff + m * 2048 + k * 1024); } while (0)
#define PG8_LDB(dst, b, h) do { _Pragma("unroll") for (int n = 0; n < 2; ++n) _Pragma("unroll") for (int k = 0; k < 2; ++k) dst[n][k] = *(const LAS bf16x8*)(lds + PG8_SB(b, h) + boff + n * 2048 + k * 1024); } while (0)
#define PG8_MMA(ai, bj, At, Bt) do { __builtin_amdgcn_s_setprio(1); _Pragma("unroll") for (int m = 0; m < 4; ++m) _Pragma("unroll") for (int n = 0; n < 2; ++n) _Pragma("unroll") for (int k = 0; k < 2; ++k) \
        acc[ai][bj][m][n] = __builtin_amdgcn_mfma_f32_16x16x32_bf16(Bt[n][k], At[m][k], acc[ai][bj][m][n], 0, 0, 0); __builtin_amdgcn_s_setprio(0); } while (0)
#define PG8_WAIT_V(n) asm volatile("s_waitcnt vmcnt(" #n ")" ::: "memory")
#define PG8_WAIT_L(n) asm volatile("s_waitcnt lgkmcnt(" #n ")" ::: "memory")
#define PG8_BAR __builtin_amdgcn_s_barrier()
#define PG8_SCHED __builtin_amdgcn_sched_barrier(0)
    UnitDesc cur, nxt; int ui = 0;
    if (!S.next(0, cur)) return;
    f32x4 acc[2][2][4][2];
#pragma unroll
    for (int a = 0; a < 2; ++a)
#pragma unroll
        for (int b = 0; b < 2; ++b)
#pragma unroll
            for (int m = 0; m < 4; ++m)
#pragma unroll
                for (int n = 0; n < 2; ++n) acc[a][b][m][n] = (f32x4){0.f, 0.f, 0.f, 0.f};
    bf16x8 At[4][2], B0[2][2], B1[2][2];
    const char* cA = cur.A; const char* cB = cur.B;
    PG8_STAGE(PG8_SB(0, 0), cB, voffB); PG8_STAGE(PG8_SB(0, 1), cB + hstepB, voffB); PG8_STAGE(PG8_SA(0, 0), cA, voffA); PG8_STAGE(PG8_SA(0, 1), cA + hstepA, voffA);
    if (wr == 1) PG8_BAR;
    PG8_WAIT_V(2); PG8_BAR;
    PG8_STAGE(PG8_SB(1, 0), cB + kstep, voffB); PG8_STAGE(PG8_SA(1, 0), cA + kstep, voffA); PG8_STAGE(PG8_SB(1, 1), cB + hstepB + kstep, voffB);
    PG8_WAIT_V(6); PG8_BAR;
    for (;;) {
        const bool has_next = S.next(ui + 1, nxt);
        const char* nA = has_next ? nxt.A : cA; const char* nB = has_next ? nxt.B : cB;
#pragma unroll 1
        for (int t = 0; t < nt; t += 2) {
            const bool last = (t == nt - 2);
            const char* a1 = cA + (size_t)(t + 1) * kstep;
            const char* a2 = last ? nA : cA + (size_t)(t + 2) * kstep; const char* b2 = last ? nB : cB + (size_t)(t + 2) * kstep;
            const char* a3 = a2 + kstep; const char* b3 = b2 + kstep;
            PG8_LDB(B0, 0, 0); PG8_LDB(B1, 0, 1); PG8_SCHED; PG8_LDA(At, 0, 0); PG8_STAGE(PG8_SA(1, 1), a1 + hstepA, voffA);
            PG8_WAIT_V(8); PG8_WAIT_L(0); PG8_BAR; PG8_MMA(0, 0, At, B0); PG8_MMA(0, 1, At, B1); PG8_BAR; PG8_SCHED;
            PG8_LDA(At, 0, 1); PG8_STAGE(PG8_SB(0, 0), b2, voffB); PG8_STAGE(PG8_SB(0, 1), b2 + hstepB, voffB); PG8_STAGE(PG8_SA(0, 0), a2, voffA);
            PG8_WAIT_V(8); PG8_WAIT_L(0); PG8_BAR; PG8_MMA(1, 0, At, B0); PG8_MMA(1, 1, At, B1); PG8_BAR; PG8_SCHED;
            PG8_LDB(B0, 1, 0); PG8_LDB(B1, 1, 1); PG8_SCHED; PG8_LDA(At, 1, 0); PG8_STAGE(PG8_SA(0, 1), a2 + hstepA, voffA);
            PG8_WAIT_V(8); PG8_WAIT_L(0); PG8_BAR; PG8_MMA(0, 0, At, B0); PG8_MMA(0, 1, At, B1); PG8_BAR; PG8_SCHED;
            PG8_LDA(At, 1, 1); PG8_STAGE(PG8_SB(1, 0), b3, voffB); PG8_STAGE(PG8_SB(1, 1), b3 + hstepB, voffB); PG8_STAGE(PG8_SA(1, 0), a3, voffA);
            PG8_WAIT_V(8); PG8_WAIT_L(0); PG8_BAR; PG8_MMA(1, 0, At, B0); PG8_MMA(1, 1, At, B1); PG8_BAR; PG8_SCHED;
        }
        if constexpr (ALIGN_EPI) { if (wr == 0) PG8_BAR; }
        E(acc, cur, wr, wc, fr, fq);
        if (!has_next) break;
#pragma unroll
        for (int a = 0; a < 2; ++a)
#pragma unroll
            for (int b = 0; b < 2; ++b)
#pragma unroll
                for (int m = 0; m < 4; ++m)
#pragma unroll
                    for (int n = 0; n < 2; ++n) acc[a][b][m][n] = (f32x4){0.f, 0.f, 0.f, 0.f};
        cur = nxt; cA = nA; cB = nB; ++ui;
        if constexpr (ALIGN_EPI) { if (wr == 1) PG8_BAR; }
    }
    PG8_WAIT_V(0);
    if constexpr (!ALIGN_EPI) { if (wr == 0) PG8_BAR; }
    PG8_BAR;
#undef PG8_SA
#undef PG8_SB
#undef PG8_STAGE
#undef PG8_LDA
#undef PG8_LDB
#undef PG8_MMA
#undef PG8_WAIT_V
#undef PG8_WAIT_L
#undef PG8_BAR
#undef PG8_SCHED
}

struct EpiStore {
    __device__ __forceinline__ void operator()(const f32x4 (&acc)[2][2][4][2], const UnitDesc& u, int wr, int wc, int fr, int fq) const {
#pragma unroll
        for (int ai = 0; ai < 2; ++ai)
#pragma unroll
            for (int m = 0; m < 4; ++m) { bf16_t* rowp = u.out + (size_t)(ai * HALF + wr * 64 + m * 16 + fr) * u.ldc + wc * 32 + 8 * fq;
#pragma unroll
                for (int bj = 0; bj < 2; ++bj) { const f32x4 v0 = acc[ai][bj][m][0], v1 = acc[ai][bj][m][1];
                    u32x4 w; w.x = pk2(v0[0], v0[1]); w.y = pk2(v0[2], v0[3]); w.z = pk2(v1[0], v1[1]); w.w = pk2(v1[2], v1[3]);
                    *(u32x4*)(rowp + bj * HALF) = w; } }
    }
};
__device__ __forceinline__ void store16_sc1(void* ptr, u32x4 v) { asm volatile("global_store_dwordx4 %0, %1, off sc0 sc1\n\ts_nop 3" :: "v"(ptr), "v"(v) : "memory"); }
struct EpiStoreSig {
    unsigned* cnt;
    __device__ __forceinline__ void operator()(const f32x4 (&acc)[2][2][4][2], const UnitDesc& u, int wr, int wc, int fr, int fq) const {
#pragma unroll
        for (int ai = 0; ai < 2; ++ai)
#pragma unroll
            for (int m = 0; m < 4; ++m) { bf16_t* rowp = u.out + (size_t)(ai * HALF + wr * 64 + m * 16 + fr) * u.ldc + wc * 32 + 8 * fq;
#pragma unroll
                for (int bj = 0; bj < 2; ++bj) { const f32x4 v0 = acc[ai][bj][m][0], v1 = acc[ai][bj][m][1];
                    u32x4 w; w.x = pk2(v0[0], v0[1]); w.y = pk2(v0[2], v0[3]); w.z = pk2(v1[0], v1[1]); w.w = pk2(v1[2], v1[3]);
                    if (cnt) store16_sc1(rowp + bj * HALF, w); else *(u32x4*)(rowp + bj * HALF) = w; } }
        if (cnt) { asm volatile("s_waitcnt vmcnt(0)" ::: "memory");
            if ((threadIdx.x & 63) == 0) __hip_atomic_fetch_add(cnt + (u.aux & 0xffff) * 64, 1u, __ATOMIC_RELAXED, __HIP_MEMORY_SCOPE_AGENT); }
    }
};
__device__ __forceinline__ float swiglu1(float g, float u) { return g * u * __builtin_amdgcn_rcpf(1.0f + __builtin_amdgcn_exp2f(-1.4426950408889634f * g)); }
struct EpiSwiGLU {
    unsigned* cnt;
    __device__ __forceinline__ void operator()(const f32x4 (&acc)[2][2][4][2], const UnitDesc& u, int wr, int wc, int fr, int fq) const {
#pragma unroll
        for (int ai = 0; ai < 2; ++ai)
#pragma unroll
            for (int m = 0; m < 4; ++m) { bf16_t* rowp = u.out + (size_t)(ai * HALF + wr * 64 + m * 16 + fr) * u.ldc + wc * 32 + 8 * fq;
                const f32x4 g0 = acc[ai][0][m][0], g1 = acc[ai][0][m][1], u0 = acc[ai][1][m][0], u1 = acc[ai][1][m][1];
                u32x4 w; w.x = pk2(swiglu1(g0[0], u0[0]), swiglu1(g0[1], u0[1])); w.y = pk2(swiglu1(g0[2], u0[2]), swiglu1(g0[3], u0[3]));
                w.z = pk2(swiglu1(g1[0], u1[0]), swiglu1(g1[1], u1[1])); w.w = pk2(swiglu1(g1[2], u1[2]), swiglu1(g1[3], u1[3]));
                if (cnt) store16_sc1(rowp, w); else *(u32x4*)rowp = w; }
        if (cnt) { asm volatile("s_waitcnt vmcnt(0)" ::: "memory");
            if ((threadIdx.x & 63) == 0) __hip_atomic_fetch_add(cnt + (u.aux & 0xffff) * 64, 1u, __ATOMIC_RELAXED, __HIP_MEMORY_SCOPE_AGENT); }
    }
};
struct EpiQKV {
    bf16_t* Q; bf16_t* Kb; bf16_t* Vb; float* ck; float* cv; unsigned* cnt;
    __device__ __forceinline__ void operator()(const f32x4 (&acc)[2][2][4][2], const UnitDesc& u, int wr, int wc, int fr, int fq) const {
        const int pm = u.aux & 0xffff, pn = u.aux >> 16, sel = pn >> 2, ct = (pn & 3) * BM;
        const int row0 = pm * BM + wr * 64 + fr, col0 = ct + wc * 32 + 8 * fq;
        bf16_t* base = Q + (size_t)sel * (size_t)(12 * 1024 * 1024); float* cb = ck + (size_t)(sel >= 1 ? sel - 1 : 0) * (size_t)NP * D;
        const bool wc32 = sel >= 1 && pm < NP / BM;
#pragma unroll
        for (int ai = 0; ai < 2; ++ai)
#pragma unroll
            for (int m = 0; m < 4; ++m) { const size_t off = (size_t)(row0 + ai * HALF + m * 16) * D + col0;
#pragma unroll
                for (int bj = 0; bj < 2; ++bj) { const f32x4 v0 = acc[ai][bj][m][0], v1 = acc[ai][bj][m][1];
                    u32x4 w; w.x = pk2(v0[0], v0[1]); w.y = pk2(v0[2], v0[3]); w.z = pk2(v1[0], v1[1]); w.w = pk2(v1[2], v1[3]);
                    if (cnt) store16_sc1(base + off + bj * HALF, w); else *(u32x4*)(base + off + bj * HALF) = w;
                    if (wc32) { *(f32x4*)(cb + off + bj * HALF) = v0; *(f32x4*)(cb + off + bj * HALF + 4) = v1; } } }
        if (cnt) { asm volatile("s_waitcnt vmcnt(0)" ::: "memory");
            if ((threadIdx.x & 63) == 0) __hip_atomic_fetch_add(cnt + pm * 64, 1u, __ATOMIC_RELAXED, __HIP_MEMORY_SCOPE_AGENT); }
    }
};

struct GSched {
    int nM, nN, G, c; const char* A; size_t a_tile; const char* B; size_t b_tile; bf16_t* out; size_t o_pm, o_pn; int ldc;
    __device__ __forceinline__ bool next(int i, UnitDesc& u) const {
        const long L = (long)i * G + c; if (L >= (long)nM * nN) return false;
        int pm, pn; tile_order((int)L, nM, nN, pm, pn);
        u.A = A + (size_t)pm * a_tile; u.B = B + (size_t)pn * b_tile; u.out = out + (size_t)pm * o_pm + (size_t)pn * o_pn; u.ldc = ldc; u.aux = pm | (pn << 16); return true;
    }
};
struct ChDftSched {
    int G, c; const char* cs_tab; const char* H; bf16_t* ytp; bf16_t* yts;
    __device__ __forceinline__ bool next(int i, UnitDesc& u) const {
        const long L = (long)i * G + c; if (L >= 48 * 8) return false;
        int tok, gc; tile_order((int)L, 48, 8, tok, gc); const int g = gc >> 1, cs = gc & 1;
        u.A = cs_tab + (size_t)cs * 256 * 256 * 2; u.B = H + ((size_t)tok * 256 * D + g * 256) * 2;
        if (tok < 32) { u.out = ytp + ((size_t)(tok * D + g * 256) * 512 + cs * 256); u.ldc = 512; }
        else { const int idx = tok - 32, b = idx >> 3, s0 = (idx & 7) * 256; u.out = yts + ((size_t)(b * D + g * 256) * 4096 + cs * 2048 + s0); u.ldc = 4096; }
        u.aux = 0; return true;
    }
};
struct SeqSSched {
    int c; const char* ts; const char* yts; bf16_t* F;
    __device__ __forceinline__ bool next(int i, UnitDesc& u) const {
        if (i > 0 || c >= 64) return false;
        const int b = c >> 5, pm = (c >> 2) & 7, pn = c & 3;
        u.A = ts + (size_t)pm * 256 * 4096 * 2; u.B = yts + (size_t)(b * D + pn * 256) * 4096 * 2;
        u.out = F + ((size_t)(NP + b * SS + pm * 256) * D + pn * 256); u.ldc = D; u.aux = 32 + 8 * b + pm; return true;
    }
};
struct SeqPSched {
    int G, c; const char* tp; const char* ytp; bf16_t* F;
    __device__ __forceinline__ bool next(int i, UnitDesc& u) const {
        const int G2 = G - 64; if (c < 64 || G2 <= 0) return false;
        const long L = (long)i * G2 + (c - 64); if (L >= 128) return false;
        const int b = (int)L >> 2, pn = (int)L & 3;
        u.A = tp; u.B = ytp + (size_t)(b * D + pn * 256) * 512 * 2;
        u.out = F + ((size_t)(b * 256) * D + pn * 256); u.ldc = D; u.aux = b; return true;
    }
};
struct GuSched {
    int G, c; const char* A; const char* B; bf16_t* out;
    __device__ __forceinline__ bool next(int i, UnitDesc& u) const {
        const long L = (long)i * G + c; if (L >= 1056) return false;
        int pm, pn; if (L < 1012) tile_order((int)L, 46, 22, pm, pn); else { const int j = (int)L - 1012; pm = 46 + j / 22; pn = j % 22; }
        u.A = A + (size_t)pm * 256 * D * 2; u.B = B + (size_t)pn * 256 * D * 2; u.out = out + (size_t)pm * 256 * FF + (size_t)pn * 128; u.ldc = FF; u.aux = pm | (pn << 16); return true;
    }
};
struct DownSched {
    int d; const char* A; const char* B; bf16_t* out; bf16_t* out2;
    __device__ __forceinline__ void unit(int& pm, int& pn, int& kh) const { kh = 0; if (d < 184) tile_order(d, 46, 4, pm, pn); else { const int j = d - 184, un = j >> 1; kh = j & 1; pm = 46 + un / 4; pn = un % 4; } }
    __device__ __forceinline__ bool next(int i, UnitDesc& u) const {
        if (i > 0 || d < 0 || d >= 200) return false;
        int pm, pn, kh; unit(pm, pn, kh);
        u.A = A + (size_t)pm * 256 * FF * 2 + (size_t)kh * (FF / 2) * 2; u.B = B + (size_t)pn * 256 * FF * 2 + (size_t)kh * (FF / 2) * 2;
        u.out = kh ? out2 + (size_t)(pm - 46) * 256 * D + (size_t)pn * 256 : out + (size_t)pm * 256 * D + (size_t)pn * 256; u.ldc = D; u.aux = pm | (pn << 16); return true;
    }
};
struct QkvSched {
    int G, c; const char* A; const char* B;
    __device__ __forceinline__ bool next(int i, UnitDesc& u) const {
        const long L = (long)i * G + c; if (L >= 576) return false;
        int pm, pn; if (L < 384) tile_order((int)L, 32, 12, pm, pn); else { tile_order((int)L - 384, 16, 12, pm, pn); pm += 32; }
        u.A = A + (size_t)pm * 256 * D * 2; u.B = B + (size_t)pn * 256 * D * 2; u.out = nullptr; u.ldc = D; u.aux = pm | (pn << 16); return true;
    }
};
struct OneSched {
    int pm, pn; const char* A; const char* B; bf16_t* out;
    __device__ __forceinline__ bool next(int i, UnitDesc& u) const {
        if (i > 0 || pm < 0) return false;
        u.A = A + (size_t)pm * 256 * D * 2; u.B = B + (size_t)pn * 256 * D * 2; u.out = out + (size_t)pm * 256 * D + (size_t)pn * 256; u.ldc = D; u.aux = pm | (pn << 16); return true;
    }
};
}

constexpr int TI_L0 = 16 * 32 + 2 * 16 * 88 + 44 * 32, TI_ALL = 16 * 32 + 16 * 96 + 16 * 32 + 4 * 16 * 88 + 2 * 44 * 32;
struct TItem { const float* W; bf16_t* WT; int N, ldt, dst, k0, n0; };
__device__ __forceinline__ bool titem_decode(const Params& p, int it, TItem& t) {
    constexpr int I_F = 16 * 32, I_QKV = 16 * 96, I_O = 16 * 32, I_G = 16 * 88, I_D = 44 * 32;
    constexpr int NITEMS = I_F + I_QKV + I_O + 4 * I_G + 2 * I_D;
    if (it >= NITEMS) return false;
    unsigned char* ws = p.ws; int r = it; int mode = 0;
    if (r < I_F) { t.W = p.in[9]; t.N = D; t.ldt = D; t.WT = (bf16_t*)(ws + WS_WF); }
    else { r -= I_F; int l = 0; if (r >= 2 * I_G + I_D) { r -= 2 * I_G + I_D; l = 1; }
        if (r < I_G) { t.W = p.in[13] + (size_t)l * D * FF; t.N = FF; t.ldt = D; t.WT = (bf16_t*)(ws + WS_WGU) + (size_t)l * 2 * FF * D; mode = 1; }
        else if ((r -= I_G) < I_G) { t.W = p.in[14] + (size_t)l * D * FF; t.N = FF; t.ldt = D; t.WT = (bf16_t*)(ws + WS_WGU) + (size_t)l * 2 * FF * D; mode = 2; }
        else if ((r -= I_G) < I_D) { t.W = p.in[15] + (size_t)l * FF * D; t.N = D; t.ldt = FF; t.WT = (bf16_t*)(ws + WS_WD) + (size_t)l * D * FF; }
        else if ((r -= I_D) < I_QKV) { t.W = p.in[10]; t.N = 3 * D; t.ldt = D; t.WT = (bf16_t*)(ws + WS_WQKV); }
        else { r -= I_QKV; t.W = p.in[12]; t.N = D; t.ldt = D; t.WT = (bf16_t*)(ws + WS_WO); } }
    const int nblk = t.N / 32, kb = r / nblk, nb = r % nblk; t.n0 = nb * 32; t.k0 = kb * 64;
    t.dst = t.n0; if (mode) t.dst = (t.n0 >> 7) * 256 + (t.n0 & 127) + (mode == 2 ? 128 : 0);
    return true;
}
__device__ __forceinline__ void titem_load(const TItem& t, f32x4 (&wv)[8], int lane) {
#pragma unroll
    for (int i = 0; i < 8; ++i) wv[i] = *(const f32x4*)(t.W + (size_t)(t.k0 + 8 * i + (lane >> 3)) * t.N + t.n0 + 4 * (lane & 7));
}
__device__ __forceinline__ void titem_finish(const TItem& t, const f32x4 (&wv)[8], LAS float* scr, int lane) {
#pragma unroll
    for (int i = 0; i < 8; ++i) { LAS float* d = scr + (8 * i + (lane >> 3)) * 33 + 4 * (lane & 7); d[0] = wv[i][0]; d[1] = wv[i][1]; d[2] = wv[i][2]; d[3] = wv[i][3]; }
    asm volatile("s_waitcnt lgkmcnt(0)" ::: "memory");
    const int c = lane & 7;
#pragma unroll
    for (int j = 0; j < 4; ++j) { const int n = (lane >> 3) + 8 * j; const LAS float* s = scr + (8 * c) * 33 + n;
        u32x4 o; o.x = pk2(s[0 * 33], s[1 * 33]); o.y = pk2(s[2 * 33], s[3 * 33]); o.z = pk2(s[4 * 33], s[5 * 33]); o.w = pk2(s[6 * 33], s[7 * 33]);
        *(u32x4*)(t.WT + (size_t)(t.dst + n) * t.ldt + t.k0 + 8 * c) = o; }
    asm volatile("s_waitcnt lgkmcnt(0)" ::: "memory");
}

__device__ __forceinline__ void gemv_layer(const Params& p, LAS unsigned char* lds, const int l, const int rb, const int nb) {
    const int tid = threadIdx.x;
    LAS float* sl = (LAS float*)lds;
    LAS f32x4* red = (LAS f32x4*)(lds + 12288);
    for (int i = tid; i < 3072; i += 512) { const int cond = i >> 10, k = i & 1023; const float v = cond == 0 ? p.in[5][k] : p.in[2][(cond - 1) * D + k]; sl[i] = v / (1.0f + __expf(-v)); }
    __syncthreads();
    float* mod = (float*)(p.ws + WS_MOD);
    for (int item = rb; item < 96; item += nb) {
        const int rem = item, cc = rem >> 4, kc = rem & 15, rpar = tid >> 8, col = cc * 1024 + 4 * (tid & 255);
        const float* W = p.in[6] + ((size_t)l * D + kc * 64 + rpar) * 6144 + col;
        f32x4 a0 = {0.f, 0.f, 0.f, 0.f}, a1 = a0, a2 = a0;
#pragma unroll
        for (int hf = 0; hf < 2; ++hf) {
            f32x4 w[16];
#pragma unroll
            for (int i = 0; i < 16; ++i) w[i] = *(const f32x4*)(W + (size_t)(32 * hf + 2 * i) * 6144);
#pragma unroll
            for (int i = 0; i < 16; ++i) { const int k = kc * 64 + 32 * hf + 2 * i + rpar; a0 += sl[k] * w[i]; a1 += sl[1024 + k] * w[i]; a2 += sl[2048 + k] * w[i]; }
        }
        if (rpar == 1) { red[tid - 256] = a0; red[256 + tid - 256] = a1; red[512 + tid - 256] = a2; }
        __syncthreads();
        if (rpar == 0) {
            a0 += red[tid]; a1 += red[256 + tid]; a2 += red[512 + tid];
            if (kc == 0) { const f32x4 bv = *(const f32x4*)(p.in[7] + l * 6144 + col); a0 += bv; a1 += bv; a2 += bv; }
#pragma unroll
            for (int j = 0; j < 4; ++j) {
                unsafeAtomicAdd(mod + (l * 3 + 0) * 6144 + col + j, a0[j]);
                unsafeAtomicAdd(mod + (l * 3 + 1) * 6144 + col + j, a1[j]);
                unsafeAtomicAdd(mod + (l * 3 + 2) * 6144 + col + j, a2[j]); }
        }
        __syncthreads();
    }
}
__device__ __forceinline__ void transpose_jobs(const Params& p, LAS unsigned char* lds, int gw, int NGW, int it_lo, int it_hi) {
    const int lane = threadIdx.x & 63, wave = threadIdx.x >> 6;
    LAS float* scr = (LAS float*)(lds + wave * 8448);
    TItem cur, nxt; f32x4 wa[8], wb[8];
    int it = it_lo + gw;
    bool have = it < it_hi && titem_decode(p, it, cur);
    if (have) titem_load(cur, wa, lane);
    while (have) {
        const bool hn = it + NGW < it_hi && titem_decode(p, it + NGW, nxt);
        if (hn) titem_load(nxt, wb, lane);
        titem_finish(cur, wa, scr, lane);
        if (!hn) break;
        it += 2 * NGW;
        have = it < it_hi && titem_decode(p, it, cur);
        if (have) titem_load(cur, wa, lane);
        titem_finish(nxt, wb, scr, lane);
    }
}
__device__ __forceinline__ void phase_prologue(const Params& p, LAS unsigned char* lds) {
    const int tid = threadIdx.x, G = gridDim.x, bx = blockIdx.x;
    unsigned char* ws = p.ws;
    LAS float* ct = (LAS float*)(lds + 32768);
    for (int i = tid; i < 2048; i += 512) ct[i] = cospif((float)i * (1.0f / 1024.0f));
    const bool sep = G >= 192;
    if (!sep || bx < 96) gemv_layer(p, lds, 0, bx, sep ? 96 : G);
    if (sep && bx < 96) return;
    const int gt = (sep ? bx - 96 : bx) * 512 + tid, GT = (sep ? G - 96 : G) * 512;
    for (int i = gt; i < 2 * 2 * 512 * D / 8; i += GT) { const int which = i >= 2 * 512 * D / 8; const int ii = which ? i - 2 * 512 * D / 8 : i;
        const f32x4* src = (const f32x4*)p.in[which ? 4 : 3]; const f32x4 a = src[2 * ii], b = src[2 * ii + 1];
        u32x4 o; o.x = pk2(a[0], a[1]); o.y = pk2(a[2], a[3]); o.z = pk2(b[0], b[1]); o.w = pk2(b[2], b[3]); ((u32x4*)((unsigned char*)p.out + (which ? OUTB_VC : OUTB_KC)))[ii] = o; }
    for (int i = gt; i < 512 * 256 / 8; i += GT) { const int row = i >> 5, c0 = (i & 31) * 8, cs = row >> 8, m = row & 255; float v[8];
#pragma unroll
        for (int j = 0; j < 8; ++j) { const int idx = ((m * (c0 + j)) & 255) * 8; v[j] = ct[(idx - (cs ? 512 : 0)) & 2047]; }
        u32x4 o; o.x = pk2(v[0], v[1]); o.y = pk2(v[2], v[3]); o.z = pk2(v[4], v[5]); o.w = pk2(v[6], v[7]); ((u32x4*)(ws + WS_CSCH))[i] = o; }
    for (int i = gt; i < 256 * 512 / 8; i += GT) { const int k = i >> 6, c0 = (i & 63) * 8; float v[8];
#pragma unroll
        for (int j = 0; j < 8; ++j) { const int kk = c0 + j, sidx = kk & 255; const int idx = ((k * sidx) & 255) * 8; v[j] = kk < 256 ? ct[idx] : -ct[(idx - 512) & 2047]; }
        u32x4 o; o.x = pk2(v[0], v[1]); o.y = pk2(v[2], v[3]); o.z = pk2(v[4], v[5]); o.w = pk2(v[6], v[7]); ((u32x4*)(ws + WS_TP))[i] = o; }
    for (int i = gt; i < 2048 * 4096 / 8; i += GT) { const int k = i >> 9, c0 = (i & 511) * 8; float v[8];
#pragma unroll
        for (int j = 0; j < 8; ++j) { const int kk = c0 + j, sidx = kk & 2047; const int idx = (k * sidx) & 2047; v[j] = kk < 2048 ? ct[idx] : -ct[(idx - 512) & 2047]; }
        u32x4 o; o.x = pk2(v[0], v[1]); o.y = pk2(v[2], v[3]); o.z = pk2(v[4], v[5]); o.w = pk2(v[6], v[7]); ((u32x4*)(ws + WS_TS))[i] = o; }
}
__device__ __forceinline__ void phase_side_jobs(const Params& p, LAS unsigned char* lds, const int which) {
    if (which == 5) { if (blockIdx.x < 56) transpose_jobs(p, lds, blockIdx.x * 8 + (threadIdx.x >> 6), 56 * 8, TI_L0 + 3 * 1408, TI_L0 + 3 * 1408 + 1536); return; }
    if (which == 6) { if (blockIdx.x >= 64) { const int gw = (blockIdx.x - 64) * 8 + (threadIdx.x >> 6), ngw = (gridDim.x - 64) * 8;
        transpose_jobs(p, lds, gw, ngw, TI_L0 + 2 * 1408, TI_L0 + 3 * 1408); transpose_jobs(p, lds, gw, ngw, TI_L0 + 3 * 1408 + 1536, TI_ALL); } return; }
    if (which == 8) { if (blockIdx.x >= 128) transpose_jobs(p, lds, (blockIdx.x - 128) * 8 + (threadIdx.x >> 6), (gridDim.x - 128) * 8, 0, 512); return; }
    if (which == 9) { if (blockIdx.x >= 64) transpose_jobs(p, lds, (blockIdx.x - 64) * 8 + (threadIdx.x >> 6), (gridDim.x - 64) * 8, 512, TI_L0);
        if (blockIdx.x >= 192) { __syncthreads(); gemv_layer(p, lds, 1, blockIdx.x - 192, gridDim.x - 192); } return; }
    if (which == 7) { if (blockIdx.x >= 192) transpose_jobs(p, lds, (blockIdx.x - 192) * 8 + (threadIdx.x >> 6), (gridDim.x - 192) * 8, TI_L0, TI_L0 + 2 * 1408); return; }
    const int G = gridDim.x, bx = blockIdx.x, first = which == 0 ? 64 : 192;
    const int nb = G > first ? G - first : G, b0 = G > first ? first : 0;
    if (bx < b0) return;
    const int rb = bx - b0;
    if (which == 0) transpose_jobs(p, lds, rb * 8 + (threadIdx.x >> 6), nb * 8, 0, TI_L0);
    else if (which == 1) gemv_layer(p, lds, 1, rb, nb);
    else transpose_jobs(p, lds, rb * 8 + (threadIdx.x >> 6), nb * 8, TI_L0, TI_ALL);
}

#ifndef ROW_WT
#define ROW_WT 0
#endif
__device__ __forceinline__ void store16_wt(void* ptr, u32x4 v) {
#if ROW_WT
    asm volatile("global_store_dwordx4 %0, %1, off sc0 sc1\n\ts_nop 3" :: "v"(ptr), "v"(v) : "memory");
#else
    *(u32x4*)ptr = v;
#endif
}
__device__ __forceinline__ void bf8_to_f32(const u32x4 w, f32x4& a, f32x4& b) { a = (f32x4){bf_lo(w.x), bf_hi(w.x), bf_lo(w.y), bf_hi(w.y)}; b = (f32x4){bf_lo(w.z), bf_hi(w.z), bf_lo(w.w), bf_hi(w.w)}; }
__device__ __forceinline__ u32x4 f32_to_bf8(const f32x4 a, const f32x4 b) { u32x4 w; w.x = pk2(a[0], a[1]); w.y = pk2(a[2], a[3]); w.z = pk2(b[0], b[1]); w.w = pk2(b[2], b[3]); return w; }
template <bool HAS_MP, bool HAS_NEXT, bool XIN_F32>
__device__ __forceinline__ void row_phase(const float* xin_p, const float* xin_s, bf16_t* XB, const bf16_t* mp, float* Yout, bf16_t* Hout,
                                          const float* gate, const float* gA, const float* gB, const float* sc, const float* sh, unsigned* cnt = nullptr, const bf16_t* mp2 = nullptr) {
    const int tid = threadIdx.x, lane = tid & 63, gw = blockIdx.x * 8 + (tid >> 6), NGW = gridDim.x * 8;
    if (cnt) {
        if (tid == 0) { const int p0 = (blockIdx.x * 48) >> 8, p1 = (blockIdx.x * 48 + 47) >> 8;
            for (int pp = p0; pp <= p1; ++pp) { unsigned sp = 0; while (__hip_atomic_load(cnt + pp * 64, __ATOMIC_RELAXED, __HIP_MEMORY_SCOPE_AGENT) < ((mp2 && pp >= 46) ? 64u : 32u)) { __builtin_amdgcn_s_sleep(2); if (++sp > (1u << 22)) break; } }
            __builtin_amdgcn_fence(__ATOMIC_ACQUIRE, "agent"); asm volatile("s_waitcnt vmcnt(0)" ::: "memory"); }
        __syncthreads();
    }
    constexpr int R = 3, RW = 6;
    int cur_cond = -1;
    f32x4 gga[4], gbs[4], shv[4];
    for (int rowb = gw * RW; rowb < M; rowb += NGW * RW)
    for (int row0 = rowb; row0 < rowb + RW; row0 += R) {
        f32x4 v[R][4]; u32x4 mw[R][2];
#pragma unroll
        for (int q = 0; q < R; ++q) { const int row = row0 + q;
            if constexpr (XIN_F32) { const float* xr = row < NP ? xin_p + (size_t)row * D : xin_s + (size_t)(row - NP) * D;
#pragma unroll
                for (int j = 0; j < 2; ++j) { v[q][2 * j] = *(const f32x4*)(xr + 8 * lane + 512 * j); v[q][2 * j + 1] = *(const f32x4*)(xr + 8 * lane + 512 * j + 4); }
            } else {
#pragma unroll
                for (int j = 0; j < 2; ++j) { const u32x4 w = *(const u32x4*)(XB + (size_t)row * D + 8 * lane + 512 * j); bf8_to_f32(w, v[q][2 * j], v[q][2 * j + 1]); }
            }
            if constexpr (HAS_MP) {
#pragma unroll
                for (int j = 0; j < 2; ++j) mw[q][j] = *(const u32x4*)(mp + (size_t)row * D + 8 * lane + 512 * j);
            } }
        u32x4 xo[R][2], ho[R][2];
#pragma unroll
        for (int q = 0; q < R; ++q) { const int row = row0 + q; const int cond = row < NP ? 0 : (row < NP + SS ? 1 : 2);
            if (cond != cur_cond) { cur_cond = cond;
#pragma unroll
                for (int j = 0; j < 4; ++j) { const int col = 8 * lane + 512 * (j >> 1) + 4 * (j & 1);
                    if constexpr (HAS_MP) gga[j] = *(const f32x4*)(gate + cond * 6144 + col) * *(const f32x4*)(gA + col);
                    if constexpr (HAS_NEXT) { gbs[j] = *(const f32x4*)(gB + col) * (1.0f + *(const f32x4*)(sc + cond * 6144 + col)); shv[j] = *(const f32x4*)(sh + cond * 6144 + col); } } }
            if constexpr (HAS_MP) {
                f32x4 mv[4]; float s = 0.f;
#pragma unroll
                for (int j = 0; j < 2; ++j) bf8_to_f32(mw[q][j], mv[2 * j], mv[2 * j + 1]);
                if (mp2 && row >= 46 * 256) {
#pragma unroll
                    for (int j = 0; j < 2; ++j) { f32x4 a, b; bf8_to_f32(*(const u32x4*)(mp2 + (size_t)(row - 46 * 256) * D + 8 * lane + 512 * j), a, b); mv[2 * j] += a; mv[2 * j + 1] += b; } }
#pragma unroll
                for (int j = 0; j < 4; ++j) s += (mv[j][0] * mv[j][0] + mv[j][1] * mv[j][1]) + (mv[j][2] * mv[j][2] + mv[j][3] * mv[j][3]);
                const float rstd = 1.0f / sqrtf(wave_sum(s) * (1.0f / D) + 1e-6f);
#pragma unroll
                for (int j = 0; j < 4; ++j) v[q][j] = v[q][j] + gga[j] * (mv[j] * rstd);
                if constexpr (HAS_NEXT) {
#pragma unroll
                    for (int j = 0; j < 2; ++j) xo[q][j] = f32_to_bf8(v[q][2 * j], v[q][2 * j + 1]);
                }
            }
            if constexpr (HAS_NEXT) {
                float s = 0.f;
#pragma unroll
                for (int j = 0; j < 4; ++j) s += (v[q][j][0] * v[q][j][0] + v[q][j][1] * v[q][j][1]) + (v[q][j][2] * v[q][j][2] + v[q][j][3] * v[q][j][3]);
                const float rstd = 1.0f / sqrtf(wave_sum(s) * (1.0f / D) + 1e-6f);
                f32x4 hh[4];
#pragma unroll
                for (int j = 0; j < 4; ++j) hh[j] = (v[q][j] * rstd) * gbs[j] + shv[j];
#pragma unroll
                for (int j = 0; j < 2; ++j) ho[q][j] = f32_to_bf8(hh[2 * j], hh[2 * j + 1]);
            } }
#pragma unroll
        for (int q = 0; q < R; ++q) { const int row = row0 + q;
            if constexpr (HAS_MP && !HAS_NEXT) {
#pragma unroll
                for (int j = 0; j < 4; ++j) *(f32x4*)(Yout + (size_t)row * D + 8 * lane + 512 * (j >> 1) + 4 * (j & 1)) = v[q][j];
            }
            if constexpr (HAS_MP && HAS_NEXT) {
#pragma unroll
                for (int j = 0; j < 2; ++j) store16_wt(XB + (size_t)row * D + 8 * lane + 512 * j, xo[q][j]);
            }
            if constexpr (HAS_NEXT) {
#pragma unroll
                for (int j = 0; j < 2; ++j) store16_wt(Hout + (size_t)row * D + 8 * lane + 512 * j, ho[q][j]);
            } }
    }
}

__device__ __forceinline__ void attn_phase(const Params& p, LAS unsigned char* lds, const int u_lo, const int u_hi, const int rb, const int nb) {
    const int tid = threadIdx.x, lane = tid & 63, wave = __builtin_amdgcn_readfirstlane(tid >> 6), r = lane & 31, hh = lane >> 5;
    unsigned char* ws = p.ws;
    const bf16_t* Qb = (const bf16_t*)(ws + WS_Q); const bf16_t* Kb = (const bf16_t*)(ws + WS_K); const bf16_t* Vb = (const bf16_t*)(ws + WS_VT);
    const bf16_t* Kc = (const bf16_t*)((const unsigned char*)p.out + OUTB_KC); const bf16_t* Vc = (const bf16_t*)((const unsigned char*)p.out + OUTB_VC);
    bf16_t* Ob = (bf16_t*)(ws + WS_H);
    LAS float* Bl = (LAS float*)(lds + 36864 + 512);
    const int srow = tid >> 3, sch = tid & 7, krho = (srow & ~12) | ((srow & 4) << 1) | ((srow & 8) >> 1);
    const float c2 = 0.125f * 1.4426950408889634f;
    for (int unit = u_lo + rb; unit < u_hi; unit += nb) {
        const bool is_na = unit < 256;
        int b, h, qtok, nt, jmin = 0, nloc = 0, rq = 0, half = 0, ktok0;
        if (is_na) { b = unit >> 7; h = (unit >> 3) & 15; const int r0 = (unit & 7) * 4; rq = r0 + (wave >> 1); half = wave & 1;
            jmin = min(max(r0 - 4, 0), 24); const int jmax = min(max(r0 - 1, 0), 24) + 7; nloc = jmax - jmin + 1; nt = nloc + 8;
            qtok = NP + b * SS + rq * 64 + half * 32 + r; ktok0 = NP + b * SS; }
        else { const int u2 = unit - 256; b = u2 >> 4; h = u2 & 15; nt = 4; qtok = b * SP + wave * 32 + r; ktok0 = b * SP; }
        const int rs = min(max(rq - 4, 0), 24);
        if (is_na) { for (int i = tid; i < 15 * 32; i += 512) { const int rr = i >> 5, x = i & 31; Bl[i] = x < 31 ? p.in[11][(h * 15 + rr) * 31 + x] * 1.4426950408889634f : 0.f; } }
        bf16x8 qf[4];
#pragma unroll
        for (int d0 = 0; d0 < 4; ++d0) qf[d0] = *(const bf16x8*)(Qb + (size_t)qtok * D + h * HD + d0 * 16 + hh * 8);
        f32x16 o0, o1;
#pragma unroll
        for (int i = 0; i < 16; ++i) { o0[i] = 0.f; o1[i] = 0.f; }
        float m_run = -1e30f, l_run = 0.f;
        u32x4 kreg, vreg;
#define ATT_LOAD(t) do { const int t_ = (t); size_t off_; const bf16_t* kb_; const bf16_t* vb_; \
            if (is_na && t_ >= nloc) { off_ = ((size_t)(b * 512 + (t_ - nloc) * 64 + srow)) * D + h * HD + sch * 8; kb_ = Kc; vb_ = Vc; } \
            else { off_ = (size_t)(ktok0 + (is_na ? (jmin + t_) * 64 : t_ * 64) + srow) * D + h * HD + sch * 8; kb_ = Kb; vb_ = Vb; } \
            kreg = *(const u32x4*)(kb_ + off_); vreg = *(const u32x4*)(vb_ + off_); } while (0)
#define ATT_STORE(buf) do { LAS unsigned char* kl_ = lds + (buf) * 18432; LAS unsigned char* vl_ = kl_ + 9216; \
            *(LAS u32x4*)(kl_ + krho * 144 + sch * 16) = kreg; \
            LAS bf16_t* vd_ = (LAS bf16_t*)(vl_ + (8 * sch) * 144 + srow * 2); \
            vd_[0 * 72] = (bf16_t)vreg.x; vd_[1 * 72] = (bf16_t)(vreg.x >> 16); vd_[2 * 72] = (bf16_t)vreg.y; vd_[3 * 72] = (bf16_t)(vreg.y >> 16); \
            vd_[4 * 72] = (bf16_t)vreg.z; vd_[5 * 72] = (bf16_t)(vreg.z >> 16); vd_[6 * 72] = (bf16_t)vreg.w; vd_[7 * 72] = (bf16_t)(vreg.w >> 16); } while (0)
        ATT_LOAD(0); ATT_STORE(0); if (nt > 1) ATT_LOAD(1);
        __syncthreads();
        for (int t = 0; t < nt; ++t) {
            if (t + 1 < nt) { ATT_STORE((t + 1) & 1); if (t + 2 < nt) ATT_LOAD(t + 2); }
            const bool local = is_na && t < nloc; const int j = jmin + t;
            if (!(local && (j < rs || j >= rs + 8))) {
                const LAS unsigned char* Kl = lds + (t & 1) * 18432; const LAS unsigned char* Vl = Kl + 9216;
                f32x16 p0, p1;
#pragma unroll
                for (int i = 0; i < 16; ++i) { p0[i] = 0.f; p1[i] = 0.f; }
#pragma unroll
                for (int d0 = 0; d0 < 4; ++d0) { const bf16x8 a0 = *(const LAS bf16x8*)(Kl + r * 144 + d0 * 32 + hh * 16), a1 = *(const LAS bf16x8*)(Kl + (32 + r) * 144 + d0 * 32 + hh * 16);
                    p0 = __builtin_amdgcn_mfma_f32_32x32x16_bf16(a0, qf[d0], p0, 0, 0, 0); p1 = __builtin_amdgcn_mfma_f32_32x32x16_bf16(a1, qf[d0], p1, 0, 0, 0); }
                float m_new, alpha;
                if (local) {
                    const int qc = half * 32 + r, cs = min(max(qc - 8, 0), 48);
                    const LAS float* bp = Bl + (j - rq + 7) * 32 + 8 * hh - qc + 15;
                    float bb0[16], bb1[16];
#pragma unroll
                    for (int i = 0; i < 16; ++i) { const int kc = 16 * (i >> 3) + (i & 7); bb0[i] = bp[kc]; bb1[i] = bp[kc + 32]; }
                    asm volatile("" : "+v"(bb0[0]), "+v"(bb0[1]), "+v"(bb0[2]), "+v"(bb0[3]), "+v"(bb0[4]), "+v"(bb0[5]), "+v"(bb0[6]), "+v"(bb0[7]));
                    asm volatile("" : "+v"(bb0[8]), "+v"(bb0[9]), "+v"(bb0[10]), "+v"(bb0[11]), "+v"(bb0[12]), "+v"(bb0[13]), "+v"(bb0[14]), "+v"(bb0[15]));
                    asm volatile("" : "+v"(bb1[0]), "+v"(bb1[1]), "+v"(bb1[2]), "+v"(bb1[3]), "+v"(bb1[4]), "+v"(bb1[5]), "+v"(bb1[6]), "+v"(bb1[7]));
                    asm volatile("" : "+v"(bb1[8]), "+v"(bb1[9]), "+v"(bb1[10]), "+v"(bb1[11]), "+v"(bb1[12]), "+v"(bb1[13]), "+v"(bb1[14]), "+v"(bb1[15]));
                    const unsigned sh0 = (unsigned)(8 * hh - cs);
#pragma unroll
                    for (int i = 0; i < 16; ++i) { const int kc = 16 * (i >> 3) + (i & 7);
                        const float s0 = __builtin_fmaf(p0[i], c2, bb0[i]), s1 = __builtin_fmaf(p1[i], c2, bb1[i]);
                        p0[i] = (sh0 + (unsigned)kc) < 16u ? s0 : -1e30f; p1[i] = (sh0 + (unsigned)(kc + 32)) < 16u ? s1 : -1e30f; }
                    float mt = fmaxf(p0[0], p1[0]);
#pragma unroll
                    for (int i = 1; i < 16; ++i) mt = fmaxf(mt, fmaxf(p0[i], p1[i]));
                    mt = fmaxf(mt, __shfl_xor(mt, 32));
                    m_new = fmaxf(m_run, mt); alpha = __builtin_amdgcn_exp2f(m_run - m_new);
#pragma unroll
                    for (int i = 0; i < 16; ++i) { p0[i] = __builtin_amdgcn_exp2f(p0[i] - m_new); p1[i] = __builtin_amdgcn_exp2f(p1[i] - m_new); }
                } else {
                    float mt = fmaxf(p0[0], p1[0]);
#pragma unroll
                    for (int i = 1; i < 16; ++i) mt = fmaxf(mt, fmaxf(p0[i], p1[i]));
                    mt = fmaxf(mt, __shfl_xor(mt, 32)) * c2;
                    m_new = fmaxf(m_run, mt); alpha = __builtin_amdgcn_exp2f(m_run - m_new);
#pragma unroll
                    for (int i = 0; i < 16; ++i) { p0[i] = __builtin_amdgcn_exp2f(__builtin_fmaf(p0[i], c2, -m_new)); p1[i] = __builtin_amdgcn_exp2f(__builtin_fmaf(p1[i], c2, -m_new)); }
                }
                m_run = m_new;
                float ls = 0.f;
#pragma unroll
                for (int i = 0; i < 16; ++i) ls += p0[i] + p1[i];
                l_run = l_run * alpha + ls;
#pragma unroll
                for (int i = 0; i < 16; ++i) { o0[i] *= alpha; o1[i] *= alpha; }
                bf16x8 pa[4];
#pragma unroll
                for (int s2 = 0; s2 < 2; ++s2) { u32x4 w; w.x = pk2(p0[8 * s2], p0[8 * s2 + 1]); w.y = pk2(p0[8 * s2 + 2], p0[8 * s2 + 3]); w.z = pk2(p0[8 * s2 + 4], p0[8 * s2 + 5]); w.w = pk2(p0[8 * s2 + 6], p0[8 * s2 + 7]); pa[s2] = __builtin_bit_cast(bf16x8, w);
                    u32x4 w2; w2.x = pk2(p1[8 * s2], p1[8 * s2 + 1]); w2.y = pk2(p1[8 * s2 + 2], p1[8 * s2 + 3]); w2.z = pk2(p1[8 * s2 + 4], p1[8 * s2 + 5]); w2.w = pk2(p1[8 * s2 + 6], p1[8 * s2 + 7]); pa[2 + s2] = __builtin_bit_cast(bf16x8, w2); }
#pragma unroll
                for (int s2 = 0; s2 < 4; ++s2) { const bf16x8 v0 = *(const LAS bf16x8*)(Vl + r * 144 + s2 * 32 + hh * 16), v1 = *(const LAS bf16x8*)(Vl + (32 + r) * 144 + s2 * 32 + hh * 16);
                    o0 = __builtin_amdgcn_mfma_f32_32x32x16_bf16(v0, pa[s2], o0, 0, 0, 0); o1 = __builtin_amdgcn_mfma_f32_32x32x16_bf16(v1, pa[s2], o1, 0, 0, 0); }
            }
            __syncthreads();
        }
#undef ATT_LOAD
#undef ATT_STORE
        const float inv = 1.0f / (l_run + __shfl_xor(l_run, 32));
        bf16_t* orow = Ob + (size_t)qtok * D + h * HD + 4 * hh;
#pragma unroll
        for (int g = 0; g < 4; ++g) { u32x2 w; w.x = pk2(o0[4 * g] * inv, o0[4 * g + 1] * inv); w.y = pk2(o0[4 * g + 2] * inv, o0[4 * g + 3] * inv); *(u32x2*)(orow + 8 * g) = w;
            u32x2 w2; w2.x = pk2(o1[4 * g] * inv, o1[4 * g + 1] * inv); w2.y = pk2(o1[4 * g + 2] * inv, o1[4 * g + 3] * inv); *(u32x2*)(orow + 32 + 8 * g) = w2; }
    }
    __syncthreads();
}

#define XB_TMO      128
#define XB_XCNT(j)  (256  + 64 * (j))
#define XB_XSUB(j)  (1280 + 64 * (j))
#define XB_XGEN(j)  (2304 + 64 * (j))
#define XB_TOP      3328
#define XB_TOPGEN   3392
#define XCD_BAR_WORDS 3456
#define XB_SPIN_CAP (1u << 18)
__device__ __forceinline__ unsigned xb_ld(unsigned* p)              { return __hip_atomic_load(p, __ATOMIC_RELAXED, __HIP_MEMORY_SCOPE_AGENT); }
__device__ __forceinline__ unsigned xb_add(unsigned* p, unsigned v) { return __hip_atomic_fetch_add(p, v, __ATOMIC_RELAXED, __HIP_MEMORY_SCOPE_AGENT); }
__device__ __forceinline__ unsigned xb_xcc_id() { return (unsigned)__builtin_amdgcn_s_getreg((3 << 11) | 20) & 0xFu; }
#define XB_SPIN(cond, bar) do { unsigned _sp = 0; while (cond) { __builtin_amdgcn_s_sleep(1); \
    if ((++_sp & 255u) == 0u) { if (xb_ld(&(bar)[XB_TMO])) break; if (_sp > XB_SPIN_CAP) { atomicAdd(&(bar)[XB_TMO], 1u); break; } } } } while (0)
struct XcdBarrier { unsigned* bar; unsigned x; volatile LAS unsigned* st; };
__device__ __forceinline__ XcdBarrier xcd_barrier_post(unsigned* bar, volatile LAS unsigned* st) {
    XcdBarrier b; b.bar = bar; b.x = xb_xcc_id(); b.st = st;
    if (threadIdx.x == 0) (void)xb_add(&bar[XB_XCNT(b.x)], 1u);
    return b;
}
__device__ __forceinline__ void xcd_barrier_complete(unsigned* bar, unsigned x, unsigned& nloc, unsigned& nx) {
    const unsigned G = gridDim.x * gridDim.y * gridDim.z;
    unsigned sum, cnt, mine, sp = 0u;
    for (;;) {
        sum = 0u; cnt = 0u; mine = 0u;
#pragma unroll
        for (unsigned j = 0; j < 16; ++j) { const unsigned c = xb_ld(&bar[XB_XCNT(j)]); sum += c; cnt += (c > 0u) ? 1u : 0u; mine = (j == x) ? c : mine; }
        if (sum == G) break;
        __builtin_amdgcn_s_sleep(1);
        if ((++sp & 255u) == 0u) { if (xb_ld(&bar[XB_TMO])) break; if (sp > XB_SPIN_CAP) { atomicAdd(&bar[XB_TMO], 1u); break; } }
    }
    nloc = mine > 0u ? mine : 1u; nx = cnt > 0u ? cnt : 1u;
}
__device__ __forceinline__ void xcd_barrier(const XcdBarrier& b) {
    asm volatile("s_waitcnt vmcnt(0)" ::: "memory");
    __syncthreads();
    if (threadIdx.x == 0) {
        unsigned* bar = b.bar;
        __builtin_amdgcn_s_waitcnt(0);
        unsigned nloc = b.st[0], nx = b.st[1];
        if (nloc == 0u) { xcd_barrier_complete(bar, b.x, nloc, nx); b.st[0] = nloc; b.st[1] = nx; }
        const unsigned old = xb_add(&bar[XB_XSUB(b.x)], 1u);
        const unsigned gen = old / nloc;
        if (old + 1u == (gen + 1u) * nloc) {
            __builtin_amdgcn_fence(__ATOMIC_RELEASE, "agent");
            asm volatile("s_waitcnt vmcnt(0)" ::: "memory");
            const unsigned og = xb_add(&bar[XB_TOP], 1u);
            const unsigned tg = og / nx;
            if (og + 1u == (tg + 1u) * nx) xb_add(&bar[XB_TOPGEN], 1u);
            else XB_SPIN(xb_ld(&bar[XB_TOPGEN]) == tg, bar);
            __builtin_amdgcn_fence(__ATOMIC_ACQUIRE, "agent");
            xb_add(&bar[XB_XGEN(b.x)], 1u);
            asm volatile("s_waitcnt vmcnt(0)" ::: "memory");
        } else {
            XB_SPIN(xb_ld(&bar[XB_XGEN(b.x)]) == gen, bar);
            __builtin_amdgcn_fence(__ATOMIC_ACQUIRE, "agent");
            asm volatile("s_waitcnt vmcnt(0)" ::: "memory");
        }
    }
    __syncthreads();
}

__global__ void __launch_bounds__(512, 2) mega_fwd(Params p) {
    extern __shared__ __attribute__((aligned(16))) unsigned char lds_raw[];
    LAS unsigned char* lds = (LAS unsigned char*)lds_raw;
    unsigned char* ws = p.ws;
    const int G = gridDim.x, c = blockIdx.x, lo = p.ph_lo, hi = p.ph_hi;
    const float* mod = (const float*)(ws + WS_MOD);
    const float* norm_g = p.in[8];
    bf16_t* H = (bf16_t*)(ws + WS_H); bf16_t* MPb = (bf16_t*)(ws + WS_MP); bf16_t* U = (bf16_t*)(ws + WS_U);
    float* X = p.out + OUT_X; bf16_t* XB = (bf16_t*)(ws + WS_XB);
    volatile LAS unsigned* MISC = (volatile LAS unsigned*)(lds + 131072 + 320);
    if (threadIdx.x < 32) MISC[threadIdx.x] = 0u;
    __syncthreads();
    XcdBarrier bar; bar.bar = (unsigned*)(ws + WS_CTL); bar.x = 0; bar.st = nullptr;
    if (hi - lo > 1) bar = xcd_barrier_post((unsigned*)(ws + WS_CTL), MISC + 8);
    if (hi > 1000) cg::this_grid().sync();
#ifndef PH_MASK
#define PH_MASK 0xffff
#endif
#define IN(k) (((PH_MASK >> (k)) & 1) && lo <= (k) && (k) < hi)
    const bool handoff = (G == 256) && (hi - lo > 1);
    unsigned* const cntb = (unsigned*)(ws + WS_CTL) + CW_CNT;
#ifndef PROBE_REP
#define PROBE_REP -1
#endif
#ifndef PROBE_SYNC2
#define PROBE_SYNC2 0
#endif
#define REPS(k) for (int rep_ = 0; rep_ < ((k) == PROBE_REP ? 2 : 1); ++rep_)
#ifndef PROBE_PHASE
#define PROBE_PHASE -1
#endif
    unsigned long long pt0 = 0, pt1 = 0;
    if (PROBE_PHASE == 0) pt0 = __builtin_amdgcn_s_memrealtime();
#define SEAM(k) SEAMX(k, false)
#define SEAMX(k, skip) do { if ((k) + 1 < hi && !(skip)) { xcd_barrier(bar); if (PROBE_SYNC2) xcd_barrier(bar); } \
        if ((k) == PROBE_PHASE) pt1 = __builtin_amdgcn_s_memrealtime(); if ((k) + 1 == PROBE_PHASE) pt0 = __builtin_amdgcn_s_memrealtime(); } while (0)

    if (IN(0)) { REPS(0) { phase_prologue(p, lds); } SEAM(0); }
    if (IN(1)) { REPS(1) {
        row_phase<false, true, true>(p.in[0], p.in[1], nullptr, nullptr, nullptr, H, nullptr, nullptr, norm_g, mod + 1 * D, mod + 0 * D);
        } SEAM(1);
    }
    if (IN(2)) {
        pg8::ChDftSched S{G, c, (const char*)(ws + WS_CSCH), (const char*)H, (bf16_t*)(ws + WS_YTP), (bf16_t*)(ws + WS_YTS)};
        pg8::gemm_phase<pg8::EpiStore, pg8::ChDftSched, true>(lds, 256, D, 256, S, pg8::EpiStore{});
        if (handoff) phase_side_jobs(p, lds, 8);
        SEAM(2);
    }
    if (IN(3)) {
        unsigned* const cf = cntb + 32;
        if (handoff) {
            int pm = -1, pn = 0;
            if (c < 64) { pm = 32 + 8 * (c >> 5) + ((c >> 2) & 7); pn = c & 3; } else if (c < 192) { pm = (c - 64) >> 2; pn = (c - 64) & 3; }
            { pg8::SeqSSched S{c, (const char*)(ws + WS_TS), (const char*)(ws + WS_YTS), (bf16_t*)(ws + WS_F)};
              pg8::gemm_phase<pg8::EpiStoreSig, pg8::SeqSSched, true>(lds, 4096, 4096, 4096, S, pg8::EpiStoreSig{cf}); }
            { pg8::SeqPSched S{G, c, (const char*)(ws + WS_TP), (const char*)(ws + WS_YTP), (bf16_t*)(ws + WS_F)};
              pg8::gemm_phase<pg8::EpiStoreSig, pg8::SeqPSched, true>(lds, 512, 512, 512, S, pg8::EpiStoreSig{cf}); }
            if (pm >= 0) {
                if (threadIdx.x == 0) { unsigned* w = cf + pm * 64; unsigned sp = 0;
                    while (__hip_atomic_load(w, __ATOMIC_RELAXED, __HIP_MEMORY_SCOPE_AGENT) < 32u) { __builtin_amdgcn_s_sleep(4); if (++sp > (1u << 22)) break; }
                    __builtin_amdgcn_fence(__ATOMIC_ACQUIRE, "agent"); asm volatile("s_waitcnt vmcnt(0)" ::: "memory"); }
                __syncthreads();
                pg8::OneSched S{pm, pn, (const char*)(ws + WS_F), (const char*)(ws + WS_WF), MPb};
                pg8::gemm_phase<pg8::EpiStoreSig, pg8::OneSched, true>(lds, D, D, D, S, pg8::EpiStoreSig{cntb + 0 * CNT_SEAM});
            }
            phase_side_jobs(p, lds, 9);
        } else {
            { pg8::SeqSSched S{c, (const char*)(ws + WS_TS), (const char*)(ws + WS_YTS), (bf16_t*)(ws + WS_F)};
              pg8::gemm_phase<pg8::EpiStoreSig, pg8::SeqSSched, true>(lds, 4096, 4096, 4096, S, pg8::EpiStoreSig{nullptr}); }
            { pg8::SeqPSched S{G, c, (const char*)(ws + WS_TP), (const char*)(ws + WS_YTP), (bf16_t*)(ws + WS_F)};
              pg8::gemm_phase<pg8::EpiStoreSig, pg8::SeqPSched, true>(lds, 512, 512, 512, S, pg8::EpiStoreSig{nullptr}); }
            phase_side_jobs(p, lds, 0);
        }
        SEAMX(3, handoff);
    }
    if (IN(4)) {
        if (!handoff) { pg8::GSched S{48, 4, G, c, (const char*)(ws + WS_F), (size_t)256 * D * 2, (const char*)(ws + WS_WF), (size_t)256 * D * 2, MPb, (size_t)256 * D, 256, D};
            pg8::gemm_phase<pg8::EpiStoreSig, pg8::GSched, true>(lds, D, D, D, S, pg8::EpiStoreSig{nullptr});
            phase_side_jobs(p, lds, 1); }
        SEAMX(4, handoff);
    }
    if (IN(5)) { REPS(5) {
        row_phase<true, true, true>(p.in[0], p.in[1], XB, MPb, nullptr, H, mod + 2 * D, norm_g + 1 * D, norm_g + 2 * D, mod + 4 * D, mod + 3 * D, handoff ? cntb + 0 * CNT_SEAM : nullptr);
        } SEAM(5);
    }
    if (IN(6)) {
        if (handoff) { pg8::GuSched S{G, c, (const char*)H, (const char*)(ws + WS_WGU), U};
            pg8::gemm_phase<pg8::EpiSwiGLU, pg8::GuSched, true>(lds, D, D, D, S, pg8::EpiSwiGLU{cntb + 4 * CNT_SEAM}); }
        else { pg8::GSched S{48, 22, G, c, (const char*)H, (size_t)256 * D * 2, (const char*)(ws + WS_WGU), (size_t)256 * D * 2, U, (size_t)256 * FF, 128, FF};
            pg8::gemm_phase<pg8::EpiSwiGLU, pg8::GSched, true>(lds, D, D, D, S, pg8::EpiSwiGLU{nullptr}); }
        SEAMX(6, handoff);
    }
    if (IN(7)) {
        if (handoff) {
            const int dd = c >= 248 ? 184 + (c - 248) : (c >= 64 ? c - 64 : (c >= 56 ? 192 + (c - 56) : -1));
            if (dd >= 0) { pg8::DownSched S{dd, (const char*)U, (const char*)(ws + WS_WD), MPb, (bf16_t*)(ws + WS_MP2)};
                if (threadIdx.x == 0) { int pm, pn, kh; S.unit(pm, pn, kh); unsigned* w = cntb + 4 * CNT_SEAM + pm * 64; unsigned sp = 0;
                    while (__hip_atomic_load(w, __ATOMIC_RELAXED, __HIP_MEMORY_SCOPE_AGENT) < 176u) { __builtin_amdgcn_s_sleep(4); if (++sp > (1u << 22)) break; }
                    __builtin_amdgcn_fence(__ATOMIC_ACQUIRE, "agent"); asm volatile("s_waitcnt vmcnt(0)" ::: "memory"); }
                __syncthreads();
                if (dd < 184) pg8::gemm_phase<pg8::EpiStoreSig, pg8::DownSched, true>(lds, FF, FF, FF, S, pg8::EpiStoreSig{cntb + 1 * CNT_SEAM});
                else pg8::gemm_phase<pg8::EpiStoreSig, pg8::DownSched, true>(lds, FF, FF, FF / 2, S, pg8::EpiStoreSig{cntb + 1 * CNT_SEAM}); }
            else { phase_side_jobs(p, lds, 5); }
        } else { pg8::GSched S{48, 4, G, c, (const char*)U, (size_t)256 * FF * 2, (const char*)(ws + WS_WD), (size_t)256 * FF * 2, MPb, (size_t)256 * D, 256, D};
            pg8::gemm_phase<pg8::EpiStoreSig, pg8::GSched, true>(lds, FF, FF, FF, S, pg8::EpiStoreSig{nullptr});
            phase_side_jobs(p, lds, 2); }
        SEAMX(7, handoff);
    }
    if (IN(8)) { REPS(8) {
        row_phase<true, true, false>(nullptr, nullptr, XB, MPb, nullptr, H, mod + 5 * D, norm_g + 3 * D, norm_g + 4 * D, mod + 3 * 6144 + 1 * D, mod + 3 * 6144 + 0 * D, handoff ? cntb + 1 * CNT_SEAM : nullptr, handoff ? (const bf16_t*)(ws + WS_MP2) : nullptr);
        } SEAM(8);
    }
    if (IN(9)) {
        unsigned* const cq = cntb + 16;
        pg8::EpiQKV E{(bf16_t*)(ws + WS_Q), (bf16_t*)(ws + WS_K), (bf16_t*)(ws + WS_VT), p.out + OUT_CK, p.out + OUT_CV, handoff ? cq : nullptr};
        if (handoff) {
            { pg8::QkvSched S{G, c, (const char*)H, (const char*)(ws + WS_WQKV)};
              pg8::gemm_phase<pg8::EpiQKV, pg8::QkvSched, true>(lds, D, D, D, S, E); }
            if (c >= 64) {
                if (threadIdx.x == 0) { for (int u = 256 + (c - 64); u < 768; u += 192) { unsigned* w = cq + ((u - 256) >> 4) * 64; unsigned sp = 0;
                        while (__hip_atomic_load(w, __ATOMIC_RELAXED, __HIP_MEMORY_SCOPE_AGENT) < 96u) { __builtin_amdgcn_s_sleep(4); if (++sp > (1u << 22)) break; } }
                    __builtin_amdgcn_fence(__ATOMIC_ACQUIRE, "agent"); asm volatile("s_waitcnt vmcnt(0)" ::: "memory"); }
                __syncthreads();
                attn_phase(p, lds, 256, 768, c - 64, 192);
            }
            if (threadIdx.x == 0) { for (int pp = 32 + 8 * (c >> 7); pp < 40 + 8 * (c >> 7); ++pp) { unsigned* w = cq + pp * 64; unsigned sp = 0;
                    while (__hip_atomic_load(w, __ATOMIC_RELAXED, __HIP_MEMORY_SCOPE_AGENT) < 96u) { __builtin_amdgcn_s_sleep(4); if (++sp > (1u << 22)) break; } }
                __builtin_amdgcn_fence(__ATOMIC_ACQUIRE, "agent"); asm volatile("s_waitcnt vmcnt(0)" ::: "memory"); }
            __syncthreads();
            attn_phase(p, lds, c, c + 1, 0, 1);
            if (c < 64) { const int gw = c * 8 + (threadIdx.x >> 6);
                transpose_jobs(p, lds, gw, 64 * 8, TI_L0 + 2 * 1408, TI_L0 + 3 * 1408); transpose_jobs(p, lds, gw, 64 * 8, TI_L0 + 3 * 1408 + 1536, TI_ALL); }
        } else {
            pg8::GSched S{48, 12, G, c, (const char*)H, (size_t)256 * D * 2, (const char*)(ws + WS_WQKV), (size_t)256 * D * 2, nullptr, 0, 0, D};
            pg8::gemm_phase<pg8::EpiQKV, pg8::GSched, true>(lds, D, D, D, S, E);
        }
        SEAMX(9, handoff);
    }
    if (IN(10)) { if (!handoff) attn_phase(p, lds, 0, 768, c, G); SEAM(10); }
    if (IN(11)) { REPS(11) {
        pg8::GSched S{48, 4, G, c, (const char*)H, (size_t)256 * D * 2, (const char*)(ws + WS_WO), (size_t)256 * D * 2, MPb, (size_t)256 * D, 256, D};
        pg8::gemm_phase<pg8::EpiStoreSig, pg8::GSched, true>(lds, D, D, D, S, pg8::EpiStoreSig{handoff ? cntb + 2 * CNT_SEAM : nullptr});
        if (handoff) phase_side_jobs(p, lds, 7);
        } SEAMX(11, handoff);
    }
    if (IN(12)) { REPS(12) {
        row_phase<true, true, false>(nullptr, nullptr, XB, MPb, nullptr, H, mod + 3 * 6144 + 2 * D, norm_g + 5 * D, norm_g + 6 * D, mod + 3 * 6144 + 4 * D, mod + 3 * 6144 + 3 * D, handoff ? cntb + 2 * CNT_SEAM : nullptr);
        } SEAM(12);
    }
    if (IN(13)) {
        if (handoff) { pg8::GuSched S{G, c, (const char*)H, (const char*)(ws + WS_WGU) + (size_t)2 * FF * D * 2, U};
            pg8::gemm_phase<pg8::EpiSwiGLU, pg8::GuSched, true>(lds, D, D, D, S, pg8::EpiSwiGLU{cntb + 5 * CNT_SEAM}); }
        else { pg8::GSched S{48, 22, G, c, (const char*)H, (size_t)256 * D * 2, (const char*)(ws + WS_WGU) + (size_t)2 * FF * D * 2, (size_t)256 * D * 2, U, (size_t)256 * FF, 128, FF};
            pg8::gemm_phase<pg8::EpiSwiGLU, pg8::GSched, true>(lds, D, D, D, S, pg8::EpiSwiGLU{nullptr}); }
        SEAMX(13, handoff);
    }
    if (IN(14)) {
        if (handoff) {
            const int dd = c >= 248 ? 184 + (c - 248) : (c >= 64 ? c - 64 : (c >= 56 ? 192 + (c - 56) : -1));
            if (dd >= 0) { pg8::DownSched S{dd, (const char*)U, (const char*)(ws + WS_WD) + (size_t)D * FF * 2, MPb, (bf16_t*)(ws + WS_MP2)};
                if (threadIdx.x == 0) { int pm, pn, kh; S.unit(pm, pn, kh); unsigned* w = cntb + 5 * CNT_SEAM + pm * 64; unsigned sp = 0;
                    while (__hip_atomic_load(w, __ATOMIC_RELAXED, __HIP_MEMORY_SCOPE_AGENT) < 176u) { __builtin_amdgcn_s_sleep(4); if (++sp > (1u << 22)) break; }
                    __builtin_amdgcn_fence(__ATOMIC_ACQUIRE, "agent"); asm volatile("s_waitcnt vmcnt(0)" ::: "memory"); }
                __syncthreads();
                if (dd < 184) pg8::gemm_phase<pg8::EpiStoreSig, pg8::DownSched, true>(lds, FF, FF, FF, S, pg8::EpiStoreSig{cntb + 3 * CNT_SEAM});
                else pg8::gemm_phase<pg8::EpiStoreSig, pg8::DownSched, true>(lds, FF, FF, FF / 2, S, pg8::EpiStoreSig{cntb + 3 * CNT_SEAM}); }
            else {  }
        } else { pg8::GSched S{48, 4, G, c, (const char*)U, (size_t)256 * FF * 2, (const char*)(ws + WS_WD) + (size_t)D * FF * 2, (size_t)256 * FF * 2, MPb, (size_t)256 * D, 256, D};
            pg8::gemm_phase<pg8::EpiStoreSig, pg8::GSched, true>(lds, FF, FF, FF, S, pg8::EpiStoreSig{nullptr});
             }
        SEAMX(14, handoff);
    }
    if (IN(15)) { REPS(15) {
        row_phase<true, false, false>(nullptr, nullptr, XB, MPb, X, nullptr, mod + 3 * 6144 + 5 * D, norm_g + 7 * D, nullptr, nullptr, nullptr, handoff ? cntb + 3 * CNT_SEAM : nullptr, handoff ? (const bf16_t*)(ws + WS_MP2) : nullptr); }
    }
    if (PROBE_PHASE >= 0 && blockIdx.x == 0) { if (PROBE_PHASE == 15) pt1 = __builtin_amdgcn_s_memrealtime();
        const unsigned long long tend = __builtin_amdgcn_s_memrealtime(), wait = 9ull * (pt1 - pt0);
        while (__builtin_amdgcn_s_memrealtime() - tend < wait) __builtin_amdgcn_s_sleep(8); }
#undef IN
#undef SEAM
}

constexpr int LDS_BYTES = 147456;
extern "C" void kernel_launch(void* const* d_in, const int* in_sizes, int n_in, void* d_out, int out_size, void* d_ws, size_t ws_size, hipStream_t stream) {
    static int grid = 0;
    if (grid == 0) {
        int dev = 0, cus = 0, per_cu = 0;
        hipGetDevice(&dev);
        hipDeviceGetAttribute(&cus, hipDeviceAttributeMultiprocessorCount, dev);
        if (hipFuncSetAttribute((const void*)mega_fwd, hipFuncAttributeMaxDynamicSharedMemorySize, LDS_BYTES) != hipSuccess) fprintf(stderr, "kernel_launch: hipFuncSetAttribute failed\n");
        if (hipOccupancyMaxActiveBlocksPerMultiprocessor(&per_cu, (const void*)mega_fwd, 512, LDS_BYTES) != hipSuccess || per_cu < 1) { fprintf(stderr, "kernel_launch: occupancy query says %d\n", per_cu); per_cu = 1; }
        (void)hipGetLastError();
        grid = cus * 1;
        if (n_in != 16 || ws_size < WS_END) { fprintf(stderr, "kernel_launch: unexpected n_in %d / ws %zu\n", n_in, ws_size); }
    }
    Params p{};
    (void)hipMemsetAsync((unsigned char*)d_ws, 0, WS_CTL + CTL_BYTES, stream);
    for (int i = 0; i < 16; ++i) p.in[i] = (const float*)d_in[i];
    p.out = (float*)d_out; p.ws = (unsigned char*)d_ws;
    if (MK_N_LAUNCHES == 1) {
        p.ph_lo = 0; p.ph_hi = NPHASE;
        void* args[] = {&p};
        hipError_t e = hipLaunchCooperativeKernel((const void*)mega_fwd, dim3(grid), dim3(512), args, LDS_BYTES, stream);
        if (e != hipSuccess) fprintf(stderr, "cooperative launch failed: %s (grid %d)\n", hipGetErrorString(e), grid);
    } else {
        for (int k = 0; k < NPHASE; ++k) { p.ph_lo = k; p.ph_hi = k + 1; hipLaunchKernelGGL(mega_fwd, dim3(grid), dim3(512), LDS_BYTES, stream, p); }
    }
}
```

```cpp
#include <hip/hip_runtime.h>
#include <hip/hip_cooperative_groups.h>
#include <cstdio>
#include <cstdint>
namespace cg = cooperative_groups;

#ifndef MK_N_LAUNCHES
#define MK_N_LAUNCHES 1
#endif

#define LAS __attribute__((address_space(3)))
typedef unsigned short bf16_t;
typedef short bf16x8 __attribute__((ext_vector_type(8)));
typedef float f32x2 __attribute__((ext_vector_type(2)));
typedef float f32x4 __attribute__((ext_vector_type(4)));
typedef float f32x16 __attribute__((ext_vector_type(16)));
typedef unsigned u32x2 __attribute__((ext_vector_type(2)));
typedef unsigned u32x4 __attribute__((ext_vector_type(4)));
typedef __bf16 bf16x2_t __attribute__((ext_vector_type(2)));

constexpr int D = 1024, NP = 8192, NS = 4096, M = NP + NS, SP = 256, SS = 2048, FF = 2816, NH = 16, HD = 64;
constexpr int NPHASE = 16;
constexpr size_t MiB = 1u << 20;
constexpr size_t WS_CTL = 160 * 1024, CTL_BYTES = 96 * 1024;
constexpr int CW_CNT = 4096, CNT_SEAM = 48 * 64;
constexpr size_t WS_MOD = 0, WS_CSCH = 256 * 1024, WS_TP = 512 * 1024, WS_WF = 1 * MiB, WS_WQKV = 3 * MiB,
                 WS_WO = 9 * MiB, WS_WGU = 11 * MiB, WS_WD = 33 * MiB, WS_H = 44 * MiB, WS_MP = 68 * MiB, WS_U = 92 * MiB, WS_R = 158 * MiB;
constexpr size_t WS_YTP = WS_U, WS_YTS = WS_U + 32 * MiB;
constexpr size_t WS_TS = WS_R, WS_F = WS_R + 16 * MiB;
constexpr size_t WS_Q = WS_R, WS_K = WS_R + 24 * MiB, WS_VT = WS_R + 48 * MiB;
constexpr size_t WS_XB = WS_R + 72 * MiB, WS_MP2 = WS_XB + 24 * MiB, WS_END = WS_MP2 + 1 * MiB;
constexpr size_t OUTB_KC = 0, OUTB_VC = 2 * MiB;
constexpr size_t OUT_X = 0, OUT_CK = (size_t)M * D, OUT_CV = OUT_CK + (size_t)NP * D;

struct Params {
    const float* in[16];
    float* out; unsigned char* ws;
    int ph_lo, ph_hi;
};

__device__ __forceinline__ unsigned pk2(float lo, float hi) { f32x2 v = {lo, hi}; bf16x2_t b = __builtin_convertvector(v, bf16x2_t); return __builtin_bit_cast(unsigned, b); }
__device__ __forceinline__ float bf_lo(unsigned w) { return __uint_as_float(w << 16); }
__device__ __forceinline__ float bf_hi(unsigned w) { return __uint_as_float(w & 0xffff0000u); }
template <int CTRL> __device__ __forceinline__ float dpp_mov(float v) { return __builtin_bit_cast(float, __builtin_amdgcn_mov_dpp(__builtin_bit_cast(int, v), CTRL, 0xf, 0xf, true)); }
__device__ __forceinline__ float wave_sum(float v) {
    v += dpp_mov<0xB1>(v); v += dpp_mov<0x4E>(v); v += dpp_mov<0x141>(v); v += dpp_mov<0x140>(v);
    { auto rr = __builtin_amdgcn_permlane16_swap(__float_as_uint(v), __float_as_uint(v), false, false); v = __uint_as_float(rr[0]) + __uint_as_float(rr[1]); }
    { auto rr = __builtin_amdgcn_permlane32_swap(__float_as_uint(v), __float_as_uint(v), false, false); v = __uint_as_float(rr[0]) + __uint_as_float(rr[1]); }
    return v;
}

namespace pg8 {
constexpr int BM = 256, BK = 64, HALF = 128, HTB = HALF * BK * 2, STAGE_BYTES = 8 * HTB;
__device__ __forceinline__ int lds_byte(int r, int c) { const int st = (r >> 4) * 2 + (c >> 5), rr = r & 15, cc = c & 31, ob = rr * 64 + cc * 2; return st * 1024 + (ob ^ (((ob >> 9) & 1) << 5)); }
__device__ __forceinline__ void stage_rc(int b, int& R, int& C) { const int st = b / 1024, sb = b % 1024, swz = sb ^ (((sb >> 9) & 1) << 5); R = (st >> 1) * 16 + swz / 64; C = (st & 1) * 32 + (swz % 64) / 2; }
__device__ __forceinline__ int perm32(int rho) { const int n = rho >> 4, i = rho & 15; return 8 * (i >> 2) + 4 * n + (i & 3); }

struct UnitDesc { const char* A; const char* B; bf16_t* out; int ldc; int aux; };

__device__ __forceinline__ void tile_order(int L, int nM, int nN, int& pm, int& pn) {
    const int nwg = nM * nN; int wgid = L;
    { const int q = nwg / 8, r = nwg % 8, xcd = wgid % 8, off = wgid / 8; wgid = (xcd < r ? xcd * (q + 1) : r * (q + 1) + (xcd - r) * q) + off; }
    const int nig = 8 * nN, gid = wgid / nig, fm = gid * 8, gsz = (nM - fm) < 8 ? (nM - fm) : 8;
    pm = fm + ((wgid % nig) % gsz); pn = (wgid % nig) / gsz;
}

template <class Epi, class Sched, bool ALIGN_EPI>
__device__ __forceinline__ void gemm_phase(LAS unsigned char* lds, const int lda, const int ldb, const int K, const Sched& S, const Epi& E) {
    const int tid = threadIdx.x, wid = __builtin_amdgcn_readfirstlane(tid >> 6), lane = tid & 63, wr = wid >> 2, wc = wid & 3, fr = lane & 15, fq = lane >> 4;
    const int nt = K / BK;
    unsigned voffA[2], voffB[2];
#pragma unroll
    for (int i = 0; i < 2; ++i) { int R, C; stage_rc(tid * 16 + i * 8192, R, C); const int Rb = (R & ~31) + perm32(R & 31);
        voffA[i] = (unsigned)(R * lda + C) * 2u; voffB[i] = (unsigned)(Rb * ldb + C) * 2u; }
    const size_t kstep = (size_t)(BK * 2);
    const size_t hstepA = (size_t)HALF * lda * 2, hstepB = (size_t)HALF * ldb * 2;
    const unsigned ldsw = (unsigned)wid * 1024u;
    const int aoff = lds_byte(wr * 64 + fr, fq * 8), boff = lds_byte(wc * 32 + fr, fq * 8);
#define PG8_SA(b, h) (((b) * 2 + (h)) * HTB)
#define PG8_SB(b, h) ((4 + (b) * 2 + (h)) * HTB)
#define PG8_STAGE(bufoff, gbase, voff) do { _Pragma("unroll") for (int _i = 0; _i < 2; ++_i) \
        __builtin_amdgcn_global_load_lds((const unsigned*)((const char*)(gbase) + (voff)[_i]), (LAS unsigned*)(lds + (bufoff) + ldsw + _i * 8192), 16, 0, 0); } while (0)
#define PG8_LDA(dst, b, h) do { _Pragma("unroll") for (int m = 0; m < 4; ++m) _Pragma("unroll") for (int k = 0; k < 2; ++k) dst[m][k] = *(const LAS bf16x8*)(lds + PG8_SA(b, h) + aoff + m * 2048 + k * 1024); } while (0)
#define PG8_LDB(dst, b, h) do { _Pragma("unroll") for (int n = 0; n < 2; ++n) _Pragma("unroll") for (int k = 0; k < 2; ++k) dst[n][k] = *(const LAS bf16x8*)(lds + PG8_SB(b, h) + boff + n * 2048 + k * 1024); } while (0)
#define PG8_MMA(ai, bj, At, Bt) do { __builtin_amdgcn_s_setprio(1); _Pragma("unroll") for (int m = 0; m < 4; ++m) _Pragma("unroll") for (int n = 0; n < 2; ++n) _Pragma("unroll") for (int k = 0; k < 2; ++k) \
        acc[ai][bj][m][n] = __builtin_amdgcn_mfma_f32_16x16x32_bf16(Bt[n][k], At[m][k], acc[ai][bj][m][n], 0, 0, 0); __builtin_amdgcn_s_setprio(0); } while (0)
#define PG8_WAIT_V(n) asm volatile("s_waitcnt vmcnt(" #n ")" ::: "memory")
#define PG8_WAIT_L(n) asm volatile("s_waitcnt lgkmcnt(" #n ")" ::: "memory")
#define PG8_BAR __builtin_amdgcn_s_barrier()
#define PG8_SCHED __builtin_amdgcn_sched_barrier(0)
    UnitDesc cur, nxt; int ui = 0;
    if (!S.next(0, cur)) return;
    f32x4 acc[2][2][4][2];
#pragma unroll
    for (int a = 0; a < 2; ++a)
#pragma unroll
        for (int b = 0; b < 2; ++b)
#pragma unroll
            for (int m = 0; m < 4; ++m)
#pragma unroll
                for (int n = 0; n < 2; ++n) acc[a][b][m][n] = (f32x4){0.f, 0.f, 0.f, 0.f};
    bf16x8 At[4][2], B0[2][2], B1[2][2];
    const char* cA = cur.A; const char* cB = cur.B;
    PG8_STAGE(PG8_SB(0, 0), cB, voffB); PG8_STAGE(PG8_SB(0, 1), cB + hstepB, voffB); PG8_STAGE(PG8_SA(0, 0), cA, voffA); PG8_STAGE(PG8_SA(0, 1), cA + hstepA, voffA);
    if (wr == 1) PG8_BAR;
    PG8_WAIT_V(2); PG8_BAR;
    PG8_STAGE(PG8_SB(1, 0), cB + kstep, voffB); PG8_STAGE(PG8_SA(1, 0), cA + kstep, voffA); PG8_STAGE(PG8_SB(1, 1), cB + hstepB + kstep, voffB);
    PG8_WAIT_V(6); PG8_BAR;
    for (;;) {
        const bool has_next = S.next(ui + 1, nxt);
        const char* nA = has_next ? nxt.A : cA; const char* nB = has_next ? nxt.B : cB;
#pragma unroll 1
        for (int t = 0; t < nt; t += 2) {
            const bool last = (t == nt - 2);
            const char* a1 = cA + (size_t)(t + 1) * kstep;
            const char* a2 = last ? nA : cA + (size_t)(t + 2) * kstep; const char* b2 = last ? nB : cB + (size_t)(t + 2) * kstep;
            const char* a3 = a2 + kstep; const char* b3 = b2 + kstep;
            PG8_LDB(B0, 0, 0); PG8_LDB(B1, 0, 1); PG8_SCHED; PG8_LDA(At, 0, 0); PG8_STAGE(PG8_SA(1, 1), a1 + hstepA, voffA);
            PG8_WAIT_V(8); PG8_WAIT_L(0); PG8_BAR; PG8_MMA(0, 0, At, B0); PG8_MMA(0, 1, At, B1); PG8_BAR; PG8_SCHED;
            PG8_LDA(At, 0, 1); PG8_STAGE(PG8_SB(0, 0), b2, voffB); PG8_STAGE(PG8_SB(0, 1), b2 + hstepB, voffB); PG8_STAGE(PG8_SA(0, 0), a2, voffA);
            PG8_WAIT_V(8); PG8_WAIT_L(0); PG8_BAR; PG8_MMA(1, 0, At, B0); PG8_MMA(1, 1, At, B1); PG8_BAR; PG8_SCHED;
            PG8_LDB(B0, 1, 0); PG8_LDB(B1, 1, 1); PG8_SCHED; PG8_LDA(At, 1, 0); PG8_STAGE(PG8_SA(0, 1), a2 + hstepA, voffA);
            PG8_WAIT_V(8); PG8_WAIT_L(0); PG8_BAR; PG8_MMA(0, 0, At, B0); PG8_MMA(0, 1, At, B1); PG8_BAR; PG8_SCHED;
            PG8_LDA(At, 1, 1); PG8_STAGE(PG8_SB(1, 0), b3, voffB); PG8_STAGE(PG8_SB(1, 1), b3 + hstepB, voffB); PG8_STAGE(PG8_SA(1, 0), a3, voffA);
            PG8_WAIT_V(8); PG8_WAIT_L(0); PG8_BAR; PG8_MMA(1, 0, At, B0); PG8_MMA(1, 1, At, B1); PG8_BAR; PG8_SCHED;
        }
        if constexpr (ALIGN_EPI) { if (wr == 0) PG8_BAR; }
        E(acc, cur, wr, wc, fr, fq);
        if (!has_next) break;
#pragma unroll
        for (int a = 0; a < 2; ++a)
#pragma unroll
            for (int b = 0; b < 2; ++b)
#pragma unroll
                for (int m = 0; m < 4; ++m)
#pragma unroll
                    for (int n = 0; n < 2; ++n) acc[a][b][m][n] = (f32x4){0.f, 0.f, 0.f, 0.f};
        cur = nxt; cA = nA; cB = nB; ++ui;
        if constexpr (ALIGN_EPI) { if (wr == 1) PG8_BAR; }
    }
    PG8_WAIT_V(0);
    if constexpr (!ALIGN_EPI) { if (wr == 0) PG8_BAR; }
    PG8_BAR;
#undef PG8_SA
#undef PG8_SB
#undef PG8_STAGE
#undef PG8_LDA
#undef PG8_LDB
#undef PG8_MMA
#undef PG8_WAIT_V
#undef PG8_WAIT_L
#undef PG8_BAR
#undef PG8_SCHED
}

struct EpiStore {
    __device__ __forceinline__ void operator()(const f32x4 (&acc)[2][2][4][2], const UnitDesc& u, int wr, int wc, int fr, int fq) const {
#pragma unroll
        for (int ai = 0; ai < 2; ++ai)
#pragma unroll
            for (int m = 0; m < 4; ++m) { bf16_t* rowp = u.out + (size_t)(ai * HALF + wr * 64 + m * 16 + fr) * u.ldc + wc * 32 + 8 * fq;
#pragma unroll
                for (int bj = 0; bj < 2; ++bj) { const f32x4 v0 = acc[ai][bj][m][0], v1 = acc[ai][bj][m][1];
                    u32x4 w; w.x = pk2(v0[0], v0[1]); w.y = pk2(v0[2], v0[3]); w.z = pk2(v1[0], v1[1]); w.w = pk2(v1[2], v1[3]);
                    *(u32x4*)(rowp + bj * HALF) = w; } }
    }
};
__device__ __forceinline__ void store16_sc1(void* ptr, u32x4 v) { asm volatile("global_store_dwordx4 %0, %1, off sc0 sc1\n\ts_nop 3" :: "v"(ptr), "v"(v) : "memory"); }
struct EpiStoreSig {
    unsigned* cnt;
    __device__ __forceinline__ void operator()(const f32x4 (&acc)[2][2][4][2], const UnitDesc& u, int wr, int wc, int fr, int fq) const {
#pragma unroll
        for (int ai = 0; ai < 2; ++ai)
#pragma unroll
            for (int m = 0; m < 4; ++m) { bf16_t* rowp = u.out + (size_t)(ai * HALF + wr * 64 + m * 16 + fr) * u.ldc + wc * 32 + 8 * fq;
#pragma unroll
                for (int bj = 0; bj < 2; ++bj) { const f32x4 v0 = acc[ai][bj][m][0], v1 = acc[ai][bj][m][1];
                    u32x4 w; w.x = pk2(v0[0], v0[1]); w.y = pk2(v0[2], v0[3]); w.z = pk2(v1[0], v1[1]); w.w = pk2(v1[2], v1[3]);
                    if (cnt) store16_sc1(rowp + bj * HALF, w); else *(u32x4*)(rowp + bj * HALF) = w; } }
        if (cnt) { asm volatile("s_waitcnt vmcnt(0)" ::: "memory");
            if ((threadIdx.x & 63) == 0) __hip_atomic_fetch_add(cnt + (u.aux & 0xffff) * 64, 1u, __ATOMIC_RELAXED, __HIP_MEMORY_SCOPE_AGENT); }
    }
};
__device__ __forceinline__ float swiglu1(float g, float u) { return g * u * __builtin_amdgcn_rcpf(1.0f + __builtin_amdgcn_exp2f(-1.4426950408889634f * g)); }
struct EpiSwiGLU {
    unsigned* cnt;
    __device__ __forceinline__ void operator()(const f32x4 (&acc)[2][2][4][2], const UnitDesc& u, int wr, int wc, int fr, int fq) const {
#pragma unroll
        for (int ai = 0; ai < 2; ++ai)
#pragma unroll
            for (int m = 0; m < 4; ++m) { bf16_t* rowp = u.out + (size_t)(ai * HALF + wr * 64 + m * 16 + fr) * u.ldc + wc * 32 + 8 * fq;
                const f32x4 g0 = acc[ai][0][m][0], g1 = acc[ai][0][m][1], u0 = acc[ai][1][m][0], u1 = acc[ai][1][m][1];
                u32x4 w; w.x = pk2(swiglu1(g0[0], u0[0]), swiglu1(g0[1], u0[1])); w.y = pk2(swiglu1(g0[2], u0[2]), swiglu1(g0[3], u0[3]));
                w.z = pk2(swiglu1(g1[0], u1[0]), swiglu1(g1[1], u1[1])); w.w = pk2(swiglu1(g1[2], u1[2]), swiglu1(g1[3], u1[3]));
                if (cnt) store16_sc1(rowp, w); else *(u32x4*)rowp = w; }
        if (cnt) { asm volatile("s_waitcnt vmcnt(0)" ::: "memory");
            if ((threadIdx.x & 63) == 0) __hip_atomic_fetch_add(cnt + (u.aux & 0xffff) * 64, 1u, __ATOMIC_RELAXED, __HIP_MEMORY_SCOPE_AGENT); }
    }
};
struct EpiQKV {
    bf16_t* Q; bf16_t* Kb; bf16_t* Vb; float* ck; float* cv; unsigned* cnt;
    __device__ __forceinline__ void operator()(const f32x4 (&acc)[2][2][4][2], const UnitDesc& u, int wr, int wc, int fr, int fq) const {
        const int pm = u.aux & 0xffff, pn = u.aux >> 16, sel = pn >> 2, ct = (pn & 3) * BM;
        const int row0 = pm * BM + wr * 64 + fr, col0 = ct + wc * 32 + 8 * fq;
        bf16_t* base = Q + (size_t)sel * (size_t)(12 * 1024 * 1024); float* cb = ck + (size_t)(sel >= 1 ? sel - 1 : 0) * (size_t)NP * D;
        const bool wc32 = sel >= 1 && pm < NP / BM;
#pragma unroll
        for (int ai = 0; ai < 2; ++ai)
#pragma unroll
            for (int m = 0; m < 4; ++m) { const size_t off = (size_t)(row0 + ai * HALF + m * 16) * D + col0;
#pragma unroll
                for (int bj = 0; bj < 2; ++bj) { const f32x4 v0 = acc[ai][bj][m][0], v1 = acc[ai][bj][m][1];
                    u32x4 w; w.x = pk2(v0[0], v0[1]); w.y = pk2(v0[2], v0[3]); w.z = pk2(v1[0], v1[1]); w.w = pk2(v1[2], v1[3]);
                    if (cnt) store16_sc1(base + off + bj * HALF, w); else *(u32x4*)(base + off + bj * HALF) = w;
                    if (wc32) { *(f32x4*)(cb + off + bj * HALF) = v0; *(f32x4*)(cb + off + bj * HALF + 4) = v1; } } }
        if (cnt) { asm volatile("s_waitcnt vmcnt(0)" ::: "memory");
            if ((threadIdx.x & 63) == 0) __hip_atomic_fetch_add(cnt + pm * 64, 1u, __ATOMIC_RELAXED, __HIP_MEMORY_SCOPE_AGENT); }
    }
};

struct GSched {
    int nM, nN, G, c; const char* A; size_t a_tile; const char* B; size_t b_tile; bf16_t* out; size_t o_pm, o_pn; int ldc;
    __device__ __forceinline__ bool next(int i, UnitDesc& u) const {
        const long L = (long)i * G + c; if (L >= (long)nM * nN) return false;
        int pm, pn; tile_order((int)L, nM, nN, pm, pn);
        u.A = A + (size_t)pm * a_tile; u.B = B + (size_t)pn * b_tile; u.out = out + (size_t)pm * o_pm + (size_t)pn * o_pn; u.ldc = ldc; u.aux = pm | (pn << 16); return true;
    }
};
struct ChDftSched {
    int G, c; const char* cs_tab; const char* H; bf16_t* ytp; bf16_t* yts;
    __device__ __forceinline__ bool next(int i, UnitDesc& u) const {
        const long L = (long)i * G + c; if (L >= 48 * 8) return false;
        int tok, gc; tile_order((int)L, 48, 8, tok, gc); const int g = gc >> 1, cs = gc & 1;
        u.A = cs_tab + (size_t)cs * 256 * 256 * 2; u.B = H + ((size_t)tok * 256 * D + g * 256) * 2;
        if (tok < 32) { u.out = ytp + ((size_t)(tok * D + g * 256) * 512 + cs * 256); u.ldc = 512; }
        else { const int idx = tok - 32, b = idx >> 3, s0 = (idx & 7) * 256; u.out = yts + ((size_t)(b * D + g * 256) * 4096 + cs * 2048 + s0); u.ldc = 4096; }
        u.aux = 0; return true;
    }
};
struct SeqSSched {
    int c; const char* ts; const char* yts; bf16_t* F;
    __device__ __forceinline__ bool next(int i, UnitDesc& u) const {
        if (i > 0 || c >= 64) return false;
        const int b = c >> 5, pm = (c >> 2) & 7, pn = c & 3;
        u.A = ts + (size_t)pm * 256 * 4096 * 2; u.B = yts + (size_t)(b * D + pn * 256) * 4096 * 2;
        u.out = F + ((size_t)(NP + b * SS + pm * 256) * D + pn * 256); u.ldc = D; u.aux = 32 + 8 * b + pm; return true;
    }
};
struct SeqPSched {
    int G, c; const char* tp; const char* ytp; bf16_t* F;
    __device__ __forceinline__ bool next(int i, UnitDesc& u) const {
        const int G2 = G - 64; if (c < 64 || G2 <= 0) return false;
        const long L = (long)i * G2 + (c - 64); if (L >= 128) return false;
        const int b = (int)L >> 2, pn = (int)L & 3;
        u.A = tp; u.B = ytp + (size_t)(b * D + pn * 256) * 512 * 2;
        u.out = F + ((size_t)(b * 256) * D + pn * 256); u.ldc = D; u.aux = b; return true;
    }
};
struct GuSched {
    int G, c; const char* A; const char* B; bf16_t* out;
    __device__ __forceinline__ bool next(int i, UnitDesc& u) const {
        const long L = (long)i * G + c; if (L >= 1056) return false;
        int pm, pn; if (L < 1012) tile_order((int)L, 46, 22, pm, pn); else { const int j = (int)L - 1012; pm = 46 + j / 22; pn = j % 22; }
        u.A = A + (size_t)pm * 256 * D * 2; u.B = B + (size_t)pn * 256 * D * 2; u.out = out + (size_t)pm * 256 * FF + (size_t)pn * 128; u.ldc = FF; u.aux = pm | (pn << 16); return true;
    }
};
struct DownSched {
    int d; const char* A; const char* B; bf16_t* out; bf16_t* out2;
    __device__ __forceinline__ void unit(int& pm, int& pn, int& kh) const { kh = 0; if (d < 184) tile_order(d, 46, 4, pm, pn); else { const int j = d - 184, un = j >> 1; kh = j & 1; pm = 46 + un / 4; pn = un % 4; } }
    __device__ __forceinline__ bool next(int i, UnitDesc& u) const {
        if (i > 0 || d < 0 || d >= 200) return false;
        int pm, pn, kh; unit(pm, pn, kh);
        u.A = A + (size_t)pm * 256 * FF * 2 + (size_t)kh * (FF / 2) * 2; u.B = B + (size_t)pn * 256 * FF * 2 + (size_t)kh * (FF / 2) * 2;
        u.out = kh ? out2 + (size_t)(pm - 46) * 256 * D + (size_t)pn * 256 : out + (size_t)pm * 256 * D + (size_t)pn * 256; u.ldc = D; u.aux = pm | (pn << 16); return true;
    }
};
struct QkvSched {
    int G, c; const char* A; const char* B;
    __device__ __forceinline__ bool next(int i, UnitDesc& u) const {
        const long L = (long)i * G + c; if (L >= 576) return false;
        int pm, pn; if (L < 384) tile_order((int)L, 32, 12, pm, pn); else { tile_order((int)L - 384, 16, 12, pm, pn); pm += 32; }
        u.A = A + (size_t)pm * 256 * D * 2; u.B = B + (size_t)pn * 256 * D * 2; u.out = nullptr; u.ldc = D; u.aux = pm | (pn << 16); return true;
    }
};
struct OneSched {
    int pm, pn; const char* A; const char* B; bf16_t* out;
    __device__ __forceinline__ bool next(int i, UnitDesc& u) const {
        if (i > 0 || pm < 0) return false;
        u.A = A + (size_t)pm * 256 * D * 2; u.B = B + (size_t)pn * 256 * D * 2; u.out = out + (size_t)pm * 256 * D + (size_t)pn * 256; u.ldc = D; u.aux = pm | (pn << 16); return true;
    }
};
}

constexpr int TI_L0 = 16 * 32 + 2 * 16 * 88 + 44 * 32, TI_ALL = 16 * 32 + 16 * 96 + 16 * 32 + 4 * 16 * 88 + 2 * 44 * 32;
struct TItem { const float* W; bf16_t* WT; int N, ldt, dst, k0, n0; };
__device__ __forceinline__ bool titem_decode(const Params& p, int it, TItem& t) {
    constexpr int I_F = 16 * 32, I_QKV = 16 * 96, I_O = 16 * 32, I_G = 16 * 88, I_D = 44 * 32;
    constexpr int NITEMS = I_F + I_QKV + I_O + 4 * I_G + 2 * I_D;
    if (it >= NITEMS) return false;
    unsigned char* ws = p.ws; int r = it; int mode = 0;
    if (r < I_F) { t.W = p.in[9]; t.N = D; t.ldt = D; t.WT = (bf16_t*)(ws + WS_WF); }
    else { r -= I_F; int l = 0; if (r >= 2 * I_G + I_D) { r -= 2 * I_G + I_D; l = 1; }
        if (r < I_G) { t.W = p.in[13] + (size_t)l * D * FF; t.N = FF; t.ldt = D; t.WT = (bf16_t*)(ws + WS_WGU) + (size_t)l * 2 * FF * D; mode = 1; }
        else if ((r -= I_G) < I_G) { t.W = p.in[14] + (size_t)l * D * FF; t.N = FF; t.ldt = D; t.WT = (bf16_t*)(ws + WS_WGU) + (size_t)l * 2 * FF * D; mode = 2; }
        else if ((r -= I_G) < I_D) { t.W = p.in[15] + (size_t)l * FF * D; t.N = D; t.ldt = FF; t.WT = (bf16_t*)(ws + WS_WD) + (size_t)l * D * FF; }
        else if ((r -= I_D) < I_QKV) { t.W = p.in[10]; t.N = 3 * D; t.ldt = D; t.WT = (bf16_t*)(ws + WS_WQKV); }
        else { r -= I_QKV; t.W = p.in[12]; t.N = D; t.ldt = D; t.WT = (bf16_t*)(ws + WS_WO); } }
    const int nblk = t.N / 32, kb = r / nblk, nb = r % nblk; t.n0 = nb * 32; t.k0 = kb * 64;
    t.dst = t.n0; if (mode) t.dst = (t.n0 >> 7) * 256 + (t.n0 & 127) + (mode == 2 ? 128 : 0);
    return true;
}
__device__ __forceinline__ void titem_load(const TItem& t, f32x4 (&wv)[8], int lane) {
#pragma unroll
    for (int i = 0; i < 8; ++i) wv[i] = *(const f32x4*)(t.W + (size_t)(t.k0 + 8 * i + (lane >> 3)) * t.N + t.n0 + 4 * (lane & 7));
}
__device__ __forceinline__ void titem_finish(const TItem& t, const f32x4 (&wv)[8], LAS float* scr, int lane) {
#pragma unroll
    for (int i = 0; i < 8; ++i) { LAS float* d = scr + (8 * i + (lane >> 3)) * 33 + 4 * (lane & 7); d[0] = wv[i][0]; d[1] = wv[i][1]; d[2] = wv[i][2]; d[3] = wv[i][3]; }
    asm volatile("s_waitcnt lgkmcnt(0)" ::: "memory");
    const int c = lane & 7;
#pragma unroll
    for (int j = 0; j < 4; ++j) { const int n = (lane >> 3) + 8 * j; const LAS float* s = scr + (8 * c) * 33 + n;
        u32x4 o; o.x = pk2(s[0 * 33], s[1 * 33]); o.y = pk2(s[2 * 33], s[3 * 33]); o.z = pk2(s[4 * 33], s[5 * 33]); o.w = pk2(s[6 * 33], s[7 * 33]);
        *(u32x4*)(t.WT + (size_t)(t.dst + n) * t.ldt + t.k0 + 8 * c) = o; }
    asm volatile("s_waitcnt lgkmcnt(0)" ::: "memory");
}

__device__ __forceinline__ void gemv_layer(const Params& p, LAS unsigned char* lds, const int l, const int rb, const int nb, unsigned* done = nullptr) {
    const int tid = threadIdx.x;
    LAS float* sl = (LAS float*)lds;
    LAS f32x4* red = (LAS f32x4*)(lds + 12288);
    for (int i = tid; i < 3072; i += 512) { const int cond = i >> 10, k = i & 1023; const float v = cond == 0 ? p.in[5][k] : p.in[2][(cond - 1) * D + k]; sl[i] = v / (1.0f + __expf(-v)); }
    __syncthreads();
    float* mod = (float*)(p.ws + WS_MOD);
    for (int item = rb; item < 96; item += nb) {
        const int rem = item, cc = rem >> 4, kc = rem & 15, rpar = tid >> 8, col = cc * 1024 + 4 * (tid & 255);
        const float* W = p.in[6] + ((size_t)l * D + kc * 64 + rpar) * 6144 + col;
        f32x4 a0 = {0.f, 0.f, 0.f, 0.f}, a1 = a0, a2 = a0;
#pragma unroll
        for (int hf = 0; hf < 2; ++hf) {
            f32x4 w[16];
#pragma unroll
            for (int i = 0; i < 16; ++i) w[i] = *(const f32x4*)(W + (size_t)(32 * hf + 2 * i) * 6144);
#pragma unroll
            for (int i = 0; i < 16; ++i) { const int k = kc * 64 + 32 * hf + 2 * i + rpar; a0 += sl[k] * w[i]; a1 += sl[1024 + k] * w[i]; a2 += sl[2048 + k] * w[i]; }
        }
        if (rpar == 1) { red[tid - 256] = a0; red[256 + tid - 256] = a1; red[512 + tid - 256] = a2; }
        __syncthreads();
        if (rpar == 0) {
            a0 += red[tid]; a1 += red[256 + tid]; a2 += red[512 + tid];
            if (kc == 0) { const f32x4 bv = *(const f32x4*)(p.in[7] + l * 6144 + col); a0 += bv; a1 += bv; a2 += bv; }
#pragma unroll
            for (int j = 0; j < 4; ++j) {
                unsafeAtomicAdd(mod + (l * 3 + 0) * 6144 + col + j, a0[j]);
                unsafeAtomicAdd(mod + (l * 3 + 1) * 6144 + col + j, a1[j]);
                unsafeAtomicAdd(mod + (l * 3 + 2) * 6144 + col + j, a2[j]); }
        }
        if (done) asm volatile("s_waitcnt vmcnt(0)" ::: "memory");
        __syncthreads();
        if (done && tid == 0) __hip_atomic_fetch_add(done, 1u, __ATOMIC_RELAXED, __HIP_MEMORY_SCOPE_AGENT);
    }
}
__device__ __forceinline__ void transpose_jobs(const Params& p, LAS unsigned char* lds, int gw, int NGW, int it_lo, int it_hi) {
    const int lane = threadIdx.x & 63, wave = threadIdx.x >> 6;
    LAS float* scr = (LAS float*)(lds + wave * 8448);
    TItem cur, nxt; f32x4 wa[8], wb[8];
    int it = it_lo + gw;
    bool have = it < it_hi && titem_decode(p, it, cur);
    if (have) titem_load(cur, wa, lane);
    while (have) {
        const bool hn = it + NGW < it_hi && titem_decode(p, it + NGW, nxt);
        if (hn) titem_load(nxt, wb, lane);
        titem_finish(cur, wa, scr, lane);
        if (!hn) break;
        it += 2 * NGW;
        have = it < it_hi && titem_decode(p, it, cur);
        if (have) titem_load(cur, wa, lane);
        titem_finish(nxt, wb, scr, lane);
    }
}
__device__ __forceinline__ void phase_prologue(const Params& p, LAS unsigned char* lds, unsigned* gemv_done) {
    const int tid = threadIdx.x, G = gridDim.x, bx = blockIdx.x;
    unsigned char* ws = p.ws;
    LAS float* ct = (LAS float*)(lds + 32768);
    for (int i = tid; i < 2048; i += 512) ct[i] = cospif((float)i * (1.0f / 1024.0f));
    const bool sep = G >= 192;
    if (!sep || bx < 96) gemv_layer(p, lds, 0, bx, sep ? 96 : G, gemv_done);
    if (sep && bx < 96) return;
    const int gt = (sep ? bx - 96 : bx) * 512 + tid, GT = (sep ? G - 96 : G) * 512;
    for (int i = gt; i < 2 * 2 * 512 * D / 8; i += GT) { const int which = i >= 2 * 512 * D / 8; const int ii = which ? i - 2 * 512 * D / 8 : i;
        const f32x4* src = (const f32x4*)p.in[which ? 4 : 3]; const f32x4 a = src[2 * ii], b = src[2 * ii + 1];
        u32x4 o; o.x = pk2(a[0], a[1]); o.y = pk2(a[2], a[3]); o.z = pk2(b[0], b[1]); o.w = pk2(b[2], b[3]); ((u32x4*)((unsigned char*)p.out + (which ? OUTB_VC : OUTB_KC)))[ii] = o; }
    for (int i = gt; i < 512 * 256 / 8; i += GT) { const int row = i >> 5, c0 = (i & 31) * 8, cs = row >> 8, m = row & 255; float v[8];
#pragma unroll
        for (int j = 0; j < 8; ++j) { const int idx = ((m * (c0 + j)) & 255) * 8; v[j] = ct[(idx - (cs ? 512 : 0)) & 2047]; }
        u32x4 o; o.x = pk2(v[0], v[1]); o.y = pk2(v[2], v[3]); o.z = pk2(v[4], v[5]); o.w = pk2(v[6], v[7]); ((u32x4*)(ws + WS_CSCH))[i] = o; }
    for (int i = gt; i < 256 * 512 / 8; i += GT) { const int k = i >> 6, c0 = (i & 63) * 8; float v[8];
#pragma unroll
        for (int j = 0; j < 8; ++j) { const int kk = c0 + j, sidx = kk & 255; const int idx = ((k * sidx) & 255) * 8; v[j] = kk < 256 ? ct[idx] : -ct[(idx - 512) & 2047]; }
        u32x4 o; o.x = pk2(v[0], v[1]); o.y = pk2(v[2], v[3]); o.z = pk2(v[4], v[5]); o.w = pk2(v[6], v[7]); ((u32x4*)(ws + WS_TP))[i] = o; }
    for (int i = gt; i < 2048 * 4096 / 8; i += GT) { const int k = i >> 9, c0 = (i & 511) * 8; float v[8];
#pragma unroll
        for (int j = 0; j < 8; ++j) { const int kk = c0 + j, sidx = kk & 2047; const int idx = (k * sidx) & 2047; v[j] = kk < 2048 ? ct[idx] : -ct[(idx - 512) & 2047]; }
        u32x4 o; o.x = pk2(v[0], v[1]); o.y = pk2(v[2], v[3]); o.z = pk2(v[4], v[5]); o.w = pk2(v[6], v[7]); ((u32x4*)(ws + WS_TS))[i] = o; }
}
__device__ __forceinline__ void phase_side_jobs(const Params& p, LAS unsigned char* lds, const int which) {
    if (which == 5) { if (blockIdx.x < 56) transpose_jobs(p, lds, blockIdx.x * 8 + (threadIdx.x >> 6), 56 * 8, TI_L0 + 3 * 1408, TI_L0 + 3 * 1408 + 1536); return; }
    if (which == 6) { if (blockIdx.x >= 64) { const int gw = (blockIdx.x - 64) * 8 + (threadIdx.x >> 6), ngw = (gridDim.x - 64) * 8;
        transpose_jobs(p, lds, gw, ngw, TI_L0 + 2 * 1408, TI_L0 + 3 * 1408); transpose_jobs(p, lds, gw, ngw, TI_L0 + 3 * 1408 + 1536, TI_ALL); } return; }
    if (which == 8) { if (blockIdx.x >= 128) transpose_jobs(p, lds, (blockIdx.x - 128) * 8 + (threadIdx.x >> 6), (gridDim.x - 128) * 8, 0, 512); return; }
    if (which == 9) { if (blockIdx.x >= 64) transpose_jobs(p, lds, (blockIdx.x - 64) * 8 + (threadIdx.x >> 6), (gridDim.x - 64) * 8, 512, TI_L0);
        if (blockIdx.x >= 192) { __syncthreads(); gemv_layer(p, lds, 1, blockIdx.x - 192, gridDim.x - 192); } return; }
    if (which == 7) { if (blockIdx.x >= 192) transpose_jobs(p, lds, (blockIdx.x - 192) * 8 + (threadIdx.x >> 6), (gridDim.x - 192) * 8, TI_L0, TI_L0 + 2 * 1408); return; }
    const int G = gridDim.x, bx = blockIdx.x, first = which == 0 ? 64 : 192;
    const int nb = G > first ? G - first : G, b0 = G > first ? first : 0;
    if (bx < b0) return;
    const int rb = bx - b0;
    if (which == 0) transpose_jobs(p, lds, rb * 8 + (threadIdx.x >> 6), nb * 8, 0, TI_L0);
    else if (which == 1) gemv_layer(p, lds, 1, rb, nb);
    else transpose_jobs(p, lds, rb * 8 + (threadIdx.x >> 6), nb * 8, TI_L0, TI_ALL);
}

#ifndef ROW_WT
#define ROW_WT 0
#endif
__device__ __forceinline__ void store16_wt(void* ptr, u32x4 v) {
#if ROW_WT
    asm volatile("global_store_dwordx4 %0, %1, off sc0 sc1\n\ts_nop 3" :: "v"(ptr), "v"(v) : "memory");
#else
    *(u32x4*)ptr = v;
#endif
}
__device__ __forceinline__ void bf8_to_f32(const u32x4 w, f32x4& a, f32x4& b) { a = (f32x4){bf_lo(w.x), bf_hi(w.x), bf_lo(w.y), bf_hi(w.y)}; b = (f32x4){bf_lo(w.z), bf_hi(w.z), bf_lo(w.w), bf_hi(w.w)}; }
__device__ __forceinline__ u32x4 f32_to_bf8(const f32x4 a, const f32x4 b) { u32x4 w; w.x = pk2(a[0], a[1]); w.y = pk2(a[2], a[3]); w.z = pk2(b[0], b[1]); w.w = pk2(b[2], b[3]); return w; }
template <bool HAS_MP, bool HAS_NEXT, bool XIN_F32>
__device__ __forceinline__ void row_phase(const float* xin_p, const float* xin_s, bf16_t* XB, const bf16_t* mp, float* Yout, bf16_t* Hout,
                                          const float* gate, const float* gA, const float* gB, const float* sc, const float* sh, unsigned* cnt = nullptr, const bf16_t* mp2 = nullptr) {
    const int tid = threadIdx.x, lane = tid & 63, gw = blockIdx.x * 8 + (tid >> 6), NGW = gridDim.x * 8;
    if (cnt) {
        if (tid == 0) { const int p0 = (blockIdx.x * 48) >> 8, p1 = (blockIdx.x * 48 + 47) >> 8;
            for (int pp = p0; pp <= p1; ++pp) { unsigned sp = 0; while (__hip_atomic_load(cnt + pp * 64, __ATOMIC_RELAXED, __HIP_MEMORY_SCOPE_AGENT) < ((mp2 && pp >= 46) ? 64u : 32u)) { __builtin_amdgcn_s_sleep(2); if (++sp > (1u << 22)) break; } }
            __builtin_amdgcn_fence(__ATOMIC_ACQUIRE, "agent"); asm volatile("s_waitcnt vmcnt(0)" ::: "memory"); }
        __syncthreads();
    }
    constexpr int R = 3, RW = 6;
    int cur_cond = -1;
    f32x4 gga[4], gbs[4], shv[4];
    for (int rowb = gw * RW; rowb < M; rowb += NGW * RW)
    for (int row0 = rowb; row0 < rowb + RW; row0 += R) {
        f32x4 v[R][4]; u32x4 mw[R][2];
#pragma unroll
        for (int q = 0; q < R; ++q) { const int row = row0 + q;
            if constexpr (XIN_F32) { const float* xr = row < NP ? xin_p + (size_t)row * D : xin_s + (size_t)(row - NP) * D;
#pragma unroll
                for (int j = 0; j < 2; ++j) { v[q][2 * j] = *(const f32x4*)(xr + 8 * lane + 512 * j); v[q][2 * j + 1] = *(const f32x4*)(xr + 8 * lane + 512 * j + 4); }
            } else {
#pragma unroll
                for (int j = 0; j < 2; ++j) { const u32x4 w = *(const u32x4*)(XB + (size_t)row * D + 8 * lane + 512 * j); bf8_to_f32(w, v[q][2 * j], v[q][2 * j + 1]); }
            }
            if constexpr (HAS_MP) {
#pragma unroll
                for (int j = 0; j < 2; ++j) mw[q][j] = *(const u32x4*)(mp + (size_t)row * D + 8 * lane + 512 * j);
            } }
        u32x4 xo[R][2], ho[R][2];
#pragma unroll
        for (int q = 0; q < R; ++q) { const int row = row0 + q; const int cond = row < NP ? 0 : (row < NP + SS ? 1 : 2);
            if (cond != cur_cond) { cur_cond = cond;
#pragma unroll
                for (int j = 0; j < 4; ++j) { const int col = 8 * lane + 512 * (j >> 1) + 4 * (j & 1);
                    if constexpr (HAS_MP) gga[j] = *(const f32x4*)(gate + cond * 6144 + col) * *(const f32x4*)(gA + col);
                    if constexpr (HAS_NEXT) { gbs[j] = *(const f32x4*)(gB + col) * (1.0f + *(const f32x4*)(sc + cond * 6144 + col)); shv[j] = *(const f32x4*)(sh + cond * 6144 + col); } } }
            if constexpr (HAS_MP) {
                f32x4 mv[4]; float s = 0.f;
#pragma unroll
                for (int j = 0; j < 2; ++j) bf8_to_f32(mw[q][j], mv[2 * j], mv[2 * j + 1]);
                if (mp2 && row >= 46 * 256) {
#pragma unroll
                    for (int j = 0; j < 2; ++j) { f32x4 a, b; bf8_to_f32(*(const u32x4*)(mp2 + (size_t)(row - 46 * 256) * D + 8 * lane + 512 * j), a, b); mv[2 * j] += a; mv[2 * j + 1] += b; } }
#pragma unroll
                for (int j = 0; j < 4; ++j) s += (mv[j][0] * mv[j][0] + mv[j][1] * mv[j][1]) + (mv[j][2] * mv[j][2] + mv[j][3] * mv[j][3]);
                const float rstd = 1.0f / sqrtf(wave_sum(s) * (1.0f / D) + 1e-6f);
#pragma unroll
                for (int j = 0; j < 4; ++j) v[q][j] = v[q][j] + gga[j] * (mv[j] * rstd);
                if constexpr (HAS_NEXT) {
#pragma unroll
                    for (int j = 0; j < 2; ++j) xo[q][j] = f32_to_bf8(v[q][2 * j], v[q][2 * j + 1]);
                }
            }
            if constexpr (HAS_NEXT) {
                float s = 0.f;
#pragma unroll
                for (int j = 0; j < 4; ++j) s += (v[q][j][0] * v[q][j][0] + v[q][j][1] * v[q][j][1]) + (v[q][j][2] * v[q][j][2] + v[q][j][3] * v[q][j][3]);
                const float rstd = 1.0f / sqrtf(wave_sum(s) * (1.0f / D) + 1e-6f);
                f32x4 hh[4];
#pragma unroll
                for (int j = 0; j < 4; ++j) hh[j] = (v[q][j] * rstd) * gbs[j] + shv[j];
#pragma unroll
                for (int j = 0; j < 2; ++j) ho[q][j] = f32_to_bf8(hh[2 * j], hh[2 * j + 1]);
            } }
#pragma unroll
        for (int q = 0; q < R; ++q) { const int row = row0 + q;
            if constexpr (HAS_MP && !HAS_NEXT) {
#pragma unroll
                for (int j = 0; j < 4; ++j) *(f32x4*)(Yout + (size_t)row * D + 8 * lane + 512 * (j >> 1) + 4 * (j & 1)) = v[q][j];
            }
            if constexpr (HAS_MP && HAS_NEXT) {
#pragma unroll
                for (int j = 0; j < 2; ++j) store16_wt(XB + (size_t)row * D + 8 * lane + 512 * j, xo[q][j]);
            }
            if constexpr (HAS_NEXT) {
#pragma unroll
                for (int j = 0; j < 2; ++j) store16_wt(Hout + (size_t)row * D + 8 * lane + 512 * j, ho[q][j]);
            } }
    }
}

__device__ __forceinline__ void attn_phase(const Params& p, LAS unsigned char* lds, const int u_lo, const int u_hi, const int rb, const int nb) {
    const int tid = threadIdx.x, lane = tid & 63, wave = __builtin_amdgcn_readfirstlane(tid >> 6), r = lane & 31, hh = lane >> 5;
    unsigned char* ws = p.ws;
    const bf16_t* Qb = (const bf16_t*)(ws + WS_Q); const bf16_t* Kb = (const bf16_t*)(ws + WS_K); const bf16_t* Vb = (const bf16_t*)(ws + WS_VT);
    const bf16_t* Kc = (const bf16_t*)((const unsigned char*)p.out + OUTB_KC); const bf16_t* Vc = (const bf16_t*)((const unsigned char*)p.out + OUTB_VC);
    bf16_t* Ob = (bf16_t*)(ws + WS_H);
    LAS float* Bl = (LAS float*)(lds + 36864 + 512);
    const int srow = tid >> 3, sch = tid & 7, krho = (srow & ~12) | ((srow & 4) << 1) | ((srow & 8) >> 1);
    const float c2 = 0.125f * 1.4426950408889634f;
    for (int unit = u_lo + rb; unit < u_hi; unit += nb) {
        const bool is_na = unit < 256;
        int b, h, qtok, nt, jmin = 0, nloc = 0, rq = 0, half = 0, ktok0;
        if (is_na) { b = unit >> 7; h = (unit >> 3) & 15; const int r0 = (unit & 7) * 4; rq = r0 + (wave >> 1); half = wave & 1;
            jmin = min(max(r0 - 4, 0), 24); const int jmax = min(max(r0 - 1, 0), 24) + 7; nloc = jmax - jmin + 1; nt = nloc + 8;
            qtok = NP + b * SS + rq * 64 + half * 32 + r; ktok0 = NP + b * SS; }
        else { const int u2 = unit - 256; b = u2 >> 4; h = u2 & 15; nt = 4; qtok = b * SP + wave * 32 + r; ktok0 = b * SP; }
        const int rs = min(max(rq - 4, 0), 24);
        if (is_na) { for (int i = tid; i < 15 * 32; i += 512) { const int rr = i >> 5, x = i & 31; Bl[i] = x < 31 ? p.in[11][(h * 15 + rr) * 31 + x] * 1.4426950408889634f : 0.f; } }
        bf16x8 qf[4];
#pragma unroll
        for (int d0 = 0; d0 < 4; ++d0) qf[d0] = *(const bf16x8*)(Qb + (size_t)qtok * D + h * HD + d0 * 16 + hh * 8);
        f32x16 o0, o1;
#pragma unroll
        for (int i = 0; i < 16; ++i) { o0[i] = 0.f; o1[i] = 0.f; }
        float m_run = -1e30f, l_run = 0.f;
        u32x4 kreg, vreg;
#define ATT_LOAD(t) do { const int t_ = (t); size_t off_; const bf16_t* kb_; const bf16_t* vb_; \
            if (is_na && t_ >= nloc) { off_ = ((size_t)(b * 512 + (t_ - nloc) * 64 + srow)) * D + h * HD + sch * 8; kb_ = Kc; vb_ = Vc; } \
            else { off_ = (size_t)(ktok0 + (is_na ? (jmin + t_) * 64 : t_ * 64) + srow) * D + h * HD + sch * 8; kb_ = Kb; vb_ = Vb; } \
            kreg = *(const u32x4*)(kb_ + off_); vreg = *(const u32x4*)(vb_ + off_); } while (0)
#define ATT_STORE(buf) do { LAS unsigned char* kl_ = lds + (buf) * 18432; LAS unsigned char* vl_ = kl_ + 9216; \
            *(LAS u32x4*)(kl_ + krho * 144 + sch * 16) = kreg; \
            LAS bf16_t* vd_ = (LAS bf16_t*)(vl_ + (8 * sch) * 144 + srow * 2); \
            vd_[0 * 72] = (bf16_t)vreg.x; vd_[1 * 72] = (bf16_t)(vreg.x >> 16); vd_[2 * 72] = (bf16_t)vreg.y; vd_[3 * 72] = (bf16_t)(vreg.y >> 16); \
            vd_[4 * 72] = (bf16_t)vreg.z; vd_[5 * 72] = (bf16_t)(vreg.z >> 16); vd_[6 * 72] = (bf16_t)vreg.w; vd_[7 * 72] = (bf16_t)(vreg.w >> 16); } while (0)
        ATT_LOAD(0); ATT_STORE(0); if (nt > 1) ATT_LOAD(1);
        __syncthreads();
        for (int t = 0; t < nt; ++t) {
            if (t + 1 < nt) { ATT_STORE((t + 1) & 1); if (t + 2 < nt) ATT_LOAD(t + 2); }
            const bool local = is_na && t < nloc; const int j = jmin + t;
            if (!(local && (j < rs || j >= rs + 8))) {
                const LAS unsigned char* Kl = lds + (t & 1) * 18432; const LAS unsigned char* Vl = Kl + 9216;
                f32x16 p0, p1;
#pragma unroll
                for (int i = 0; i < 16; ++i) { p0[i] = 0.f; p1[i] = 0.f; }
#pragma unroll
                for (int d0 = 0; d0 < 4; ++d0) { const bf16x8 a0 = *(const LAS bf16x8*)(Kl + r * 144 + d0 * 32 + hh * 16), a1 = *(const LAS bf16x8*)(Kl + (32 + r) * 144 + d0 * 32 + hh * 16);
                    p0 = __builtin_amdgcn_mfma_f32_32x32x16_bf16(a0, qf[d0], p0, 0, 0, 0); p1 = __builtin_amdgcn_mfma_f32_32x32x16_bf16(a1, qf[d0], p1, 0, 0, 0); }
                float m_new, alpha;
                if (local) {
                    const int qc = half * 32 + r, cs = min(max(qc - 8, 0), 48);
                    const LAS float* bp = Bl + (j - rq + 7) * 32 + 8 * hh - qc + 15;
                    float bb0[16], bb1[16];
#pragma unroll
                    for (int i = 0; i < 16; ++i) { const int kc = 16 * (i >> 3) + (i & 7); bb0[i] = bp[kc]; bb1[i] = bp[kc + 32]; }
                    asm volatile("" : "+v"(bb0[0]), "+v"(bb0[1]), "+v"(bb0[2]), "+v"(bb0[3]), "+v"(bb0[4]), "+v"(bb0[5]), "+v"(bb0[6]), "+v"(bb0[7]));
                    asm volatile("" : "+v"(bb0[8]), "+v"(bb0[9]), "+v"(bb0[10]), "+v"(bb0[11]), "+v"(bb0[12]), "+v"(bb0[13]), "+v"(bb0[14]), "+v"(bb0[15]));
                    asm volatile("" : "+v"(bb1[0]), "+v"(bb1[1]), "+v"(bb1[2]), "+v"(bb1[3]), "+v"(bb1[4]), "+v"(bb1[5]), "+v"(bb1[6]), "+v"(bb1[7]));
                    asm volatile("" : "+v"(bb1[8]), "+v"(bb1[9]), "+v"(bb1[10]), "+v"(bb1[11]), "+v"(bb1[12]), "+v"(bb1[13]), "+v"(bb1[14]), "+v"(bb1[15]));
                    const unsigned sh0 = (unsigned)(8 * hh - cs);
#pragma unroll
                    for (int i = 0; i < 16; ++i) { const int kc = 16 * (i >> 3) + (i & 7);
                        const float s0 = __builtin_fmaf(p0[i], c2, bb0[i]), s1 = __builtin_fmaf(p1[i], c2, bb1[i]);
                        p0[i] = (sh0 + (unsigned)kc) < 16u ? s0 : -1e30f; p1[i] = (sh0 + (unsigned)(kc + 32)) < 16u ? s1 : -1e30f; }
                    float mt = fmaxf(p0[0], p1[0]);
#pragma unroll
                    for (int i = 1; i < 16; ++i) mt = fmaxf(mt, fmaxf(p0[i], p1[i]));
                    mt = fmaxf(mt, __shfl_xor(mt, 32));
                    m_new = fmaxf(m_run, mt); alpha = __builtin_amdgcn_exp2f(m_run - m_new);
#pragma unroll
                    for (int i = 0; i < 16; ++i) { p0[i] = __builtin_amdgcn_exp2f(p0[i] - m_new); p1[i] = __builtin_amdgcn_exp2f(p1[i] - m_new); }
                } else {
                    float mt = fmaxf(p0[0], p1[0]);
#pragma unroll
                    for (int i = 1; i < 16; ++i) mt = fmaxf(mt, fmaxf(p0[i], p1[i]));
                    mt = fmaxf(mt, __shfl_xor(mt, 32)) * c2;
                    m_new = fmaxf(m_run, mt); alpha = __builtin_amdgcn_exp2f(m_run - m_new);
#pragma unroll
                    for (int i = 0; i < 16; ++i) { p0[i] = __builtin_amdgcn_exp2f(__builtin_fmaf(p0[i], c2, -m_new)); p1[i] = __builtin_amdgcn_exp2f(__builtin_fmaf(p1[i], c2, -m_new)); }
                }
                m_run = m_new;
                float ls = 0.f;
#pragma unroll
                for (int i = 0; i < 16; ++i) ls += p0[i] + p1[i];
                l_run = l_run * alpha + ls;
#pragma unroll
                for (int i = 0; i < 16; ++i) { o0[i] *= alpha; o1[i] *= alpha; }
                bf16x8 pa[4];
#pragma unroll
                for (int s2 = 0; s2 < 2; ++s2) { u32x4 w; w.x = pk2(p0[8 * s2], p0[8 * s2 + 1]); w.y = pk2(p0[8 * s2 + 2], p0[8 * s2 + 3]); w.z = pk2(p0[8 * s2 + 4], p0[8 * s2 + 5]); w.w = pk2(p0[8 * s2 + 6], p0[8 * s2 + 7]); pa[s2] = __builtin_bit_cast(bf16x8, w);
                    u32x4 w2; w2.x = pk2(p1[8 * s2], p1[8 * s2 + 1]); w2.y = pk2(p1[8 * s2 + 2], p1[8 * s2 + 3]); w2.z = pk2(p1[8 * s2 + 4], p1[8 * s2 + 5]); w2.w = pk2(p1[8 * s2 + 6], p1[8 * s2 + 7]); pa[2 + s2] = __builtin_bit_cast(bf16x8, w2); }
#pragma unroll
                for (int s2 = 0; s2 < 4; ++s2) { const bf16x8 v0 = *(const LAS bf16x8*)(Vl + r * 144 + s2 * 32 + hh * 16), v1 = *(const LAS bf16x8*)(Vl + (32 + r) * 144 + s2 * 32 + hh * 16);
                    o0 = __builtin_amdgcn_mfma_f32_32x32x16_bf16(v0, pa[s2], o0, 0, 0, 0); o1 = __builtin_amdgcn_mfma_f32_32x32x16_bf16(v1, pa[s2], o1, 0, 0, 0); }
            }
            __syncthreads();
        }
#undef ATT_LOAD
#undef ATT_STORE
        const float inv = 1.0f / (l_run + __shfl_xor(l_run, 32));
        bf16_t* orow = Ob + (size_t)qtok * D + h * HD + 4 * hh;
#pragma unroll
        for (int g = 0; g < 4; ++g) { u32x2 w; w.x = pk2(o0[4 * g] * inv, o0[4 * g + 1] * inv); w.y = pk2(o0[4 * g + 2] * inv, o0[4 * g + 3] * inv); *(u32x2*)(orow + 8 * g) = w;
            u32x2 w2; w2.x = pk2(o1[4 * g] * inv, o1[4 * g + 1] * inv); w2.y = pk2(o1[4 * g + 2] * inv, o1[4 * g + 3] * inv); *(u32x2*)(orow + 32 + 8 * g) = w2; }
    }
    __syncthreads();
}

#define XB_TMO      128
#define XB_XCNT(j)  (256  + 64 * (j))
#define XB_XSUB(j)  (1280 + 64 * (j))
#define XB_XGEN(j)  (2304 + 64 * (j))
#define XB_TOP      3328
#define XB_TOPGEN   3392
#define XCD_BAR_WORDS 3456
#define XB_SPIN_CAP (1u << 18)
__device__ __forceinline__ unsigned xb_ld(unsigned* p)              { return __hip_atomic_load(p, __ATOMIC_RELAXED, __HIP_MEMORY_SCOPE_AGENT); }
__device__ __forceinline__ unsigned xb_add(unsigned* p, unsigned v) { return __hip_atomic_fetch_add(p, v, __ATOMIC_RELAXED, __HIP_MEMORY_SCOPE_AGENT); }
__device__ __forceinline__ unsigned xb_xcc_id() { return (unsigned)__builtin_amdgcn_s_getreg((3 << 11) | 20) & 0xFu; }
#define XB_SPIN(cond, bar) do { unsigned _sp = 0; while (cond) { __builtin_amdgcn_s_sleep(1); \
    if ((++_sp & 255u) == 0u) { if (xb_ld(&(bar)[XB_TMO])) break; if (_sp > XB_SPIN_CAP) { atomicAdd(&(bar)[XB_TMO], 1u); break; } } } } while (0)
struct XcdBarrier { unsigned* bar; unsigned x; volatile LAS unsigned* st; };
__device__ __forceinline__ XcdBarrier xcd_barrier_post(unsigned* bar, volatile LAS unsigned* st) {
    XcdBarrier b; b.bar = bar; b.x = xb_xcc_id(); b.st = st;
    if (threadIdx.x == 0) (void)xb_add(&bar[XB_XCNT(b.x)], 1u);
    return b;
}
__device__ __forceinline__ void xcd_barrier_complete(unsigned* bar, unsigned x, unsigned& nloc, unsigned& nx) {
    const unsigned G = gridDim.x * gridDim.y * gridDim.z;
    unsigned sum, cnt, mine, sp = 0u;
    for (;;) {
        sum = 0u; cnt = 0u; mine = 0u;
#pragma unroll
        for (unsigned j = 0; j < 16; ++j) { const unsigned c = xb_ld(&bar[XB_XCNT(j)]); sum += c; cnt += (c > 0u) ? 1u : 0u; mine = (j == x) ? c : mine; }
        if (sum == G) break;
        __builtin_amdgcn_s_sleep(1);
        if ((++sp & 255u) == 0u) { if (xb_ld(&bar[XB_TMO])) break; if (sp > XB_SPIN_CAP) { atomicAdd(&bar[XB_TMO], 1u); break; } }
    }
    nloc = mine > 0u ? mine : 1u; nx = cnt > 0u ? cnt : 1u;
}
__device__ __forceinline__ void xcd_barrier(const XcdBarrier& b) {
    asm volatile("s_waitcnt vmcnt(0)" ::: "memory");
    __syncthreads();
    if (threadIdx.x == 0) {
        unsigned* bar = b.bar;
        __builtin_amdgcn_s_waitcnt(0);
        unsigned nloc = b.st[0], nx = b.st[1];
        if (nloc == 0u) { xcd_barrier_complete(bar, b.x, nloc, nx); b.st[0] = nloc; b.st[1] = nx; }
        const unsigned old = xb_add(&bar[XB_XSUB(b.x)], 1u);
        const unsigned gen = old / nloc;
        if (old + 1u == (gen + 1u) * nloc) {
            __builtin_amdgcn_fence(__ATOMIC_RELEASE, "agent");
            asm volatile("s_waitcnt vmcnt(0)" ::: "memory");
            const unsigned og = xb_add(&bar[XB_TOP], 1u);
            const unsigned tg = og / nx;
            if (og + 1u == (tg + 1u) * nx) xb_add(&bar[XB_TOPGEN], 1u);
            else XB_SPIN(xb_ld(&bar[XB_TOPGEN]) == tg, bar);
            __builtin_amdgcn_fence(__ATOMIC_ACQUIRE, "agent");
            xb_add(&bar[XB_XGEN(b.x)], 1u);
            asm volatile("s_waitcnt vmcnt(0)" ::: "memory");
        } else {
            XB_SPIN(xb_ld(&bar[XB_XGEN(b.x)]) == gen, bar);
            __builtin_amdgcn_fence(__ATOMIC_ACQUIRE, "agent");
            asm volatile("s_waitcnt vmcnt(0)" ::: "memory");
        }
    }
    __syncthreads();
}

__global__ void __launch_bounds__(512, 2) mega_fwd(Params p) {
    extern __shared__ __attribute__((aligned(16))) unsigned char lds_raw[];
    LAS unsigned char* lds = (LAS unsigned char*)lds_raw;
    unsigned char* ws = p.ws;
    const int G = gridDim.x, c = blockIdx.x, lo = p.ph_lo, hi = p.ph_hi;
    const float* mod = (const float*)(ws + WS_MOD);
    const float* norm_g = p.in[8];
    bf16_t* H = (bf16_t*)(ws + WS_H); bf16_t* MPb = (bf16_t*)(ws + WS_MP); bf16_t* U = (bf16_t*)(ws + WS_U);
    float* X = p.out + OUT_X; bf16_t* XB = (bf16_t*)(ws + WS_XB);
    volatile LAS unsigned* MISC = (volatile LAS unsigned*)(lds + 131072 + 320);
    if (threadIdx.x < 32) MISC[threadIdx.x] = 0u;
    __syncthreads();
    XcdBarrier bar; bar.bar = (unsigned*)(ws + WS_CTL); bar.x = 0; bar.st = nullptr;
    if (hi - lo > 1) bar = xcd_barrier_post((unsigned*)(ws + WS_CTL), MISC + 8);
    if (hi > 1000) cg::this_grid().sync();
#ifndef PH_MASK
#define PH_MASK 0xffff
#endif
#define IN(k) (((PH_MASK >> (k)) & 1) && lo <= (k) && (k) < hi)
    const bool handoff = (G == 256) && (hi - lo > 1);
    unsigned* const cntb = (unsigned*)(ws + WS_CTL) + CW_CNT;
#ifndef PROBE_REP
#define PROBE_REP -1
#endif
#ifndef PROBE_SYNC2
#define PROBE_SYNC2 0
#endif
#define REPS(k) for (int rep_ = 0; rep_ < ((k) == PROBE_REP ? 2 : 1); ++rep_)
#ifndef PROBE_PHASE
#define PROBE_PHASE -1
#endif
    unsigned long long pt0 = 0, pt1 = 0;
    if (PROBE_PHASE == 0) pt0 = __builtin_amdgcn_s_memrealtime();
#define SEAM(k) SEAMX(k, false)
#define SEAMX(k, skip) do { if ((k) + 1 < hi && !(skip)) { xcd_barrier(bar); if (PROBE_SYNC2) xcd_barrier(bar); } \
        if ((k) == PROBE_PHASE) pt1 = __builtin_amdgcn_s_memrealtime(); if ((k) + 1 == PROBE_PHASE) pt0 = __builtin_amdgcn_s_memrealtime(); } while (0)

    unsigned* const gdone = cntb + 48;
    if (IN(0)) { phase_prologue(p, lds, handoff ? gdone : nullptr); SEAMX(0, handoff); }
    if (IN(1)) { {
        if (handoff) { if (threadIdx.x == 0) { unsigned sp = 0; while (__hip_atomic_load(gdone, __ATOMIC_RELAXED, __HIP_MEMORY_SCOPE_AGENT) < 96u) { __builtin_amdgcn_s_sleep(4); if (++sp > (1u << 22)) break; }
                __builtin_amdgcn_fence(__ATOMIC_ACQUIRE, "agent"); asm volatile("s_waitcnt vmcnt(0)" ::: "memory"); }
            __syncthreads(); }
        row_phase<false, true, true>(p.in[0], p.in[1], nullptr, nullptr, nullptr, H, nullptr, nullptr, norm_g, mod + 1 * D, mod + 0 * D);
        } SEAM(1);
    }
    if (IN(2)) {
        pg8::ChDftSched S{G, c, (const char*)(ws + WS_CSCH), (const char*)H, (bf16_t*)(ws + WS_YTP), (bf16_t*)(ws + WS_YTS)};
        pg8::gemm_phase<pg8::EpiStore, pg8::ChDftSched, true>(lds, 256, D, 256, S, pg8::EpiStore{});
        if (handoff) phase_side_jobs(p, lds, 8);
        SEAM(2);
    }
    if (IN(3)) {
        unsigned* const cf = cntb + 32;
        if (handoff) {
            int pm = -1, pn = 0;
            if (c < 64) { pm = 32 + 8 * (c >> 5) + ((c >> 2) & 7); pn = c & 3; } else if (c < 192) { pm = (c - 64) >> 2; pn = (c - 64) & 3; }
            { pg8::SeqSSched S{c, (const char*)(ws + WS_TS), (const char*)(ws + WS_YTS), (bf16_t*)(ws + WS_F)};
              pg8::gemm_phase<pg8::EpiStoreSig, pg8::SeqSSched, true>(lds, 4096, 4096, 4096, S, pg8::EpiStoreSig{cf}); }
            { pg8::SeqPSched S{G, c, (const char*)(ws + WS_TP), (const char*)(ws + WS_YTP), (bf16_t*)(ws + WS_F)};
              pg8::gemm_phase<pg8::EpiStoreSig, pg8::SeqPSched, true>(lds, 512, 512, 512, S, pg8::EpiStoreSig{cf}); }
            if (pm >= 0) {
                if (threadIdx.x == 0) { unsigned* w = cf + pm * 64; unsigned sp = 0;
                    while (__hip_atomic_load(w, __ATOMIC_RELAXED, __HIP_MEMORY_SCOPE_AGENT) < 32u) { __builtin_amdgcn_s_sleep(4); if (++sp > (1u << 22)) break; }
                    __builtin_amdgcn_fence(__ATOMIC_ACQUIRE, "agent"); asm volatile("s_waitcnt vmcnt(0)" ::: "memory"); }
                __syncthreads();
                pg8::OneSched S{pm, pn, (const char*)(ws + WS_F), (const char*)(ws + WS_WF), MPb};
                pg8::gemm_phase<pg8::EpiStoreSig, pg8::OneSched, true>(lds, D, D, D, S, pg8::EpiStoreSig{cntb + 0 * CNT_SEAM});
            }
            phase_side_jobs(p, lds, 9);
        } else {
            { pg8::SeqSSched S{c, (const char*)(ws + WS_TS), (const char*)(ws + WS_YTS), (bf16_t*)(ws + WS_F)};
              pg8::gemm_phase<pg8::EpiStoreSig, pg8::SeqSSched, true>(lds, 4096, 4096, 4096, S, pg8::EpiStoreSig{nullptr}); }
            { pg8::SeqPSched S{G, c, (const char*)(ws + WS_TP), (const char*)(ws + WS_YTP), (bf16_t*)(ws + WS_F)};
              pg8::gemm_phase<pg8::EpiStoreSig, pg8::SeqPSched, true>(lds, 512, 512, 512, S, pg8::EpiStoreSig{nullptr}); }
            phase_side_jobs(p, lds, 0);
        }
        SEAMX(3, handoff);
    }
    if (IN(4)) {
        if (!handoff) { pg8::GSched S{48, 4, G, c, (const char*)(ws + WS_F), (size_t)256 * D * 2, (const char*)(ws + WS_WF), (size_t)256 * D * 2, MPb, (size_t)256 * D, 256, D};
            pg8::gemm_phase<pg8::EpiStoreSig, pg8::GSched, true>(lds, D, D, D, S, pg8::EpiStoreSig{nullptr});
            phase_side_jobs(p, lds, 1); }
        SEAMX(4, handoff);
    }
    if (IN(5)) { REPS(5) {
        row_phase<true, true, true>(p.in[0], p.in[1], XB, MPb, nullptr, H, mod + 2 * D, norm_g + 1 * D, norm_g + 2 * D, mod + 4 * D, mod + 3 * D, handoff ? cntb + 0 * CNT_SEAM : nullptr);
        } SEAM(5);
    }
    if (IN(6)) {
        if (handoff) { pg8::GuSched S{G, c, (const char*)H, (const char*)(ws + WS_WGU), U};
            pg8::gemm_phase<pg8::EpiSwiGLU, pg8::GuSched, true>(lds, D, D, D, S, pg8::EpiSwiGLU{cntb + 4 * CNT_SEAM}); }
        else { pg8::GSched S{48, 22, G, c, (const char*)H, (size_t)256 * D * 2, (const char*)(ws + WS_WGU), (size_t)256 * D * 2, U, (size_t)256 * FF, 128, FF};
            pg8::gemm_phase<pg8::EpiSwiGLU, pg8::GSched, true>(lds, D, D, D, S, pg8::EpiSwiGLU{nullptr}); }
        SEAMX(6, handoff);
    }
    if (IN(7)) {
        if (handoff) {
            const int dd = c >= 248 ? 184 + (c - 248) : (c >= 64 ? c - 64 : (c >= 56 ? 192 + (c - 56) : -1));
            if (dd >= 0) { pg8::DownSched S{dd, (const char*)U, (const char*)(ws + WS_WD), MPb, (bf16_t*)(ws + WS_MP2)};
                if (threadIdx.x == 0) { int pm, pn, kh; S.unit(pm, pn, kh); unsigned* w = cntb + 4 * CNT_SEAM + pm * 64; unsigned sp = 0;
                    while (__hip_atomic_load(w, __ATOMIC_RELAXED, __HIP_MEMORY_SCOPE_AGENT) < 176u) { __builtin_amdgcn_s_sleep(4); if (++sp > (1u << 22)) break; }
                    __builtin_amdgcn_fence(__ATOMIC_ACQUIRE, "agent"); asm volatile("s_waitcnt vmcnt(0)" ::: "memory"); }
                __syncthreads();
                if (dd < 184) pg8::gemm_phase<pg8::EpiStoreSig, pg8::DownSched, true>(lds, FF, FF, FF, S, pg8::EpiStoreSig{cntb + 1 * CNT_SEAM});
                else pg8::gemm_phase<pg8::EpiStoreSig, pg8::DownSched, true>(lds, FF, FF, FF / 2, S, pg8::EpiStoreSig{cntb + 1 * CNT_SEAM}); }
            else { phase_side_jobs(p, lds, 5); }
        } else { pg8::GSched S{48, 4, G, c, (const char*)U, (size_t)256 * FF * 2, (const char*)(ws + WS_WD), (size_t)256 * FF * 2, MPb, (size_t)256 * D, 256, D};
            pg8::gemm_phase<pg8::EpiStoreSig, pg8::GSched, true>(lds, FF, FF, FF, S, pg8::EpiStoreSig{nullptr});
            phase_side_jobs(p, lds, 2); }
        SEAMX(7, handoff);
    }
    if (IN(8)) { REPS(8) {
        row_phase<true, true, false>(nullptr, nullptr, XB, MPb, nullptr, H, mod + 5 * D, norm_g + 3 * D, norm_g + 4 * D, mod + 3 * 6144 + 1 * D, mod + 3 * 6144 + 0 * D, handoff ? cntb + 1 * CNT_SEAM : nullptr, handoff ? (const bf16_t*)(ws + WS_MP2) : nullptr);
        } SEAM(8);
    }
    if (IN(9)) {
        unsigned* const cq = cntb + 16;
        pg8::EpiQKV E{(bf16_t*)(ws + WS_Q), (bf16_t*)(ws + WS_K), (bf16_t*)(ws + WS_VT), p.out + OUT_CK, p.out + OUT_CV, handoff ? cq : nullptr};
        if (handoff) {
            { pg8::QkvSched S{G, c, (const char*)H, (const char*)(ws + WS_WQKV)};
              pg8::gemm_phase<pg8::EpiQKV, pg8::QkvSched, true>(lds, D, D, D, S, E); }
            if (c >= 64) {
                if (threadIdx.x == 0) { for (int u = 256 + (c - 64); u < 768; u += 192) { unsigned* w = cq + ((u - 256) >> 4) * 64; unsigned sp = 0;
                        while (__hip_atomic_load(w, __ATOMIC_RELAXED, __HIP_MEMORY_SCOPE_AGENT) < 96u) { __builtin_amdgcn_s_sleep(4); if (++sp > (1u << 22)) break; } }
                    __builtin_amdgcn_fence(__ATOMIC_ACQUIRE, "agent"); asm volatile("s_waitcnt vmcnt(0)" ::: "memory"); }
                __syncthreads();
                attn_phase(p, lds, 256, 768, c - 64, 192);
            }
            if (threadIdx.x == 0) { for (int pp = 32 + 8 * (c >> 7); pp < 40 + 8 * (c >> 7); ++pp) { unsigned* w = cq + pp * 64; unsigned sp = 0;
                    while (__hip_atomic_load(w, __ATOMIC_RELAXED, __HIP_MEMORY_SCOPE_AGENT) < 96u) { __builtin_amdgcn_s_sleep(4); if (++sp > (1u << 22)) break; } }
                __builtin_amdgcn_fence(__ATOMIC_ACQUIRE, "agent"); asm volatile("s_waitcnt vmcnt(0)" ::: "memory"); }
            __syncthreads();
            attn_phase(p, lds, c, c + 1, 0, 1);
            if (c < 64) { const int gw = c * 8 + (threadIdx.x >> 6);
                transpose_jobs(p, lds, gw, 64 * 8, TI_L0 + 2 * 1408, TI_L0 + 3 * 1408); transpose_jobs(p, lds, gw, 64 * 8, TI_L0 + 3 * 1408 + 1536, TI_ALL); }
        } else {
            pg8::GSched S{48, 12, G, c, (const char*)H, (size_t)256 * D * 2, (const char*)(ws + WS_WQKV), (size_t)256 * D * 2, nullptr, 0, 0, D};
            pg8::gemm_phase<pg8::EpiQKV, pg8::GSched, true>(lds, D, D, D, S, E);
        }
        SEAMX(9, handoff);
    }
    if (IN(10)) { if (!handoff) attn_phase(p, lds, 0, 768, c, G); SEAM(10); }
    if (IN(11)) { REPS(11) {
        pg8::GSched S{48, 4, G, c, (const char*)H, (size_t)256 * D * 2, (const char*)(ws + WS_WO), (size_t)256 * D * 2, MPb, (size_t)256 * D, 256, D};
        pg8::gemm_phase<pg8::EpiStoreSig, pg8::GSched, true>(lds, D, D, D, S, pg8::EpiStoreSig{handoff ? cntb + 2 * CNT_SEAM : nullptr});
        if (handoff) phase_side_jobs(p, lds, 7);
        } SEAMX(11, handoff);
    }
    if (IN(12)) { REPS(12) {
        row_phase<true, true, false>(nullptr, nullptr, XB, MPb, nullptr, H, mod + 3 * 6144 + 2 * D, norm_g + 5 * D, norm_g + 6 * D, mod + 3 * 6144 + 4 * D, mod + 3 * 6144 + 3 * D, handoff ? cntb + 2 * CNT_SEAM : nullptr);
        } SEAM(12);
    }
    if (IN(13)) {
        if (handoff) { pg8::GuSched S{G, c, (const char*)H, (const char*)(ws + WS_WGU) + (size_t)2 * FF * D * 2, U};
            pg8::gemm_phase<pg8::EpiSwiGLU, pg8::GuSched, true>(lds, D, D, D, S, pg8::EpiSwiGLU{cntb + 5 * CNT_SEAM}); }
        else { pg8::GSched S{48, 22, G, c, (const char*)H, (size_t)256 * D * 2, (const char*)(ws + WS_WGU) + (size_t)2 * FF * D * 2, (size_t)256 * D * 2, U, (size_t)256 * FF, 128, FF};
            pg8::gemm_phase<pg8::EpiSwiGLU, pg8::GSched, true>(lds, D, D, D, S, pg8::EpiSwiGLU{nullptr}); }
        SEAMX(13, handoff);
    }
    if (IN(14)) {
        if (handoff) {
            const int dd = c >= 248 ? 184 + (c - 248) : (c >= 64 ? c - 64 : (c >= 56 ? 192 + (c - 56) : -1));
            if (dd >= 0) { pg8::DownSched S{dd, (const char*)U, (const char*)(ws + WS_WD) + (size_t)D * FF * 2, MPb, (bf16_t*)(ws + WS_MP2)};
                if (threadIdx.x == 0) { int pm, pn, kh; S.unit(pm, pn, kh); unsigned* w = cntb + 5 * CNT_SEAM + pm * 64; unsigned sp = 0;
                    while (__hip_atomic_load(w, __ATOMIC_RELAXED, __HIP_MEMORY_SCOPE_AGENT) < 176u) { __builtin_amdgcn_s_sleep(4); if (++sp > (1u << 22)) break; }
                    __builtin_amdgcn_fence(__ATOMIC_ACQUIRE, "agent"); asm volatile("s_waitcnt vmcnt(0)" ::: "memory"); }
                __syncthreads();
                if (dd < 184) pg8::gemm_phase<pg8::EpiStoreSig, pg8::DownSched, true>(lds, FF, FF, FF, S, pg8::EpiStoreSig{cntb + 3 * CNT_SEAM});
                else pg8::gemm_phase<pg8::EpiStoreSig, pg8::DownSched, true>(lds, FF, FF, FF / 2, S, pg8::EpiStoreSig{cntb + 3 * CNT_SEAM}); }
            else {  }
        } else { pg8::GSched S{48, 4, G, c, (const char*)U, (size_t)256 * FF * 2, (const char*)(ws + WS_WD) + (size_t)D * FF * 2, (size_t)256 * FF * 2, MPb, (size_t)256 * D, 256, D};
            pg8::gemm_phase<pg8::EpiStoreSig, pg8::GSched, true>(lds, FF, FF, FF, S, pg8::EpiStoreSig{nullptr});
             }
        SEAMX(14, handoff);
    }
    if (IN(15)) { REPS(15) {
        row_phase<true, false, false>(nullptr, nullptr, XB, MPb, X, nullptr, mod + 3 * 6144 + 5 * D, norm_g + 7 * D, nullptr, nullptr, nullptr, handoff ? cntb + 3 * CNT_SEAM : nullptr, handoff ? (const bf16_t*)(ws + WS_MP2) : nullptr); }
    }
    if (PROBE_PHASE >= 0 && blockIdx.x == 0) { if (PROBE_PHASE == 15) pt1 = __builtin_amdgcn_s_memrealtime();
        const unsigned long long tend = __builtin_amdgcn_s_memrealtime(), wait = 9ull * (pt1 - pt0);
        while (__builtin_amdgcn_s_memrealtime() - tend < wait) __builtin_amdgcn_s_sleep(8); }
#undef IN
#undef SEAM
}

constexpr int LDS_BYTES = 147456;
extern "C" void kernel_launch(void* const* d_in, const int* in_sizes, int n_in, void* d_out, int out_size, void* d_ws, size_t ws_size, hipStream_t stream) {
    static int grid = 0;
    if (grid == 0) {
        int dev = 0, cus = 0, per_cu = 0;
        hipGetDevice(&dev);
        hipDeviceGetAttribute(&cus, hipDeviceAttributeMultiprocessorCount, dev);
        if (hipFuncSetAttribute((const void*)mega_fwd, hipFuncAttributeMaxDynamicSharedMemorySize, LDS_BYTES) != hipSuccess) fprintf(stderr, "kernel_launch: hipFuncSetAttribute failed\n");
        if (hipOccupancyMaxActiveBlocksPerMultiprocessor(&per_cu, (const void*)mega_fwd, 512, LDS_BYTES) != hipSuccess || per_cu < 1) { fprintf(stderr, "kernel_launch: occupancy query says %d\n", per_cu); per_cu = 1; }
        (void)hipGetLastError();
        grid = cus * 1;
        if (n_in != 16 || ws_size < WS_END) { fprintf(stderr, "kernel_launch: unexpected n_in %d / ws %zu\n", n_in, ws_size); }
    }
    Params p{};
    (void)hipMemsetAsync((unsigned char*)d_ws, 0, WS_CTL + CTL_BYTES, stream);
    for (int i = 0; i < 16; ++i) p.in[i] = (const float*)d_in[i];
    p.out = (float*)d_out; p.ws = (unsigned char*)d_ws;
    if (MK_N_LAUNCHES == 1) {
        p.ph_lo = 0; p.ph_hi = NPHASE;
        void* args[] = {&p};
        hipError_t e = hipLaunchCooperativeKernel((const void*)mega_fwd, dim3(grid), dim3(512), args, LDS_BYTES, stream);
        if (e != hipSuccess) fprintf(stderr, "cooperative launch failed: %s (grid %d)\n", hipGetErrorString(e), grid);
    } else {
        for (int k = 0; k < NPHASE; ++k) { p.ph_lo = k; p.ph_hi = k + 1; hipLaunchKernelGGL(mega_fwd, dim3(grid), dim3(512), LDS_BYTES, stream, p); }
    }
}
```

```cpp
#include <hip/hip_runtime.h>
#include <hip/hip_cooperative_groups.h>
#include <cstdio>
#include <cstdint>
namespace cg = cooperative_groups;

#ifndef MK_N_LAUNCHES
#define MK_N_LAUNCHES 1
#endif

#define LAS __attribute__((address_space(3)))
typedef unsigned short bf16_t;
typedef short bf16x8 __attribute__((ext_vector_type(8)));
typedef float f32x2 __attribute__((ext_vector_type(2)));
typedef float f32x4 __attribute__((ext_vector_type(4)));
typedef float f32x16 __attribute__((ext_vector_type(16)));
typedef unsigned u32x2 __attribute__((ext_vector_type(2)));
typedef unsigned u32x4 __attribute__((ext_vector_type(4)));
typedef __bf16 bf16x2_t __attribute__((ext_vector_type(2)));

constexpr int D = 1024, NP = 8192, NS = 4096, M = NP + NS, SP = 256, SS = 2048, FF = 2816, NH = 16, HD = 64;
constexpr int NPHASE = 16;
constexpr size_t MiB = 1u << 20;
constexpr size_t WS_CTL = 160 * 1024, CTL_BYTES = 96 * 1024;
constexpr int CW_CNT = 4096, CNT_SEAM = 48 * 64;
constexpr size_t WS_MOD = 0, WS_CSCH = 256 * 1024, WS_TP = 512 * 1024, WS_WF = 1 * MiB, WS_WQKV = 3 * MiB,
                 WS_WO = 9 * MiB, WS_WGU = 11 * MiB, WS_WD = 33 * MiB, WS_H = 44 * MiB, WS_MP = 68 * MiB, WS_U = 92 * MiB, WS_R = 158 * MiB;
constexpr size_t WS_YTP = WS_U, WS_YTS = WS_U + 32 * MiB;
constexpr size_t WS_TS = WS_R, WS_F = WS_R + 16 * MiB;
constexpr size_t WS_Q = WS_R, WS_K = WS_R + 24 * MiB, WS_VT = WS_R + 48 * MiB;
constexpr size_t WS_XB = WS_R + 72 * MiB, WS_MP2 = WS_XB + 24 * MiB, WS_END = WS_MP2 + 1 * MiB;
constexpr size_t OUTB_KC = 0, OUTB_VC = 2 * MiB;
constexpr size_t OUT_X = 0, OUT_CK = (size_t)M * D, OUT_CV = OUT_CK + (size_t)NP * D;

struct Params {
    const float* in[16];
    float* out; unsigned char* ws;
    int ph_lo, ph_hi;
};

__device__ __forceinline__ unsigned pk2(float lo, float hi) { f32x2 v = {lo, hi}; bf16x2_t b = __builtin_convertvector(v, bf16x2_t); return __builtin_bit_cast(unsigned, b); }
__device__ __forceinline__ float bf_lo(unsigned w) { return __uint_as_float(w << 16); }
__device__ __forceinline__ float bf_hi(unsigned w) { return __uint_as_float(w & 0xffff0000u); }
template <int CTRL> __device__ __forceinline__ float dpp_mov(float v) { return __builtin_bit_cast(float, __builtin_amdgcn_mov_dpp(__builtin_bit_cast(int, v), CTRL, 0xf, 0xf, true)); }
__device__ __forceinline__ float wave_sum(float v) {
    v += dpp_mov<0xB1>(v); v += dpp_mov<0x4E>(v); v += dpp_mov<0x141>(v); v += dpp_mov<0x140>(v);
    { auto rr = __builtin_amdgcn_permlane16_swap(__float_as_uint(v), __float_as_uint(v), false, false); v = __uint_as_float(rr[0]) + __uint_as_float(rr[1]); }
    { auto rr = __builtin_amdgcn_permlane32_swap(__float_as_uint(v), __float_as_uint(v), false, false); v = __uint_as_float(rr[0]) + __uint_as_float(rr[1]); }
    return v;
}

namespace pg8 {
constexpr int BM = 256, BK = 64, HALF = 128, HTB = HALF * BK * 2, STAGE_BYTES = 8 * HTB;
__device__ __forceinline__ int lds_byte(int r, int c) { const int st = (r >> 4) * 2 + (c >> 5), rr = r & 15, cc = c & 31, ob = rr * 64 + cc * 2; return st * 1024 + (ob ^ (((ob >> 9) & 1) << 5)); }
__device__ __forceinline__ void stage_rc(int b, int& R, int& C) { const int st = b / 1024, sb = b % 1024, swz = sb ^ (((sb >> 9) & 1) << 5); R = (st >> 1) * 16 + swz / 64; C = (st & 1) * 32 + (swz % 64) / 2; }
__device__ __forceinline__ int perm32(int rho) { const int n = rho >> 4, i = rho & 15; return 8 * (i >> 2) + 4 * n + (i & 3); }

struct UnitDesc { const char* A; const char* B; bf16_t* out; int ldc; int aux; };

__device__ __forceinline__ void tile_order(int L, int nM, int nN, int& pm, int& pn) {
    const int nwg = nM * nN; int wgid = L;
    { const int q = nwg / 8, r = nwg % 8, xcd = wgid % 8, off = wgid / 8; wgid = (xcd < r ? xcd * (q + 1) : r * (q + 1) + (xcd - r) * q) + off; }
    const int nig = 8 * nN, gid = wgid / nig, fm = gid * 8, gsz = (nM - fm) < 8 ? (nM - fm) : 8;
    pm = fm + ((wgid % nig) % gsz); pn = (wgid % nig) / gsz;
}

template <class Epi, class Sched, bool ALIGN_EPI>
__device__ __forceinline__ void gemm_phase(LAS unsigned char* lds, const int lda, const int ldb, const int K, const Sched& S, const Epi& E) {
    const int tid = threadIdx.x, wid = __builtin_amdgcn_readfirstlane(tid >> 6), lane = tid & 63, wr = wid >> 2, wc = wid & 3, fr = lane & 15, fq = lane >> 4;
    const int nt = K / BK;
    unsigned voffA[2], voffB[2];
#pragma unroll
    for (int i = 0; i < 2; ++i) { int R, C; stage_rc(tid * 16 + i * 8192, R, C); const int Rb = (R & ~31) + perm32(R & 31);
        voffA[i] = (unsigned)(R * lda + C) * 2u; voffB[i] = (unsigned)(Rb * ldb + C) * 2u; }
    const size_t kstep = (size_t)(BK * 2);
    const size_t hstepA = (size_t)HALF * lda * 2, hstepB = (size_t)HALF * ldb * 2;
    const unsigned ldsw = (unsigned)wid * 1024u;
    const int aoff = lds_byte(wr * 64 + fr, fq * 8), boff = lds_byte(wc * 32 + fr, fq * 8);
#define PG8_SA(b, h) (((b) * 2 + (h)) * HTB)
#define PG8_SB(b, h) ((4 + (b) * 2 + (h)) * HTB)
#define PG8_STAGE(bufoff, gbase, voff) do { _Pragma("unroll") for (int _i = 0; _i < 2; ++_i) \
        __builtin_amdgcn_global_load_lds((const unsigned*)((const char*)(gbase) + (voff)[_i]), (LAS unsigned*)(lds + (bufoff) + ldsw + _i * 8192), 16, 0, 0); } while (0)
#define PG8_LDA(dst, b, h) do { _Pragma("unroll") for (int m = 0; m < 4; ++m) _Pragma("unroll") for (int k = 0; k < 2; ++k) dst[m][k] = *(const LAS bf16x8*)(lds + PG8_SA(b, h) + aoff + m * 2048 + k * 1024); } while (0)
#define PG8_LDB(dst, b, h) do { _Pragma("unroll") for (int n = 0; n < 2; ++n) _Pragma("unroll") for (int k = 0; k < 2; ++k) dst[n][k] = *(const LAS bf16x8*)(lds + PG8_SB(b, h) + boff + n * 2048 + k * 1024); } while (0)
#define PG8_MMA(ai, bj, At, Bt) do { __builtin_amdgcn_s_setprio(1); _Pragma("unroll") for (int m = 0; m < 4; ++m) _Pragma("unroll") for (int n = 0; n < 2; ++n) _Pragma("unroll") for (int k = 0; k < 2; ++k) \
        acc[ai][bj][m][n] = __builtin_amdgcn_mfma_f32_16x16x32_bf16(Bt[n][k], At[m][k], acc[ai][bj][m][n], 0, 0, 0); __builtin_amdgcn_s_setprio(0); } while (0)
#define PG8_WAIT_V(n) asm volatile("s_waitcnt vmcnt(" #n ")" ::: "memory")
#define PG8_WAIT_L(n) asm volatile("s_waitcnt lgkmcnt(" #n ")" ::: "memory")
#define PG8_BAR __builtin_amdgcn_s_barrier()
#define PG8_SCHED __builtin_amdgcn_sched_barrier(0)
    UnitDesc cur, nxt; int ui = 0;
    if (!S.next(0, cur)) return;
    f32x4 acc[2][2][4][2];
#pragma unroll
    for (int a = 0; a < 2; ++a)
#pragma unroll
        for (int b = 0; b < 2; ++b)
#pragma unroll
            for (int m = 0; m < 4; ++m)
#pragma unroll
                for (int n = 0; n < 2; ++n) acc[a][b][m][n] = (f32x4){0.f, 0.f, 0.f, 0.f};
    bf16x8 At[4][2], B0[2][2], B1[2][2];
    const char* cA = cur.A; const char* cB = cur.B;
    PG8_STAGE(PG8_SB(0, 0), cB, voffB); PG8_STAGE(PG8_SB(0, 1), cB + hstepB, voffB); PG8_STAGE(PG8_SA(0, 0), cA, voffA); PG8_STAGE(PG8_SA(0, 1), cA + hstepA, voffA);
    if (wr == 1) PG8_BAR;
    PG8_WAIT_V(2); PG8_BAR;
    PG8_STAGE(PG8_SB(1, 0), cB + kstep, voffB); PG8_STAGE(PG8_SA(1, 0), cA + kstep, voffA); PG8_STAGE(PG8_SB(1, 1), cB + hstepB + kstep, voffB);
    PG8_WAIT_V(6); PG8_BAR;
    for (;;) {
        const bool has_next = S.next(ui + 1, nxt);
        const char* nA = has_next ? nxt.A : cA; const char* nB = has_next ? nxt.B : cB;
#pragma unroll 1
        for (int t = 0; t < nt; t += 2) {
            const bool last = (t == nt - 2);
            const char* a1 = cA + (size_t)(t + 1) * kstep;
            const char* a2 = last ? nA : cA + (size_t)(t + 2) * kstep; const char* b2 = last ? nB : cB + (size_t)(t + 2) * kstep;
            const char* a3 = a2 + kstep; const char* b3 = b2 + kstep;
            PG8_LDB(B0, 0, 0); PG8_LDB(B1, 0, 1); PG8_SCHED; PG8_LDA(At, 0, 0); PG8_STAGE(PG8_SA(1, 1), a1 + hstepA, voffA);
            PG8_WAIT_V(8); PG8_WAIT_L(0); PG8_BAR; PG8_MMA(0, 0, At, B0); PG8_MMA(0, 1, At, B1); PG8_BAR; PG8_SCHED;
            PG8_LDA(At, 0, 1); PG8_STAGE(PG8_SB(0, 0), b2, voffB); PG8_STAGE(PG8_SB(0, 1), b2 + hstepB, voffB); PG8_STAGE(PG8_SA(0, 0), a2, voffA);
            PG8_WAIT_V(8); PG8_WAIT_L(0); PG8_BAR; PG8_MMA(1, 0, At, B0); PG8_MMA(1, 1, At, B1); PG8_BAR; PG8_SCHED;
            PG8_LDB(B0, 1, 0); PG8_LDB(B1, 1, 1); PG8_SCHED; PG8_LDA(At, 1, 0); PG8_STAGE(PG8_SA(0, 1), a2 + hstepA, voffA);
            PG8_WAIT_V(8); PG8_WAIT_L(0); PG8_BAR; PG8_MMA(0, 0, At, B0); PG8_MMA(0, 1, At, B1); PG8_BAR; PG8_SCHED;
            PG8_LDA(At, 1, 1); PG8_STAGE(PG8_SB(1, 0), b3, voffB); PG8_STAGE(PG8_SB(1, 1), b3 + hstepB, voffB); PG8_STAGE(PG8_SA(1, 0), a3, voffA);
            PG8_WAIT_V(8); PG8_WAIT_L(0); PG8_BAR; PG8_MMA(1, 0, At, B0); PG8_MMA(1, 1, At, B1); PG8_BAR; PG8_SCHED;
        }
        if constexpr (ALIGN_EPI) { if (wr == 0) PG8_BAR; }
        E(acc, cur, wr, wc, fr, fq);
        if (!has_next) break;
#pragma unroll
        for (int a = 0; a < 2; ++a)
#pragma unroll
            for (int b = 0; b < 2; ++b)
#pragma unroll
                for (int m = 0; m < 4; ++m)
#pragma unroll
                    for (int n = 0; n < 2; ++n) acc[a][b][m][n] = (f32x4){0.f, 0.f, 0.f, 0.f};
        cur = nxt; cA = nA; cB = nB; ++ui;
        if constexpr (ALIGN_EPI) { if (wr == 1) PG8_BAR; }
    }
    PG8_WAIT_V(0);
    if constexpr (!ALIGN_EPI) { if (wr == 0) PG8_BAR; }
    PG8_BAR;
#undef PG8_SA
#undef PG8_SB
#undef PG8_STAGE
#undef PG8_LDA
#undef PG8_LDB
#undef PG8_MMA
#undef PG8_WAIT_V
#undef PG8_WAIT_L
#undef PG8_BAR
#undef PG8_SCHED
}

struct EpiStore {
    __device__ __forceinline__ void operator()(const f32x4 (&acc)[2][2][4][2], const UnitDesc& u, int wr, int wc, int fr, int fq) const {
#pragma unroll
        for (int ai = 0; ai < 2; ++ai)
#pragma unroll
            for (int m = 0; m < 4; ++m) { bf16_t* rowp = u.out + (size_t)(ai * HALF + wr * 64 + m * 16 + fr) * u.ldc + wc * 32 + 8 * fq;
#pragma unroll
                for (int bj = 0; bj < 2; ++bj) { const f32x4 v0 = acc[ai][bj][m][0], v1 = acc[ai][bj][m][1];
                    u32x4 w; w.x = pk2(v0[0], v0[1]); w.y = pk2(v0[2], v0[3]); w.z = pk2(v1[0], v1[1]); w.w = pk2(v1[2], v1[3]);
                    *(u32x4*)(rowp + bj * HALF) = w; } }
    }
};
__device__ __forceinline__ void store16_sc1(void* ptr, u32x4 v) { asm volatile("global_store_dwordx4 %0, %1, off sc0 sc1\n\ts_nop 3" :: "v"(ptr), "v"(v) : "memory"); }
struct EpiStoreSig {
    unsigned* cnt;
    __device__ __forceinline__ void operator()(const f32x4 (&acc)[2][2][4][2], const UnitDesc& u, int wr, int wc, int fr, int fq) const {
#pragma unroll
        for (int ai = 0; ai < 2; ++ai)
#pragma unroll
            for (int m = 0; m < 4; ++m) { bf16_t* rowp = u.out + (size_t)(ai * HALF + wr * 64 + m * 16 + fr) * u.ldc + wc * 32 + 8 * fq;
#pragma unroll
                for (int bj = 0; bj < 2; ++bj) { const f32x4 v0 = acc[ai][bj][m][0], v1 = acc[ai][bj][m][1];
                    u32x4 w; w.x = pk2(v0[0], v0[1]); w.y = pk2(v0[2], v0[3]); w.z = pk2(v1[0], v1[1]); w.w = pk2(v1[2], v1[3]);
                    if (cnt) store16_sc1(rowp + bj * HALF, w); else *(u32x4*)(rowp + bj * HALF) = w; } }
        if (cnt) { asm volatile("s_waitcnt vmcnt(0)" ::: "memory");
            if ((threadIdx.x & 63) == 0) __hip_atomic_fetch_add(cnt + (u.aux & 0xffff) * 64, 1u, __ATOMIC_RELAXED, __HIP_MEMORY_SCOPE_AGENT); }
    }
};
__device__ __forceinline__ float swiglu1(float g, float u) { return g * u * __builtin_amdgcn_rcpf(1.0f + __builtin_amdgcn_exp2f(-1.4426950408889634f * g)); }
struct EpiSwiGLU {
    unsigned* cnt;
    __device__ __forceinline__ void operator()(const f32x4 (&acc)[2][2][4][2], const UnitDesc& u, int wr, int wc, int fr, int fq) const {
#pragma unroll
        for (int ai = 0; ai < 2; ++ai)
#pragma unroll
            for (int m = 0; m < 4; ++m) { bf16_t* rowp = u.out + (size_t)(ai * HALF + wr * 64 + m * 16 + fr) * u.ldc + wc * 32 + 8 * fq;
                const f32x4 g0 = acc[ai][0][m][0], g1 = acc[ai][0][m][1], u0 = acc[ai][1][m][0], u1 = acc[ai][1][m][1];
                u32x4 w; w.x = pk2(swiglu1(g0[0], u0[0]), swiglu1(g0[1], u0[1])); w.y = pk2(swiglu1(g0[2], u0[2]), swiglu1(g0[3], u0[3]));
                w.z = pk2(swiglu1(g1[0], u1[0]), swiglu1(g1[1], u1[1])); w.w = pk2(swiglu1(g1[2], u1[2]), swiglu1(g1[3], u1[3]));
                if (cnt) store16_sc1(rowp, w); else *(u32x4*)rowp = w; }
        if (cnt) { asm volatile("s_waitcnt vmcnt(0)" ::: "memory");
            if ((threadIdx.x & 63) == 0) __hip_atomic_fetch_add(cnt + (u.aux & 0xffff) * 64, 1u, __ATOMIC_RELAXED, __HIP_MEMORY_SCOPE_AGENT); }
    }
};
struct EpiQKV {
    bf16_t* Q; bf16_t* Kb; bf16_t* Vb; float* ck; float* cv; unsigned* cnt;
    __device__ __forceinline__ void operator()(const f32x4 (&acc)[2][2][4][2], const UnitDesc& u, int wr, int wc, int fr, int fq) const {
        const int pm = u.aux & 0xffff, pn = u.aux >> 16, sel = pn >> 2, ct = (pn & 3) * BM;
        const int row0 = pm * BM + wr * 64 + fr, col0 = ct + wc * 32 + 8 * fq;
        bf16_t* base = Q + (size_t)sel * (size_t)(12 * 1024 * 1024); float* cb = ck + (size_t)(sel >= 1 ? sel - 1 : 0) * (size_t)NP * D;
        const bool wc32 = sel >= 1 && pm < NP / BM;
#pragma unroll
        for (int ai = 0; ai < 2; ++ai)
#pragma unroll
            for (int m = 0; m < 4; ++m) { const size_t off = (size_t)(row0 + ai * HALF + m * 16) * D + col0;
#pragma unroll
                for (int bj = 0; bj < 2; ++bj) { const f32x4 v0 = acc[ai][bj][m][0], v1 = acc[ai][bj][m][1];
                    u32x4 w; w.x = pk2(v0[0], v0[1]); w.y = pk2(v0[2], v0[3]); w.z = pk2(v1[0], v1[1]); w.w = pk2(v1[2], v1[3]);
                    if (cnt) store16_sc1(base + off + bj * HALF, w); else *(u32x4*)(base + off + bj * HALF) = w;
                    if (wc32) { *(f32x4*)(cb + off + bj * HALF) = v0; *(f32x4*)(cb + off + bj * HALF + 4) = v1; } } }
        if (cnt) { asm volatile("s_waitcnt vmcnt(0)" ::: "memory");
            if ((threadIdx.x & 63) == 0) __hip_atomic_fetch_add(cnt + pm * 64, 1u, __ATOMIC_RELAXED, __HIP_MEMORY_SCOPE_AGENT); }
    }
};

struct GSched {
    int nM, nN, G, c; const char* A; size_t a_tile; const char* B; size_t b_tile; bf16_t* out; size_t o_pm, o_pn; int ldc;
    __device__ __forceinline__ bool next(int i, UnitDesc& u) const {
        const long L = (long)i * G + c; if (L >= (long)nM * nN) return false;
        int pm, pn; tile_order((int)L, nM, nN, pm, pn);
        u.A = A + (size_t)pm * a_tile; u.B = B + (size_t)pn * b_tile; u.out = out + (size_t)pm * o_pm + (size_t)pn * o_pn; u.ldc = ldc; u.aux = pm | (pn << 16); return true;
    }
};
struct ChDftSched {
    int G, c; const char* cs_tab; const char* H; bf16_t* ytp; bf16_t* yts;
    __device__ __forceinline__ bool next(int i, UnitDesc& u) const {
        const long L = (long)i * G + c; if (L >= 48 * 8) return false;
        int tok, gc; tile_order((int)L, 48, 8, tok, gc); const int g = gc >> 1, cs = gc & 1;
        u.A = cs_tab + (size_t)cs * 256 * 256 * 2; u.B = H + ((size_t)tok * 256 * D + g * 256) * 2;
        if (tok < 32) { u.out = ytp + ((size_t)(tok * D + g * 256) * 512 + cs * 256); u.ldc = 512; }
        else { const int idx = tok - 32, b = idx >> 3, s0 = (idx & 7) * 256; u.out = yts + ((size_t)(b * D + g * 256) * 4096 + cs * 2048 + s0); u.ldc = 4096; }
        u.aux = 0; return true;
    }
};
struct SeqSSched {
    int c; const char* ts; const char* yts; bf16_t* F;
    __device__ __forceinline__ bool next(int i, UnitDesc& u) const {
        if (i > 0 || c >= 64) return false;
        const int b = c >> 5, pm = (c >> 2) & 7, pn = c & 3;
        u.A = ts + (size_t)pm * 256 * 4096 * 2; u.B = yts + (size_t)(b * D + pn * 256) * 4096 * 2;
        u.out = F + ((size_t)(NP + b * SS + pm * 256) * D + pn * 256); u.ldc = D; u.aux = 32 + 8 * b + pm; return true;
    }
};
struct SeqPSched {
    int G, c; const char* tp; const char* ytp; bf16_t* F;
    __device__ __forceinline__ bool next(int i, UnitDesc& u) const {
        const int G2 = G - 64; if (c < 64 || G2 <= 0) return false;
        const long L = (long)i * G2 + (c - 64); if (L >= 128) return false;
        const int b = (int)L >> 2, pn = (int)L & 3;
        u.A = tp; u.B = ytp + (size_t)(b * D + pn * 256) * 512 * 2;
        u.out = F + ((size_t)(b * 256) * D + pn * 256); u.ldc = D; u.aux = b; return true;
    }
};
struct GuSched {
    int G, c; const char* A; const char* B; bf16_t* out;
    __device__ __forceinline__ bool next(int i, UnitDesc& u) const {
        const long L = (long)i * G + c; if (L >= 1056) return false;
        int pm, pn; if (L < 1012) tile_order((int)L, 46, 22, pm, pn); else { const int j = (int)L - 1012; pm = 46 + j / 22; pn = j % 22; }
        u.A = A + (size_t)pm * 256 * D * 2; u.B = B + (size_t)pn * 256 * D * 2; u.out = out + (size_t)pm * 256 * FF + (size_t)pn * 128; u.ldc = FF; u.aux = pm | (pn << 16); return true;
    }
};
struct DownSched {
    int d; const char* A; const char* B; bf16_t* out; bf16_t* out2;
    __device__ __forceinline__ void unit(int& pm, int& pn, int& kh) const { kh = 0; if (d < 184) tile_order(d, 46, 4, pm, pn); else { const int j = d - 184, un = j >> 1; kh = j & 1; pm = 46 + un / 4; pn = un % 4; } }
    __device__ __forceinline__ bool next(int i, UnitDesc& u) const {
        if (i > 0 || d < 0 || d >= 200) return false;
        int pm, pn, kh; unit(pm, pn, kh);
        u.A = A + (size_t)pm * 256 * FF * 2 + (size_t)kh * (FF / 2) * 2; u.B = B + (size_t)pn * 256 * FF * 2 + (size_t)kh * (FF / 2) * 2;
        u.out = kh ? out2 + (size_t)(pm - 46) * 256 * D + (size_t)pn * 256 : out + (size_t)pm * 256 * D + (size_t)pn * 256; u.ldc = D; u.aux = pm | (pn << 16); return true;
    }
};
struct QkvSched {
    int G, c; const char* A; const char* B;
    __device__ __forceinline__ bool next(int i, UnitDesc& u) const {
        const long L = (long)i * G + c; if (L >= 576) return false;
        int pm, pn; if (L < 384) tile_order((int)L, 32, 12, pm, pn); else { tile_order((int)L - 384, 16, 12, pm, pn); pm += 32; }
        u.A = A + (size_t)pm * 256 * D * 2; u.B = B + (size_t)pn * 256 * D * 2; u.out = nullptr; u.ldc = D; u.aux = pm | (pn << 16); return true;
    }
};
struct OneSched {
    int pm, pn; const char* A; const char* B; bf16_t* out;
    __device__ __forceinline__ bool next(int i, UnitDesc& u) const {
        if (i > 0 || pm < 0) return false;
        u.A = A + (size_t)pm * 256 * D * 2; u.B = B + (size_t)pn * 256 * D * 2; u.out = out + (size_t)pm * 256 * D + (size_t)pn * 256; u.ldc = D; u.aux = pm | (pn << 16); return true;
    }
};
}

constexpr int TI_L0 = 16 * 32 + 2 * 16 * 88 + 44 * 32, TI_ALL = 16 * 32 + 16 * 96 + 16 * 32 + 4 * 16 * 88 + 2 * 44 * 32;
struct TItem { const float* W; bf16_t* WT; int N, ldt, dst, k0, n0; };
__device__ __forceinline__ bool titem_decode(const Params& p, int it, TItem& t) {
    constexpr int I_F = 16 * 32, I_QKV = 16 * 96, I_O = 16 * 32, I_G = 16 * 88, I_D = 44 * 32;
    constexpr int NITEMS = I_F + I_QKV + I_O + 4 * I_G + 2 * I_D;
    if (it >= NITEMS) return false;
    unsigned char* ws = p.ws; int r = it; int mode = 0;
    if (r < I_F) { t.W = p.in[9]; t.N = D; t.ldt = D; t.WT = (bf16_t*)(ws + WS_WF); }
    else { r -= I_F; int l = 0; if (r >= 2 * I_G + I_D) { r -= 2 * I_G + I_D; l = 1; }
        if (r < I_G) { t.W = p.in[13] + (size_t)l * D * FF; t.N = FF; t.ldt = D; t.WT = (bf16_t*)(ws + WS_WGU) + (size_t)l * 2 * FF * D; mode = 1; }
        else if ((r -= I_G) < I_G) { t.W = p.in[14] + (size_t)l * D * FF; t.N = FF; t.ldt = D; t.WT = (bf16_t*)(ws + WS_WGU) + (size_t)l * 2 * FF * D; mode = 2; }
        else if ((r -= I_G) < I_D) { t.W = p.in[15] + (size_t)l * FF * D; t.N = D; t.ldt = FF; t.WT = (bf16_t*)(ws + WS_WD) + (size_t)l * D * FF; }
        else if ((r -= I_D) < I_QKV) { t.W = p.in[10]; t.N = 3 * D; t.ldt = D; t.WT = (bf16_t*)(ws + WS_WQKV); }
        else { r -= I_QKV; t.W = p.in[12]; t.N = D; t.ldt = D; t.WT = (bf16_t*)(ws + WS_WO); } }
    const int nblk = t.N / 32, kb = r / nblk, nb = r % nblk; t.n0 = nb * 32; t.k0 = kb * 64;
    t.dst = t.n0; if (mode) t.dst = (t.n0 >> 7) * 256 + (t.n0 & 127) + (mode == 2 ? 128 : 0);
    return true;
}
__device__ __forceinline__ void titem_load(const TItem& t, f32x4 (&wv)[8], int lane) {
#pragma unroll
    for (int i = 0; i < 8; ++i) wv[i] = __builtin_nontemporal_load((const f32x4*)(t.W + (size_t)(t.k0 + 8 * i + (lane >> 3)) * t.N + t.n0 + 4 * (lane & 7)));
}
__device__ __forceinline__ void titem_finish(const TItem& t, const f32x4 (&wv)[8], LAS float* scr, int lane) {
#pragma unroll
    for (int i = 0; i < 8; ++i) { LAS float* d = scr + (8 * i + (lane >> 3)) * 33 + 4 * (lane & 7); d[0] = wv[i][0]; d[1] = wv[i][1]; d[2] = wv[i][2]; d[3] = wv[i][3]; }
    asm volatile("s_waitcnt lgkmcnt(0)" ::: "memory");
    const int c = lane & 7;
#pragma unroll
    for (int j = 0; j < 4; ++j) { const int n = (lane >> 3) + 8 * j; const LAS float* s = scr + (8 * c) * 33 + n;
        u32x4 o; o.x = pk2(s[0 * 33], s[1 * 33]); o.y = pk2(s[2 * 33], s[3 * 33]); o.z = pk2(s[4 * 33], s[5 * 33]); o.w = pk2(s[6 * 33], s[7 * 33]);
        *(u32x4*)(t.WT + (size_t)(t.dst + n) * t.ldt + t.k0 + 8 * c) = o; }
    asm volatile("s_waitcnt lgkmcnt(0)" ::: "memory");
}

__device__ __forceinline__ void gemv_layer(const Params& p, LAS unsigned char* lds, const int l, const int rb, const int nb, unsigned* done = nullptr) {
    const int tid = threadIdx.x;
    LAS float* sl = (LAS float*)lds;
    LAS f32x4* red = (LAS f32x4*)(lds + 12288);
    for (int i = tid; i < 3072; i += 512) { const int cond = i >> 10, k = i & 1023; const float v = cond == 0 ? p.in[5][k] : p.in[2][(cond - 1) * D + k]; sl[i] = v / (1.0f + __expf(-v)); }
    __syncthreads();
    float* mod = (float*)(p.ws + WS_MOD);
    for (int item = rb; item < 96; item += nb) {
        const int rem = item, cc = rem >> 4, kc = rem & 15, rpar = tid >> 8, col = cc * 1024 + 4 * (tid & 255);
        const float* W = p.in[6] + ((size_t)l * D + kc * 64 + rpar) * 6144 + col;
        f32x4 a0 = {0.f, 0.f, 0.f, 0.f}, a1 = a0, a2 = a0;
#pragma unroll
        for (int hf = 0; hf < 2; ++hf) {
            f32x4 w[16];
#pragma unroll
            for (int i = 0; i < 16; ++i) w[i] = *(const f32x4*)(W + (size_t)(32 * hf + 2 * i) * 6144);
#pragma unroll
            for (int i = 0; i < 16; ++i) { const int k = kc * 64 + 32 * hf + 2 * i + rpar; a0 += sl[k] * w[i]; a1 += sl[1024 + k] * w[i]; a2 += sl[2048 + k] * w[i]; }
        }
        if (rpar == 1) { red[tid - 256] = a0; red[256 + tid - 256] = a1; red[512 + tid - 256] = a2; }
        __syncthreads();
        if (rpar == 0) {
            a0 += red[tid]; a1 += red[256 + tid]; a2 += red[512 + tid];
            if (kc == 0) { const f32x4 bv = *(const f32x4*)(p.in[7] + l * 6144 + col); a0 += bv; a1 += bv; a2 += bv; }
#pragma unroll
            for (int j = 0; j < 4; ++j) {
                unsafeAtomicAdd(mod + (l * 3 + 0) * 6144 + col + j, a0[j]);
                unsafeAtomicAdd(mod + (l * 3 + 1) * 6144 + col + j, a1[j]);
                unsafeAtomicAdd(mod + (l * 3 + 2) * 6144 + col + j, a2[j]); }
        }
        if (done) asm volatile("s_waitcnt vmcnt(0)" ::: "memory");
        __syncthreads();
        if (done && tid == 0) __hip_atomic_fetch_add(done, 1u, __ATOMIC_RELAXED, __HIP_MEMORY_SCOPE_AGENT);
    }
}
__device__ __forceinline__ void transpose_jobs(const Params& p, LAS unsigned char* lds, int gw, int NGW, int it_lo, int it_hi) {
    const int lane = threadIdx.x & 63, wave = threadIdx.x >> 6;
    LAS float* scr = (LAS float*)(lds + wave * 8448);
    TItem cur, nxt; f32x4 wa[8], wb[8];
    int it = it_lo + gw;
    bool have = it < it_hi && titem_decode(p, it, cur);
    if (have) titem_load(cur, wa, lane);
    while (have) {
        const bool hn = it + NGW < it_hi && titem_decode(p, it + NGW, nxt);
        if (hn) titem_load(nxt, wb, lane);
        titem_finish(cur, wa, scr, lane);
        if (!hn) break;
        it += 2 * NGW;
        have = it < it_hi && titem_decode(p, it, cur);
        if (have) titem_load(cur, wa, lane);
        titem_finish(nxt, wb, scr, lane);
    }
}
__device__ __forceinline__ void phase_prologue(const Params& p, LAS unsigned char* lds, unsigned* gemv_done) {
    const int tid = threadIdx.x, G = gridDim.x, bx = blockIdx.x;
    unsigned char* ws = p.ws;
    LAS float* ct = (LAS float*)(lds + 32768);
    for (int i = tid; i < 2048; i += 512) ct[i] = cospif((float)i * (1.0f / 1024.0f));
    const bool sep = G >= 192;
    if (!sep || bx < 96) gemv_layer(p, lds, 0, bx, sep ? 96 : G, gemv_done);
    if (sep && bx < 96) return;
    const int gt = (sep ? bx - 96 : bx) * 512 + tid, GT = (sep ? G - 96 : G) * 512;
    for (int i = gt; i < 2 * 2 * 512 * D / 8; i += GT) { const int which = i >= 2 * 512 * D / 8; const int ii = which ? i - 2 * 512 * D / 8 : i;
        const f32x4* src = (const f32x4*)p.in[which ? 4 : 3]; const f32x4 a = src[2 * ii], b = src[2 * ii + 1];
        u32x4 o; o.x = pk2(a[0], a[1]); o.y = pk2(a[2], a[3]); o.z = pk2(b[0], b[1]); o.w = pk2(b[2], b[3]); ((u32x4*)((unsigned char*)p.out + (which ? OUTB_VC : OUTB_KC)))[ii] = o; }
    for (int i = gt; i < 512 * 256 / 8; i += GT) { const int row = i >> 5, c0 = (i & 31) * 8, cs = row >> 8, m = row & 255; float v[8];
#pragma unroll
        for (int j = 0; j < 8; ++j) { const int idx = ((m * (c0 + j)) & 255) * 8; v[j] = ct[(idx - (cs ? 512 : 0)) & 2047]; }
        u32x4 o; o.x = pk2(v[0], v[1]); o.y = pk2(v[2], v[3]); o.z = pk2(v[4], v[5]); o.w = pk2(v[6], v[7]); ((u32x4*)(ws + WS_CSCH))[i] = o; }
    for (int i = gt; i < 256 * 512 / 8; i += GT) { const int k = i >> 6, c0 = (i & 63) * 8; float v[8];
#pragma unroll
        for (int j = 0; j < 8; ++j) { const int kk = c0 + j, sidx = kk & 255; const int idx = ((k * sidx) & 255) * 8; v[j] = kk < 256 ? ct[idx] : -ct[(idx - 512) & 2047]; }
        u32x4 o; o.x = pk2(v[0], v[1]); o.y = pk2(v[2], v[3]); o.z = pk2(v[4], v[5]); o.w = pk2(v[6], v[7]); ((u32x4*)(ws + WS_TP))[i] = o; }
    for (int i = gt; i < 2048 * 4096 / 8; i += GT) { const int k = i >> 9, c0 = (i & 511) * 8; float v[8];
#pragma unroll
        for (int j = 0; j < 8; ++j) { const int kk = c0 + j, sidx = kk & 2047; const int idx = (k * sidx) & 2047; v[j] = kk < 2048 ? ct[idx] : -ct[(idx - 512) & 2047]; }
        u32x4 o; o.x = pk2(v[0], v[1]); o.y = pk2(v[2], v[3]); o.z = pk2(v[4], v[5]); o.w = pk2(v[6], v[7]); ((u32x4*)(ws + WS_TS))[i] = o; }
}
__device__ __forceinline__ void phase_side_jobs(const Params& p, LAS unsigned char* lds, const int which) {
    if (which == 5) { if (blockIdx.x < 56) transpose_jobs(p, lds, blockIdx.x * 8 + (threadIdx.x >> 6), 56 * 8, TI_L0 + 3 * 1408, TI_L0 + 3 * 1408 + 1536); return; }
    if (which == 6) { if (blockIdx.x >= 64) { const int gw = (blockIdx.x - 64) * 8 + (threadIdx.x >> 6), ngw = (gridDim.x - 64) * 8;
        transpose_jobs(p, lds, gw, ngw, TI_L0 + 2 * 1408, TI_L0 + 3 * 1408); transpose_jobs(p, lds, gw, ngw, TI_L0 + 3 * 1408 + 1536, TI_ALL); } return; }
    if (which == 8) { if (blockIdx.x >= 128) transpose_jobs(p, lds, (blockIdx.x - 128) * 8 + (threadIdx.x >> 6), (gridDim.x - 128) * 8, 0, 512); return; }
    if (which == 9) { if (blockIdx.x >= 64) transpose_jobs(p, lds, (blockIdx.x - 64) * 8 + (threadIdx.x >> 6), (gridDim.x - 64) * 8, 512, TI_L0);
        if (blockIdx.x >= 192) { __syncthreads(); gemv_layer(p, lds, 1, blockIdx.x - 192, gridDim.x - 192); } return; }
    if (which == 7) { if (blockIdx.x >= 192) transpose_jobs(p, lds, (blockIdx.x - 192) * 8 + (threadIdx.x >> 6), (gridDim.x - 192) * 8, TI_L0, TI_L0 + 2 * 1408); return; }
    const int G = gridDim.x, bx = blockIdx.x, first = which == 0 ? 64 : 192;
    const int nb = G > first ? G - first : G, b0 = G > first ? first : 0;
    if (bx < b0) return;
    const int rb = bx - b0;
    if (which == 0) transpose_jobs(p, lds, rb * 8 + (threadIdx.x >> 6), nb * 8, 0, TI_L0);
    else if (which == 1) gemv_layer(p, lds, 1, rb, nb);
    else transpose_jobs(p, lds, rb * 8 + (threadIdx.x >> 6), nb * 8, TI_L0, TI_ALL);
}

#ifndef ROW_WT
#define ROW_WT 0
#endif
__device__ __forceinline__ void store16_wt(void* ptr, u32x4 v) {
#if ROW_WT
    asm volatile("global_store_dwordx4 %0, %1, off sc0 sc1\n\ts_nop 3" :: "v"(ptr), "v"(v) : "memory");
#else
    *(u32x4*)ptr = v;
#endif
}
__device__ __forceinline__ void bf8_to_f32(const u32x4 w, f32x4& a, f32x4& b) { a = (f32x4){bf_lo(w.x), bf_hi(w.x), bf_lo(w.y), bf_hi(w.y)}; b = (f32x4){bf_lo(w.z), bf_hi(w.z), bf_lo(w.w), bf_hi(w.w)}; }
__device__ __forceinline__ u32x4 f32_to_bf8(const f32x4 a, const f32x4 b) { u32x4 w; w.x = pk2(a[0], a[1]); w.y = pk2(a[2], a[3]); w.z = pk2(b[0], b[1]); w.w = pk2(b[2], b[3]); return w; }
template <bool HAS_MP, bool HAS_NEXT, bool XIN_F32>
__device__ __forceinline__ void row_phase(const float* xin_p, const float* xin_s, bf16_t* XB, const bf16_t* mp, float* Yout, bf16_t* Hout,
                                          const float* gate, const float* gA, const float* gB, const float* sc, const float* sh, unsigned* cnt = nullptr, const bf16_t* mp2 = nullptr) {
    const int tid = threadIdx.x, lane = tid & 63, gw = blockIdx.x * 8 + (tid >> 6), NGW = gridDim.x * 8;
    if (cnt) {
        if (tid == 0) { const int p0 = (blockIdx.x * 48) >> 8, p1 = (blockIdx.x * 48 + 47) >> 8;
            for (int pp = p0; pp <= p1; ++pp) { unsigned sp = 0; while (__hip_atomic_load(cnt + pp * 64, __ATOMIC_RELAXED, __HIP_MEMORY_SCOPE_AGENT) < ((mp2 && pp >= 46) ? 64u : 32u)) { __builtin_amdgcn_s_sleep(2); if (++sp > (1u << 22)) break; } }
            __builtin_amdgcn_fence(__ATOMIC_ACQUIRE, "agent"); asm volatile("s_waitcnt vmcnt(0)" ::: "memory"); }
        __syncthreads();
    }
    constexpr int R = 3, RW = 6;
    int cur_cond = -1;
    f32x4 gga[4], gbs[4], shv[4];
    for (int rowb = gw * RW; rowb < M; rowb += NGW * RW)
    for (int row0 = rowb; row0 < rowb + RW; row0 += R) {
        f32x4 v[R][4]; u32x4 mw[R][2];
#pragma unroll
        for (int q = 0; q < R; ++q) { const int row = row0 + q;
            if constexpr (XIN_F32) { const float* xr = row < NP ? xin_p + (size_t)row * D : xin_s + (size_t)(row - NP) * D;
#pragma unroll
                for (int j = 0; j < 2; ++j) { v[q][2 * j] = *(const f32x4*)(xr + 8 * lane + 512 * j); v[q][2 * j + 1] = *(const f32x4*)(xr + 8 * lane + 512 * j + 4); }
            } else {
#pragma unroll
                for (int j = 0; j < 2; ++j) { const u32x4 w = *(const u32x4*)(XB + (size_t)row * D + 8 * lane + 512 * j); bf8_to_f32(w, v[q][2 * j], v[q][2 * j + 1]); }
            }
            if constexpr (HAS_MP) {
#pragma unroll
                for (int j = 0; j < 2; ++j) mw[q][j] = *(const u32x4*)(mp + (size_t)row * D + 8 * lane + 512 * j);
            } }
        u32x4 xo[R][2], ho[R][2];
#pragma unroll
        for (int q = 0; q < R; ++q) { const int row = row0 + q; const int cond = row < NP ? 0 : (row < NP + SS ? 1 : 2);
            if (cond != cur_cond) { cur_cond = cond;
#pragma unroll
                for (int j = 0; j < 4; ++j) { const int col = 8 * lane + 512 * (j >> 1) + 4 * (j & 1);
                    if constexpr (HAS_MP) gga[j] = *(const f32x4*)(gate + cond * 6144 + col) * *(const f32x4*)(gA + col);
                    if constexpr (HAS_NEXT) { gbs[j] = *(const f32x4*)(gB + col) * (1.0f + *(const f32x4*)(sc + cond * 6144 + col)); shv[j] = *(const f32x4*)(sh + cond * 6144 + col); } } }
            if constexpr (HAS_MP) {
                f32x4 mv[4]; float s = 0.f;
#pragma unroll
                for (int j = 0; j < 2; ++j) bf8_to_f32(mw[q][j], mv[2 * j], mv[2 * j + 1]);
                if (mp2 && row >= 46 * 256) {
#pragma unroll
                    for (int j = 0; j < 2; ++j) { f32x4 a, b; bf8_to_f32(*(const u32x4*)(mp2 + (size_t)(row - 46 * 256) * D + 8 * lane + 512 * j), a, b); mv[2 * j] += a; mv[2 * j + 1] += b; } }
#pragma unroll
                for (int j = 0; j < 4; ++j) s += (mv[j][0] * mv[j][0] + mv[j][1] * mv[j][1]) + (mv[j][2] * mv[j][2] + mv[j][3] * mv[j][3]);
                const float rstd = 1.0f / sqrtf(wave_sum(s) * (1.0f / D) + 1e-6f);
#pragma unroll
                for (int j = 0; j < 4; ++j) v[q][j] = v[q][j] + gga[j] * (mv[j] * rstd);
                if constexpr (HAS_NEXT) {
#pragma unroll
                    for (int j = 0; j < 2; ++j) xo[q][j] = f32_to_bf8(v[q][2 * j], v[q][2 * j + 1]);
                }
            }
            if constexpr (HAS_NEXT) {
                float s = 0.f;
#pragma unroll
                for (int j = 0; j < 4; ++j) s += (v[q][j][0] * v[q][j][0] + v[q][j][1] * v[q][j][1]) + (v[q][j][2] * v[q][j][2] + v[q][j][3] * v[q][j][3]);
                const float rstd = 1.0f / sqrtf(wave_sum(s) * (1.0f / D) + 1e-6f);
                f32x4 hh[4];
#pragma unroll
                for (int j = 0; j < 4; ++j) hh[j] = (v[q][j] * rstd) * gbs[j] + shv[j];
#pragma unroll
                for (int j = 0; j < 2; ++j) ho[q][j] = f32_to_bf8(hh[2 * j], hh[2 * j + 1]);
            } }
#pragma unroll
        for (int q = 0; q < R; ++q) { const int row = row0 + q;
            if constexpr (HAS_MP && !HAS_NEXT) {
#pragma unroll
                for (int j = 0; j < 4; ++j) *(f32x4*)(Yout + (size_t)row * D + 8 * lane + 512 * (j >> 1) + 4 * (j & 1)) = v[q][j];
            }
            if constexpr (HAS_MP && HAS_NEXT) {
#pragma unroll
                for (int j = 0; j < 2; ++j) store16_wt(XB + (size_t)row * D + 8 * lane + 512 * j, xo[q][j]);
            }
            if constexpr (HAS_NEXT) {
#pragma unroll
                for (int j = 0; j < 2; ++j) store16_wt(Hout + (size_t)row * D + 8 * lane + 512 * j, ho[q][j]);
            } }
    }
}

__device__ __forceinline__ void attn_phase(const Params& p, LAS unsigned char* lds, const int u_lo, const int u_hi, const int rb, const int nb) {
    const int tid = threadIdx.x, lane = tid & 63, wave = __builtin_amdgcn_readfirstlane(tid >> 6), r = lane & 31, hh = lane >> 5;
    unsigned char* ws = p.ws;
    const bf16_t* Qb = (const bf16_t*)(ws + WS_Q); const bf16_t* Kb = (const bf16_t*)(ws + WS_K); const bf16_t* Vb = (const bf16_t*)(ws + WS_VT);
    const bf16_t* Kc = (const bf16_t*)((const unsigned char*)p.out + OUTB_KC); const bf16_t* Vc = (const bf16_t*)((const unsigned char*)p.out + OUTB_VC);
    bf16_t* Ob = (bf16_t*)(ws + WS_H);
    LAS float* Bl = (LAS float*)(lds + 36864 + 512);
    const int srow = tid >> 3, sch = tid & 7, krho = (srow & ~12) | ((srow & 4) << 1) | ((srow & 8) >> 1);
    const float c2 = 0.125f * 1.4426950408889634f;
    for (int unit = u_lo + rb; unit < u_hi; unit += nb) {
        const bool is_na = unit < 256;
        int b, h, qtok, nt, jmin = 0, nloc = 0, rq = 0, half = 0, ktok0;
        if (is_na) { b = unit >> 7; h = (unit >> 3) & 15; const int r0 = (unit & 7) * 4; rq = r0 + (wave >> 1); half = wave & 1;
            jmin = min(max(r0 - 4, 0), 24); const int jmax = min(max(r0 - 1, 0), 24) + 7; nloc = jmax - jmin + 1; nt = nloc + 8;
            qtok = NP + b * SS + rq * 64 + half * 32 + r; ktok0 = NP + b * SS; }
        else { const int u2 = unit - 256; b = u2 >> 4; h = u2 & 15; nt = 4; qtok = b * SP + wave * 32 + r; ktok0 = b * SP; }
        const int rs = min(max(rq - 4, 0), 24);
        if (is_na) { for (int i = tid; i < 15 * 32; i += 512) { const int rr = i >> 5, x = i & 31; Bl[i] = x < 31 ? p.in[11][(h * 15 + rr) * 31 + x] * 1.4426950408889634f : 0.f; } }
        bf16x8 qf[4];
#pragma unroll
        for (int d0 = 0; d0 < 4; ++d0) qf[d0] = *(const bf16x8*)(Qb + (size_t)qtok * D + h * HD + d0 * 16 + hh * 8);
        f32x16 o0, o1;
#pragma unroll
        for (int i = 0; i < 16; ++i) { o0[i] = 0.f; o1[i] = 0.f; }
        float m_run = -1e30f, l_run = 0.f;
        u32x4 kreg, vreg;
#define ATT_LOAD(t) do { const int t_ = (t); size_t off_; const bf16_t* kb_; const bf16_t* vb_; \
            if (is_na && t_ >= nloc) { off_ = ((size_t)(b * 512 + (t_ - nloc) * 64 + srow)) * D + h * HD + sch * 8; kb_ = Kc; vb_ = Vc; } \
            else { off_ = (size_t)(ktok0 + (is_na ? (jmin + t_) * 64 : t_ * 64) + srow) * D + h * HD + sch * 8; kb_ = Kb; vb_ = Vb; } \
            kreg = *(const u32x4*)(kb_ + off_); vreg = *(const u32x4*)(vb_ + off_); } while (0)
#define ATT_STORE(buf) do { LAS unsigned char* kl_ = lds + (buf) * 18432; LAS unsigned char* vl_ = kl_ + 9216; \
            *(LAS u32x4*)(kl_ + krho * 144 + sch * 16) = kreg; \
            LAS bf16_t* vd_ = (LAS bf16_t*)(vl_ + (8 * sch) * 144 + srow * 2); \
            vd_[0 * 72] = (bf16_t)vreg.x; vd_[1 * 72] = (bf16_t)(vreg.x >> 16); vd_[2 * 72] = (bf16_t)vreg.y; vd_[3 * 72] = (bf16_t)(vreg.y >> 16); \
            vd_[4 * 72] = (bf16_t)vreg.z; vd_[5 * 72] = (bf16_t)(vreg.z >> 16); vd_[6 * 72] = (bf16_t)vreg.w; vd_[7 * 72] = (bf16_t)(vreg.w >> 16); } while (0)
        ATT_LOAD(0); ATT_STORE(0); if (nt > 1) ATT_LOAD(1);
        __syncthreads();
        for (int t = 0; t < nt; ++t) {
            if (t + 1 < nt) { ATT_STORE((t + 1) & 1); if (t + 2 < nt) ATT_LOAD(t + 2); }
            const bool local = is_na && t < nloc; const int j = jmin + t;
            if (!(local && (j < rs || j >= rs + 8))) {
                const LAS unsigned char* Kl = lds + (t & 1) * 18432; const LAS unsigned char* Vl = Kl + 9216;
                f32x16 p0, p1;
#pragma unroll
                for (int i = 0; i < 16; ++i) { p0[i] = 0.f; p1[i] = 0.f; }
#pragma unroll
                for (int d0 = 0; d0 < 4; ++d0) { const bf16x8 a0 = *(const LAS bf16x8*)(Kl + r * 144 + d0 * 32 + hh * 16), a1 = *(const LAS bf16x8*)(Kl + (32 + r) * 144 + d0 * 32 + hh * 16);
                    p0 = __builtin_amdgcn_mfma_f32_32x32x16_bf16(a0, qf[d0], p0, 0, 0, 0); p1 = __builtin_amdgcn_mfma_f32_32x32x16_bf16(a1, qf[d0], p1, 0, 0, 0); }
                float m_new, alpha;
                if (local) {
                    const int qc = half * 32 + r, cs = min(max(qc - 8, 0), 48);
                    const LAS float* bp = Bl + (j - rq + 7) * 32 + 8 * hh - qc + 15;
                    float bb0[16], bb1[16];
#pragma unroll
                    for (int i = 0; i < 16; ++i) { const int kc = 16 * (i >> 3) + (i & 7); bb0[i] = bp[kc]; bb1[i] = bp[kc + 32]; }
                    asm volatile("" : "+v"(bb0[0]), "+v"(bb0[1]), "+v"(bb0[2]), "+v"(bb0[3]), "+v"(bb0[4]), "+v"(bb0[5]), "+v"(bb0[6]), "+v"(bb0[7]));
                    asm volatile("" : "+v"(bb0[8]), "+v"(bb0[9]), "+v"(bb0[10]), "+v"(bb0[11]), "+v"(bb0[12]), "+v"(bb0[13]), "+v"(bb0[14]), "+v"(bb0[15]));
                    asm volatile("" : "+v"(bb1[0]), "+v"(bb1[1]), "+v"(bb1[2]), "+v"(bb1[3]), "+v"(bb1[4]), "+v"(bb1[5]), "+v"(bb1[6]), "+v"(bb1[7]));
                    asm volatile("" : "+v"(bb1[8]), "+v"(bb1[9]), "+v"(bb1[10]), "+v"(bb1[11]), "+v"(bb1[12]), "+v"(bb1[13]), "+v"(bb1[14]), "+v"(bb1[15]));
                    const unsigned sh0 = (unsigned)(8 * hh - cs);
#pragma unroll
                    for (int i = 0; i < 16; ++i) { const int kc = 16 * (i >> 3) + (i & 7);
                        const float s0 = __builtin_fmaf(p0[i], c2, bb0[i]), s1 = __builtin_fmaf(p1[i], c2, bb1[i]);
                        p0[i] = (sh0 + (unsigned)kc) < 16u ? s0 : -1e30f; p1[i] = (sh0 + (unsigned)(kc + 32)) < 16u ? s1 : -1e30f; }
                    float mt = fmaxf(p0[0], p1[0]);
#pragma unroll
                    for (int i = 1; i < 16; ++i) mt = fmaxf(mt, fmaxf(p0[i], p1[i]));
                    mt = fmaxf(mt, __shfl_xor(mt, 32));
                    m_new = fmaxf(m_run, mt); alpha = __builtin_amdgcn_exp2f(m_run - m_new);
#pragma unroll
                    for (int i = 0; i < 16; ++i) { p0[i] = __builtin_amdgcn_exp2f(p0[i] - m_new); p1[i] = __builtin_amdgcn_exp2f(p1[i] - m_new); }
                } else {
                    float mt = fmaxf(p0[0], p1[0]);
#pragma unroll
                    for (int i = 1; i < 16; ++i) mt = fmaxf(mt, fmaxf(p0[i], p1[i]));
                    mt = fmaxf(mt, __shfl_xor(mt, 32)) * c2;
                    m_new = fmaxf(m_run, mt); alpha = __builtin_amdgcn_exp2f(m_run - m_new);
#pragma unroll
                    for (int i = 0; i < 16; ++i) { p0[i] = __builtin_amdgcn_exp2f(__builtin_fmaf(p0[i], c2, -m_new)); p1[i] = __builtin_amdgcn_exp2f(__builtin_fmaf(p1[i], c2, -m_new)); }
                }
                m_run = m_new;
                float ls = 0.f;
#pragma unroll
                for (int i = 0; i < 16; ++i) ls += p0[i] + p1[i];
                l_run = l_run * alpha + ls;
#pragma unroll
                for (int i = 0; i < 16; ++i) { o0[i] *= alpha; o1[i] *= alpha; }
                bf16x8 pa[4];
#pragma unroll
                for (int s2 = 0; s2 < 2; ++s2) { u32x4 w; w.x = pk2(p0[8 * s2], p0[8 * s2 + 1]); w.y = pk2(p0[8 * s2 + 2], p0[8 * s2 + 3]); w.z = pk2(p0[8 * s2 + 4], p0[8 * s2 + 5]); w.w = pk2(p0[8 * s2 + 6], p0[8 * s2 + 7]); pa[s2] = __builtin_bit_cast(bf16x8, w);
                    u32x4 w2; w2.x = pk2(p1[8 * s2], p1[8 * s2 + 1]); w2.y = pk2(p1[8 * s2 + 2], p1[8 * s2 + 3]); w2.z = pk2(p1[8 * s2 + 4], p1[8 * s2 + 5]); w2.w = pk2(p1[8 * s2 + 6], p1[8 * s2 + 7]); pa[2 + s2] = __builtin_bit_cast(bf16x8, w2); }
#pragma unroll
                for (int s2 = 0; s2 < 4; ++s2) { const bf16x8 v0 = *(const LAS bf16x8*)(Vl + r * 144 + s2 * 32 + hh * 16), v1 = *(const LAS bf16x8*)(Vl + (32 + r) * 144 + s2 * 32 + hh * 16);
                    o0 = __builtin_amdgcn_mfma_f32_32x32x16_bf16(v0, pa[s2], o0, 0, 0, 0); o1 = __builtin_amdgcn_mfma_f32_32x32x16_bf16(v1, pa[s2], o1, 0, 0, 0); }
            }
            __syncthreads();
        }
#undef ATT_LOAD
#undef ATT_STORE
        const float inv = 1.0f / (l_run + __shfl_xor(l_run, 32));
        bf16_t* orow = Ob + (size_t)qtok * D + h * HD + 4 * hh;
#pragma unroll
        for (int g = 0; g < 4; ++g) { u32x2 w; w.x = pk2(o0[4 * g] * inv, o0[4 * g + 1] * inv); w.y = pk2(o0[4 * g + 2] * inv, o0[4 * g + 3] * inv); *(u32x2*)(orow + 8 * g) = w;
            u32x2 w2; w2.x = pk2(o1[4 * g] * inv, o1[4 * g + 1] * inv); w2.y = pk2(o1[4 * g + 2] * inv, o1[4 * g + 3] * inv); *(u32x2*)(orow + 32 + 8 * g) = w2; }
    }
    __syncthreads();
}

#define XB_TMO      128
#define XB_XCNT(j)  (256  + 64 * (j))
#define XB_XSUB(j)  (1280 + 64 * (j))
#define XB_XGEN(j)  (2304 + 64 * (j))
#define XB_TOP      3328
#define XB_TOPGEN   3392
#define XCD_BAR_WORDS 3456
#define XB_SPIN_CAP (1u << 18)
__device__ __forceinline__ unsigned xb_ld(unsigned* p)              { return __hip_atomic_load(p, __ATOMIC_RELAXED, __HIP_MEMORY_SCOPE_AGENT); }
__device__ __forceinline__ unsigned xb_add(unsigned* p, unsigned v) { return __hip_atomic_fetch_add(p, v, __ATOMIC_RELAXED, __HIP_MEMORY_SCOPE_AGENT); }
__device__ __forceinline__ unsigned xb_xcc_id() { return (unsigned)__builtin_amdgcn_s_getreg((3 << 11) | 20) & 0xFu; }
#define XB_SPIN(cond, bar) do { unsigned _sp = 0; while (cond) { __builtin_amdgcn_s_sleep(1); \
    if ((++_sp & 255u) == 0u) { if (xb_ld(&(bar)[XB_TMO])) break; if (_sp > XB_SPIN_CAP) { atomicAdd(&(bar)[XB_TMO], 1u); break; } } } } while (0)
struct XcdBarrier { unsigned* bar; unsigned x; volatile LAS unsigned* st; };
__device__ __forceinline__ XcdBarrier xcd_barrier_post(unsigned* bar, volatile LAS unsigned* st) {
    XcdBarrier b; b.bar = bar; b.x = xb_xcc_id(); b.st = st;
    if (threadIdx.x == 0) (void)xb_add(&bar[XB_XCNT(b.x)], 1u);
    return b;
}
__device__ __forceinline__ void xcd_barrier_complete(unsigned* bar, unsigned x, unsigned& nloc, unsigned& nx) {
    const unsigned G = gridDim.x * gridDim.y * gridDim.z;
    unsigned sum, cnt, mine, sp = 0u;
    for (;;) {
        sum = 0u; cnt = 0u; mine = 0u;
#pragma unroll
        for (unsigned j = 0; j < 16; ++j) { const unsigned c = xb_ld(&bar[XB_XCNT(j)]); sum += c; cnt += (c > 0u) ? 1u : 0u; mine = (j == x) ? c : mine; }
        if (sum == G) break;
        __builtin_amdgcn_s_sleep(1);
        if ((++sp & 255u) == 0u) { if (xb_ld(&bar[XB_TMO])) break; if (sp > XB_SPIN_CAP) { atomicAdd(&bar[XB_TMO], 1u); break; } }
    }
    nloc = mine > 0u ? mine : 1u; nx = cnt > 0u ? cnt : 1u;
}
__device__ __forceinline__ void xcd_barrier(const XcdBarrier& b) {
    asm volatile("s_waitcnt vmcnt(0)" ::: "memory");
    __syncthreads();
    if (threadIdx.x == 0) {
        unsigned* bar = b.bar;
        __builtin_amdgcn_s_waitcnt(0);
        unsigned nloc = b.st[0], nx = b.st[1];
        if (nloc == 0u) { xcd_barrier_complete(bar, b.x, nloc, nx); b.st[0] = nloc; b.st[1] = nx; }
        const unsigned old = xb_add(&bar[XB_XSUB(b.x)], 1u);
        const unsigned gen = old / nloc;
        if (old + 1u == (gen + 1u) * nloc) {
            __builtin_amdgcn_fence(__ATOMIC_RELEASE, "agent");
            asm volatile("s_waitcnt vmcnt(0)" ::: "memory");
            const unsigned og = xb_add(&bar[XB_TOP], 1u);
            const unsigned tg = og / nx;
            if (og + 1u == (tg + 1u) * nx) xb_add(&bar[XB_TOPGEN], 1u);
            else XB_SPIN(xb_ld(&bar[XB_TOPGEN]) == tg, bar);
            __builtin_amdgcn_fence(__ATOMIC_ACQUIRE, "agent");
            xb_add(&bar[XB_XGEN(b.x)], 1u);
            asm volatile("s_waitcnt vmcnt(0)" ::: "memory");
        } else {
            XB_SPIN(xb_ld(&bar[XB_XGEN(b.x)]) == gen, bar);
            __builtin_amdgcn_fence(__ATOMIC_ACQUIRE, "agent");
            asm volatile("s_waitcnt vmcnt(0)" ::: "memory");
        }
    }
    __syncthreads();
}

__global__ void __launch_bounds__(512, 2) mega_fwd(Params p) {
    extern __shared__ __attribute__((aligned(16))) unsigned char lds_raw[];
    LAS unsigned char* lds = (LAS unsigned char*)lds_raw;
    unsigned char* ws = p.ws;
    const int G = gridDim.x, c = blockIdx.x, lo = p.ph_lo, hi = p.ph_hi;
    const float* mod = (const float*)(ws + WS_MOD);
    const float* norm_g = p.in[8];
    bf16_t* H = (bf16_t*)(ws + WS_H); bf16_t* MPb = (bf16_t*)(ws + WS_MP); bf16_t* U = (bf16_t*)(ws + WS_U);
    float* X = p.out + OUT_X; bf16_t* XB = (bf16_t*)(ws + WS_XB);
    volatile LAS unsigned* MISC = (volatile LAS unsigned*)(lds + 131072 + 320);
    if (threadIdx.x < 32) MISC[threadIdx.x] = 0u;
    __syncthreads();
    XcdBarrier bar; bar.bar = (unsigned*)(ws + WS_CTL); bar.x = 0; bar.st = nullptr;
    if (hi - lo > 1) bar = xcd_barrier_post((unsigned*)(ws + WS_CTL), MISC + 8);
    if (hi > 1000) cg::this_grid().sync();
#ifndef PH_MASK
#define PH_MASK 0xffff
#endif
#define IN(k) (((PH_MASK >> (k)) & 1) && lo <= (k) && (k) < hi)
    const bool handoff = (G == 256) && (hi - lo > 1);
    unsigned* const cntb = (unsigned*)(ws + WS_CTL) + CW_CNT;
#ifndef PROBE_REP
#define PROBE_REP -1
#endif
#ifndef PROBE_SYNC2
#define PROBE_SYNC2 0
#endif
#define REPS(k) for (int rep_ = 0; rep_ < ((k) == PROBE_REP ? 2 : 1); ++rep_)
#ifndef PROBE_PHASE
#define PROBE_PHASE -1
#endif
    unsigned long long pt0 = 0, pt1 = 0;
    if (PROBE_PHASE == 0) pt0 = __builtin_amdgcn_s_memrealtime();
#define SEAM(k) SEAMX(k, false)
#define SEAMX(k, skip) do { if ((k) + 1 < hi && !(skip)) { xcd_barrier(bar); if (PROBE_SYNC2) xcd_barrier(bar); } \
        if ((k) == PROBE_PHASE) pt1 = __builtin_amdgcn_s_memrealtime(); if ((k) + 1 == PROBE_PHASE) pt0 = __builtin_amdgcn_s_memrealtime(); } while (0)

    unsigned* const gdone = cntb + 48;
    if (IN(0)) { phase_prologue(p, lds, handoff ? gdone : nullptr); SEAMX(0, handoff); }
    if (IN(1)) { {
        if (handoff) { if (threadIdx.x == 0) { unsigned sp = 0; while (__hip_atomic_load(gdone, __ATOMIC_RELAXED, __HIP_MEMORY_SCOPE_AGENT) < 96u) { __builtin_amdgcn_s_sleep(4); if (++sp > (1u << 22)) break; }
                __builtin_amdgcn_fence(__ATOMIC_ACQUIRE, "agent"); asm volatile("s_waitcnt vmcnt(0)" ::: "memory"); }
            __syncthreads(); }
        row_phase<false, true, true>(p.in[0], p.in[1], nullptr, nullptr, nullptr, H, nullptr, nullptr, norm_g, mod + 1 * D, mod + 0 * D);
        } SEAM(1);
    }
    if (IN(2)) {
        pg8::ChDftSched S{G, c, (const char*)(ws + WS_CSCH), (const char*)H, (bf16_t*)(ws + WS_YTP), (bf16_t*)(ws + WS_YTS)};
        pg8::gemm_phase<pg8::EpiStore, pg8::ChDftSched, true>(lds, 256, D, 256, S, pg8::EpiStore{});
        if (handoff) phase_side_jobs(p, lds, 8);
        SEAM(2);
    }
    if (IN(3)) {
        unsigned* const cf = cntb + 32;
        if (handoff) {
            int pm = -1, pn = 0;
            if (c < 64) { pm = 32 + 8 * (c >> 5) + ((c >> 2) & 7); pn = c & 3; } else if (c < 192) { pm = (c - 64) >> 2; pn = (c - 64) & 3; }
            { pg8::SeqSSched S{c, (const char*)(ws + WS_TS), (const char*)(ws + WS_YTS), (bf16_t*)(ws + WS_F)};
              pg8::gemm_phase<pg8::EpiStoreSig, pg8::SeqSSched, true>(lds, 4096, 4096, 4096, S, pg8::EpiStoreSig{cf}); }
            { pg8::SeqPSched S{G, c, (const char*)(ws + WS_TP), (const char*)(ws + WS_YTP), (bf16_t*)(ws + WS_F)};
              pg8::gemm_phase<pg8::EpiStoreSig, pg8::SeqPSched, true>(lds, 512, 512, 512, S, pg8::EpiStoreSig{cf}); }
            if (pm >= 0) {
                if (threadIdx.x == 0) { unsigned* w = cf + pm * 64; unsigned sp = 0;
                    while (__hip_atomic_load(w, __ATOMIC_RELAXED, __HIP_MEMORY_SCOPE_AGENT) < 32u) { __builtin_amdgcn_s_sleep(4); if (++sp > (1u << 22)) break; }
                    __builtin_amdgcn_fence(__ATOMIC_ACQUIRE, "agent"); asm volatile("s_waitcnt vmcnt(0)" ::: "memory"); }
                __syncthreads();
                pg8::OneSched S{pm, pn, (const char*)(ws + WS_F), (const char*)(ws + WS_WF), MPb};
                pg8::gemm_phase<pg8::EpiStoreSig, pg8::OneSched, true>(lds, D, D, D, S, pg8::EpiStoreSig{cntb + 0 * CNT_SEAM});
            }
            phase_side_jobs(p, lds, 9);
        } else {
            { pg8::SeqSSched S{c, (const char*)(ws + WS_TS), (const char*)(ws + WS_YTS), (bf16_t*)(ws + WS_F)};
              pg8::gemm_phase<pg8::EpiStoreSig, pg8::SeqSSched, true>(lds, 4096, 4096, 4096, S, pg8::EpiStoreSig{nullptr}); }
            { pg8::SeqPSched S{G, c, (const char*)(ws + WS_TP), (const char*)(ws + WS_YTP), (bf16_t*)(ws + WS_F)};
              pg8::gemm_phase<pg8::EpiStoreSig, pg8::SeqPSched, true>(lds, 512, 512, 512, S, pg8::EpiStoreSig{nullptr}); }
            phase_side_jobs(p, lds, 0);
        }
        SEAMX(3, handoff);
    }
    if (IN(4)) {
        if (!handoff) { pg8::GSched S{48, 4, G, c, (const char*)(ws + WS_F), (size_t)256 * D * 2, (const char*)(ws + WS_WF), (size_t)256 * D * 2, MPb, (size_t)256 * D, 256, D};
            pg8::gemm_phase<pg8::EpiStoreSig, pg8::GSched, true>(lds, D, D, D, S, pg8::EpiStoreSig{nullptr});
            phase_side_jobs(p, lds, 1); }
        SEAMX(4, handoff);
    }
    if (IN(5)) { REPS(5) {
        row_phase<true, true, true>(p.in[0], p.in[1], XB, MPb, nullptr, H, mod + 2 * D, norm_g + 1 * D, norm_g + 2 * D, mod + 4 * D, mod + 3 * D, handoff ? cntb + 0 * CNT_SEAM : nullptr);
        } SEAM(5);
    }
    if (IN(6)) {
        if (handoff) { pg8::GuSched S{G, c, (const char*)H, (const char*)(ws + WS_WGU), U};
            pg8::gemm_phase<pg8::EpiSwiGLU, pg8::GuSched, true>(lds, D, D, D, S, pg8::EpiSwiGLU{cntb + 4 * CNT_SEAM}); }
        else { pg8::GSched S{48, 22, G, c, (const char*)H, (size_t)256 * D * 2, (const char*)(ws + WS_WGU), (size_t)256 * D * 2, U, (size_t)256 * FF, 128, FF};
            pg8::gemm_phase<pg8::EpiSwiGLU, pg8::GSched, true>(lds, D, D, D, S, pg8::EpiSwiGLU{nullptr}); }
        SEAMX(6, handoff);
    }
    if (IN(7)) {
        if (handoff) {
            const int dd = c >= 248 ? 184 + (c - 248) : (c >= 64 ? c - 64 : (c >= 56 ? 192 + (c - 56) : -1));
            if (dd >= 0) { pg8::DownSched S{dd, (const char*)U, (const char*)(ws + WS_WD), MPb, (bf16_t*)(ws + WS_MP2)};
                if (threadIdx.x == 0) { int pm, pn, kh; S.unit(pm, pn, kh); unsigned* w = cntb + 4 * CNT_SEAM + pm * 64; unsigned sp = 0;
                    while (__hip_atomic_load(w, __ATOMIC_RELAXED, __HIP_MEMORY_SCOPE_AGENT) < 176u) { __builtin_amdgcn_s_sleep(4); if (++sp > (1u << 22)) break; }
                    __builtin_amdgcn_fence(__ATOMIC_ACQUIRE, "agent"); asm volatile("s_waitcnt vmcnt(0)" ::: "memory"); }
                __syncthreads();
                if (dd < 184) pg8::gemm_phase<pg8::EpiStoreSig, pg8::DownSched, true>(lds, FF, FF, FF, S, pg8::EpiStoreSig{cntb + 1 * CNT_SEAM});
                else pg8::gemm_phase<pg8::EpiStoreSig, pg8::DownSched, true>(lds, FF, FF, FF / 2, S, pg8::EpiStoreSig{cntb + 1 * CNT_SEAM}); }
            else { phase_side_jobs(p, lds, 5); }
        } else { pg8::GSched S{48, 4, G, c, (const char*)U, (size_t)256 * FF * 2, (const char*)(ws + WS_WD), (size_t)256 * FF * 2, MPb, (size_t)256 * D, 256, D};
            pg8::gemm_phase<pg8::EpiStoreSig, pg8::GSched, true>(lds, FF, FF, FF, S, pg8::EpiStoreSig{nullptr});
            phase_side_jobs(p, lds, 2); }
        SEAMX(7, handoff);
    }
    if (IN(8)) { REPS(8) {
        row_phase<true, true, false>(nullptr, nullptr, XB, MPb, nullptr, H, mod + 5 * D, norm_g + 3 * D, norm_g + 4 * D, mod + 3 * 6144 + 1 * D, mod + 3 * 6144 + 0 * D, handoff ? cntb + 1 * CNT_SEAM : nullptr, handoff ? (const bf16_t*)(ws + WS_MP2) : nullptr);
        } SEAM(8);
    }
    if (IN(9)) {
        unsigned* const cq = cntb + 16;
        pg8::EpiQKV E{(bf16_t*)(ws + WS_Q), (bf16_t*)(ws + WS_K), (bf16_t*)(ws + WS_VT), p.out + OUT_CK, p.out + OUT_CV, handoff ? cq : nullptr};
        if (handoff) {
            { pg8::QkvSched S{G, c, (const char*)H, (const char*)(ws + WS_WQKV)};
              pg8::gemm_phase<pg8::EpiQKV, pg8::QkvSched, true>(lds, D, D, D, S, E); }
            if (c >= 64) {
                if (threadIdx.x == 0) { for (int u = 256 + (c - 64); u < 768; u += 192) { unsigned* w = cq + ((u - 256) >> 4) * 64; unsigned sp = 0;
                        while (__hip_atomic_load(w, __ATOMIC_RELAXED, __HIP_MEMORY_SCOPE_AGENT) < 96u) { __builtin_amdgcn_s_sleep(4); if (++sp > (1u << 22)) break; } }
                    __builtin_amdgcn_fence(__ATOMIC_ACQUIRE, "agent"); asm volatile("s_waitcnt vmcnt(0)" ::: "memory"); }
                __syncthreads();
                attn_phase(p, lds, 256, 768, c - 64, 192);
            }
            if (threadIdx.x == 0) { for (int pp = 32 + 8 * (c >> 7); pp < 40 + 8 * (c >> 7); ++pp) { unsigned* w = cq + pp * 64; unsigned sp = 0;
                    while (__hip_atomic_load(w, __ATOMIC_RELAXED, __HIP_MEMORY_SCOPE_AGENT) < 96u) { __builtin_amdgcn_s_sleep(4); if (++sp > (1u << 22)) break; } }
                __builtin_amdgcn_fence(__ATOMIC_ACQUIRE, "agent"); asm volatile("s_waitcnt vmcnt(0)" ::: "memory"); }
            __syncthreads();
            attn_phase(p, lds, c, c + 1, 0, 1);
            if (c < 64) { const int gw = c * 8 + (threadIdx.x >> 6);
                transpose_jobs(p, lds, gw, 64 * 8, TI_L0 + 2 * 1408, TI_L0 + 3 * 1408); transpose_jobs(p, lds, gw, 64 * 8, TI_L0 + 3 * 1408 + 1536, TI_ALL); }
        } else {
            pg8::GSched S{48, 12, G, c, (const char*)H, (size_t)256 * D * 2, (const char*)(ws + WS_WQKV), (size_t)256 * D * 2, nullptr, 0, 0, D};
            pg8::gemm_phase<pg8::EpiQKV, pg8::GSched, true>(lds, D, D, D, S, E);
        }
        SEAMX(9, handoff);
    }
    if (IN(10)) { if (!handoff) attn_phase(p, lds, 0, 768, c, G); SEAM(10); }
    if (IN(11)) { REPS(11) {
        pg8::GSched S{48, 4, G, c, (const char*)H, (size_t)256 * D * 2, (const char*)(ws + WS_WO), (size_t)256 * D * 2, MPb, (size_t)256 * D, 256, D};
        pg8::gemm_phase<pg8::EpiStoreSig, pg8::GSched, true>(lds, D, D, D, S, pg8::EpiStoreSig{handoff ? cntb + 2 * CNT_SEAM : nullptr});
        if (handoff) phase_side_jobs(p, lds, 7);
        } SEAMX(11, handoff);
    }
    if (IN(12)) { REPS(12) {
        row_phase<true, true, false>(nullptr, nullptr, XB, MPb, nullptr, H, mod + 3 * 6144 + 2 * D, norm_g + 5 * D, norm_g + 6 * D, mod + 3 * 6144 + 4 * D, mod + 3 * 6144 + 3 * D, handoff ? cntb + 2 * CNT_SEAM : nullptr);
        } SEAM(12);
    }
    if (IN(13)) {
        if (handoff) { pg8::GuSched S{G, c, (const char*)H, (const char*)(ws + WS_WGU) + (size_t)2 * FF * D * 2, U};
            pg8::gemm_phase<pg8::EpiSwiGLU, pg8::GuSched, true>(lds, D, D, D, S, pg8::EpiSwiGLU{cntb + 5 * CNT_SEAM}); }
        else { pg8::GSched S{48, 22, G, c, (const char*)H, (size_t)256 * D * 2, (const char*)(ws + WS_WGU) + (size_t)2 * FF * D * 2, (size_t)256 * D * 2, U, (size_t)256 * FF, 128, FF};
            pg8::gemm_phase<pg8::EpiSwiGLU, pg8::GSched, true>(lds, D, D, D, S, pg8::EpiSwiGLU{nullptr}); }
        SEAMX(13, handoff);
    }
    if (IN(14)) {
        if (handoff) {
            const int dd = c >= 248 ? 184 + (c - 248) : (c >= 64 ? c - 64 : (c >= 56 ? 192 + (c - 56) : -1));
            if (dd >= 0) { pg8::DownSched S{dd, (const char*)U, (const char*)(ws + WS_WD) + (size_t)D * FF * 2, MPb, (bf16_t*)(ws + WS_MP2)};
                if (threadIdx.x == 0) { int pm, pn, kh; S.unit(pm, pn, kh); unsigned* w = cntb + 5 * CNT_SEAM + pm * 64; unsigned sp = 0;
                    while (__hip_atomic_load(w, __ATOMIC_RELAXED, __HIP_MEMORY_SCOPE_AGENT) < 176u) { __builtin_amdgcn_s_sleep(4); if (++sp > (1u << 22)) break; }
                    __builtin_amdgcn_fence(__ATOMIC_ACQUIRE, "agent"); asm volatile("s_waitcnt vmcnt(0)" ::: "memory"); }
                __syncthreads();
                if (dd < 184) pg8::gemm_phase<pg8::EpiStoreSig, pg8::DownSched, true>(lds, FF, FF, FF, S, pg8::EpiStoreSig{cntb + 3 * CNT_SEAM});
                else pg8::gemm_phase<pg8::EpiStoreSig, pg8::DownSched, true>(lds, FF, FF, FF / 2, S, pg8::EpiStoreSig{cntb + 3 * CNT_SEAM}); }
            else {  }
        } else { pg8::GSched S{48, 4, G, c, (const char*)U, (size_t)256 * FF * 2, (const char*)(ws + WS_WD) + (size_t)D * FF * 2, (size_t)256 * FF * 2, MPb, (size_t)256 * D, 256, D};
            pg8::gemm_phase<pg8::EpiStoreSig, pg8::GSched, true>(lds, FF, FF, FF, S, pg8::EpiStoreSig{nullptr});
             }
        SEAMX(14, handoff);
    }
    if (IN(15)) { REPS(15) {
        row_phase<true, false, false>(nullptr, nullptr, XB, MPb, X, nullptr, mod + 3 * 6144 + 5 * D, norm_g + 7 * D, nullptr, nullptr, nullptr, handoff ? cntb + 3 * CNT_SEAM : nullptr, handoff ? (const bf16_t*)(ws + WS_MP2) : nullptr); }
    }
    if (PROBE_PHASE >= 0 && blockIdx.x == 0) { if (PROBE_PHASE == 15) pt1 = __builtin_amdgcn_s_memrealtime();
        const unsigned long long tend = __builtin_amdgcn_s_memrealtime(), wait = 9ull * (pt1 - pt0);
        while (__builtin_amdgcn_s_memrealtime() - tend < wait) __builtin_amdgcn_s_sleep(8); }
#undef IN
#undef SEAM
}

constexpr int LDS_BYTES = 147456;
extern "C" void kernel_launch(void* const* d_in, const int* in_sizes, int n_in, void* d_out, int out_size, void* d_ws, size_t ws_size, hipStream_t stream) {
    static int grid = 0;
    if (grid == 0) {
        int dev = 0, cus = 0, per_cu = 0;
        hipGetDevice(&dev);
        hipDeviceGetAttribute(&cus, hipDeviceAttributeMultiprocessorCount, dev);
        if (hipFuncSetAttribute((const void*)mega_fwd, hipFuncAttributeMaxDynamicSharedMemorySize, LDS_BYTES) != hipSuccess) fprintf(stderr, "kernel_launch: hipFuncSetAttribute failed\n");
        if (hipOccupancyMaxActiveBlocksPerMultiprocessor(&per_cu, (const void*)mega_fwd, 512, LDS_BYTES) != hipSuccess || per_cu < 1) { fprintf(stderr, "kernel_launch: occupancy query says %d\n", per_cu); per_cu = 1; }
        (void)hipGetLastError();
        grid = cus * 1;
        if (n_in != 16 || ws_size < WS_END) { fprintf(stderr, "kernel_launch: unexpected n_in %d / ws %zu\n", n_in, ws_size); }
    }
    Params p{};
    (void)hipMemsetAsync((unsigned char*)d_ws, 0, WS_CTL + CTL_BYTES, stream);
    for (int i = 0; i < 16; ++i) p.in[i] = (const float*)d_in[i];
    p.out = (float*)d_out; p.ws = (unsigned char*)d_ws;
    if (MK_N_LAUNCHES == 1) {
        p.ph_lo = 0; p.ph_hi = NPHASE;
        void* args[] = {&p};
        hipError_t e = hipLaunchCooperativeKernel((const void*)mega_fwd, dim3(grid), dim3(512), args, LDS_BYTES, stream);
        if (e != hipSuccess) fprintf(stderr, "cooperative launch failed: %s (grid %d)\n", hipGetErrorString(e), grid);
    } else {
        for (int k = 0; k < NPHASE; ++k) { p.ph_lo = k; p.ph_hi = k + 1; hipLaunchKernelGGL(mega_fwd, dim3(grid), dim3(512), LDS_BYTES, stream, p); }
    }
}
```

```cpp
#include <hip/hip_runtime.h>
#include <hip/hip_cooperative_groups.h>
#include <cstdio>
#include <cstdint>
namespace cg = cooperative_groups;

#ifndef MK_N_LAUNCHES
#define MK_N_LAUNCHES 1
#endif

#define LAS __attribute__((address_space(3)))
typedef unsigned short bf16_t;
typedef short bf16x8 __attribute__((ext_vector_type(8)));
typedef float f32x2 __attribute__((ext_vector_type(2)));
typedef float f32x4 __attribute__((ext_vector_type(4)));
typedef float f32x16 __attribute__((ext_vector_type(16)));
typedef unsigned u32x2 __attribute__((ext_vector_type(2)));
typedef unsigned u32x4 __attribute__((ext_vector_type(4)));
typedef __bf16 bf16x2_t __attribute__((ext_vector_type(2)));

constexpr int D = 1024, NP = 8192, NS = 4096, M = NP + NS, SP = 256, SS = 2048, FF = 2816, NH = 16, HD = 64;
constexpr int NPHASE = 16;
constexpr size_t MiB = 1u << 20;
constexpr size_t WS_CTL = 160 * 1024, CTL_BYTES = 96 * 1024;
constexpr int CW_CNT = 4096, CNT_SEAM = 48 * 64;
constexpr size_t WS_MOD = 0, WS_CSCH = 256 * 1024, WS_TP = 512 * 1024, WS_WF = 1 * MiB, WS_WQKV = 3 * MiB,
                 WS_WO = 9 * MiB, WS_WGU = 11 * MiB, WS_WD = 33 * MiB, WS_H = 44 * MiB, WS_MP = 68 * MiB, WS_U = 92 * MiB, WS_R = 158 * MiB;
constexpr size_t WS_YTP = WS_U, WS_YTS = WS_U + 32 * MiB;
constexpr size_t WS_TS = WS_R, WS_F = WS_R + 16 * MiB;
constexpr size_t WS_Q = WS_R, WS_K = WS_R + 24 * MiB, WS_VT = WS_R + 48 * MiB;
constexpr size_t WS_XB = WS_R + 72 * MiB, WS_MP2 = WS_XB + 24 * MiB, WS_END = WS_MP2 + 1 * MiB;
constexpr size_t OUTB_KC = 0, OUTB_VC = 2 * MiB;
constexpr size_t OUT_X = 0, OUT_CK = (size_t)M * D, OUT_CV = OUT_CK + (size_t)NP * D;

struct Params {
    const float* in[16];
    float* out; unsigned char* ws;
    int ph_lo, ph_hi;
};

__device__ __forceinline__ unsigned pk2(float lo, float hi) { f32x2 v = {lo, hi}; bf16x2_t b = __builtin_convertvector(v, bf16x2_t); return __builtin_bit_cast(unsigned, b); }
__device__ __forceinline__ float bf_lo(unsigned w) { return __uint_as_float(w << 16); }
__device__ __forceinline__ float bf_hi(unsigned w) { return __uint_as_float(w & 0xffff0000u); }
template <int CTRL> __device__ __forceinline__ float dpp_mov(float v) { return __builtin_bit_cast(float, __builtin_amdgcn_mov_dpp(__builtin_bit_cast(int, v), CTRL, 0xf, 0xf, true)); }
__device__ __forceinline__ float wave_sum(float v) {
    v += dpp_mov<0xB1>(v); v += dpp_mov<0x4E>(v); v += dpp_mov<0x141>(v); v += dpp_mov<0x140>(v);
    { auto rr = __builtin_amdgcn_permlane16_swap(__float_as_uint(v), __float_as_uint(v), false, false); v = __uint_as_float(rr[0]) + __uint_as_float(rr[1]); }
    { auto rr = __builtin_amdgcn_permlane32_swap(__float_as_uint(v), __float_as_uint(v), false, false); v = __uint_as_float(rr[0]) + __uint_as_float(rr[1]); }
    return v;
}

namespace pg8 {
constexpr int BM = 256, BK = 64, HALF = 128, HTB = HALF * BK * 2, STAGE_BYTES = 8 * HTB;
__device__ __forceinline__ int lds_byte(int r, int c) { const int st = (r >> 4) * 2 + (c >> 5), rr = r & 15, cc = c & 31, ob = rr * 64 + cc * 2; return st * 1024 + (ob ^ (((ob >> 9) & 1) << 5)); }
__device__ __forceinline__ void stage_rc(int b, int& R, int& C) { const int st = b / 1024, sb = b % 1024, swz = sb ^ (((sb >> 9) & 1) << 5); R = (st >> 1) * 16 + swz / 64; C = (st & 1) * 32 + (swz % 64) / 2; }
__device__ __forceinline__ int perm32(int rho) { const int n = rho >> 4, i = rho & 15; return 8 * (i >> 2) + 4 * n + (i & 3); }

struct UnitDesc { const char* A; const char* B; bf16_t* out; int ldc; int aux; };

__device__ __forceinline__ void tile_order(int L, int nM, int nN, int& pm, int& pn) {
    const int nwg = nM * nN; int wgid = L;
    { const int q = nwg / 8, r = nwg % 8, xcd = wgid % 8, off = wgid / 8; wgid = (xcd < r ? xcd * (q + 1) : r * (q + 1) + (xcd - r) * q) + off; }
    const int nig = 8 * nN, gid = wgid / nig, fm = gid * 8, gsz = (nM - fm) < 8 ? (nM - fm) : 8;
    pm = fm + ((wgid % nig) % gsz); pn = (wgid % nig) / gsz;
}

template <class Epi, class Sched, bool ALIGN_EPI>
__device__ __forceinline__ void gemm_phase(LAS unsigned char* lds, const int lda, const int ldb, const int K, const Sched& S, const Epi& E) {
    const int tid = threadIdx.x, wid = __builtin_amdgcn_readfirstlane(tid >> 6), lane = tid & 63, wr = wid >> 2, wc = wid & 3, fr = lane & 15, fq = lane >> 4;
    const int nt = K / BK;
    unsigned voffA[2], voffB[2];
#pragma unroll
    for (int i = 0; i < 2; ++i) { int R, C; stage_rc(tid * 16 + i * 8192, R, C); const int Rb = (R & ~31) + perm32(R & 31);
        voffA[i] = (unsigned)(R * lda + C) * 2u; voffB[i] = (unsigned)(Rb * ldb + C) * 2u; }
    const size_t kstep = (size_t)(BK * 2);
    const size_t hstepA = (size_t)HALF * lda * 2, hstepB = (size_t)HALF * ldb * 2;
    const unsigned ldsw = (unsigned)wid * 1024u;
    const int aoff = lds_byte(wr * 64 + fr, fq * 8), boff = lds_byte(wc * 32 + fr, fq * 8);
#define PG8_SA(b, h) (((b) * 2 + (h)) * HTB)
#define PG8_SB(b, h) ((4 + (b) * 2 + (h)) * HTB)
#define PG8_STAGE(bufoff, gbase, voff) do { _Pragma("unroll") for (int _i = 0; _i < 2; ++_i) \
        __builtin_amdgcn_global_load_lds((const unsigned*)((const char*)(gbase) + (voff)[_i]), (LAS unsigned*)(lds + (bufoff) + ldsw + _i * 8192), 16, 0, 0); } while (0)
#define PG8_LDA(dst, b, h) do { _Pragma("unroll") for (int m = 0; m < 4; ++m) _Pragma("unroll") for (int k = 0; k < 2; ++k) dst[m][k] = *(const LAS bf16x8*)(lds + PG8_SA(b, h) + aoff + m * 2048 + k * 1024); } while (0)
#define PG8_LDB(dst, b, h) do { _Pragma("unroll") for (int n = 0; n < 2; ++n) _Pragma("unroll") for (int k = 0; k < 2; ++k) dst[n][k] = *(const LAS bf16x8*)(lds + PG8_SB(b, h) + boff + n * 2048 + k * 1024); } while (0)
#define PG8_MMA(ai, bj, At, Bt) do { __builtin_amdgcn_s_setprio(1); _Pragma("unroll") for (int m = 0; m < 4; ++m) _Pragma("unroll") for (int n = 0; n < 2; ++n) _Pragma("unroll") for (int k = 0; k < 2; ++k) \
        acc[ai][bj][m][n] = __builtin_amdgcn_mfma_f32_16x16x32_bf16(Bt[n][k], At[m][k], acc[ai][bj][m][n], 0, 0, 0); __builtin_amdgcn_s_setprio(0); } while (0)
#define PG8_WAIT_V(n) asm volatile("s_waitcnt vmcnt(" #n ")" ::: "memory")
#define PG8_WAIT_L(n) asm volatile("s_waitcnt lgkmcnt(" #n ")" ::: "memory")
#define PG8_BAR __builtin_amdgcn_s_barrier()
#define PG8_SCHED __builtin_amdgcn_sched_barrier(0)
    UnitDesc cur, nxt; int ui = 0;
    if (!S.next(0, cur)) return;
    f32x4 acc[2][2][4][2];
#pragma unroll
    for (int a = 0; a < 2; ++a)
#pragma unroll
        for (int b = 0; b < 2; ++b)
#pragma unroll
            for (int m = 0; m < 4; ++m)
#pragma unroll
                for (int n = 0; n < 2; ++n) acc[a][b][m][n] = (f32x4){0.f, 0.f, 0.f, 0.f};
    bf16x8 At[4][2], B0[2][2], B1[2][2];
    const char* cA = cur.A; const char* cB = cur.B;
    PG8_STAGE(PG8_SB(0, 0), cB, voffB); PG8_STAGE(PG8_SB(0, 1), cB + hstepB, voffB); PG8_STAGE(PG8_SA(0, 0), cA, voffA); PG8_STAGE(PG8_SA(0, 1), cA + hstepA, voffA);
    if (wr == 1) PG8_BAR;
    PG8_WAIT_V(2); PG8_BAR;
    PG8_STAGE(PG8_SB(1, 0), cB + kstep, voffB); PG8_STAGE(PG8_SA(1, 0), cA + kstep, voffA); PG8_STAGE(PG8_SB(1, 1), cB + hstepB + kstep, voffB);
    PG8_WAIT_V(6); PG8_BAR;
    for (;;) {
        const bool has_next = S.next(ui + 1, nxt);
        const char* nA = has_next ? nxt.A : cA; const char* nB = has_next ? nxt.B : cB;
#pragma unroll 1
        for (int t = 0; t < nt; t += 2) {
            const bool last = (t == nt - 2);
            const char* a1 = cA + (size_t)(t + 1) * kstep;
            const char* a2 = last ? nA : cA + (size_t)(t + 2) * kstep; const char* b2 = last ? nB : cB + (size_t)(t + 2) * kstep;
            const char* a3 = a2 + kstep; const char* b3 = b2 + kstep;
            PG8_LDB(B0, 0, 0); PG8_LDB(B1, 0, 1); PG8_SCHED; PG8_LDA(At, 0, 0); PG8_STAGE(PG8_SA(1, 1), a1 + hstepA, voffA);
            PG8_WAIT_V(8); PG8_WAIT_L(0); PG8_BAR; PG8_MMA(0, 0, At, B0); PG8_MMA(0, 1, At, B1); PG8_BAR; PG8_SCHED;
            PG8_LDA(At, 0, 1); PG8_STAGE(PG8_SB(0, 0), b2, voffB); PG8_STAGE(PG8_SB(0, 1), b2 + hstepB, voffB); PG8_STAGE(PG8_SA(0, 0), a2, voffA);
            PG8_WAIT_V(8); PG8_WAIT_L(0); PG8_BAR; PG8_MMA(1, 0, At, B0); PG8_MMA(1, 1, At, B1); PG8_BAR; PG8_SCHED;
            PG8_LDB(B0, 1, 0); PG8_LDB(B1, 1, 1); PG8_SCHED; PG8_LDA(At, 1, 0); PG8_STAGE(PG8_SA(0, 1), a2 + hstepA, voffA);
            PG8_WAIT_V(8); PG8_WAIT_L(0); PG8_BAR; PG8_MMA(0, 0, At, B0); PG8_MMA(0, 1, At, B1); PG8_BAR; PG8_SCHED;
            PG8_LDA(At, 1, 1); PG8_STAGE(PG8_SB(1, 0), b3, voffB); PG8_STAGE(PG8_SB(1, 1), b3 + hstepB, voffB); PG8_STAGE(PG8_SA(1, 0), a3, voffA);
            PG8_WAIT_V(8); PG8_WAIT_L(0); PG8_BAR; PG8_MMA(1, 0, At, B0); PG8_MMA(1, 1, At, B1); PG8_BAR; PG8_SCHED;
        }
        if constexpr (ALIGN_EPI) { if (wr == 0) PG8_BAR; }
        E(acc, cur, wr, wc, fr, fq);
        if (!has_next) break;
#pragma unroll
        for (int a = 0; a < 2; ++a)
#pragma unroll
            for (int b = 0; b < 2; ++b)
#pragma unroll
                for (int m = 0; m < 4; ++m)
#pragma unroll
                    for (int n = 0; n < 2; ++n) acc[a][b][m][n] = (f32x4){0.f, 0.f, 0.f, 0.f};
        cur = nxt; cA = nA; cB = nB; ++ui;
        if constexpr (ALIGN_EPI) { if (wr == 1) PG8_BAR; }
    }
    PG8_WAIT_V(0);
    if constexpr (!ALIGN_EPI) { if (wr == 0) PG8_BAR; }
    PG8_BAR;
#undef PG8_SA
#undef PG8_SB
#undef PG8_STAGE
#undef PG8_LDA
#undef PG8_LDB
#undef PG8_MMA
#undef PG8_WAIT_V
#undef PG8_WAIT_L
#undef PG8_BAR
#undef PG8_SCHED
}

struct EpiStore {
    __device__ __forceinline__ void operator()(const f32x4 (&acc)[2][2][4][2], const UnitDesc& u, int wr, int wc, int fr, int fq) const {
#pragma unroll
        for (int ai = 0; ai < 2; ++ai)
#pragma unroll
            for (int m = 0; m < 4; ++m) { bf16_t* rowp = u.out + (size_t)(ai * HALF + wr * 64 + m * 16 + fr) * u.ldc + wc * 32 + 8 * fq;
#pragma unroll
                for (int bj = 0; bj < 2; ++bj) { const f32x4 v0 = acc[ai][bj][m][0], v1 = acc[ai][bj][m][1];
                    u32x4 w; w.x = pk2(v0[0], v0[1]); w.y = pk2(v0[2], v0[3]); w.z = pk2(v1[0], v1[1]); w.w = pk2(v1[2], v1[3]);
                    *(u32x4*)(rowp + bj * HALF) = w; } }
    }
};
__device__ __forceinline__ void store16_sc1(void* ptr, u32x4 v) { asm volatile("global_store_dwordx4 %0, %1, off sc0 sc1\n\ts_nop 3" :: "v"(ptr), "v"(v) : "memory"); }
struct EpiStoreSig {
    unsigned* cnt;
    __device__ __forceinline__ void operator()(const f32x4 (&acc)[2][2][4][2], const UnitDesc& u, int wr, int wc, int fr, int fq) const {
#pragma unroll
        for (int ai = 0; ai < 2; ++ai)
#pragma unroll
            for (int m = 0; m < 4; ++m) { bf16_t* rowp = u.out + (size_t)(ai * HALF + wr * 64 + m * 16 + fr) * u.ldc + wc * 32 + 8 * fq;
#pragma unroll
                for (int bj = 0; bj < 2; ++bj) { const f32x4 v0 = acc[ai][bj][m][0], v1 = acc[ai][bj][m][1];
                    u32x4 w; w.x = pk2(v0[0], v0[1]); w.y = pk2(v0[2], v0[3]); w.z = pk2(v1[0], v1[1]); w.w = pk2(v1[2], v1[3]);
                    if (cnt) store16_sc1(rowp + bj * HALF, w); else *(u32x4*)(rowp + bj * HALF) = w; } }
        if (cnt) { asm volatile("s_waitcnt vmcnt(0)" ::: "memory");
            if ((threadIdx.x & 63) == 0) __hip_atomic_fetch_add(cnt + (u.aux & 0xffff) * 64, 1u, __ATOMIC_RELAXED, __HIP_MEMORY_SCOPE_AGENT); }
    }
};
__device__ __forceinline__ float swiglu1(float g, float u) { return g * u * __builtin_amdgcn_rcpf(1.0f + __builtin_amdgcn_exp2f(-1.4426950408889634f * g)); }
struct EpiSwiGLU {
    unsigned* cnt;
    __device__ __forceinline__ void operator()(const f32x4 (&acc)[2][2][4][2], const UnitDesc& u, int wr, int wc, int fr, int fq) const {
#pragma unroll
        for (int ai = 0; ai < 2; ++ai)
#pragma unroll
            for (int m = 0; m < 4; ++m) { bf16_t* rowp = u.out + (size_t)(ai * HALF + wr * 64 + m * 16 + fr) * u.ldc + wc * 32 + 8 * fq;
                const f32x4 g0 = acc[ai][0][m][0], g1 = acc[ai][0][m][1], u0 = acc[ai][1][m][0], u1 = acc[ai][1][m][1];
                u32x4 w; w.x = pk2(swiglu1(g0[0], u0[0]), swiglu1(g0[1], u0[1])); w.y = pk2(swiglu1(g0[2], u0[2]), swiglu1(g0[3], u0[3]));
                w.z = pk2(swiglu1(g1[0], u1[0]), swiglu1(g1[1], u1[1])); w.w = pk2(swiglu1(g1[2], u1[2]), swiglu1(g1[3], u1[3]));
                if (cnt) store16_sc1(rowp, w); else *(u32x4*)rowp = w; }
        if (cnt) { asm volatile("s_waitcnt vmcnt(0)" ::: "memory");
            if ((threadIdx.x & 63) == 0) __hip_atomic_fetch_add(cnt + (u.aux & 0xffff) * 64, 1u, __ATOMIC_RELAXED, __HIP_MEMORY_SCOPE_AGENT); }
    }
};
struct EpiQKV {
    bf16_t* Q; bf16_t* Kb; bf16_t* Vb; float* ck; float* cv; unsigned* cnt;
    __device__ __forceinline__ void operator()(const f32x4 (&acc)[2][2][4][2], const UnitDesc& u, int wr, int wc, int fr, int fq) const {
        const int pm = u.aux & 0xffff, pn = u.aux >> 16, sel = pn >> 2, ct = (pn & 3) * BM;
        const int row0 = pm * BM + wr * 64 + fr, col0 = ct + wc * 32 + 8 * fq;
        bf16_t* base = Q + (size_t)sel * (size_t)(12 * 1024 * 1024); float* cb = ck + (size_t)(sel >= 1 ? sel - 1 : 0) * (size_t)NP * D;
        const bool wc32 = sel >= 1 && pm < NP / BM;
#pragma unroll
        for (int ai = 0; ai < 2; ++ai)
#pragma unroll
            for (int m = 0; m < 4; ++m) { const size_t off = (size_t)(row0 + ai * HALF + m * 16) * D + col0;
#pragma unroll
                for (int bj = 0; bj < 2; ++bj) { const f32x4 v0 = acc[ai][bj][m][0], v1 = acc[ai][bj][m][1];
                    u32x4 w; w.x = pk2(v0[0], v0[1]); w.y = pk2(v0[2], v0[3]); w.z = pk2(v1[0], v1[1]); w.w = pk2(v1[2], v1[3]);
                    if (cnt) store16_sc1(base + off + bj * HALF, w); else *(u32x4*)(base + off + bj * HALF) = w;
                    if (wc32) { *(f32x4*)(cb + off + bj * HALF) = v0; *(f32x4*)(cb + off + bj * HALF + 4) = v1; } } }
        if (cnt) { asm volatile("s_waitcnt vmcnt(0)" ::: "memory");
            if ((threadIdx.x & 63) == 0) __hip_atomic_fetch_add(cnt + pm * 64, 1u, __ATOMIC_RELAXED, __HIP_MEMORY_SCOPE_AGENT); }
    }
};

struct GSched {
    int nM, nN, G, c; const char* A; size_t a_tile; const char* B; size_t b_tile; bf16_t* out; size_t o_pm, o_pn; int ldc;
    __device__ __forceinline__ bool next(int i, UnitDesc& u) const {
        const long L = (long)i * G + c; if (L >= (long)nM * nN) return false;
        int pm, pn; tile_order((int)L, nM, nN, pm, pn);
        u.A = A + (size_t)pm * a_tile; u.B = B + (size_t)pn * b_tile; u.out = out + (size_t)pm * o_pm + (size_t)pn * o_pn; u.ldc = ldc; u.aux = pm | (pn << 16); return true;
    }
};
struct ChDftSched {
    int G, c; const char* cs_tab; const char* H; bf16_t* ytp; bf16_t* yts;
    __device__ __forceinline__ bool next(int i, UnitDesc& u) const {
        const long L = (long)i * G + c; if (L >= 48 * 8) return false;
        int tok, gc; tile_order((int)L, 48, 8, tok, gc); const int g = gc >> 1, cs = gc & 1;
        u.A = cs_tab + (size_t)cs * 256 * 256 * 2; u.B = H + ((size_t)tok * 256 * D + g * 256) * 2;
        if (tok < 32) { u.out = ytp + ((size_t)(tok * D + g * 256) * 512 + cs * 256); u.ldc = 512; }
        else { const int idx = tok - 32, b = idx >> 3, s0 = (idx & 7) * 256; u.out = yts + ((size_t)(b * D + g * 256) * 4096 + cs * 2048 + s0); u.ldc = 4096; }
        u.aux = 0; return true;
    }
};
struct SeqSSched {
    int c; const char* ts; const char* yts; bf16_t* F;
    __device__ __forceinline__ bool next(int i, UnitDesc& u) const {
        if (i > 0 || c >= 64) return false;
        const int b = c >> 5, pm = (c >> 2) & 7, pn = c & 3;
        u.A = ts + (size_t)pm * 256 * 4096 * 2; u.B = yts + (size_t)(b * D + pn * 256) * 4096 * 2;
        u.out = F + ((size_t)(NP + b * SS + pm * 256) * D + pn * 256); u.ldc = D; u.aux = 32 + 8 * b + pm; return true;
    }
};
struct SeqPSched {
    int G, c; const char* tp; const char* ytp; bf16_t* F;
    __device__ __forceinline__ bool next(int i, UnitDesc& u) const {
        const int G2 = G - 64; if (c < 64 || G2 <= 0) return false;
        const long L = (long)i * G2 + (c - 64); if (L >= 128) return false;
        const int b = (int)L >> 2, pn = (int)L & 3;
        u.A = tp; u.B = ytp + (size_t)(b * D + pn * 256) * 512 * 2;
        u.out = F + ((size_t)(b * 256) * D + pn * 256); u.ldc = D; u.aux = b; return true;
    }
};
struct GuSched {
    int G, c; const char* A; const char* B; bf16_t* out;
    __device__ __forceinline__ bool next(int i, UnitDesc& u) const {
        const long L = (long)i * G + c; if (L >= 1056) return false;
        int pm, pn; if (L < 1012) tile_order((int)L, 46, 22, pm, pn); else { const int j = (int)L - 1012; pm = 46 + j / 22; pn = j % 22; }
        u.A = A + (size_t)pm * 256 * D * 2; u.B = B + (size_t)pn * 256 * D * 2; u.out = out + (size_t)pm * 256 * FF + (size_t)pn * 128; u.ldc = FF; u.aux = pm | (pn << 16); return true;
    }
};
struct DownSched {
    int d; const char* A; const char* B; bf16_t* out; bf16_t* out2;
    __device__ __forceinline__ void unit(int& pm, int& pn, int& kh) const { kh = 0; if (d < 184) tile_order(d, 46, 4, pm, pn); else { const int j = d - 184, un = j >> 1; kh = j & 1; pm = 46 + un / 4; pn = un % 4; } }
    __device__ __forceinline__ bool next(int i, UnitDesc& u) const {
        if (i > 0 || d < 0 || d >= 200) return false;
        int pm, pn, kh; unit(pm, pn, kh);
        u.A = A + (size_t)pm * 256 * FF * 2 + (size_t)kh * (FF / 2) * 2; u.B = B + (size_t)pn * 256 * FF * 2 + (size_t)kh * (FF / 2) * 2;
        u.out = kh ? out2 + (size_t)(pm - 46) * 256 * D + (size_t)pn * 256 : out + (size_t)pm * 256 * D + (size_t)pn * 256; u.ldc = D; u.aux = pm | (pn << 16); return true;
    }
};
struct QkvSched {
    int G, c; const char* A; const char* B;
    __device__ __forceinline__ bool next(int i, UnitDesc& u) const {
        const long L = (long)i * G + c; if (L >= 576) return false;
        int pm, pn; if (L < 384) tile_order((int)L, 32, 12, pm, pn); else { tile_order((int)L - 384, 16, 12, pm, pn); pm += 32; }
        u.A = A + (size_t)pm * 256 * D * 2; u.B = B + (size_t)pn * 256 * D * 2; u.out = nullptr; u.ldc = D; u.aux = pm | (pn << 16); return true;
    }
};
struct OneSched {
    int pm, pn; const char* A; const char* B; bf16_t* out;
    __device__ __forceinline__ bool next(int i, UnitDesc& u) const {
        if (i > 0 || pm < 0) return false;
        u.A = A + (size_t)pm * 256 * D * 2; u.B = B + (size_t)pn * 256 * D * 2; u.out = out + (size_t)pm * 256 * D + (size_t)pn * 256; u.ldc = D; u.aux = pm | (pn << 16); return true;
    }
};
}

constexpr int TI_L0 = 16 * 32 + 2 * 16 * 88 + 44 * 32, TI_ALL = 16 * 32 + 16 * 96 + 16 * 32 + 4 * 16 * 88 + 2 * 44 * 32;
struct TItem { const float* W; bf16_t* WT; int N, ldt, dst, k0, n0; };
__device__ __forceinline__ bool titem_decode(const Params& p, int it, TItem& t) {
    constexpr int I_F = 16 * 32, I_QKV = 16 * 96, I_O = 16 * 32, I_G = 16 * 88, I_D = 44 * 32;
    constexpr int NITEMS = I_F + I_QKV + I_O + 4 * I_G + 2 * I_D;
    if (it >= NITEMS) return false;
    unsigned char* ws = p.ws; int r = it; int mode = 0;
    if (r < I_F) { t.W = p.in[9]; t.N = D; t.ldt = D; t.WT = (bf16_t*)(ws + WS_WF); }
    else { r -= I_F; int l = 0; if (r >= 2 * I_G + I_D) { r -= 2 * I_G + I_D; l = 1; }
        if (r < I_G) { t.W = p.in[13] + (size_t)l * D * FF; t.N = FF; t.ldt = D; t.WT = (bf16_t*)(ws + WS_WGU) + (size_t)l * 2 * FF * D; mode = 1; }
        else if ((r -= I_G) < I_G) { t.W = p.in[14] + (size_t)l * D * FF; t.N = FF; t.ldt = D; t.WT = (bf16_t*)(ws + WS_WGU) + (size_t)l * 2 * FF * D; mode = 2; }
        else if ((r -= I_G) < I_D) { t.W = p.in[15] + (size_t)l * FF * D; t.N = D; t.ldt = FF; t.WT = (bf16_t*)(ws + WS_WD) + (size_t)l * D * FF; }
        else if ((r -= I_D) < I_QKV) { t.W = p.in[10]; t.N = 3 * D; t.ldt = D; t.WT = (bf16_t*)(ws + WS_WQKV); }
        else { r -= I_QKV; t.W = p.in[12]; t.N = D; t.ldt = D; t.WT = (bf16_t*)(ws + WS_WO); } }
    const int nblk = t.N / 32, kb = r / nblk, nb = r % nblk; t.n0 = nb * 32; t.k0 = kb * 64;
    t.dst = t.n0; if (mode) t.dst = (t.n0 >> 7) * 256 + (t.n0 & 127) + (mode == 2 ? 128 : 0);
    return true;
}
__device__ __forceinline__ void titem_load(const TItem& t, f32x4 (&wv)[8], int lane) {
#pragma unroll
    for (int i = 0; i < 8; ++i) wv[i] = __builtin_nontemporal_load((const f32x4*)(t.W + (size_t)(t.k0 + 8 * i + (lane >> 3)) * t.N + t.n0 + 4 * (lane & 7)));
}
__device__ __forceinline__ void titem_finish(const TItem& t, const f32x4 (&wv)[8], LAS float* scr, int lane) {
#pragma unroll
    for (int i = 0; i < 8; ++i) { LAS float* d = scr + (8 * i + (lane >> 3)) * 33 + 4 * (lane & 7); d[0] = wv[i][0]; d[1] = wv[i][1]; d[2] = wv[i][2]; d[3] = wv[i][3]; }
    asm volatile("s_waitcnt lgkmcnt(0)" ::: "memory");
    const int c = lane & 7;
#pragma unroll
    for (int j = 0; j < 4; ++j) { const int n = (lane >> 3) + 8 * j; const LAS float* s = scr + (8 * c) * 33 + n;
        u32x4 o; o.x = pk2(s[0 * 33], s[1 * 33]); o.y = pk2(s[2 * 33], s[3 * 33]); o.z = pk2(s[4 * 33], s[5 * 33]); o.w = pk2(s[6 * 33], s[7 * 33]);
        *(u32x4*)(t.WT + (size_t)(t.dst + n) * t.ldt + t.k0 + 8 * c) = o; }
    asm volatile("s_waitcnt lgkmcnt(0)" ::: "memory");
}

__device__ __forceinline__ void gemv_layer(const Params& p, LAS unsigned char* lds, const int l, const int rb, const int nb, unsigned* done = nullptr) {
    const int tid = threadIdx.x;
    LAS float* sl = (LAS float*)lds;
    LAS f32x4* red = (LAS f32x4*)(lds + 12288);
    for (int i = tid; i < 3072; i += 512) { const int cond = i >> 10, k = i & 1023; const float v = cond == 0 ? p.in[5][k] : p.in[2][(cond - 1) * D + k]; sl[i] = v / (1.0f + __expf(-v)); }
    __syncthreads();
    float* mod = (float*)(p.ws + WS_MOD);
    for (int item = rb; item < 96; item += nb) {
        const int rem = item, cc = rem >> 4, kc = rem & 15, rpar = tid >> 8, col = cc * 1024 + 4 * (tid & 255);
        const float* W = p.in[6] + ((size_t)l * D + kc * 64 + rpar) * 6144 + col;
        f32x4 a0 = {0.f, 0.f, 0.f, 0.f}, a1 = a0, a2 = a0;
#pragma unroll
        for (int hf = 0; hf < 2; ++hf) {
            f32x4 w[16];
#pragma unroll
            for (int i = 0; i < 16; ++i) w[i] = __builtin_nontemporal_load((const f32x4*)(W + (size_t)(32 * hf + 2 * i) * 6144));
#pragma unroll
            for (int i = 0; i < 16; ++i) { const int k = kc * 64 + 32 * hf + 2 * i + rpar; a0 += sl[k] * w[i]; a1 += sl[1024 + k] * w[i]; a2 += sl[2048 + k] * w[i]; }
        }
        if (rpar == 1) { red[tid - 256] = a0; red[256 + tid - 256] = a1; red[512 + tid - 256] = a2; }
        __syncthreads();
        if (rpar == 0) {
            a0 += red[tid]; a1 += red[256 + tid]; a2 += red[512 + tid];
            if (kc == 0) { const f32x4 bv = *(const f32x4*)(p.in[7] + l * 6144 + col); a0 += bv; a1 += bv; a2 += bv; }
#pragma unroll
            for (int j = 0; j < 4; ++j) {
                unsafeAtomicAdd(mod + (l * 3 + 0) * 6144 + col + j, a0[j]);
                unsafeAtomicAdd(mod + (l * 3 + 1) * 6144 + col + j, a1[j]);
                unsafeAtomicAdd(mod + (l * 3 + 2) * 6144 + col + j, a2[j]); }
        }
        if (done) asm volatile("s_waitcnt vmcnt(0)" ::: "memory");
        __syncthreads();
        if (done && tid == 0) __hip_atomic_fetch_add(done, 1u, __ATOMIC_RELAXED, __HIP_MEMORY_SCOPE_AGENT);
    }
}
__device__ __forceinline__ void transpose_jobs(const Params& p, LAS unsigned char* lds, int gw, int NGW, int it_lo, int it_hi) {
    const int lane = threadIdx.x & 63, wave = threadIdx.x >> 6;
    LAS float* scr = (LAS float*)(lds + wave * 8448);
    TItem cur, nxt; f32x4 wa[8], wb[8];
    int it = it_lo + gw;
    bool have = it < it_hi && titem_decode(p, it, cur);
    if (have) titem_load(cur, wa, lane);
    while (have) {
        const bool hn = it + NGW < it_hi && titem_decode(p, it + NGW, nxt);
        if (hn) titem_load(nxt, wb, lane);
        titem_finish(cur, wa, scr, lane);
        if (!hn) break;
        it += 2 * NGW;
        have = it < it_hi && titem_decode(p, it, cur);
        if (have) titem_load(cur, wa, lane);
        titem_finish(nxt, wb, scr, lane);
    }
}
__device__ __forceinline__ void phase_prologue(const Params& p, LAS unsigned char* lds, unsigned* gemv_done) {
    const int tid = threadIdx.x, G = gridDim.x, bx = blockIdx.x;
    unsigned char* ws = p.ws;
    LAS float* ct = (LAS float*)(lds + 32768);
    for (int i = tid; i < 2048; i += 512) ct[i] = cospif((float)i * (1.0f / 1024.0f));
    const bool sep = G >= 192;
    if (!sep || bx < 96) gemv_layer(p, lds, 0, bx, sep ? 96 : G, gemv_done);
    if (sep && bx < 96) return;
    const int gt = (sep ? bx - 96 : bx) * 512 + tid, GT = (sep ? G - 96 : G) * 512;
    for (int i = gt; i < 2 * 2 * 512 * D / 8; i += GT) { const int which = i >= 2 * 512 * D / 8; const int ii = which ? i - 2 * 512 * D / 8 : i;
        const f32x4* src = (const f32x4*)p.in[which ? 4 : 3]; const f32x4 a = __builtin_nontemporal_load(src + 2 * ii), b = __builtin_nontemporal_load(src + 2 * ii + 1);
        u32x4 o; o.x = pk2(a[0], a[1]); o.y = pk2(a[2], a[3]); o.z = pk2(b[0], b[1]); o.w = pk2(b[2], b[3]); ((u32x4*)((unsigned char*)p.out + (which ? OUTB_VC : OUTB_KC)))[ii] = o; }
    for (int i = gt; i < 512 * 256 / 8; i += GT) { const int row = i >> 5, c0 = (i & 31) * 8, cs = row >> 8, m = row & 255; float v[8];
#pragma unroll
        for (int j = 0; j < 8; ++j) { const int idx = ((m * (c0 + j)) & 255) * 8; v[j] = ct[(idx - (cs ? 512 : 0)) & 2047]; }
        u32x4 o; o.x = pk2(v[0], v[1]); o.y = pk2(v[2], v[3]); o.z = pk2(v[4], v[5]); o.w = pk2(v[6], v[7]); ((u32x4*)(ws + WS_CSCH))[i] = o; }
    for (int i = gt; i < 256 * 512 / 8; i += GT) { const int k = i >> 6, c0 = (i & 63) * 8; float v[8];
#pragma unroll
        for (int j = 0; j < 8; ++j) { const int kk = c0 + j, sidx = kk & 255; const int idx = ((k * sidx) & 255) * 8; v[j] = kk < 256 ? ct[idx] : -ct[(idx - 512) & 2047]; }
        u32x4 o; o.x = pk2(v[0], v[1]); o.y = pk2(v[2], v[3]); o.z = pk2(v[4], v[5]); o.w = pk2(v[6], v[7]); ((u32x4*)(ws + WS_TP))[i] = o; }
    for (int i = gt; i < 2048 * 4096 / 8; i += GT) { const int k = i >> 9, c0 = (i & 511) * 8; float v[8];
#pragma unroll
        for (int j = 0; j < 8; ++j) { const int kk = c0 + j, sidx = kk & 2047; const int idx = (k * sidx) & 2047; v[j] = kk < 2048 ? ct[idx] : -ct[(idx - 512) & 2047]; }
        u32x4 o; o.x = pk2(v[0], v[1]); o.y = pk2(v[2], v[3]); o.z = pk2(v[4], v[5]); o.w = pk2(v[6], v[7]); ((u32x4*)(ws + WS_TS))[i] = o; }
}
__device__ __forceinline__ void phase_side_jobs(const Params& p, LAS unsigned char* lds, const int which) {
    if (which == 5) { if (blockIdx.x < 56) transpose_jobs(p, lds, blockIdx.x * 8 + (threadIdx.x >> 6), 56 * 8, TI_L0 + 3 * 1408, TI_L0 + 3 * 1408 + 1536); return; }
    if (which == 6) { if (blockIdx.x >= 64) { const int gw = (blockIdx.x - 64) * 8 + (threadIdx.x >> 6), ngw = (gridDim.x - 64) * 8;
        transpose_jobs(p, lds, gw, ngw, TI_L0 + 2 * 1408, TI_L0 + 3 * 1408); transpose_jobs(p, lds, gw, ngw, TI_L0 + 3 * 1408 + 1536, TI_ALL); } return; }
    if (which == 8) { if (blockIdx.x >= 128) transpose_jobs(p, lds, (blockIdx.x - 128) * 8 + (threadIdx.x >> 6), (gridDim.x - 128) * 8, 0, 512); return; }
    if (which == 9) { if (blockIdx.x >= 64) transpose_jobs(p, lds, (blockIdx.x - 64) * 8 + (threadIdx.x >> 6), (gridDim.x - 64) * 8, 512, TI_L0);
        if (blockIdx.x >= 192) { __syncthreads(); gemv_layer(p, lds, 1, blockIdx.x - 192, gridDim.x - 192); } return; }
    if (which == 7) { if (blockIdx.x >= 192) transpose_jobs(p, lds, (blockIdx.x - 192) * 8 + (threadIdx.x >> 6), (gridDim.x - 192) * 8, TI_L0, TI_L0 + 2 * 1408); return; }
    const int G = gridDim.x, bx = blockIdx.x, first = which == 0 ? 64 : 192;
    const int nb = G > first ? G - first : G, b0 = G > first ? first : 0;
    if (bx < b0) return;
    const int rb = bx - b0;
    if (which == 0) transpose_jobs(p, lds, rb * 8 + (threadIdx.x >> 6), nb * 8, 0, TI_L0);
    else if (which == 1) gemv_layer(p, lds, 1, rb, nb);
    else transpose_jobs(p, lds, rb * 8 + (threadIdx.x >> 6), nb * 8, TI_L0, TI_ALL);
}

#ifndef ROW_WT
#define ROW_WT 0
#endif
__device__ __forceinline__ void store16_wt(void* ptr, u32x4 v) {
#if ROW_WT
    asm volatile("global_store_dwordx4 %0, %1, off sc0 sc1\n\ts_nop 3" :: "v"(ptr), "v"(v) : "memory");
#else
    *(u32x4*)ptr = v;
#endif
}
__device__ __forceinline__ void bf8_to_f32(const u32x4 w, f32x4& a, f32x4& b) { a = (f32x4){bf_lo(w.x), bf_hi(w.x), bf_lo(w.y), bf_hi(w.y)}; b = (f32x4){bf_lo(w.z), bf_hi(w.z), bf_lo(w.w), bf_hi(w.w)}; }
__device__ __forceinline__ u32x4 f32_to_bf8(const f32x4 a, const f32x4 b) { u32x4 w; w.x = pk2(a[0], a[1]); w.y = pk2(a[2], a[3]); w.z = pk2(b[0], b[1]); w.w = pk2(b[2], b[3]); return w; }
template <bool HAS_MP, bool HAS_NEXT, bool XIN_F32>
__device__ __forceinline__ void row_phase(const float* xin_p, const float* xin_s, bf16_t* XB, const bf16_t* mp, float* Yout, bf16_t* Hout,
                                          const float* gate, const float* gA, const float* gB, const float* sc, const float* sh, unsigned* cnt = nullptr, const bf16_t* mp2 = nullptr) {
    const int tid = threadIdx.x, lane = tid & 63, gw = blockIdx.x * 8 + (tid >> 6), NGW = gridDim.x * 8;
    if (cnt) {
        if (tid == 0) { const int p0 = (blockIdx.x * 48) >> 8, p1 = (blockIdx.x * 48 + 47) >> 8;
            for (int pp = p0; pp <= p1; ++pp) { unsigned sp = 0; while (__hip_atomic_load(cnt + pp * 64, __ATOMIC_RELAXED, __HIP_MEMORY_SCOPE_AGENT) < ((mp2 && pp >= 46) ? 64u : 32u)) { __builtin_amdgcn_s_sleep(2); if (++sp > (1u << 22)) break; } }
            __builtin_amdgcn_fence(__ATOMIC_ACQUIRE, "agent"); asm volatile("s_waitcnt vmcnt(0)" ::: "memory"); }
        __syncthreads();
    }
    constexpr int R = 3, RW = 6;
    int cur_cond = -1;
    f32x4 gga[4], gbs[4], shv[4];
    for (int rowb = gw * RW; rowb < M; rowb += NGW * RW)
    for (int row0 = rowb; row0 < rowb + RW; row0 += R) {
        f32x4 v[R][4]; u32x4 mw[R][2];
#pragma unroll
        for (int q = 0; q < R; ++q) { const int row = row0 + q;
            if constexpr (XIN_F32) { const float* xr = row < NP ? xin_p + (size_t)row * D : xin_s + (size_t)(row - NP) * D;
#pragma unroll
                for (int j = 0; j < 2; ++j) { v[q][2 * j] = *(const f32x4*)(xr + 8 * lane + 512 * j); v[q][2 * j + 1] = *(const f32x4*)(xr + 8 * lane + 512 * j + 4); }
            } else {
#pragma unroll
                for (int j = 0; j < 2; ++j) { const u32x4 w = *(const u32x4*)(XB + (size_t)row * D + 8 * lane + 512 * j); bf8_to_f32(w, v[q][2 * j], v[q][2 * j + 1]); }
            }
            if constexpr (HAS_MP) {
#pragma unroll
                for (int j = 0; j < 2; ++j) mw[q][j] = *(const u32x4*)(mp + (size_t)row * D + 8 * lane + 512 * j);
            } }
        u32x4 xo[R][2], ho[R][2];
#pragma unroll
        for (int q = 0; q < R; ++q) { const int row = row0 + q; const int cond = row < NP ? 0 : (row < NP + SS ? 1 : 2);
            if (cond != cur_cond) { cur_cond = cond;
#pragma unroll
                for (int j = 0; j < 4; ++j) { const int col = 8 * lane + 512 * (j >> 1) + 4 * (j & 1);
                    if constexpr (HAS_MP) gga[j] = *(const f32x4*)(gate + cond * 6144 + col) * *(const f32x4*)(gA + col);
                    if constexpr (HAS_NEXT) { gbs[j] = *(const f32x4*)(gB + col) * (1.0f + *(const f32x4*)(sc + cond * 6144 + col)); shv[j] = *(const f32x4*)(sh + cond * 6144 + col); } } }
            if constexpr (HAS_MP) {
                f32x4 mv[4]; float s = 0.f;
#pragma unroll
                for (int j = 0; j < 2; ++j) bf8_to_f32(mw[q][j], mv[2 * j], mv[2 * j + 1]);
                if (mp2 && row >= 46 * 256) {
#pragma unroll
                    for (int j = 0; j < 2; ++j) { f32x4 a, b; bf8_to_f32(*(const u32x4*)(mp2 + (size_t)(row - 46 * 256) * D + 8 * lane + 512 * j), a, b); mv[2 * j] += a; mv[2 * j + 1] += b; } }
#pragma unroll
                for (int j = 0; j < 4; ++j) s += (mv[j][0] * mv[j][0] + mv[j][1] * mv[j][1]) + (mv[j][2] * mv[j][2] + mv[j][3] * mv[j][3]);
                const float rstd = 1.0f / sqrtf(wave_sum(s) * (1.0f / D) + 1e-6f);
#pragma unroll
                for (int j = 0; j < 4; ++j) v[q][j] = v[q][j] + gga[j] * (mv[j] * rstd);
                if constexpr (HAS_NEXT) {
#pragma unroll
                    for (int j = 0; j < 2; ++j) xo[q][j] = f32_to_bf8(v[q][2 * j], v[q][2 * j + 1]);
                }
            }
            if constexpr (HAS_NEXT) {
                float s = 0.f;
#pragma unroll
                for (int j = 0; j < 4; ++j) s += (v[q][j][0] * v[q][j][0] + v[q][j][1] * v[q][j][1]) + (v[q][j][2] * v[q][j][2] + v[q][j][3] * v[q][j][3]);
                const float rstd = 1.0f / sqrtf(wave_sum(s) * (1.0f / D) + 1e-6f);
                f32x4 hh[4];
#pragma unroll
                for (int j = 0; j < 4; ++j) hh[j] = (v[q][j] * rstd) * gbs[j] + shv[j];
#pragma unroll
                for (int j = 0; j < 2; ++j) ho[q][j] = f32_to_bf8(hh[2 * j], hh[2 * j + 1]);
            } }
#pragma unroll
        for (int q = 0; q < R; ++q) { const int row = row0 + q;
            if constexpr (HAS_MP && !HAS_NEXT) {
#pragma unroll
                for (int j = 0; j < 4; ++j) *(f32x4*)(Yout + (size_t)row * D + 8 * lane + 512 * (j >> 1) + 4 * (j & 1)) = v[q][j];
            }
            if constexpr (HAS_MP && HAS_NEXT) {
#pragma unroll
                for (int j = 0; j < 2; ++j) store16_wt(XB + (size_t)row * D + 8 * lane + 512 * j, xo[q][j]);
            }
            if constexpr (HAS_NEXT) {
#pragma unroll
                for (int j = 0; j < 2; ++j) store16_wt(Hout + (size_t)row * D + 8 * lane + 512 * j, ho[q][j]);
            } }
    }
}

__device__ __forceinline__ void attn_phase(const Params& p, LAS unsigned char* lds, const int u_lo, const int u_hi, const int rb, const int nb) {
    const int tid = threadIdx.x, lane = tid & 63, wave = __builtin_amdgcn_readfirstlane(tid >> 6), r = lane & 31, hh = lane >> 5;
    unsigned char* ws = p.ws;
    const bf16_t* Qb = (const bf16_t*)(ws + WS_Q); const bf16_t* Kb = (const bf16_t*)(ws + WS_K); const bf16_t* Vb = (const bf16_t*)(ws + WS_VT);
    const bf16_t* Kc = (const bf16_t*)((const unsigned char*)p.out + OUTB_KC); const bf16_t* Vc = (const bf16_t*)((const unsigned char*)p.out + OUTB_VC);
    bf16_t* Ob = (bf16_t*)(ws + WS_H);
    LAS float* Bl = (LAS float*)(lds + 36864 + 512);
    const int srow = tid >> 3, sch = tid & 7, krho = (srow & ~12) | ((srow & 4) << 1) | ((srow & 8) >> 1);
    const float c2 = 0.125f * 1.4426950408889634f;
    for (int unit = u_lo + rb; unit < u_hi; unit += nb) {
        const bool is_na = unit < 256;
        int b, h, qtok, nt, jmin = 0, nloc = 0, rq = 0, half = 0, ktok0;
        if (is_na) { b = unit >> 7; h = (unit >> 3) & 15; const int r0 = (unit & 7) * 4; rq = r0 + (wave >> 1); half = wave & 1;
            jmin = min(max(r0 - 4, 0), 24); const int jmax = min(max(r0 - 1, 0), 24) + 7; nloc = jmax - jmin + 1; nt = nloc + 8;
            qtok = NP + b * SS + rq * 64 + half * 32 + r; ktok0 = NP + b * SS; }
        else { const int u2 = unit - 256; b = u2 >> 4; h = u2 & 15; nt = 4; qtok = b * SP + wave * 32 + r; ktok0 = b * SP; }
        const int rs = min(max(rq - 4, 0), 24);
        if (is_na) { for (int i = tid; i < 15 * 32; i += 512) { const int rr = i >> 5, x = i & 31; Bl[i] = x < 31 ? p.in[11][(h * 15 + rr) * 31 + x] * 1.4426950408889634f : 0.f; } }
        bf16x8 qf[4];
#pragma unroll
        for (int d0 = 0; d0 < 4; ++d0) qf[d0] = *(const bf16x8*)(Qb + (size_t)qtok * D + h * HD + d0 * 16 + hh * 8);
        f32x16 o0, o1;
#pragma unroll
        for (int i = 0; i < 16; ++i) { o0[i] = 0.f; o1[i] = 0.f; }
        float m_run = -1e30f, l_run = 0.f;
        u32x4 kreg, vreg;
#define ATT_LOAD(t) do { const int t_ = (t); size_t off_; const bf16_t* kb_; const bf16_t* vb_; \
            if (is_na && t_ >= nloc) { off_ = ((size_t)(b * 512 + (t_ - nloc) * 64 + srow)) * D + h * HD + sch * 8; kb_ = Kc; vb_ = Vc; } \
            else { off_ = (size_t)(ktok0 + (is_na ? (jmin + t_) * 64 : t_ * 64) + srow) * D + h * HD + sch * 8; kb_ = Kb; vb_ = Vb; } \
            kreg = *(const u32x4*)(kb_ + off_); vreg = *(const u32x4*)(vb_ + off_); } while (0)
#define ATT_STORE(buf) do { LAS unsigned char* kl_ = lds + (buf) * 18432; LAS unsigned char* vl_ = kl_ + 9216; \
            *(LAS u32x4*)(kl_ + krho * 144 + sch * 16) = kreg; \
            LAS bf16_t* vd_ = (LAS bf16_t*)(vl_ + (8 * sch) * 144 + srow * 2); \
            vd_[0 * 72] = (bf16_t)vreg.x; vd_[1 * 72] = (bf16_t)(vreg.x >> 16); vd_[2 * 72] = (bf16_t)vreg.y; vd_[3 * 72] = (bf16_t)(vreg.y >> 16); \
            vd_[4 * 72] = (bf16_t)vreg.z; vd_[5 * 72] = (bf16_t)(vreg.z >> 16); vd_[6 * 72] = (bf16_t)vreg.w; vd_[7 * 72] = (bf16_t)(vreg.w >> 16); } while (0)
        ATT_LOAD(0); ATT_STORE(0); if (nt > 1) ATT_LOAD(1);
        __syncthreads();
        for (int t = 0; t < nt; ++t) {
            if (t + 1 < nt) { ATT_STORE((t + 1) & 1); if (t + 2 < nt) ATT_LOAD(t + 2); }
            const bool local = is_na && t < nloc; const int j = jmin + t;
            if (!(local && (j < rs || j >= rs + 8))) {
                const LAS unsigned char* Kl = lds + (t & 1) * 18432; const LAS unsigned char* Vl = Kl + 9216;
                f32x16 p0, p1;
#pragma unroll
                for (int i = 0; i < 16; ++i) { p0[i] = 0.f; p1[i] = 0.f; }
#pragma unroll
                for (int d0 = 0; d0 < 4; ++d0) { const bf16x8 a0 = *(const LAS bf16x8*)(Kl + r * 144 + d0 * 32 + hh * 16), a1 = *(const LAS bf16x8*)(Kl + (32 + r) * 144 + d0 * 32 + hh * 16);
                    p0 = __builtin_amdgcn_mfma_f32_32x32x16_bf16(a0, qf[d0], p0, 0, 0, 0); p1 = __builtin_amdgcn_mfma_f32_32x32x16_bf16(a1, qf[d0], p1, 0, 0, 0); }
                float m_new, alpha;
                if (local) {
                    const int qc = half * 32 + r, cs = min(max(qc - 8, 0), 48);
                    const LAS float* bp = Bl + (j - rq + 7) * 32 + 8 * hh - qc + 15;
                    float bb0[16], bb1[16];
#pragma unroll
                    for (int i = 0; i < 16; ++i) { const int kc = 16 * (i >> 3) + (i & 7); bb0[i] = bp[kc]; bb1[i] = bp[kc + 32]; }
                    asm volatile("" : "+v"(bb0[0]), "+v"(bb0[1]), "+v"(bb0[2]), "+v"(bb0[3]), "+v"(bb0[4]), "+v"(bb0[5]), "+v"(bb0[6]), "+v"(bb0[7]));
                    asm volatile("" : "+v"(bb0[8]), "+v"(bb0[9]), "+v"(bb0[10]), "+v"(bb0[11]), "+v"(bb0[12]), "+v"(bb0[13]), "+v"(bb0[14]), "+v"(bb0[15]));
                    asm volatile("" : "+v"(bb1[0]), "+v"(bb1[1]), "+v"(bb1[2]), "+v"(bb1[3]), "+v"(bb1[4]), "+v"(bb1[5]), "+v"(bb1[6]), "+v"(bb1[7]));
                    asm volatile("" : "+v"(bb1[8]), "+v"(bb1[9]), "+v"(bb1[10]), "+v"(bb1[11]), "+v"(bb1[12]), "+v"(bb1[13]), "+v"(bb1[14]), "+v"(bb1[15]));
                    const unsigned sh0 = (unsigned)(8 * hh - cs);
#pragma unroll
                    for (int i = 0; i < 16; ++i) { const int kc = 16 * (i >> 3) + (i & 7);
                        const float s0 = __builtin_fmaf(p0[i], c2, bb0[i]), s1 = __builtin_fmaf(p1[i], c2, bb1[i]);
                        p0[i] = (sh0 + (unsigned)kc) < 16u ? s0 : -1e30f; p1[i] = (sh0 + (unsigned)(kc + 32)) < 16u ? s1 : -1e30f; }
                    float mt = fmaxf(p0[0], p1[0]);
#pragma unroll
                    for (int i = 1; i < 16; ++i) mt = fmaxf(mt, fmaxf(p0[i], p1[i]));
                    mt = fmaxf(mt, __shfl_xor(mt, 32));
                    m_new = fmaxf(m_run, mt); alpha = __builtin_amdgcn_exp2f(m_run - m_new);
#pragma unroll
                    for (int i = 0; i < 16; ++i) { p0[i] = __builtin_amdgcn_exp2f(p0[i] - m_new); p1[i] = __builtin_amdgcn_exp2f(p1[i] - m_new); }
                } else {
                    float mt = fmaxf(p0[0], p1[0]);
#pragma unroll
                    for (int i = 1; i < 16; ++i) mt = fmaxf(mt, fmaxf(p0[i], p1[i]));
                    mt = fmaxf(mt, __shfl_xor(mt, 32)) * c2;
                    m_new = fmaxf(m_run, mt); alpha = __builtin_amdgcn_exp2f(m_run - m_new);
#pragma unroll
                    for (int i = 0; i < 16; ++i) { p0[i] = __builtin_amdgcn_exp2f(__builtin_fmaf(p0[i], c2, -m_new)); p1[i] = __builtin_amdgcn_exp2f(__builtin_fmaf(p1[i], c2, -m_new)); }
                }
                m_run = m_new;
                float ls = 0.f;
#pragma unroll
                for (int i = 0; i < 16; ++i) ls += p0[i] + p1[i];
                l_run = l_run * alpha + ls;
#pragma unroll
                for (int i = 0; i < 16; ++i) { o0[i] *= alpha; o1[i] *= alpha; }
                bf16x8 pa[4];
#pragma unroll
                for (int s2 = 0; s2 < 2; ++s2) { u32x4 w; w.x = pk2(p0[8 * s2], p0[8 * s2 + 1]); w.y = pk2(p0[8 * s2 + 2], p0[8 * s2 + 3]); w.z = pk2(p0[8 * s2 + 4], p0[8 * s2 + 5]); w.w = pk2(p0[8 * s2 + 6], p0[8 * s2 + 7]); pa[s2] = __builtin_bit_cast(bf16x8, w);
                    u32x4 w2; w2.x = pk2(p1[8 * s2], p1[8 * s2 + 1]); w2.y = pk2(p1[8 * s2 + 2], p1[8 * s2 + 3]); w2.z = pk2(p1[8 * s2 + 4], p1[8 * s2 + 5]); w2.w = pk2(p1[8 * s2 + 6], p1[8 * s2 + 7]); pa[2 + s2] = __builtin_bit_cast(bf16x8, w2); }
#pragma unroll
                for (int s2 = 0; s2 < 4; ++s2) { const bf16x8 v0 = *(const LAS bf16x8*)(Vl + r * 144 + s2 * 32 + hh * 16), v1 = *(const LAS bf16x8*)(Vl + (32 + r) * 144 + s2 * 32 + hh * 16);
                    o0 = __builtin_amdgcn_mfma_f32_32x32x16_bf16(v0, pa[s2], o0, 0, 0, 0); o1 = __builtin_amdgcn_mfma_f32_32x32x16_bf16(v1, pa[s2], o1, 0, 0, 0); }
            }
            __syncthreads();
        }
#undef ATT_LOAD
#undef ATT_STORE
        const float inv = 1.0f / (l_run + __shfl_xor(l_run, 32));
        bf16_t* orow = Ob + (size_t)qtok * D + h * HD + 4 * hh;
#pragma unroll
        for (int g = 0; g < 4; ++g) { u32x2 w; w.x = pk2(o0[4 * g] * inv, o0[4 * g + 1] * inv); w.y = pk2(o0[4 * g + 2] * inv, o0[4 * g + 3] * inv); *(u32x2*)(orow + 8 * g) = w;
            u32x2 w2; w2.x = pk2(o1[4 * g] * inv, o1[4 * g + 1] * inv); w2.y = pk2(o1[4 * g + 2] * inv, o1[4 * g + 3] * inv); *(u32x2*)(orow + 32 + 8 * g) = w2; }
    }
    __syncthreads();
}

#define XB_TMO      128
#define XB_XCNT(j)  (256  + 64 * (j))
#define XB_XSUB(j)  (1280 + 64 * (j))
#define XB_XGEN(j)  (2304 + 64 * (j))
#define XB_TOP      3328
#define XB_TOPGEN   3392
#define XCD_BAR_WORDS 3456
#define XB_SPIN_CAP (1u << 18)
__device__ __forceinline__ unsigned xb_ld(unsigned* p)              { return __hip_atomic_load(p, __ATOMIC_RELAXED, __HIP_MEMORY_SCOPE_AGENT); }
__device__ __forceinline__ unsigned xb_add(unsigned* p, unsigned v) { return __hip_atomic_fetch_add(p, v, __ATOMIC_RELAXED, __HIP_MEMORY_SCOPE_AGENT); }
__device__ __forceinline__ unsigned xb_xcc_id() { return (unsigned)__builtin_amdgcn_s_getreg((3 << 11) | 20) & 0xFu; }
#define XB_SPIN(cond, bar) do { unsigned _sp = 0; while (cond) { __builtin_amdgcn_s_sleep(1); \
    if ((++_sp & 255u) == 0u) { if (xb_ld(&(bar)[XB_TMO])) break; if (_sp > XB_SPIN_CAP) { atomicAdd(&(bar)[XB_TMO], 1u); break; } } } } while (0)
struct XcdBarrier { unsigned* bar; unsigned x; volatile LAS unsigned* st; };
__device__ __forceinline__ XcdBarrier xcd_barrier_post(unsigned* bar, volatile LAS unsigned* st) {
    XcdBarrier b; b.bar = bar; b.x = xb_xcc_id(); b.st = st;
    if (threadIdx.x == 0) (void)xb_add(&bar[XB_XCNT(b.x)], 1u);
    return b;
}
__device__ __forceinline__ void xcd_barrier_complete(unsigned* bar, unsigned x, unsigned& nloc, unsigned& nx) {
    const unsigned G = gridDim.x * gridDim.y * gridDim.z;
    unsigned sum, cnt, mine, sp = 0u;
    for (;;) {
        sum = 0u; cnt = 0u; mine = 0u;
#pragma unroll
        for (unsigned j = 0; j < 16; ++j) { const unsigned c = xb_ld(&bar[XB_XCNT(j)]); sum += c; cnt += (c > 0u) ? 1u : 0u; mine = (j == x) ? c : mine; }
        if (sum == G) break;
        __builtin_amdgcn_s_sleep(1);
        if ((++sp & 255u) == 0u) { if (xb_ld(&bar[XB_TMO])) break; if (sp > XB_SPIN_CAP) { atomicAdd(&bar[XB_TMO], 1u); break; } }
    }
    nloc = mine > 0u ? mine : 1u; nx = cnt > 0u ? cnt : 1u;
}
__device__ __forceinline__ void xcd_barrier(const XcdBarrier& b) {
    asm volatile("s_waitcnt vmcnt(0)" ::: "memory");
    __syncthreads();
    if (threadIdx.x == 0) {
        unsigned* bar = b.bar;
        __builtin_amdgcn_s_waitcnt(0);
        unsigned nloc = b.st[0], nx = b.st[1];
        if (nloc == 0u) { xcd_barrier_complete(bar, b.x, nloc, nx); b.st[0] = nloc; b.st[1] = nx; }
        const unsigned old = xb_add(&bar[XB_XSUB(b.x)], 1u);
        const unsigned gen = old / nloc;
        if (old + 1u == (gen + 1u) * nloc) {
            __builtin_amdgcn_fence(__ATOMIC_RELEASE, "agent");
            asm volatile("s_waitcnt vmcnt(0)" ::: "memory");
            const unsigned og = xb_add(&bar[XB_TOP], 1u);
            const unsigned tg = og / nx;
            if (og + 1u == (tg + 1u) * nx) xb_add(&bar[XB_TOPGEN], 1u);
            else XB_SPIN(xb_ld(&bar[XB_TOPGEN]) == tg, bar);
            __builtin_amdgcn_fence(__ATOMIC_ACQUIRE, "agent");
            xb_add(&bar[XB_XGEN(b.x)], 1u);
            asm volatile("s_waitcnt vmcnt(0)" ::: "memory");
        } else {
            XB_SPIN(xb_ld(&bar[XB_XGEN(b.x)]) == gen, bar);
            __builtin_amdgcn_fence(__ATOMIC_ACQUIRE, "agent");
            asm volatile("s_waitcnt vmcnt(0)" ::: "memory");
        }
    }
    __syncthreads();
}

__global__ void __launch_bounds__(512, 2) mega_fwd(Params p) {
    extern __shared__ __attribute__((aligned(16))) unsigned char lds_raw[];
    LAS unsigned char* lds = (LAS unsigned char*)lds_raw;
    unsigned char* ws = p.ws;
    const int G = gridDim.x, c = blockIdx.x, lo = p.ph_lo, hi = p.ph_hi;
    const float* mod = (const float*)(ws + WS_MOD);
    const float* norm_g = p.in[8];
    bf16_t* H = (bf16_t*)(ws + WS_H); bf16_t* MPb = (bf16_t*)(ws + WS_MP); bf16_t* U = (bf16_t*)(ws + WS_U);
    float* X = p.out + OUT_X; bf16_t* XB = (bf16_t*)(ws + WS_XB);
    volatile LAS unsigned* MISC = (volatile LAS unsigned*)(lds + 131072 + 320);
    if (threadIdx.x < 32) MISC[threadIdx.x] = 0u;
    __syncthreads();
    XcdBarrier bar; bar.bar = (unsigned*)(ws + WS_CTL); bar.x = 0; bar.st = nullptr;
    if (hi - lo > 1) bar = xcd_barrier_post((unsigned*)(ws + WS_CTL), MISC + 8);
    if (hi > 1000) cg::this_grid().sync();
#ifndef PH_MASK
#define PH_MASK 0xffff
#endif
#define IN(k) (((PH_MASK >> (k)) & 1) && lo <= (k) && (k) < hi)
    const bool handoff = (G == 256) && (hi - lo > 1);
    unsigned* const cntb = (unsigned*)(ws + WS_CTL) + CW_CNT;
#ifndef PROBE_REP
#define PROBE_REP -1
#endif
#ifndef PROBE_SYNC2
#define PROBE_SYNC2 0
#endif
#define REPS(k) for (int rep_ = 0; rep_ < ((k) == PROBE_REP ? 2 : 1); ++rep_)
#ifndef PROBE_PHASE
#define PROBE_PHASE -1
#endif
    unsigned long long pt0 = 0, pt1 = 0;
    if (PROBE_PHASE == 0) pt0 = __builtin_amdgcn_s_memrealtime();
#define SEAM(k) SEAMX(k, false)
#define SEAMX(k, skip) do { if ((k) + 1 < hi && !(skip)) { xcd_barrier(bar); if (PROBE_SYNC2) xcd_barrier(bar); } \
        if ((k) == PROBE_PHASE) pt1 = __builtin_amdgcn_s_memrealtime(); if ((k) + 1 == PROBE_PHASE) pt0 = __builtin_amdgcn_s_memrealtime(); } while (0)

    unsigned* const gdone = cntb + 48;
    if (IN(0)) { phase_prologue(p, lds, handoff ? gdone : nullptr); SEAMX(0, handoff); }
    if (IN(1)) { {
        if (handoff) { if (threadIdx.x == 0) { unsigned sp = 0; while (__hip_atomic_load(gdone, __ATOMIC_RELAXED, __HIP_MEMORY_SCOPE_AGENT) < 96u) { __builtin_amdgcn_s_sleep(4); if (++sp > (1u << 22)) break; }
                __builtin_amdgcn_fence(__ATOMIC_ACQUIRE, "agent"); asm volatile("s_waitcnt vmcnt(0)" ::: "memory"); }
            __syncthreads(); }
        row_phase<false, true, true>(p.in[0], p.in[1], nullptr, nullptr, nullptr, H, nullptr, nullptr, norm_g, mod + 1 * D, mod + 0 * D);
        } SEAM(1);
    }
    if (IN(2)) {
        pg8::ChDftSched S{G, c, (const char*)(ws + WS_CSCH), (const char*)H, (bf16_t*)(ws + WS_YTP), (bf16_t*)(ws + WS_YTS)};
        pg8::gemm_phase<pg8::EpiStore, pg8::ChDftSched, true>(lds, 256, D, 256, S, pg8::EpiStore{});
        if (handoff) phase_side_jobs(p, lds, 8);
        SEAM(2);
    }
    if (IN(3)) {
        unsigned* const cf = cntb + 32;
        if (handoff) {
            int pm = -1, pn = 0;
            if (c < 64) { pm = 32 + 8 * (c >> 5) + ((c >> 2) & 7); pn = c & 3; } else if (c < 192) { pm = (c - 64) >> 2; pn = (c - 64) & 3; }
            { pg8::SeqSSched S{c, (const char*)(ws + WS_TS), (const char*)(ws + WS_YTS), (bf16_t*)(ws + WS_F)};
              pg8::gemm_phase<pg8::EpiStoreSig, pg8::SeqSSched, true>(lds, 4096, 4096, 4096, S, pg8::EpiStoreSig{cf}); }
            { pg8::SeqPSched S{G, c, (const char*)(ws + WS_TP), (const char*)(ws + WS_YTP), (bf16_t*)(ws + WS_F)};
              pg8::gemm_phase<pg8::EpiStoreSig, pg8::SeqPSched, true>(lds, 512, 512, 512, S, pg8::EpiStoreSig{cf}); }
            if (pm >= 0) {
                if (threadIdx.x == 0) { unsigned* w = cf + pm * 64; unsigned sp = 0;
                    while (__hip_atomic_load(w, __ATOMIC_RELAXED, __HIP_MEMORY_SCOPE_AGENT) < 32u) { __builtin_amdgcn_s_sleep(4); if (++sp > (1u << 22)) break; }
                    __builtin_amdgcn_fence(__ATOMIC_ACQUIRE, "agent"); asm volatile("s_waitcnt vmcnt(0)" ::: "memory"); }
                __syncthreads();
                pg8::OneSched S{pm, pn, (const char*)(ws + WS_F), (const char*)(ws + WS_WF), MPb};
                pg8::gemm_phase<pg8::EpiStoreSig, pg8::OneSched, true>(lds, D, D, D, S, pg8::EpiStoreSig{cntb + 0 * CNT_SEAM});
            }
            phase_side_jobs(p, lds, 9);
        } else {
            { pg8::SeqSSched S{c, (const char*)(ws + WS_TS), (const char*)(ws + WS_YTS), (bf16_t*)(ws + WS_F)};
              pg8::gemm_phase<pg8::EpiStoreSig, pg8::SeqSSched, true>(lds, 4096, 4096, 4096, S, pg8::EpiStoreSig{nullptr}); }
            { pg8::SeqPSched S{G, c, (const char*)(ws + WS_TP), (const char*)(ws + WS_YTP), (bf16_t*)(ws + WS_F)};
              pg8::gemm_phase<pg8::EpiStoreSig, pg8::SeqPSched, true>(lds, 512, 512, 512, S, pg8::EpiStoreSig{nullptr}); }
            phase_side_jobs(p, lds, 0);
        }
        SEAMX(3, handoff);
    }
    if (IN(4)) {
        if (!handoff) { pg8::GSched S{48, 4, G, c, (const char*)(ws + WS_F), (size_t)256 * D * 2, (const char*)(ws + WS_WF), (size_t)256 * D * 2, MPb, (size_t)256 * D, 256, D};
            pg8::gemm_phase<pg8::EpiStoreSig, pg8::GSched, true>(lds, D, D, D, S, pg8::EpiStoreSig{nullptr});
            phase_side_jobs(p, lds, 1); }
        SEAMX(4, handoff);
    }
    if (IN(5)) { REPS(5) {
        row_phase<true, true, true>(p.in[0], p.in[1], XB, MPb, nullptr, H, mod + 2 * D, norm_g + 1 * D, norm_g + 2 * D, mod + 4 * D, mod + 3 * D, handoff ? cntb + 0 * CNT_SEAM : nullptr);
        } SEAM(5);
    }
    if (IN(6)) {
        if (handoff) { pg8::GuSched S{G, c, (const char*)H, (const char*)(ws + WS_WGU), U};
            pg8::gemm_phase<pg8::EpiSwiGLU, pg8::GuSched, true>(lds, D, D, D, S, pg8::EpiSwiGLU{cntb + 4 * CNT_SEAM}); }
        else { pg8::GSched S{48, 22, G, c, (const char*)H, (size_t)256 * D * 2, (const char*)(ws + WS_WGU), (size_t)256 * D * 2, U, (size_t)256 * FF, 128, FF};
            pg8::gemm_phase<pg8::EpiSwiGLU, pg8::GSched, true>(lds, D, D, D, S, pg8::EpiSwiGLU{nullptr}); }
        SEAMX(6, handoff);
    }
    if (IN(7)) {
        if (handoff) {
            const int dd = c >= 248 ? 184 + (c - 248) : (c >= 64 ? c - 64 : (c >= 56 ? 192 + (c - 56) : -1));
            if (dd >= 0) { pg8::DownSched S{dd, (const char*)U, (const char*)(ws + WS_WD), MPb, (bf16_t*)(ws + WS_MP2)};
                if (threadIdx.x == 0) { int pm, pn, kh; S.unit(pm, pn, kh); unsigned* w = cntb + 4 * CNT_SEAM + pm * 64; unsigned sp = 0;
                    while (__hip_atomic_load(w, __ATOMIC_RELAXED, __HIP_MEMORY_SCOPE_AGENT) < 176u) { __builtin_amdgcn_s_sleep(4); if (++sp > (1u << 22)) break; }
                    __builtin_amdgcn_fence(__ATOMIC_ACQUIRE, "agent"); asm volatile("s_waitcnt vmcnt(0)" ::: "memory"); }
                __syncthreads();
                if (dd < 184) pg8::gemm_phase<pg8::EpiStoreSig, pg8::DownSched, true>(lds, FF, FF, FF, S, pg8::EpiStoreSig{cntb + 1 * CNT_SEAM});
                else pg8::gemm_phase<pg8::EpiStoreSig, pg8::DownSched, true>(lds, FF, FF, FF / 2, S, pg8::EpiStoreSig{cntb + 1 * CNT_SEAM}); }
            else { phase_side_jobs(p, lds, 5); }
        } else { pg8::GSched S{48, 4, G, c, (const char*)U, (size_t)256 * FF * 2, (const char*)(ws + WS_WD), (size_t)256 * FF * 2, MPb, (size_t)256 * D, 256, D};
            pg8::gemm_phase<pg8::EpiStoreSig, pg8::GSched, true>(lds, FF, FF, FF, S, pg8::EpiStoreSig{nullptr});
            phase_side_jobs(p, lds, 2); }
        SEAMX(7, handoff);
    }
    if (IN(8)) { REPS(8) {
        row_phase<true, true, false>(nullptr, nullptr, XB, MPb, nullptr, H, mod + 5 * D, norm_g + 3 * D, norm_g + 4 * D, mod + 3 * 6144 + 1 * D, mod + 3 * 6144 + 0 * D, handoff ? cntb + 1 * CNT_SEAM : nullptr, handoff ? (const bf16_t*)(ws + WS_MP2) : nullptr);
        } SEAM(8);
    }
    if (IN(9)) {
        unsigned* const cq = cntb + 16;
        pg8::EpiQKV E{(bf16_t*)(ws + WS_Q), (bf16_t*)(ws + WS_K), (bf16_t*)(ws + WS_VT), p.out + OUT_CK, p.out + OUT_CV, handoff ? cq : nullptr};
        if (handoff) {
            { pg8::QkvSched S{G, c, (const char*)H, (const char*)(ws + WS_WQKV)};
              pg8::gemm_phase<pg8::EpiQKV, pg8::QkvSched, true>(lds, D, D, D, S, E); }
            if (c >= 64) {
                if (threadIdx.x == 0) { for (int u = 256 + (c - 64); u < 768; u += 192) { unsigned* w = cq + ((u - 256) >> 4) * 64; unsigned sp = 0;
                        while (__hip_atomic_load(w, __ATOMIC_RELAXED, __HIP_MEMORY_SCOPE_AGENT) < 96u) { __builtin_amdgcn_s_sleep(4); if (++sp > (1u << 22)) break; } }
                    __builtin_amdgcn_fence(__ATOMIC_ACQUIRE, "agent"); asm volatile("s_waitcnt vmcnt(0)" ::: "memory"); }
                __syncthreads();
                attn_phase(p, lds, 256, 768, c - 64, 192);
            }
            if (threadIdx.x == 0) { for (int pp = 32 + 8 * (c >> 7); pp < 40 + 8 * (c >> 7); ++pp) { unsigned* w = cq + pp * 64; unsigned sp = 0;
                    while (__hip_atomic_load(w, __ATOMIC_RELAXED, __HIP_MEMORY_SCOPE_AGENT) < 96u) { __builtin_amdgcn_s_sleep(4); if (++sp > (1u << 22)) break; } }
                __builtin_amdgcn_fence(__ATOMIC_ACQUIRE, "agent"); asm volatile("s_waitcnt vmcnt(0)" ::: "memory"); }
            __syncthreads();
            attn_phase(p, lds, c, c + 1, 0, 1);
            if (c < 64) { const int gw = c * 8 + (threadIdx.x >> 6);
                transpose_jobs(p, lds, gw, 64 * 8, TI_L0 + 2 * 1408, TI_L0 + 3 * 1408); transpose_jobs(p, lds, gw, 64 * 8, TI_L0 + 3 * 1408 + 1536, TI_ALL); }
        } else {
            pg8::GSched S{48, 12, G, c, (const char*)H, (size_t)256 * D * 2, (const char*)(ws + WS_WQKV), (size_t)256 * D * 2, nullptr, 0, 0, D};
            pg8::gemm_phase<pg8::EpiQKV, pg8::GSched, true>(lds, D, D, D, S, E);
        }
        SEAMX(9, handoff);
    }
    if (IN(10)) { if (!handoff) attn_phase(p, lds, 0, 768, c, G); SEAM(10); }
    if (IN(11)) { REPS(11) {
        pg8::GSched S{48, 4, G, c, (const char*)H, (size_t)256 * D * 2, (const char*)(ws + WS_WO), (size_t)256 * D * 2, MPb, (size_t)256 * D, 256, D};
        pg8::gemm_phase<pg8::EpiStoreSig, pg8::GSched, true>(lds, D, D, D, S, pg8::EpiStoreSig{handoff ? cntb + 2 * CNT_SEAM : nullptr});
        if (handoff) phase_side_jobs(p, lds, 7);
        } SEAMX(11, handoff);
    }
    if (IN(12)) { REPS(12) {
        row_phase<true, true, false>(nullptr, nullptr, XB, MPb, nullptr, H, mod + 3 * 6144 + 2 * D, norm_g + 5 * D, norm_g + 6 * D, mod + 3 * 6144 + 4 * D, mod + 3 * 6144 + 3 * D, handoff ? cntb + 2 * CNT_SEAM : nullptr);
        } SEAM(12);
    }
    if (IN(13)) {
        if (handoff) { pg8::GuSched S{G, c, (const char*)H, (const char*)(ws + WS_WGU) + (size_t)2 * FF * D * 2, U};
            pg8::gemm_phase<pg8::EpiSwiGLU, pg8::GuSched, true>(lds, D, D, D, S, pg8::EpiSwiGLU{cntb + 5 * CNT_SEAM}); }
        else { pg8::GSched S{48, 22, G, c, (const char*)H, (size_t)256 * D * 2, (const char*)(ws + WS_WGU) + (size_t)2 * FF * D * 2, (size_t)256 * D * 2, U, (size_t)256 * FF, 128, FF};
            pg8::gemm_phase<pg8::EpiSwiGLU, pg8::GSched, true>(lds, D, D, D, S, pg8::EpiSwiGLU{nullptr}); }
        SEAMX(13, handoff);
    }
    if (IN(14)) {
        if (handoff) {
            const int dd = c >= 248 ? 184 + (c - 248) : (c >= 64 ? c - 64 : (c >= 56 ? 192 + (c - 56) : -1));
            if (dd >= 0) { pg8::DownSched S{dd, (const char*)U, (const char*)(ws + WS_WD) + (size_t)D * FF * 2, MPb, (bf16_t*)(ws + WS_MP2)};
                if (threadIdx.x == 0) { int pm, pn, kh; S.unit(pm, pn, kh); unsigned* w = cntb + 5 * CNT_SEAM + pm * 64; unsigned sp = 0;
                    while (__hip_atomic_load(w, __ATOMIC_RELAXED, __HIP_MEMORY_SCOPE_AGENT) < 176u) { __builtin_amdgcn_s_sleep(4); if (++sp > (1u << 22)) break; }
                    __builtin_amdgcn_fence(__ATOMIC_ACQUIRE, "agent"); asm volatile("s_waitcnt vmcnt(0)" ::: "memory"); }
                __syncthreads();
                if (dd < 184) pg8::gemm_phase<pg8::EpiStoreSig, pg8::DownSched, true>(lds, FF, FF, FF, S, pg8::EpiStoreSig{cntb + 3 * CNT_SEAM});
                else pg8::gemm_phase<pg8::EpiStoreSig, pg8::DownSched, true>(lds, FF, FF, FF / 2, S, pg8::EpiStoreSig{cntb + 3 * CNT_SEAM}); }
            else {  }
        } else { pg8::GSched S{48, 4, G, c, (const char*)U, (size_t)256 * FF * 2, (const char*)(ws + WS_WD) + (size_t)D * FF * 2, (size_t)256 * FF * 2, MPb, (size_t)256 * D, 256, D};
            pg8::gemm_phase<pg8::EpiStoreSig, pg8::GSched, true>(lds, FF, FF, FF, S, pg8::EpiStoreSig{nullptr});
             }
        SEAMX(14, handoff);
    }
    if (IN(15)) { REPS(15) {
        row_phase<true, false, false>(nullptr, nullptr, XB, MPb, X, nullptr, mod + 3 * 6144 + 5 * D, norm_g + 7 * D, nullptr, nullptr, nullptr, handoff ? cntb + 3 * CNT_SEAM : nullptr, handoff ? (const bf16_t*)(ws + WS_MP2) : nullptr); }
    }
    if (PROBE_PHASE >= 0 && blockIdx.x == 0) { if (PROBE_PHASE == 15) pt1 = __builtin_amdgcn_s_memrealtime();
        const unsigned long long tend = __builtin_amdgcn_s_memrealtime(), wait = 9ull * (pt1 - pt0);
        while (__builtin_amdgcn_s_memrealtime() - tend < wait) __builtin_amdgcn_s_sleep(8); }
#undef IN
#undef SEAM
}

constexpr int LDS_BYTES = 147456;
extern "C" void kernel_launch(void* const* d_in, const int* in_sizes, int n_in, void* d_out, int out_size, void* d_ws, size_t ws_size, hipStream_t stream) {
    static int grid = 0;
    if (grid == 0) {
        int dev = 0, cus = 0, per_cu = 0;
        hipGetDevice(&dev);
        hipDeviceGetAttribute(&cus, hipDeviceAttributeMultiprocessorCount, dev);
        if (hipFuncSetAttribute((const void*)mega_fwd, hipFuncAttributeMaxDynamicSharedMemorySize, LDS_BYTES) != hipSuccess) fprintf(stderr, "kernel_launch: hipFuncSetAttribute failed\n");
        if (hipOccupancyMaxActiveBlocksPerMultiprocessor(&per_cu, (const void*)mega_fwd, 512, LDS_BYTES) != hipSuccess || per_cu < 1) { fprintf(stderr, "kernel_launch: occupancy query says %d\n", per_cu); per_cu = 1; }
        (void)hipGetLastError();
        grid = cus * 1;
        if (n_in != 16 || ws_size < WS_END) { fprintf(stderr, "kernel_launch: unexpected n_in %d / ws %zu\n", n_in, ws_size); }
    }
    Params p{};
    (void)hipMemsetAsync((unsigned char*)d_ws, 0, WS_CTL + CTL_BYTES, stream);
    for (int i = 0; i < 16; ++i) p.in[i] = (const float*)d_in[i];
    p.out = (float*)d_out; p.ws = (unsigned char*)d_ws;
    if (MK_N_LAUNCHES == 1) {
        p.ph_lo = 0; p.ph_hi = NPHASE;
        void* args[] = {&p};
        hipError_t e = hipLaunchCooperativeKernel((const void*)mega_fwd, dim3(grid), dim3(512), args, LDS_BYTES, stream);
        if (e != hipSuccess) fprintf(stderr, "cooperative launch failed: %s (grid %d)\n", hipGetErrorString(e), grid);
    } else {
        for (int k = 0; k < NPHASE; ++k) { p.ph_lo = k; p.ph_hi = k + 1; hipLaunchKernelGGL(mega_fwd, dim3(grid), dim3(512), LDS_BYTES, stream, p); }
    }
}
```

```cpp
#include <hip/hip_runtime.h>
#include <hip/hip_cooperative_groups.h>
#include <cstdio>
#include <cstdint>
namespace cg = cooperative_groups;

#ifndef MK_N_LAUNCHES
#define MK_N_LAUNCHES 1
#endif

#define LAS __attribute__((address_space(3)))
typedef unsigned short bf16_t;
typedef short bf16x8 __attribute__((ext_vector_type(8)));
typedef float f32x2 __attribute__((ext_vector_type(2)));
typedef float f32x4 __attribute__((ext_vector_type(4)));
typedef float f32x16 __attribute__((ext_vector_type(16)));
typedef unsigned u32x2 __attribute__((ext_vector_type(2)));
typedef unsigned u32x4 __attribute__((ext_vector_type(4)));
typedef __bf16 bf16x2_t __attribute__((ext_vector_type(2)));

constexpr int D = 1024, NP = 8192, NS = 4096, M = NP + NS, SP = 256, SS = 2048, FF = 2816, NH = 16, HD = 64;
constexpr int NPHASE = 16;
constexpr size_t MiB = 1u << 20;
constexpr size_t WS_CTL = 160 * 1024, CTL_BYTES = 96 * 1024;
constexpr int CW_CNT = 4096, CNT_SEAM = 48 * 64;
constexpr size_t WS_MOD = 0, WS_CSCH = 256 * 1024, WS_TP = 512 * 1024, WS_WF = 1 * MiB, WS_WQKV = 3 * MiB,
                 WS_WO = 9 * MiB, WS_WGU = 11 * MiB, WS_WD = 33 * MiB, WS_H = 44 * MiB, WS_MP = 68 * MiB, WS_U = 92 * MiB, WS_R = 158 * MiB;
constexpr size_t WS_YTP = WS_U, WS_YTS = WS_U + 32 * MiB;
constexpr size_t WS_TS = WS_R, WS_F = WS_R + 16 * MiB;
constexpr size_t WS_Q = WS_R, WS_K = WS_R + 24 * MiB, WS_VT = WS_R + 48 * MiB;
constexpr size_t WS_XB = WS_R + 72 * MiB, WS_MP2 = WS_XB + 24 * MiB, WS_END = WS_MP2 + 1 * MiB;
constexpr size_t OUTB_KC = 0, OUTB_VC = 2 * MiB;
constexpr size_t OUT_X = 0, OUT_CK = (size_t)M * D, OUT_CV = OUT_CK + (size_t)NP * D;

struct Params {
    const float* in[16];
    float* out; unsigned char* ws;
    int ph_lo, ph_hi;
};

__device__ __forceinline__ unsigned pk2(float lo, float hi) { f32x2 v = {lo, hi}; bf16x2_t b = __builtin_convertvector(v, bf16x2_t); return __builtin_bit_cast(unsigned, b); }
__device__ __forceinline__ float bf_lo(unsigned w) { return __uint_as_float(w << 16); }
__device__ __forceinline__ float bf_hi(unsigned w) { return __uint_as_float(w & 0xffff0000u); }
template <int CTRL> __device__ __forceinline__ float dpp_mov(float v) { return __builtin_bit_cast(float, __builtin_amdgcn_mov_dpp(__builtin_bit_cast(int, v), CTRL, 0xf, 0xf, true)); }
__device__ __forceinline__ float wave_sum(float v) {
    v += dpp_mov<0xB1>(v); v += dpp_mov<0x4E>(v); v += dpp_mov<0x141>(v); v += dpp_mov<0x140>(v);
    { auto rr = __builtin_amdgcn_permlane16_swap(__float_as_uint(v), __float_as_uint(v), false, false); v = __uint_as_float(rr[0]) + __uint_as_float(rr[1]); }
    { auto rr = __builtin_amdgcn_permlane32_swap(__float_as_uint(v), __float_as_uint(v), false, false); v = __uint_as_float(rr[0]) + __uint_as_float(rr[1]); }
    return v;
}

namespace pg8 {
constexpr int BM = 256, BK = 64, HALF = 128, HTB = HALF * BK * 2, STAGE_BYTES = 8 * HTB;
__device__ __forceinline__ int lds_byte(int r, int c) { const int st = (r >> 4) * 2 + (c >> 5), rr = r & 15, cc = c & 31, ob = rr * 64 + cc * 2; return st * 1024 + (ob ^ (((ob >> 9) & 1) << 5)); }
__device__ __forceinline__ void stage_rc(int b, int& R, int& C) { const int st = b / 1024, sb = b % 1024, swz = sb ^ (((sb >> 9) & 1) << 5); R = (st >> 1) * 16 + swz / 64; C = (st & 1) * 32 + (swz % 64) / 2; }
__device__ __forceinline__ int perm32(int rho) { const int n = rho >> 4, i = rho & 15; return 8 * (i >> 2) + 4 * n + (i & 3); }

struct UnitDesc { const char* A; const char* B; bf16_t* out; int ldc; int aux; };

__device__ __forceinline__ void tile_order(int L, int nM, int nN, int& pm, int& pn) {
    const int nwg = nM * nN; int wgid = L;
    { const int q = nwg / 8, r = nwg % 8, xcd = wgid % 8, off = wgid / 8; wgid = (xcd < r ? xcd * (q + 1) : r * (q + 1) + (xcd - r) * q) + off; }
    const int nig = 8 * nN, gid = wgid / nig, fm = gid * 8, gsz = (nM - fm) < 8 ? (nM - fm) : 8;
    pm = fm + ((wgid % nig) % gsz); pn = (wgid % nig) / gsz;
}

template <class Epi, class Sched, bool ALIGN_EPI>
__device__ __forceinline__ void gemm_phase(LAS unsigned char* lds, const int lda, const int ldb, const int K, const Sched& S, const Epi& E) {
    const int tid = threadIdx.x, wid = __builtin_amdgcn_readfirstlane(tid >> 6), lane = tid & 63, wr = wid >> 2, wc = wid & 3, fr = lane & 15, fq = lane >> 4;
    const int nt = K / BK;
    unsigned voffA[2], voffB[2];
#pragma unroll
    for (int i = 0; i < 2; ++i) { int R, C; stage_rc(tid * 16 + i * 8192, R, C); const int Rb = (R & ~31) + perm32(R & 31);
        voffA[i] = (unsigned)(R * lda + C) * 2u; voffB[i] = (unsigned)(Rb * ldb + C) * 2u; }
    const size_t kstep = (size_t)(BK * 2);
    const size_t hstepA = (size_t)HALF * lda * 2, hstepB = (size_t)HALF * ldb * 2;
    const unsigned ldsw = (unsigned)wid * 1024u;
    const int aoff = lds_byte(wr * 64 + fr, fq * 8), boff = lds_byte(wc * 32 + fr, fq * 8);
#define PG8_SA(b, h) (((b) * 2 + (h)) * HTB)
#define PG8_SB(b, h) ((4 + (b) * 2 + (h)) * HTB)
#define PG8_STAGE(bufoff, gbase, voff) do { _Pragma("unroll") for (int _i = 0; _i < 2; ++_i) \
        __builtin_amdgcn_global_load_lds((const unsigned*)((const char*)(gbase) + (voff)[_i]), (LAS unsigned*)(lds + (bufoff) + ldsw + _i * 8192), 16, 0, 0); } while (0)
#define PG8_LDA(dst, b, h) do { _Pragma("unroll") for (int m = 0; m < 4; ++m) _Pragma("unroll") for (int k = 0; k < 2; ++k) dst[m][k] = *(const LAS bf16x8*)(lds + PG8_SA(b, h) + aoff + m * 2048 + k * 1024); } while (0)
#define PG8_LDB(dst, b, h) do { _Pragma("unroll") for (int n = 0; n < 2; ++n) _Pragma("unroll") for (int k = 0; k < 2; ++k) dst[n][k] = *(const LAS bf16x8*)(lds + PG8_SB(b, h) + boff + n * 2048 + k * 1024); } while (0)
#define PG8_MMA(ai, bj, At, Bt) do { __builtin_amdgcn_s_setprio(1); _Pragma("unroll") for (int m = 0; m < 4; ++m) _Pragma("unroll") for (int n = 0; n < 2; ++n) _Pragma("unroll") for (int k = 0; k < 2; ++k) \
        acc[ai][bj][m][n] = __builtin_amdgcn_mfma_f32_16x16x32_bf16(Bt[n][k], At[m][k], acc[ai][bj][m][n], 0, 0, 0); __builtin_amdgcn_s_setprio(0); } while (0)
#define PG8_WAIT_V(n) asm volatile("s_waitcnt vmcnt(" #n ")" ::: "memory")
#define PG8_WAIT_L(n) asm volatile("s_waitcnt lgkmcnt(" #n ")" ::: "memory")
#define PG8_BAR __builtin_amdgcn_s_barrier()
#define PG8_SCHED __builtin_amdgcn_sched_barrier(0)
    UnitDesc cur, nxt; int ui = 0;
    if (!S.next(0, cur)) return;
    f32x4 acc[2][2][4][2];
#pragma unroll
    for (int a = 0; a < 2; ++a)
#pragma unroll
        for (int b = 0; b < 2; ++b)
#pragma unroll
            for (int m = 0; m < 4; ++m)
#pragma unroll
                for (int n = 0; n < 2; ++n) acc[a][b][m][n] = (f32x4){0.f, 0.f, 0.f, 0.f};
    bf16x8 At[4][2], B0[2][2], B1[2][2];
    const char* cA = cur.A; const char* cB = cur.B;
    PG8_STAGE(PG8_SB(0, 0), cB, voffB); PG8_STAGE(PG8_SB(0, 1), cB + hstepB, voffB); PG8_STAGE(PG8_SA(0, 0), cA, voffA); PG8_STAGE(PG8_SA(0, 1), cA + hstepA, voffA);
    if (wr == 1) PG8_BAR;
    PG8_WAIT_V(2); PG8_BAR;
    PG8_STAGE(PG8_SB(1, 0), cB + kstep, voffB); PG8_STAGE(PG8_SA(1, 0), cA + kstep, voffA); PG8_STAGE(PG8_SB(1, 1), cB + hstepB + kstep, voffB);
    PG8_WAIT_V(6); PG8_BAR;
    for (;;) {
        const bool has_next = S.next(ui + 1, nxt);
        const char* nA = has_next ? nxt.A : cA; const char* nB = has_next ? nxt.B : cB;
#pragma unroll 1
        for (int t = 0; t < nt; t += 2) {
            const bool last = (t == nt - 2);
            const char* a1 = cA + (size_t)(t + 1) * kstep;
            const char* a2 = last ? nA : cA + (size_t)(t + 2) * kstep; const char* b2 = last ? nB : cB + (size_t)(t + 2) * kstep;
            const char* a3 = a2 + kstep; const char* b3 = b2 + kstep;
            PG8_LDB(B0, 0, 0); PG8_LDB(B1, 0, 1); PG8_SCHED; PG8_LDA(At, 0, 0); PG8_STAGE(PG8_SA(1, 1), a1 + hstepA, voffA);
            PG8_WAIT_V(8); PG8_WAIT_L(0); PG8_BAR; PG8_MMA(0, 0, At, B0); PG8_MMA(0, 1, At, B1); PG8_BAR; PG8_SCHED;
            PG8_LDA(At, 0, 1); PG8_STAGE(PG8_SB(0, 0), b2, voffB); PG8_STAGE(PG8_SB(0, 1), b2 + hstepB, voffB); PG8_STAGE(PG8_SA(0, 0), a2, voffA);
            PG8_WAIT_V(8); PG8_WAIT_L(0); PG8_BAR; PG8_MMA(1, 0, At, B0); PG8_MMA(1, 1, At, B1); PG8_BAR; PG8_SCHED;
            PG8_LDB(B0, 1, 0); PG8_LDB(B1, 1, 1); PG8_SCHED; PG8_LDA(At, 1, 0); PG8_STAGE(PG8_SA(0, 1), a2 + hstepA, voffA);
            PG8_WAIT_V(8); PG8_WAIT_L(0); PG8_BAR; PG8_MMA(0, 0, At, B0); PG8_MMA(0, 1, At, B1); PG8_BAR; PG8_SCHED;
            PG8_LDA(At, 1, 1); PG8_STAGE(PG8_SB(1, 0), b3, voffB); PG8_STAGE(PG8_SB(1, 1), b3 + hstepB, voffB); PG8_STAGE(PG8_SA(1, 0), a3, voffA);
            PG8_WAIT_V(8); PG8_WAIT_L(0); PG8_BAR; PG8_MMA(1, 0, At, B0); PG8_MMA(1, 1, At, B1); PG8_BAR; PG8_SCHED;
        }
        if constexpr (ALIGN_EPI) { if (wr == 0) PG8_BAR; }
        E(acc, cur, wr, wc, fr, fq);
        if (!has_next) break;
#pragma unroll
        for (int a = 0; a < 2; ++a)
#pragma unroll
            for (int b = 0; b < 2; ++b)
#pragma unroll
                for (int m = 0; m < 4; ++m)
#pragma unroll
                    for (int n = 0; n < 2; ++n) acc[a][b][m][n] = (f32x4){0.f, 0.f, 0.f, 0.f};
        cur = nxt; cA = nA; cB = nB; ++ui;
        if constexpr (ALIGN_EPI) { if (wr == 1) PG8_BAR; }
    }
    PG8_WAIT_V(0);
    if constexpr (!ALIGN_EPI) { if (wr == 0) PG8_BAR; }
    PG8_BAR;
#undef PG8_SA
#undef PG8_SB
#undef PG8_STAGE
#undef PG8_LDA
#undef PG8_LDB
#undef PG8_MMA
#undef PG8_WAIT_V
#undef PG8_WAIT_L
#undef PG8_BAR
#undef PG8_SCHED
}

struct EpiStore {
    __device__ __forceinline__ void operator()(const f32x4 (&acc)[2][2][4][2], const UnitDesc& u, int wr, int wc, int fr, int fq) const {
#pragma unroll
        for (int ai = 0; ai < 2; ++ai)
#pragma unroll
            for (int m = 0; m < 4; ++m) { bf16_t* rowp = u.out + (size_t)(ai * HALF + wr * 64 + m * 16 + fr) * u.ldc + wc * 32 + 8 * fq;
#pragma unroll
                for (int bj = 0; bj < 2; ++bj) { const f32x4 v0 = acc[ai][bj][m][0], v1 = acc[ai][bj][m][1];
                    u32x4 w; w.x = pk2(v0[0], v0[1]); w.y = pk2(v0[2], v0[3]); w.z = pk2(v1[0], v1[1]); w.w = pk2(v1[2], v1[3]);
                    *(u32x4*)(rowp + bj * HALF) = w; } }
    }
};
__device__ __forceinline__ void store16_sc1(void* ptr, u32x4 v) { asm volatile("global_store_dwordx4 %0, %1, off sc0 sc1\n\ts_nop 3" :: "v"(ptr), "v"(v) : "memory"); }
struct EpiStoreSig {
    unsigned* cnt;
    __device__ __forceinline__ void operator()(const f32x4 (&acc)[2][2][4][2], const UnitDesc& u, int wr, int wc, int fr, int fq) const {
#pragma unroll
        for (int ai = 0; ai < 2; ++ai)
#pragma unroll
            for (int m = 0; m < 4; ++m) { bf16_t* rowp = u.out + (size_t)(ai * HALF + wr * 64 + m * 16 + fr) * u.ldc + wc * 32 + 8 * fq;
#pragma unroll
                for (int bj = 0; bj < 2; ++bj) { const f32x4 v0 = acc[ai][bj][m][0], v1 = acc[ai][bj][m][1];
                    u32x4 w; w.x = pk2(v0[0], v0[1]); w.y = pk2(v0[2], v0[3]); w.z = pk2(v1[0], v1[1]); w.w = pk2(v1[2], v1[3]);
                    if (cnt) store16_sc1(rowp + bj * HALF, w); else *(u32x4*)(rowp + bj * HALF) = w; } }
        if (cnt) { asm volatile("s_waitcnt vmcnt(0)" ::: "memory");
            if ((threadIdx.x & 63) == 0) __hip_atomic_fetch_add(cnt + (u.aux & 0xffff) * 64, 1u, __ATOMIC_RELAXED, __HIP_MEMORY_SCOPE_AGENT); }
    }
};
__device__ __forceinline__ float swiglu1(float g, float u) { return g * u * __builtin_amdgcn_rcpf(1.0f + __builtin_amdgcn_exp2f(-1.4426950408889634f * g)); }
struct EpiSwiGLU {
    unsigned* cnt;
    __device__ __forceinline__ void operator()(const f32x4 (&acc)[2][2][4][2], const UnitDesc& u, int wr, int wc, int fr, int fq) const {
#pragma unroll
        for (int ai = 0; ai < 2; ++ai)
#pragma unroll
            for (int m = 0; m < 4; ++m) { bf16_t* rowp = u.out + (size_t)(ai * HALF + wr * 64 + m * 16 + fr) * u.ldc + wc * 32 + 8 * fq;
                const f32x4 g0 = acc[ai][0][m][0], g1 = acc[ai][0][m][1], u0 = acc[ai][1][m][0], u1 = acc[ai][1][m][1];
                u32x4 w; w.x = pk2(swiglu1(g0[0], u0[0]), swiglu1(g0[1], u0[1])); w.y = pk2(swiglu1(g0[2], u0[2]), swiglu1(g0[3], u0[3]));
                w.z = pk2(swiglu1(g1[0], u1[0]), swiglu1(g1[1], u1[1])); w.w = pk2(swiglu1(g1[2], u1[2]), swiglu1(g1[3], u1[3]));
                if (cnt) store16_sc1(rowp, w); else *(u32x4*)rowp = w; }
        if (cnt) { asm volatile("s_waitcnt vmcnt(0)" ::: "memory");
            if ((threadIdx.x & 63) == 0) __hip_atomic_fetch_add(cnt + (u.aux & 0xffff) * 64, 1u, __ATOMIC_RELAXED, __HIP_MEMORY_SCOPE_AGENT); }
    }
};
struct EpiQKV {
    bf16_t* Q; bf16_t* Kb; bf16_t* Vb; float* ck; float* cv; unsigned* cnt;
    __device__ __forceinline__ void operator()(const f32x4 (&acc)[2][2][4][2], const UnitDesc& u, int wr, int wc, int fr, int fq) const {
        const int pm = u.aux & 0xffff, pn = u.aux >> 16, sel = pn >> 2, ct = (pn & 3) * BM;
        const int row0 = pm * BM + wr * 64 + fr, col0 = ct + wc * 32 + 8 * fq;
        bf16_t* base = Q + (size_t)sel * (size_t)(12 * 1024 * 1024); float* cb = ck + (size_t)(sel >= 1 ? sel - 1 : 0) * (size_t)NP * D;
        const bool wc32 = sel >= 1 && pm < NP / BM;
#pragma unroll
        for (int ai = 0; ai < 2; ++ai)
#pragma unroll
            for (int m = 0; m < 4; ++m) { const size_t off = (size_t)(row0 + ai * HALF + m * 16) * D + col0;
#pragma unroll
                for (int bj = 0; bj < 2; ++bj) { const f32x4 v0 = acc[ai][bj][m][0], v1 = acc[ai][bj][m][1];
                    u32x4 w; w.x = pk2(v0[0], v0[1]); w.y = pk2(v0[2], v0[3]); w.z = pk2(v1[0], v1[1]); w.w = pk2(v1[2], v1[3]);
                    if (cnt) store16_sc1(base + off + bj * HALF, w); else *(u32x4*)(base + off + bj * HALF) = w;
                    if (wc32) { __builtin_nontemporal_store(v0, (f32x4*)(cb + off + bj * HALF)); __builtin_nontemporal_store(v1, (f32x4*)(cb + off + bj * HALF + 4)); } } }
        if (cnt) { asm volatile("s_waitcnt vmcnt(0)" ::: "memory");
            if ((threadIdx.x & 63) == 0) __hip_atomic_fetch_add(cnt + pm * 64, 1u, __ATOMIC_RELAXED, __HIP_MEMORY_SCOPE_AGENT); }
    }
};

struct GSched {
    int nM, nN, G, c; const char* A; size_t a_tile; const char* B; size_t b_tile; bf16_t* out; size_t o_pm, o_pn; int ldc;
    __device__ __forceinline__ bool next(int i, UnitDesc& u) const {
        const long L = (long)i * G + c; if (L >= (long)nM * nN) return false;
        int pm, pn; tile_order((int)L, nM, nN, pm, pn);
        u.A = A + (size_t)pm * a_tile; u.B = B + (size_t)pn * b_tile; u.out = out + (size_t)pm * o_pm + (size_t)pn * o_pn; u.ldc = ldc; u.aux = pm | (pn << 16); return true;
    }
};
struct ChDftSched {
    int G, c; const char* cs_tab; const char* H; bf16_t* ytp; bf16_t* yts;
    __device__ __forceinline__ bool next(int i, UnitDesc& u) const {
        const long L = (long)i * G + c; if (L >= 48 * 8) return false;
        int tok, gc; tile_order((int)L, 48, 8, tok, gc); const int g = gc >> 1, cs = gc & 1;
        u.A = cs_tab + (size_t)cs * 256 * 256 * 2; u.B = H + ((size_t)tok * 256 * D + g * 256) * 2;
        if (tok < 32) { u.out = ytp + ((size_t)(tok * D + g * 256) * 512 + cs * 256); u.ldc = 512; }
        else { const int idx = tok - 32, b = idx >> 3, s0 = (idx & 7) * 256; u.out = yts + ((size_t)(b * D + g * 256) * 4096 + cs * 2048 + s0); u.ldc = 4096; }
        u.aux = 0; return true;
    }
};
struct SeqSSched {
    int c; const char* ts; const char* yts; bf16_t* F;
    __device__ __forceinline__ bool next(int i, UnitDesc& u) const {
        if (i > 0 || c >= 64) return false;
        const int b = c >> 5, pm = (c >> 2) & 7, pn = c & 3;
        u.A = ts + (size_t)pm * 256 * 4096 * 2; u.B = yts + (size_t)(b * D + pn * 256) * 4096 * 2;
        u.out = F + ((size_t)(NP + b * SS + pm * 256) * D + pn * 256); u.ldc = D; u.aux = 32 + 8 * b + pm; return true;
    }
};
struct SeqPSched {
    int G, c; const char* tp; const char* ytp; bf16_t* F;
    __device__ __forceinline__ bool next(int i, UnitDesc& u) const {
        const int G2 = G - 64; if (c < 64 || G2 <= 0) return false;
        const long L = (long)i * G2 + (c - 64); if (L >= 128) return false;
        const int b = (int)L >> 2, pn = (int)L & 3;
        u.A = tp; u.B = ytp + (size_t)(b * D + pn * 256) * 512 * 2;
        u.out = F + ((size_t)(b * 256) * D + pn * 256); u.ldc = D; u.aux = b; return true;
    }
};
struct GuSched {
    int G, c; const char* A; const char* B; bf16_t* out;
    __device__ __forceinline__ bool next(int i, UnitDesc& u) const {
        const long L = (long)i * G + c; if (L >= 1056) return false;
        int pm, pn; if (L < 1012) tile_order((int)L, 46, 22, pm, pn); else { const int j = (int)L - 1012; pm = 46 + j / 22; pn = j % 22; }
        u.A = A + (size_t)pm * 256 * D * 2; u.B = B + (size_t)pn * 256 * D * 2; u.out = out + (size_t)pm * 256 * FF + (size_t)pn * 128; u.ldc = FF; u.aux = pm | (pn << 16); return true;
    }
};
struct DownSched {
    int d; const char* A; const char* B; bf16_t* out; bf16_t* out2;
    __device__ __forceinline__ void unit(int& pm, int& pn, int& kh) const { kh = 0; if (d < 184) tile_order(d, 46, 4, pm, pn); else { const int j = d - 184, un = j >> 1; kh = j & 1; pm = 46 + un / 4; pn = un % 4; } }
    __device__ __forceinline__ bool next(int i, UnitDesc& u) const {
        if (i > 0 || d < 0 || d >= 200) return false;
        int pm, pn, kh; unit(pm, pn, kh);
        u.A = A + (size_t)pm * 256 * FF * 2 + (size_t)kh * (FF / 2) * 2; u.B = B + (size_t)pn * 256 * FF * 2 + (size_t)kh * (FF / 2) * 2;
        u.out = kh ? out2 + (size_t)(pm - 46) * 256 * D + (size_t)pn * 256 : out + (size_t)pm * 256 * D + (size_t)pn * 256; u.ldc = D; u.aux = pm | (pn << 16); return true;
    }
};
struct QkvSched {
    int G, c; const char* A; const char* B;
    __device__ __forceinline__ bool next(int i, UnitDesc& u) const {
        const long L = (long)i * G + c; if (L >= 576) return false;
        int pm, pn; if (L < 384) tile_order((int)L, 32, 12, pm, pn); else { tile_order((int)L - 384, 16, 12, pm, pn); pm += 32; }
        u.A = A + (size_t)pm * 256 * D * 2; u.B = B + (size_t)pn * 256 * D * 2; u.out = nullptr; u.ldc = D; u.aux = pm | (pn << 16); return true;
    }
};
struct OneSched {
    int pm, pn; const char* A; const char* B; bf16_t* out;
    __device__ __forceinline__ bool next(int i, UnitDesc& u) const {
        if (i > 0 || pm < 0) return false;
        u.A = A + (size_t)pm * 256 * D * 2; u.B = B + (size_t)pn * 256 * D * 2; u.out = out + (size_t)pm * 256 * D + (size_t)pn * 256; u.ldc = D; u.aux = pm | (pn << 16); return true;
    }
};
}

constexpr int TI_L0 = 16 * 32 + 2 * 16 * 88 + 44 * 32, TI_ALL = 16 * 32 + 16 * 96 + 16 * 32 + 4 * 16 * 88 + 2 * 44 * 32;
struct TItem { const float* W; bf16_t* WT; int N, ldt, dst, k0, n0; };
__device__ __forceinline__ bool titem_decode(const Params& p, int it, TItem& t) {
    constexpr int I_F = 16 * 32, I_QKV = 16 * 96, I_O = 16 * 32, I_G = 16 * 88, I_D = 44 * 32;
    constexpr int NITEMS = I_F + I_QKV + I_O + 4 * I_G + 2 * I_D;
    if (it >= NITEMS) return false;
    unsigned char* ws = p.ws; int r = it; int mode = 0;
    if (r < I_F) { t.W = p.in[9]; t.N = D; t.ldt = D; t.WT = (bf16_t*)(ws + WS_WF); }
    else { r -= I_F; int l = 0; if (r >= 2 * I_G + I_D) { r -= 2 * I_G + I_D; l = 1; }
        if (r < I_G) { t.W = p.in[13] + (size_t)l * D * FF; t.N = FF; t.ldt = D; t.WT = (bf16_t*)(ws + WS_WGU) + (size_t)l * 2 * FF * D; mode = 1; }
        else if ((r -= I_G) < I_G) { t.W = p.in[14] + (size_t)l * D * FF; t.N = FF; t.ldt = D; t.WT = (bf16_t*)(ws + WS_WGU) + (size_t)l * 2 * FF * D; mode = 2; }
        else if ((r -= I_G) < I_D) { t.W = p.in[15] + (size_t)l * FF * D; t.N = D; t.ldt = FF; t.WT = (bf16_t*)(ws + WS_WD) + (size_t)l * D * FF; }
        else if ((r -= I_D) < I_QKV) { t.W = p.in[10]; t.N = 3 * D; t.ldt = D; t.WT = (bf16_t*)(ws + WS_WQKV); }
        else { r -= I_QKV; t.W = p.in[12]; t.N = D; t.ldt = D; t.WT = (bf16_t*)(ws + WS_WO); } }
    const int nblk = t.N / 32, kb = r / nblk, nb = r % nblk; t.n0 = nb * 32; t.k0 = kb * 64;
    t.dst = t.n0; if (mode) t.dst = (t.n0 >> 7) * 256 + (t.n0 & 127) + (mode == 2 ? 128 : 0);
    return true;
}
__device__ __forceinline__ void titem_load(const TItem& t, f32x4 (&wv)[8], int lane) {
#pragma unroll
    for (int i = 0; i < 8; ++i) wv[i] = __builtin_nontemporal_load((const f32x4*)(t.W + (size_t)(t.k0 + 8 * i + (lane >> 3)) * t.N + t.n0 + 4 * (lane & 7)));
}
__device__ __forceinline__ void titem_finish(const TItem& t, const f32x4 (&wv)[8], LAS float* scr, int lane) {
#pragma unroll
    for (int i = 0; i < 8; ++i) { LAS float* d = scr + (8 * i + (lane >> 3)) * 33 + 4 * (lane & 7); d[0] = wv[i][0]; d[1] = wv[i][1]; d[2] = wv[i][2]; d[3] = wv[i][3]; }
    asm volatile("s_waitcnt lgkmcnt(0)" ::: "memory");
    const int c = lane & 7;
#pragma unroll
    for (int j = 0; j < 4; ++j) { const int n = (lane >> 3) + 8 * j; const LAS float* s = scr + (8 * c) * 33 + n;
        u32x4 o; o.x = pk2(s[0 * 33], s[1 * 33]); o.y = pk2(s[2 * 33], s[3 * 33]); o.z = pk2(s[4 * 33], s[5 * 33]); o.w = pk2(s[6 * 33], s[7 * 33]);
        *(u32x4*)(t.WT + (size_t)(t.dst + n) * t.ldt + t.k0 + 8 * c) = o; }
    asm volatile("s_waitcnt lgkmcnt(0)" ::: "memory");
}

__device__ __forceinline__ void gemv_layer(const Params& p, LAS unsigned char* lds, const int l, const int rb, const int nb, unsigned* done = nullptr) {
    const int tid = threadIdx.x;
    LAS float* sl = (LAS float*)lds;
    LAS f32x4* red = (LAS f32x4*)(lds + 12288);
    for (int i = tid; i < 3072; i += 512) { const int cond = i >> 10, k = i & 1023; const float v = cond == 0 ? p.in[5][k] : p.in[2][(cond - 1) * D + k]; sl[i] = v / (1.0f + __expf(-v)); }
    __syncthreads();
    float* mod = (float*)(p.ws + WS_MOD);
    for (int item = rb; item < 96; item += nb) {
        const int rem = item, cc = rem >> 4, kc = rem & 15, rpar = tid >> 8, col = cc * 1024 + 4 * (tid & 255);
        const float* W = p.in[6] + ((size_t)l * D + kc * 64 + rpar) * 6144 + col;
        f32x4 a0 = {0.f, 0.f, 0.f, 0.f}, a1 = a0, a2 = a0;
#pragma unroll
        for (int hf = 0; hf < 2; ++hf) {
            f32x4 w[16];
#pragma unroll
            for (int i = 0; i < 16; ++i) w[i] = __builtin_nontemporal_load((const f32x4*)(W + (size_t)(32 * hf + 2 * i) * 6144));
#pragma unroll
            for (int i = 0; i < 16; ++i) { const int k = kc * 64 + 32 * hf + 2 * i + rpar; a0 += sl[k] * w[i]; a1 += sl[1024 + k] * w[i]; a2 += sl[2048 + k] * w[i]; }
        }
        if (rpar == 1) { red[tid - 256] = a0; red[256 + tid - 256] = a1; red[512 + tid - 256] = a2; }
        __syncthreads();
        if (rpar == 0) {
            a0 += red[tid]; a1 += red[256 + tid]; a2 += red[512 + tid];
            if (kc == 0) { const f32x4 bv = *(const f32x4*)(p.in[7] + l * 6144 + col); a0 += bv; a1 += bv; a2 += bv; }
#pragma unroll
            for (int j = 0; j < 4; ++j) {
                unsafeAtomicAdd(mod + (l * 3 + 0) * 6144 + col + j, a0[j]);
                unsafeAtomicAdd(mod + (l * 3 + 1) * 6144 + col + j, a1[j]);
                unsafeAtomicAdd(mod + (l * 3 + 2) * 6144 + col + j, a2[j]); }
        }
        if (done) asm volatile("s_waitcnt vmcnt(0)" ::: "memory");
        __syncthreads();
        if (done && tid == 0) __hip_atomic_fetch_add(done, 1u, __ATOMIC_RELAXED, __HIP_MEMORY_SCOPE_AGENT);
    }
}
__device__ __forceinline__ void transpose_jobs(const Params& p, LAS unsigned char* lds, int gw, int NGW, int it_lo, int it_hi) {
    const int lane = threadIdx.x & 63, wave = threadIdx.x >> 6;
    LAS float* scr = (LAS float*)(lds + wave * 8448);
    TItem cur, nxt; f32x4 wa[8], wb[8];
    int it = it_lo + gw;
    bool have = it < it_hi && titem_decode(p, it, cur);
    if (have) titem_load(cur, wa, lane);
    while (have) {
        const bool hn = it + NGW < it_hi && titem_decode(p, it + NGW, nxt);
        if (hn) titem_load(nxt, wb, lane);
        titem_finish(cur, wa, scr, lane);
        if (!hn) break;
        it += 2 * NGW;
        have = it < it_hi && titem_decode(p, it, cur);
        if (have) titem_load(cur, wa, lane);
        titem_finish(nxt, wb, scr, lane);
    }
}
__device__ __forceinline__ void phase_prologue(const Params& p, LAS unsigned char* lds, unsigned* gemv_done) {
    const int tid = threadIdx.x, G = gridDim.x, bx = blockIdx.x;
    unsigned char* ws = p.ws;
    LAS float* ct = (LAS float*)(lds + 32768);
    for (int i = tid; i < 2048; i += 512) ct[i] = cospif((float)i * (1.0f / 1024.0f));
    const bool sep = G >= 192;
    if (!sep || bx < 96) gemv_layer(p, lds, 0, bx, sep ? 96 : G, gemv_done);
    if (sep && bx < 96) return;
    const int gt = (sep ? bx - 96 : bx) * 512 + tid, GT = (sep ? G - 96 : G) * 512;
    for (int i = gt; i < 2 * 2 * 512 * D / 8; i += GT) { const int which = i >= 2 * 512 * D / 8; const int ii = which ? i - 2 * 512 * D / 8 : i;
        const f32x4* src = (const f32x4*)p.in[which ? 4 : 3]; const f32x4 a = __builtin_nontemporal_load(src + 2 * ii), b = __builtin_nontemporal_load(src + 2 * ii + 1);
        u32x4 o; o.x = pk2(a[0], a[1]); o.y = pk2(a[2], a[3]); o.z = pk2(b[0], b[1]); o.w = pk2(b[2], b[3]); ((u32x4*)((unsigned char*)p.out + (which ? OUTB_VC : OUTB_KC)))[ii] = o; }
    for (int i = gt; i < 512 * 256 / 8; i += GT) { const int row = i >> 5, c0 = (i & 31) * 8, cs = row >> 8, m = row & 255; float v[8];
#pragma unroll
        for (int j = 0; j < 8; ++j) { const int idx = ((m * (c0 + j)) & 255) * 8; v[j] = ct[(idx - (cs ? 512 : 0)) & 2047]; }
        u32x4 o; o.x = pk2(v[0], v[1]); o.y = pk2(v[2], v[3]); o.z = pk2(v[4], v[5]); o.w = pk2(v[6], v[7]); ((u32x4*)(ws + WS_CSCH))[i] = o; }
    for (int i = gt; i < 256 * 512 / 8; i += GT) { const int k = i >> 6, c0 = (i & 63) * 8; float v[8];
#pragma unroll
        for (int j = 0; j < 8; ++j) { const int kk = c0 + j, sidx = kk & 255; const int idx = ((k * sidx) & 255) * 8; v[j] = kk < 256 ? ct[idx] : -ct[(idx - 512) & 2047]; }
        u32x4 o; o.x = pk2(v[0], v[1]); o.y = pk2(v[2], v[3]); o.z = pk2(v[4], v[5]); o.w = pk2(v[6], v[7]); ((u32x4*)(ws + WS_TP))[i] = o; }
    for (int i = gt; i < 2048 * 4096 / 8; i += GT) { const int k = i >> 9, c0 = (i & 511) * 8; float v[8];
#pragma unroll
        for (int j = 0; j < 8; ++j) { const int kk = c0 + j, sidx = kk & 2047; const int idx = (k * sidx) & 2047; v[j] = kk < 2048 ? ct[idx] : -ct[(idx - 512) & 2047]; }
        u32x4 o; o.x = pk2(v[0], v[1]); o.y = pk2(v[2], v[3]); o.z = pk2(v[4], v[5]); o.w = pk2(v[6], v[7]); ((u32x4*)(ws + WS_TS))[i] = o; }
}
__device__ __forceinline__ void phase_side_jobs(const Params& p, LAS unsigned char* lds, const int which) {
    if (which == 5) { if (blockIdx.x < 56) transpose_jobs(p, lds, blockIdx.x * 8 + (threadIdx.x >> 6), 56 * 8, TI_L0 + 3 * 1408, TI_L0 + 3 * 1408 + 1536); return; }
    if (which == 6) { if (blockIdx.x >= 64) { const int gw = (blockIdx.x - 64) * 8 + (threadIdx.x >> 6), ngw = (gridDim.x - 64) * 8;
        transpose_jobs(p, lds, gw, ngw, TI_L0 + 2 * 1408, TI_L0 + 3 * 1408); transpose_jobs(p, lds, gw, ngw, TI_L0 + 3 * 1408 + 1536, TI_ALL); } return; }
    if (which == 8) { if (blockIdx.x >= 128) transpose_jobs(p, lds, (blockIdx.x - 128) * 8 + (threadIdx.x >> 6), (gridDim.x - 128) * 8, 0, 512); return; }
    if (which == 9) { if (blockIdx.x >= 64) transpose_jobs(p, lds, (blockIdx.x - 64) * 8 + (threadIdx.x >> 6), (gridDim.x - 64) * 8, 512, TI_L0);
        if (blockIdx.x >= 192) { __syncthreads(); gemv_layer(p, lds, 1, blockIdx.x - 192, gridDim.x - 192); } return; }
    if (which == 7) { if (blockIdx.x >= 192) transpose_jobs(p, lds, (blockIdx.x - 192) * 8 + (threadIdx.x >> 6), (gridDim.x - 192) * 8, TI_L0, TI_L0 + 2 * 1408); return; }
    const int G = gridDim.x, bx = blockIdx.x, first = which == 0 ? 64 : 192;
    const int nb = G > first ? G - first : G, b0 = G > first ? first : 0;
    if (bx < b0) return;
    const int rb = bx - b0;
    if (which == 0) transpose_jobs(p, lds, rb * 8 + (threadIdx.x >> 6), nb * 8, 0, TI_L0);
    else if (which == 1) gemv_layer(p, lds, 1, rb, nb);
    else transpose_jobs(p, lds, rb * 8 + (threadIdx.x >> 6), nb * 8, TI_L0, TI_ALL);
}

#ifndef ROW_WT
#define ROW_WT 0
#endif
__device__ __forceinline__ void store16_wt(void* ptr, u32x4 v) {
#if ROW_WT
    asm volatile("global_store_dwordx4 %0, %1, off sc0 sc1\n\ts_nop 3" :: "v"(ptr), "v"(v) : "memory");
#else
    *(u32x4*)ptr = v;
#endif
}
__device__ __forceinline__ void bf8_to_f32(const u32x4 w, f32x4& a, f32x4& b) { a = (f32x4){bf_lo(w.x), bf_hi(w.x), bf_lo(w.y), bf_hi(w.y)}; b = (f32x4){bf_lo(w.z), bf_hi(w.z), bf_lo(w.w), bf_hi(w.w)}; }
__device__ __forceinline__ u32x4 f32_to_bf8(const f32x4 a, const f32x4 b) { u32x4 w; w.x = pk2(a[0], a[1]); w.y = pk2(a[2], a[3]); w.z = pk2(b[0], b[1]); w.w = pk2(b[2], b[3]); return w; }
template <bool HAS_MP, bool HAS_NEXT, bool XIN_F32>
__device__ __forceinline__ void row_phase(const float* xin_p, const float* xin_s, bf16_t* XB, const bf16_t* mp, float* Yout, bf16_t* Hout,
                                          const float* gate, const float* gA, const float* gB, const float* sc, const float* sh, unsigned* cnt = nullptr, const bf16_t* mp2 = nullptr) {
    const int tid = threadIdx.x, lane = tid & 63, gw = blockIdx.x * 8 + (tid >> 6), NGW = gridDim.x * 8;
    if (cnt) {
        if (tid == 0) { const int p0 = (blockIdx.x * 48) >> 8, p1 = (blockIdx.x * 48 + 47) >> 8;
            for (int pp = p0; pp <= p1; ++pp) { unsigned sp = 0; while (__hip_atomic_load(cnt + pp * 64, __ATOMIC_RELAXED, __HIP_MEMORY_SCOPE_AGENT) < ((mp2 && pp >= 46) ? 64u : 32u)) { __builtin_amdgcn_s_sleep(2); if (++sp > (1u << 22)) break; } }
            __builtin_amdgcn_fence(__ATOMIC_ACQUIRE, "agent"); asm volatile("s_waitcnt vmcnt(0)" ::: "memory"); }
        __syncthreads();
    }
    constexpr int R = 3, RW = 6;
    int cur_cond = -1;
    f32x4 gga[4], gbs[4], shv[4];
    for (int rowb = gw * RW; rowb < M; rowb += NGW * RW)
    for (int row0 = rowb; row0 < rowb + RW; row0 += R) {
        f32x4 v[R][4]; u32x4 mw[R][2];
#pragma unroll
        for (int q = 0; q < R; ++q) { const int row = row0 + q;
            if constexpr (XIN_F32) { const float* xr = row < NP ? xin_p + (size_t)row * D : xin_s + (size_t)(row - NP) * D;
#pragma unroll
                for (int j = 0; j < 2; ++j) { v[q][2 * j] = __builtin_nontemporal_load((const f32x4*)(xr + 8 * lane + 512 * j)); v[q][2 * j + 1] = __builtin_nontemporal_load((const f32x4*)(xr + 8 * lane + 512 * j + 4)); }
            } else {
#pragma unroll
                for (int j = 0; j < 2; ++j) { const u32x4 w = __builtin_nontemporal_load((const u32x4*)(XB + (size_t)row * D + 8 * lane + 512 * j)); bf8_to_f32(w, v[q][2 * j], v[q][2 * j + 1]); }
            }
            if constexpr (HAS_MP) {
#pragma unroll
                for (int j = 0; j < 2; ++j) mw[q][j] = __builtin_nontemporal_load((const u32x4*)(mp + (size_t)row * D + 8 * lane + 512 * j));
            } }
        u32x4 xo[R][2], ho[R][2];
#pragma unroll
        for (int q = 0; q < R; ++q) { const int row = row0 + q; const int cond = row < NP ? 0 : (row < NP + SS ? 1 : 2);
            if (cond != cur_cond) { cur_cond = cond;
#pragma unroll
                for (int j = 0; j < 4; ++j) { const int col = 8 * lane + 512 * (j >> 1) + 4 * (j & 1);
                    if constexpr (HAS_MP) gga[j] = *(const f32x4*)(gate + cond * 6144 + col) * *(const f32x4*)(gA + col);
                    if constexpr (HAS_NEXT) { gbs[j] = *(const f32x4*)(gB + col) * (1.0f + *(const f32x4*)(sc + cond * 6144 + col)); shv[j] = *(const f32x4*)(sh + cond * 6144 + col); } } }
            if constexpr (HAS_MP) {
                f32x4 mv[4]; float s = 0.f;
#pragma unroll
                for (int j = 0; j < 2; ++j) bf8_to_f32(mw[q][j], mv[2 * j], mv[2 * j + 1]);
                if (mp2 && row >= 46 * 256) {
#pragma unroll
                    for (int j = 0; j < 2; ++j) { f32x4 a, b; bf8_to_f32(*(const u32x4*)(mp2 + (size_t)(row - 46 * 256) * D + 8 * lane + 512 * j), a, b); mv[2 * j] += a; mv[2 * j + 1] += b; } }
#pragma unroll
                for (int j = 0; j < 4; ++j) s += (mv[j][0] * mv[j][0] + mv[j][1] * mv[j][1]) + (mv[j][2] * mv[j][2] + mv[j][3] * mv[j][3]);
                const float rstd = 1.0f / sqrtf(wave_sum(s) * (1.0f / D) + 1e-6f);
#pragma unroll
                for (int j = 0; j < 4; ++j) v[q][j] = v[q][j] + gga[j] * (mv[j] * rstd);
                if constexpr (HAS_NEXT) {
#pragma unroll
                    for (int j = 0; j < 2; ++j) xo[q][j] = f32_to_bf8(v[q][2 * j], v[q][2 * j + 1]);
                }
            }
            if constexpr (HAS_NEXT) {
                float s = 0.f;
#pragma unroll
                for (int j = 0; j < 4; ++j) s += (v[q][j][0] * v[q][j][0] + v[q][j][1] * v[q][j][1]) + (v[q][j][2] * v[q][j][2] + v[q][j][3] * v[q][j][3]);
                const float rstd = 1.0f / sqrtf(wave_sum(s) * (1.0f / D) + 1e-6f);
                f32x4 hh[4];
#pragma unroll
                for (int j = 0; j < 4; ++j) hh[j] = (v[q][j] * rstd) * gbs[j] + shv[j];
#pragma unroll
                for (int j = 0; j < 2; ++j) ho[q][j] = f32_to_bf8(hh[2 * j], hh[2 * j + 1]);
            } }
#pragma unroll
        for (int q = 0; q < R; ++q) { const int row = row0 + q;
            if constexpr (HAS_MP && !HAS_NEXT) {
#pragma unroll
                for (int j = 0; j < 4; ++j) __builtin_nontemporal_store(v[q][j], (f32x4*)(Yout + (size_t)row * D + 8 * lane + 512 * (j >> 1) + 4 * (j & 1)));
            }
            if constexpr (HAS_MP && HAS_NEXT) {
#pragma unroll
                for (int j = 0; j < 2; ++j) __builtin_nontemporal_store(xo[q][j], (u32x4*)(XB + (size_t)row * D + 8 * lane + 512 * j));
            }
            if constexpr (HAS_NEXT) {
#pragma unroll
                for (int j = 0; j < 2; ++j) store16_wt(Hout + (size_t)row * D + 8 * lane + 512 * j, ho[q][j]);
            } }
    }
}

__device__ __forceinline__ void attn_phase(const Params& p, LAS unsigned char* lds, const int u_lo, const int u_hi, const int rb, const int nb) {
    const int tid = threadIdx.x, lane = tid & 63, wave = __builtin_amdgcn_readfirstlane(tid >> 6), r = lane & 31, hh = lane >> 5;
    unsigned char* ws = p.ws;
    const bf16_t* Qb = (const bf16_t*)(ws + WS_Q); const bf16_t* Kb = (const bf16_t*)(ws + WS_K); const bf16_t* Vb = (const bf16_t*)(ws + WS_VT);
    const bf16_t* Kc = (const bf16_t*)((const unsigned char*)p.out + OUTB_KC); const bf16_t* Vc = (const bf16_t*)((const unsigned char*)p.out + OUTB_VC);
    bf16_t* Ob = (bf16_t*)(ws + WS_H);
    LAS float* Bl = (LAS float*)(lds + 36864 + 512);
    const int srow = tid >> 3, sch = tid & 7, krho = (srow & ~12) | ((srow & 4) << 1) | ((srow & 8) >> 1);
    const float c2 = 0.125f * 1.4426950408889634f;
    for (int unit = u_lo + rb; unit < u_hi; unit += nb) {
        const bool is_na = unit < 256;
        int b, h, qtok, nt, jmin = 0, nloc = 0, rq = 0, half = 0, ktok0;
        if (is_na) { b = unit >> 7; h = (unit >> 3) & 15; const int r0 = (unit & 7) * 4; rq = r0 + (wave >> 1); half = wave & 1;
            jmin = min(max(r0 - 4, 0), 24); const int jmax = min(max(r0 - 1, 0), 24) + 7; nloc = jmax - jmin + 1; nt = nloc + 8;
            qtok = NP + b * SS + rq * 64 + half * 32 + r; ktok0 = NP + b * SS; }
        else { const int u2 = unit - 256; b = u2 >> 4; h = u2 & 15; nt = 4; qtok = b * SP + wave * 32 + r; ktok0 = b * SP; }
        const int rs = min(max(rq - 4, 0), 24);
        if (is_na) { for (int i = tid; i < 15 * 32; i += 512) { const int rr = i >> 5, x = i & 31; Bl[i] = x < 31 ? p.in[11][(h * 15 + rr) * 31 + x] * 1.4426950408889634f : 0.f; } }
        bf16x8 qf[4];
#pragma unroll
        for (int d0 = 0; d0 < 4; ++d0) qf[d0] = *(const bf16x8*)(Qb + (size_t)qtok * D + h * HD + d0 * 16 + hh * 8);
        f32x16 o0, o1;
#pragma unroll
        for (int i = 0; i < 16; ++i) { o0[i] = 0.f; o1[i] = 0.f; }
        float m_run = -1e30f, l_run = 0.f;
        u32x4 kreg, vreg;
#define ATT_LOAD(t) do { const int t_ = (t); size_t off_; const bf16_t* kb_; const bf16_t* vb_; \
            if (is_na && t_ >= nloc) { off_ = ((size_t)(b * 512 + (t_ - nloc) * 64 + srow)) * D + h * HD + sch * 8; kb_ = Kc; vb_ = Vc; } \
            else { off_ = (size_t)(ktok0 + (is_na ? (jmin + t_) * 64 : t_ * 64) + srow) * D + h * HD + sch * 8; kb_ = Kb; vb_ = Vb; } \
            kreg = *(const u32x4*)(kb_ + off_); vreg = *(const u32x4*)(vb_ + off_); } while (0)
#define ATT_STORE(buf) do { LAS unsigned char* kl_ = lds + (buf) * 18432; LAS unsigned char* vl_ = kl_ + 9216; \
            *(LAS u32x4*)(kl_ + krho * 144 + sch * 16) = kreg; \
            LAS bf16_t* vd_ = (LAS bf16_t*)(vl_ + (8 * sch) * 144 + srow * 2); \
            vd_[0 * 72] = (bf16_t)vreg.x; vd_[1 * 72] = (bf16_t)(vreg.x >> 16); vd_[2 * 72] = (bf16_t)vreg.y; vd_[3 * 72] = (bf16_t)(vreg.y >> 16); \
            vd_[4 * 72] = (bf16_t)vreg.z; vd_[5 * 72] = (bf16_t)(vreg.z >> 16); vd_[6 * 72] = (bf16_t)vreg.w; vd_[7 * 72] = (bf16_t)(vreg.w >> 16); } while (0)
        ATT_LOAD(0); ATT_STORE(0); if (nt > 1) ATT_LOAD(1);
        __syncthreads();
        for (int t = 0; t < nt; ++t) {
            if (t + 1 < nt) { ATT_STORE((t + 1) & 1); if (t + 2 < nt) ATT_LOAD(t + 2); }
            const bool local = is_na && t < nloc; const int j = jmin + t;
            if (!(local && (j < rs || j >= rs + 8))) {
                const LAS unsigned char* Kl = lds + (t & 1) * 18432; const LAS unsigned char* Vl = Kl + 9216;
                f32x16 p0, p1;
#pragma unroll
                for (int i = 0; i < 16; ++i) { p0[i] = 0.f; p1[i] = 0.f; }
#pragma unroll
                for (int d0 = 0; d0 < 4; ++d0) { const bf16x8 a0 = *(const LAS bf16x8*)(Kl + r * 144 + d0 * 32 + hh * 16), a1 = *(const LAS bf16x8*)(Kl + (32 + r) * 144 + d0 * 32 + hh * 16);
                    p0 = __builtin_amdgcn_mfma_f32_32x32x16_bf16(a0, qf[d0], p0, 0, 0, 0); p1 = __builtin_amdgcn_mfma_f32_32x32x16_bf16(a1, qf[d0], p1, 0, 0, 0); }
                float m_new, alpha;
                if (local) {
                    const int qc = half * 32 + r, cs = min(max(qc - 8, 0), 48);
                    const LAS float* bp = Bl + (j - rq + 7) * 32 + 8 * hh - qc + 15;
                    float bb0[16], bb1[16];
#pragma unroll
                    for (int i = 0; i < 16; ++i) { const int kc = 16 * (i >> 3) + (i & 7); bb0[i] = bp[kc]; bb1[i] = bp[kc + 32]; }
                    asm volatile("" : "+v"(bb0[0]), "+v"(bb0[1]), "+v"(bb0[2]), "+v"(bb0[3]), "+v"(bb0[4]), "+v"(bb0[5]), "+v"(bb0[6]), "+v"(bb0[7]));
                    asm volatile("" : "+v"(bb0[8]), "+v"(bb0[9]), "+v"(bb0[10]), "+v"(bb0[11]), "+v"(bb0[12]), "+v"(bb0[13]), "+v"(bb0[14]), "+v"(bb0[15]));
                    asm volatile("" : "+v"(bb1[0]), "+v"(bb1[1]), "+v"(bb1[2]), "+v"(bb1[3]), "+v"(bb1[4]), "+v"(bb1[5]), "+v"(bb1[6]), "+v"(bb1[7]));
                    asm volatile("" : "+v"(bb1[8]), "+v"(bb1[9]), "+v"(bb1[10]), "+v"(bb1[11]), "+v"(bb1[12]), "+v"(bb1[13]), "+v"(bb1[14]), "+v"(bb1[15]));
                    const unsigned sh0 = (unsigned)(8 * hh - cs);
#pragma unroll
                    for (int i = 0; i < 16; ++i) { const int kc = 16 * (i >> 3) + (i & 7);
                        const float s0 = __builtin_fmaf(p0[i], c2, bb0[i]), s1 = __builtin_fmaf(p1[i], c2, bb1[i]);
                        p0[i] = (sh0 + (unsigned)kc) < 16u ? s0 : -1e30f; p1[i] = (sh0 + (unsigned)(kc + 32)) < 16u ? s1 : -1e30f; }
                    float mt = fmaxf(p0[0], p1[0]);
#pragma unroll
                    for (int i = 1; i < 16; ++i) mt = fmaxf(mt, fmaxf(p0[i], p1[i]));
                    mt = fmaxf(mt, __shfl_xor(mt, 32));
                    m_new = fmaxf(m_run, mt); alpha = __builtin_amdgcn_exp2f(m_run - m_new);
#pragma unroll
                    for (int i = 0; i < 16; ++i) { p0[i] = __builtin_amdgcn_exp2f(p0[i] - m_new); p1[i] = __builtin_amdgcn_exp2f(p1[i] - m_new); }
                } else {
                    float mt = fmaxf(p0[0], p1[0]);
#pragma unroll
                    for (int i = 1; i < 16; ++i) mt = fmaxf(mt, fmaxf(p0[i], p1[i]));
                    mt = fmaxf(mt, __shfl_xor(mt, 32)) * c2;
                    m_new = fmaxf(m_run, mt); alpha = __builtin_amdgcn_exp2f(m_run - m_new);
#pragma unroll
                    for (int i = 0; i < 16; ++i) { p0[i] = __builtin_amdgcn_exp2f(__builtin_fmaf(p0[i], c2, -m_new)); p1[i] = __builtin_amdgcn_exp2f(__builtin_fmaf(p1[i], c2, -m_new)); }
                }
                m_run = m_new;
                float ls = 0.f;
#pragma unroll
                for (int i = 0; i < 16; ++i) ls += p0[i] + p1[i];
                l_run = l_run * alpha + ls;
#pragma unroll
                for (int i = 0; i < 16; ++i) { o0[i] *= alpha; o1[i] *= alpha; }
                bf16x8 pa[4];
#pragma unroll
                for (int s2 = 0; s2 < 2; ++s2) { u32x4 w; w.x = pk2(p0[8 * s2], p0[8 * s2 + 1]); w.y = pk2(p0[8 * s2 + 2], p0[8 * s2 + 3]); w.z = pk2(p0[8 * s2 + 4], p0[8 * s2 + 5]); w.w = pk2(p0[8 * s2 + 6], p0[8 * s2 + 7]); pa[s2] = __builtin_bit_cast(bf16x8, w);
                    u32x4 w2; w2.x = pk2(p1[8 * s2], p1[8 * s2 + 1]); w2.y = pk2(p1[8 * s2 + 2], p1[8 * s2 + 3]); w2.z = pk2(p1[8 * s2 + 4], p1[8 * s2 + 5]); w2.w = pk2(p1[8 * s2 + 6], p1[8 * s2 + 7]); pa[2 + s2] = __builtin_bit_cast(bf16x8, w2); }
#pragma unroll
                for (int s2 = 0; s2 < 4; ++s2) { const bf16x8 v0 = *(const LAS bf16x8*)(Vl + r * 144 + s2 * 32 + hh * 16), v1 = *(const LAS bf16x8*)(Vl + (32 + r) * 144 + s2 * 32 + hh * 16);
                    o0 = __builtin_amdgcn_mfma_f32_32x32x16_bf16(v0, pa[s2], o0, 0, 0, 0); o1 = __builtin_amdgcn_mfma_f32_32x32x16_bf16(v1, pa[s2], o1, 0, 0, 0); }
            }
            __syncthreads();
        }
#undef ATT_LOAD
#undef ATT_STORE
        const float inv = 1.0f / (l_run + __shfl_xor(l_run, 32));
        bf16_t* orow = Ob + (size_t)qtok * D + h * HD + 4 * hh;
#pragma unroll
        for (int g = 0; g < 4; ++g) { u32x2 w; w.x = pk2(o0[4 * g] * inv, o0[4 * g + 1] * inv); w.y = pk2(o0[4 * g + 2] * inv, o0[4 * g + 3] * inv); *(u32x2*)(orow + 8 * g) = w;
            u32x2 w2; w2.x = pk2(o1[4 * g] * inv, o1[4 * g + 1] * inv); w2.y = pk2(o1[4 * g + 2] * inv, o1[4 * g + 3] * inv); *(u32x2*)(orow + 32 + 8 * g) = w2; }
    }
    __syncthreads();
}

#define XB_TMO      128
#define XB_XCNT(j)  (256  + 64 * (j))
#define XB_XSUB(j)  (1280 + 64 * (j))
#define XB_XGEN(j)  (2304 + 64 * (j))
#define XB_TOP      3328
#define XB_TOPGEN   3392
#define XCD_BAR_WORDS 3456
#define XB_SPIN_CAP (1u << 18)
__device__ __forceinline__ unsigned xb_ld(unsigned* p)              { return __hip_atomic_load(p, __ATOMIC_RELAXED, __HIP_MEMORY_SCOPE_AGENT); }
__device__ __forceinline__ unsigned xb_add(unsigned* p, unsigned v) { return __hip_atomic_fetch_add(p, v, __ATOMIC_RELAXED, __HIP_MEMORY_SCOPE_AGENT); }
__device__ __forceinline__ unsigned xb_xcc_id() { return (unsigned)__builtin_amdgcn_s_getreg((3 << 11) | 20) & 0xFu; }
#define XB_SPIN(cond, bar) do { unsigned _sp = 0; while (cond) { __builtin_amdgcn_s_sleep(1); \
    if ((++_sp & 255u) == 0u) { if (xb_ld(&(bar)[XB_TMO])) break; if (_sp > XB_SPIN_CAP) { atomicAdd(&(bar)[XB_TMO], 1u); break; } } } } while (0)
struct XcdBarrier { unsigned* bar; unsigned x; volatile LAS unsigned* st; };
__device__ __forceinline__ XcdBarrier xcd_barrier_post(unsigned* bar, volatile LAS unsigned* st) {
    XcdBarrier b; b.bar = bar; b.x = xb_xcc_id(); b.st = st;
    if (threadIdx.x == 0) (void)xb_add(&bar[XB_XCNT(b.x)], 1u);
    return b;
}
__device__ __forceinline__ void xcd_barrier_complete(unsigned* bar, unsigned x, unsigned& nloc, unsigned& nx) {
    const unsigned G = gridDim.x * gridDim.y * gridDim.z;
    unsigned sum, cnt, mine, sp = 0u;
    for (;;) {
        sum = 0u; cnt = 0u; mine = 0u;
#pragma unroll
        for (unsigned j = 0; j < 16; ++j) { const unsigned c = xb_ld(&bar[XB_XCNT(j)]); sum += c; cnt += (c > 0u) ? 1u : 0u; mine = (j == x) ? c : mine; }
        if (sum == G) break;
        __builtin_amdgcn_s_sleep(1);
        if ((++sp & 255u) == 0u) { if (xb_ld(&bar[XB_TMO])) break; if (sp > XB_SPIN_CAP) { atomicAdd(&bar[XB_TMO], 1u); break; } }
    }
    nloc = mine > 0u ? mine : 1u; nx = cnt > 0u ? cnt : 1u;
}
__device__ __forceinline__ void xcd_barrier(const XcdBarrier& b) {
    asm volatile("s_waitcnt vmcnt(0)" ::: "memory");
    __syncthreads();
    if (threadIdx.x == 0) {
        unsigned* bar = b.bar;
        __builtin_amdgcn_s_waitcnt(0);
        unsigned nloc = b.st[0], nx = b.st[1];
        if (nloc == 0u) { xcd_barrier_complete(bar, b.x, nloc, nx); b.st[0] = nloc; b.st[1] = nx; }
        const unsigned old = xb_add(&bar[XB_XSUB(b.x)], 1u);
        const unsigned gen = old / nloc;
        if (old + 1u == (gen + 1u) * nloc) {
            __builtin_amdgcn_fence(__ATOMIC_RELEASE, "agent");
            asm volatile("s_waitcnt vmcnt(0)" ::: "memory");
            const unsigned og = xb_add(&bar[XB_TOP], 1u);
            const unsigned tg = og / nx;
            if (og + 1u == (tg + 1u) * nx) xb_add(&bar[XB_TOPGEN], 1u);
            else XB_SPIN(xb_ld(&bar[XB_TOPGEN]) == tg, bar);
            __builtin_amdgcn_fence(__ATOMIC_ACQUIRE, "agent");
            xb_add(&bar[XB_XGEN(b.x)], 1u);
            asm volatile("s_waitcnt vmcnt(0)" ::: "memory");
        } else {
            XB_SPIN(xb_ld(&bar[XB_XGEN(b.x)]) == gen, bar);
            __builtin_amdgcn_fence(__ATOMIC_ACQUIRE, "agent");
            asm volatile("s_waitcnt vmcnt(0)" ::: "memory");
        }
    }
    __syncthreads();
}

__global__ void __launch_bounds__(512, 2) mega_fwd(Params p) {
    extern __shared__ __attribute__((aligned(16))) unsigned char lds_raw[];
    LAS unsigned char* lds = (LAS unsigned char*)lds_raw;
    unsigned char* ws = p.ws;
    const int G = gridDim.x, c = blockIdx.x, lo = p.ph_lo, hi = p.ph_hi;
    const float* mod = (const float*)(ws + WS_MOD);
    const float* norm_g = p.in[8];
    bf16_t* H = (bf16_t*)(ws + WS_H); bf16_t* MPb = (bf16_t*)(ws + WS_MP); bf16_t* U = (bf16_t*)(ws + WS_U);
    float* X = p.out + OUT_X; bf16_t* XB = (bf16_t*)(ws + WS_XB);
    volatile LAS unsigned* MISC = (volatile LAS unsigned*)(lds + 131072 + 320);
    if (threadIdx.x < 32) MISC[threadIdx.x] = 0u;
    __syncthreads();
    XcdBarrier bar; bar.bar = (unsigned*)(ws + WS_CTL); bar.x = 0; bar.st = nullptr;
    if (hi - lo > 1) bar = xcd_barrier_post((unsigned*)(ws + WS_CTL), MISC + 8);
    if (hi > 1000) cg::this_grid().sync();
#ifndef PH_MASK
#define PH_MASK 0xffff
#endif
#define IN(k) (((PH_MASK >> (k)) & 1) && lo <= (k) && (k) < hi)
    const bool handoff = (G == 256) && (hi - lo > 1);
    unsigned* const cntb = (unsigned*)(ws + WS_CTL) + CW_CNT;
#ifndef PROBE_REP
#define PROBE_REP -1
#endif
#ifndef PROBE_SYNC2
#define PROBE_SYNC2 0
#endif
#define REPS(k) for (int rep_ = 0; rep_ < ((k) == PROBE_REP ? 2 : 1); ++rep_)
#ifndef PROBE_PHASE
#define PROBE_PHASE -1
#endif
    unsigned long long pt0 = 0, pt1 = 0;
    if (PROBE_PHASE == 0) pt0 = __builtin_amdgcn_s_memrealtime();
#define SEAM(k) SEAMX(k, false)
#define SEAMX(k, skip) do { if ((k) + 1 < hi && !(skip)) { xcd_barrier(bar); if (PROBE_SYNC2) xcd_barrier(bar); } \
        if ((k) == PROBE_PHASE) pt1 = __builtin_amdgcn_s_memrealtime(); if ((k) + 1 == PROBE_PHASE) pt0 = __builtin_amdgcn_s_memrealtime(); } while (0)

    unsigned* const gdone = cntb + 48;
    if (IN(0)) { phase_prologue(p, lds, handoff ? gdone : nullptr); SEAMX(0, handoff); }
    if (IN(1)) { {
        if (handoff) { if (threadIdx.x == 0) { unsigned sp = 0; while (__hip_atomic_load(gdone, __ATOMIC_RELAXED, __HIP_MEMORY_SCOPE_AGENT) < 96u) { __builtin_amdgcn_s_sleep(4); if (++sp > (1u << 22)) break; }
                __builtin_amdgcn_fence(__ATOMIC_ACQUIRE, "agent"); asm volatile("s_waitcnt vmcnt(0)" ::: "memory"); }
            __syncthreads(); }
        row_phase<false, true, true>(p.in[0], p.in[1], nullptr, nullptr, nullptr, H, nullptr, nullptr, norm_g, mod + 1 * D, mod + 0 * D);
        } SEAM(1);
    }
    if (IN(2)) {
        pg8::ChDftSched S{G, c, (const char*)(ws + WS_CSCH), (const char*)H, (bf16_t*)(ws + WS_YTP), (bf16_t*)(ws + WS_YTS)};
        pg8::gemm_phase<pg8::EpiStore, pg8::ChDftSched, true>(lds, 256, D, 256, S, pg8::EpiStore{});
        if (handoff) phase_side_jobs(p, lds, 8);
        SEAM(2);
    }
    if (IN(3)) {
        unsigned* const cf = cntb + 32;
        if (handoff) {
            int pm = -1, pn = 0;
            if (c < 64) { pm = 32 + 8 * (c >> 5) + ((c >> 2) & 7); pn = c & 3; } else if (c < 192) { pm = (c - 64) >> 2; pn = (c - 64) & 3; }
            { pg8::SeqSSched S{c, (const char*)(ws + WS_TS), (const char*)(ws + WS_YTS), (bf16_t*)(ws + WS_F)};
              pg8::gemm_phase<pg8::EpiStoreSig, pg8::SeqSSched, true>(lds, 4096, 4096, 4096, S, pg8::EpiStoreSig{cf}); }
            { pg8::SeqPSched S{G, c, (const char*)(ws + WS_TP), (const char*)(ws + WS_YTP), (bf16_t*)(ws + WS_F)};
              pg8::gemm_phase<pg8::EpiStoreSig, pg8::SeqPSched, true>(lds, 512, 512, 512, S, pg8::EpiStoreSig{cf}); }
            if (pm >= 0) {
                if (threadIdx.x == 0) { unsigned* w = cf + pm * 64; unsigned sp = 0;
                    while (__hip_atomic_load(w, __ATOMIC_RELAXED, __HIP_MEMORY_SCOPE_AGENT) < 32u) { __builtin_amdgcn_s_sleep(4); if (++sp > (1u << 22)) break; }
                    __builtin_amdgcn_fence(__ATOMIC_ACQUIRE, "agent"); asm volatile("s_waitcnt vmcnt(0)" ::: "memory"); }
                __syncthreads();
                pg8::OneSched S{pm, pn, (const char*)(ws + WS_F), (const char*)(ws + WS_WF), MPb};
                pg8::gemm_phase<pg8::EpiStoreSig, pg8::OneSched, true>(lds, D, D, D, S, pg8::EpiStoreSig{cntb + 0 * CNT_SEAM});
            }
            phase_side_jobs(p, lds, 9);
        } else {
            { pg8::SeqSSched S{c, (const char*)(ws + WS_TS), (const char*)(ws + WS_YTS), (bf16_t*)(ws + WS_F)};
              pg8::gemm_phase<pg8::EpiStoreSig, pg8::SeqSSched, true>(lds, 4096, 4096, 4096, S, pg8::EpiStoreSig{nullptr}); }
            { pg8::SeqPSched S{G, c, (const char*)(ws + WS_TP), (const char*)(ws + WS_YTP), (bf16_t*)(ws + WS_F)};
              pg8::gemm_phase<pg8::EpiStoreSig, pg8::SeqPSched, true>(lds, 512, 512, 512, S, pg8::EpiStoreSig{nullptr}); }
            phase_side_jobs(p, lds, 0);
        }
        SEAMX(3, handoff);
    }
    if (IN(4)) {
        if (!handoff) { pg8::GSched S{48, 4, G, c, (const char*)(ws + WS_F), (size_t)256 * D * 2, (const char*)(ws + WS_WF), (size_t)256 * D * 2, MPb, (size_t)256 * D, 256, D};
            pg8::gemm_phase<pg8::EpiStoreSig, pg8::GSched, true>(lds, D, D, D, S, pg8::EpiStoreSig{nullptr});
            phase_side_jobs(p, lds, 1); }
        SEAMX(4, handoff);
    }
    if (IN(5)) { REPS(5) {
        row_phase<true, true, true>(p.in[0], p.in[1], XB, MPb, nullptr, H, mod + 2 * D, norm_g + 1 * D, norm_g + 2 * D, mod + 4 * D, mod + 3 * D, handoff ? cntb + 0 * CNT_SEAM : nullptr);
        } SEAM(5);
    }
    if (IN(6)) {
        if (handoff) { pg8::GuSched S{G, c, (const char*)H, (const char*)(ws + WS_WGU), U};
            pg8::gemm_phase<pg8::EpiSwiGLU, pg8::GuSched, true>(lds, D, D, D, S, pg8::EpiSwiGLU{cntb + 4 * CNT_SEAM}); }
        else { pg8::GSched S{48, 22, G, c, (const char*)H, (size_t)256 * D * 2, (const char*)(ws + WS_WGU), (size_t)256 * D * 2, U, (size_t)256 * FF, 128, FF};
            pg8::gemm_phase<pg8::EpiSwiGLU, pg8::GSched, true>(lds, D, D, D, S, pg8::EpiSwiGLU{nullptr}); }
        SEAMX(6, handoff);
    }
    if (IN(7)) {
        if (handoff) {
            const int dd = c >= 248 ? 184 + (c - 248) : (c >= 64 ? c - 64 : (c >= 56 ? 192 + (c - 56) : -1));
            if (dd >= 0) { pg8::DownSched S{dd, (const char*)U, (const char*)(ws + WS_WD), MPb, (bf16_t*)(ws + WS_MP2)};
                if (threadIdx.x == 0) { int pm, pn, kh; S.unit(pm, pn, kh); unsigned* w = cntb + 4 * CNT_SEAM + pm * 64; unsigned sp = 0;
                    while (__hip_atomic_load(w, __ATOMIC_RELAXED, __HIP_MEMORY_SCOPE_AGENT) < 176u) { __builtin_amdgcn_s_sleep(4); if (++sp > (1u << 22)) break; }
                    __builtin_amdgcn_fence(__ATOMIC_ACQUIRE, "agent"); asm volatile("s_waitcnt vmcnt(0)" ::: "memory"); }
                __syncthreads();
                if (dd < 184) pg8::gemm_phase<pg8::EpiStoreSig, pg8::DownSched, true>(lds, FF, FF, FF, S, pg8::EpiStoreSig{cntb + 1 * CNT_SEAM});
                else pg8::gemm_phase<pg8::EpiStoreSig, pg8::DownSched, true>(lds, FF, FF, FF / 2, S, pg8::EpiStoreSig{cntb + 1 * CNT_SEAM}); }
            else { phase_side_jobs(p, lds, 5); }
        } else { pg8::GSched S{48, 4, G, c, (const char*)U, (size_t)256 * FF * 2, (const char*)(ws + WS_WD), (size_t)256 * FF * 2, MPb, (size_t)256 * D, 256, D};
            pg8::gemm_phase<pg8::EpiStoreSig, pg8::GSched, true>(lds, FF, FF, FF, S, pg8::EpiStoreSig{nullptr});
            phase_side_jobs(p, lds, 2); }
        SEAMX(7, handoff);
    }
    if (IN(8)) { REPS(8) {
        row_phase<true, true, false>(nullptr, nullptr, XB, MPb, nullptr, H, mod + 5 * D, norm_g + 3 * D, norm_g + 4 * D, mod + 3 * 6144 + 1 * D, mod + 3 * 6144 + 0 * D, handoff ? cntb + 1 * CNT_SEAM : nullptr, handoff ? (const bf16_t*)(ws + WS_MP2) : nullptr);
        } SEAM(8);
    }
    if (IN(9)) {
        unsigned* const cq = cntb + 16;
        pg8::EpiQKV E{(bf16_t*)(ws + WS_Q), (bf16_t*)(ws + WS_K), (bf16_t*)(ws + WS_VT), p.out + OUT_CK, p.out + OUT_CV, handoff ? cq : nullptr};
        if (handoff) {
            { pg8::QkvSched S{G, c, (const char*)H, (const char*)(ws + WS_WQKV)};
              pg8::gemm_phase<pg8::EpiQKV, pg8::QkvSched, true>(lds, D, D, D, S, E); }
            if (c >= 64) {
                if (threadIdx.x == 0) { for (int u = 256 + (c - 64); u < 768; u += 192) { unsigned* w = cq + ((u - 256) >> 4) * 64; unsigned sp = 0;
                        while (__hip_atomic_load(w, __ATOMIC_RELAXED, __HIP_MEMORY_SCOPE_AGENT) < 96u) { __builtin_amdgcn_s_sleep(4); if (++sp > (1u << 22)) break; } }
                    __builtin_amdgcn_fence(__ATOMIC_ACQUIRE, "agent"); asm volatile("s_waitcnt vmcnt(0)" ::: "memory"); }
                __syncthreads();
                attn_phase(p, lds, 256, 768, c - 64, 192);
            }
            if (threadIdx.x == 0) { for (int pp = 32 + 8 * (c >> 7); pp < 40 + 8 * (c >> 7); ++pp) { unsigned* w = cq + pp * 64; unsigned sp = 0;
                    while (__hip_atomic_load(w, __ATOMIC_RELAXED, __HIP_MEMORY_SCOPE_AGENT) < 96u) { __builtin_amdgcn_s_sleep(4); if (++sp > (1u << 22)) break; } }
                __builtin_amdgcn_fence(__ATOMIC_ACQUIRE, "agent"); asm volatile("s_waitcnt vmcnt(0)" ::: "memory"); }
            __syncthreads();
            attn_phase(p, lds, c, c + 1, 0, 1);
            if (c < 64) { const int gw = c * 8 + (threadIdx.x >> 6);
                transpose_jobs(p, lds, gw, 64 * 8, TI_L0 + 2 * 1408, TI_L0 + 3 * 1408); transpose_jobs(p, lds, gw, 64 * 8, TI_L0 + 3 * 1408 + 1536, TI_ALL); }
        } else {
            pg8::GSched S{48, 12, G, c, (const char*)H, (size_t)256 * D * 2, (const char*)(ws + WS_WQKV), (size_t)256 * D * 2, nullptr, 0, 0, D};
            pg8::gemm_phase<pg8::EpiQKV, pg8::GSched, true>(lds, D, D, D, S, E);
        }
        SEAMX(9, handoff);
    }
    if (IN(10)) { if (!handoff) attn_phase(p, lds, 0, 768, c, G); SEAM(10); }
    if (IN(11)) { REPS(11) {
        pg8::GSched S{48, 4, G, c, (const char*)H, (size_t)256 * D * 2, (const char*)(ws + WS_WO), (size_t)256 * D * 2, MPb, (size_t)256 * D, 256, D};
        pg8::gemm_phase<pg8::EpiStoreSig, pg8::GSched, true>(lds, D, D, D, S, pg8::EpiStoreSig{handoff ? cntb + 2 * CNT_SEAM : nullptr});
        if (handoff) phase_side_jobs(p, lds, 7);
        } SEAMX(11, handoff);
    }
    if (IN(12)) { REPS(12) {
        row_phase<true, true, false>(nullptr, nullptr, XB, MPb, nullptr, H, mod + 3 * 6144 + 2 * D, norm_g + 5 * D, norm_g + 6 * D, mod + 3 * 6144 + 4 * D, mod + 3 * 6144 + 3 * D, handoff ? cntb + 2 * CNT_SEAM : nullptr);
        } SEAM(12);
    }
    if (IN(13)) {
        if (handoff) { pg8::GuSched S{G, c, (const char*)H, (const char*)(ws + WS_WGU) + (size_t)2 * FF * D * 2, U};
            pg8::gemm_phase<pg8::EpiSwiGLU, pg8::GuSched, true>(lds, D, D, D, S, pg8::EpiSwiGLU{cntb + 5 * CNT_SEAM}); }
        else { pg8::GSched S{48, 22, G, c, (const char*)H, (size_t)256 * D * 2, (const char*)(ws + WS_WGU) + (size_t)2 * FF * D * 2, (size_t)256 * D * 2, U, (size_t)256 * FF, 128, FF};
            pg8::gemm_phase<pg8::EpiSwiGLU, pg8::GSched, true>(lds, D, D, D, S, pg8::EpiSwiGLU{nullptr}); }
        SEAMX(13, handoff);
    }
    if (IN(14)) {
        if (handoff) {
            const int dd = c >= 248 ? 184 + (c - 248) : (c >= 64 ? c - 64 : (c >= 56 ? 192 + (c - 56) : -1));
            if (dd >= 0) { pg8::DownSched S{dd, (const char*)U, (const char*)(ws + WS_WD) + (size_t)D * FF * 2, MPb, (bf16_t*)(ws + WS_MP2)};
                if (threadIdx.x == 0) { int pm, pn, kh; S.unit(pm, pn, kh); unsigned* w = cntb + 5 * CNT_SEAM + pm * 64; unsigned sp = 0;
                    while (__hip_atomic_load(w, __ATOMIC_RELAXED, __HIP_MEMORY_SCOPE_AGENT) < 176u) { __builtin_amdgcn_s_sleep(4); if (++sp > (1u << 22)) break; }
                    __builtin_amdgcn_fence(__ATOMIC_ACQUIRE, "agent"); asm volatile("s_waitcnt vmcnt(0)" ::: "memory"); }
                __syncthreads();
                if (dd < 184) pg8::gemm_phase<pg8::EpiStoreSig, pg8::DownSched, true>(lds, FF, FF, FF, S, pg8::EpiStoreSig{cntb + 3 * CNT_SEAM});
                else pg8::gemm_phase<pg8::EpiStoreSig, pg8::DownSched, true>(lds, FF, FF, FF / 2, S, pg8::EpiStoreSig{cntb + 3 * CNT_SEAM}); }
            else {  }
        } else { pg8::GSched S{48, 4, G, c, (const char*)U, (size_t)256 * FF * 2, (const char*)(ws + WS_WD) + (size_t)D * FF * 2, (size_t)256 * FF * 2, MPb, (size_t)256 * D, 256, D};
            pg8::gemm_phase<pg8::EpiStoreSig, pg8::GSched, true>(lds, FF, FF, FF, S, pg8::EpiStoreSig{nullptr});
             }
        SEAMX(14, handoff);
    }
    if (IN(15)) { REPS(15) {
        row_phase<true, false, false>(nullptr, nullptr, XB, MPb, X, nullptr, mod + 3 * 6144 + 5 * D, norm_g + 7 * D, nullptr, nullptr, nullptr, handoff ? cntb + 3 * CNT_SEAM : nullptr, handoff ? (const bf16_t*)(ws + WS_MP2) : nullptr); }
    }
    if (PROBE_PHASE >= 0 && blockIdx.x == 0) { if (PROBE_PHASE == 15) pt1 = __builtin_amdgcn_s_memrealtime();
        const unsigned long long tend = __builtin_amdgcn_s_memrealtime(), wait = 9ull * (pt1 - pt0);
        while (__builtin_amdgcn_s_memrealtime() - tend < wait) __builtin_amdgcn_s_sleep(8); }
#undef IN
#undef SEAM
}

constexpr int LDS_BYTES = 147456;
extern "C" void kernel_launch(void* const* d_in, const int* in_sizes, int n_in, void* d_out, int out_size, void* d_ws, size_t ws_size, hipStream_t stream) {
    static int grid = 0;
    if (grid == 0) {
        int dev = 0, cus = 0, per_cu = 0;
        hipGetDevice(&dev);
        hipDeviceGetAttribute(&cus, hipDeviceAttributeMultiprocessorCount, dev);
        if (hipFuncSetAttribute((const void*)mega_fwd, hipFuncAttributeMaxDynamicSharedMemorySize, LDS_BYTES) != hipSuccess) fprintf(stderr, "kernel_launch: hipFuncSetAttribute failed\n");
        if (hipOccupancyMaxActiveBlocksPerMultiprocessor(&per_cu, (const void*)mega_fwd, 512, LDS_BYTES) != hipSuccess || per_cu < 1) { fprintf(stderr, "kernel_launch: occupancy query says %d\n", per_cu); per_cu = 1; }
        (void)hipGetLastError();
        grid = cus * 1;
        if (n_in != 16 || ws_size < WS_END) { fprintf(stderr, "kernel_launch: unexpected n_in %d / ws %zu\n", n_in, ws_size); }
    }
    Params p{};
    (void)hipMemsetAsync((unsigned char*)d_ws, 0, WS_CTL + CTL_BYTES, stream);
    for (int i = 0; i < 16; ++i) p.in[i] = (const float*)d_in[i];
    p.out = (float*)d_out; p.ws = (unsigned char*)d_ws;
    if (MK_N_LAUNCHES == 1) {
        p.ph_lo = 0; p.ph_hi = NPHASE;
        void* args[] = {&p};
        hipError_t e = hipLaunchCooperativeKernel((const void*)mega_fwd, dim3(grid), dim3(512), args, LDS_BYTES, stream);
        if (e != hipSuccess) fprintf(stderr, "cooperative launch failed: %s (grid %d)\n", hipGetErrorString(e), grid);
    } else {
        for (int k = 0; k < NPHASE; ++k) { p.ph_lo = k; p.ph_hi = k + 1; hipLaunchKernelGGL(mega_fwd, dim3(grid), dim3(512), LDS_BYTES, stream, p); }
    }
}
```
